# Optimizing an MI355X kernel written in HIP

```python
import math
import jax, jax.numpy as jnp
from jax import lax
import numpy as np

D_MODEL = 1024
BATCH = 16
SEQ = 2048
DEPTH = 2

HEAD_DIM = 64
QBLOCK = 128
EPS = 1e-5
SWA_HEADS = 8
SWA_KV_HEADS = 2
SWA_WINDOW = 128
DIFF_HEADS = 4
NSA_HEADS = 8
NSA_KV_HEADS = 2
CMP_BLOCK = 32
CMP_STRIDE = 16
CMP_HIDDEN = 256
SEL_BLOCK = 64
SEL_TOPN = 16
SEL_QCHUNK = 32
NSA_WINDOW = 512
BRANCH_WIDTH = 512
N_BRANCHES = 3
N_EXPERTS = 32
TOP_K = 4
D_EXPERT = D_MODEL
SWIGLU_LIMIT = 7.0
SWIGLU_ALPHA = 1.702
MOE_BLOCK = 128
A_Q = SWA_HEADS * HEAD_DIM
A_KV = SWA_KV_HEADS * HEAD_DIM
B_QK = DIFF_HEADS * 2 * HEAD_DIM
B_V = DIFF_HEADS * 2 * HEAD_DIM
C_Q = NSA_HEADS * HEAD_DIM
C_KV = NSA_KV_HEADS * HEAD_DIM
NSA_GATES = NSA_HEADS * 3
MERGE_GATES = N_BRANCHES * D_MODEL
IN_SPLITS = (A_Q, A_KV, A_KV, B_QK, B_QK, B_V, C_Q, C_KV, C_KV, C_KV, C_KV, C_KV, C_KV, NSA_GATES, MERGE_GATES)
IN_WIDTH = sum(IN_SPLITS)

kernel_name = 'hybrid_swa_diff_nsa_moe_adaln'


def rms_norm(x, g):
    xf = x.astype(jnp.float32)
    y = xf * lax.rsqrt(jnp.mean(xf * xf, axis=-1, keepdims=True) + EPS)
    return (y * g.astype(jnp.float32)).astype(x.dtype)


def alibi_slopes(n):
    return 2.0 ** (-8.0 * jnp.arange(1, n + 1, dtype=jnp.float32) / n)


def banded_attention(q, k, v, window, slopes, sinks=None):
    B, S, Hkv, G, d = q.shape
    nb = S // QBLOCK
    n_prev = -(-(window - 1) // QBLOCK)
    ctx = (n_prev + 1) * QBLOCK
    pad = ((0, 0), (n_prev * QBLOCK, 0), (0, 0), (0, 0))
    kp = jnp.pad(k, pad)
    vp = jnp.pad(v, pad)
    qb = q.reshape(B, nb, QBLOCK, Hkv, G, d).swapaxes(0, 1)
    scale = d ** -0.5

    def block(args):
        qi, i = args
        start = i * QBLOCK
        kc = lax.dynamic_slice_in_dim(kp, start, ctx, axis=1)
        vc = lax.dynamic_slice_in_dim(vp, start, ctx, axis=1)
        s = jnp.einsum('bqhgd,bkhd->bhgqk', qi, kc).astype(jnp.float32) * scale
        t = start + jnp.arange(QBLOCK)
        pos = start - n_prev * QBLOCK + jnp.arange(ctx)
        dist = t[:, None] - pos[None, :]
        valid = (dist >= 0) & (dist < window) & (pos[None, :] >= 0)
        s = s - slopes[:, :, None, None] * dist.astype(jnp.float32)
        s = jnp.where(valid, s, -jnp.inf)
        if sinks is None:
            p = jax.nn.softmax(s, axis=-1)
        else:
            lse = jnp.logaddexp(jax.nn.logsumexp(s, axis=-1, keepdims=True), sinks[:, :, None, None])
            p = jnp.exp(s - lse)
        return jnp.einsum('bhgqk,bkhd->bqhgd', p.astype(vc.dtype), vc)

    o = lax.map(block, (qb, jnp.arange(nb)))
    return o.swapaxes(0, 1).reshape(B, S, Hkv, G, d)


def diff_attention(q, k, v, lam_params, subln_g, slopes, lam_init):
    B, S, H, _, d = q.shape
    nb = S // QBLOCK
    lp = lam_params.astype(jnp.float32)
    lam = jnp.exp(jnp.sum(lp[0] * lp[1])) - jnp.exp(jnp.sum(lp[2] * lp[3])) + lam_init
    qb = q.reshape(B, nb, QBLOCK, H, 2, d).swapaxes(0, 1)
    kpos = jnp.arange(S)
    scale = d ** -0.5

    def block(args):
        qi, i = args
        s = jnp.einsum('bqhcd,bkhcd->bhcqk', qi, k).astype(jnp.float32) * scale
        t = i * QBLOCK + jnp.arange(QBLOCK)
        dist = t[:, None] - kpos[None, :]
        s = s - slopes[:, None, None, None] * dist.astype(jnp.float32)
        s = jnp.where(dist >= 0, s, -jnp.inf)
        p = jax.nn.softmax(s, axis=-1)
        w = p[:, :, 0] - lam * p[:, :, 1]
        return jnp.einsum('bhqk,bkhe->bqhe', w.astype(v.dtype), v)

    o = lax.map(block, (qb, jnp.arange(nb)))
    o = o.swapaxes(0, 1).reshape(B, S, H, 2 * d)
    return rms_norm(o, subln_g) * (1.0 - lam_init)


def compress_blocks(x, pos, w1, b1, w2, b2):
    B, S, Hkv, d = x.shape
    nc = (S - CMP_BLOCK) // CMP_STRIDE + 1
    idx = jnp.arange(nc)[:, None] * CMP_STRIDE + jnp.arange(CMP_BLOCK)[None, :]
    blk = x[:, idx] + pos[:, None, :]
    blk = blk.transpose(0, 1, 3, 2, 4).reshape(B, nc, Hkv, CMP_BLOCK * d)
    hid = jax.nn.gelu(blk @ w1 + b1)
    return hid @ w2 + b2


def nsa_attention(q, k_cmp, v_cmp, k_slc, v_slc, k_win, v_win, gates, cmp_pos, cmp_w1, cmp_b1, cmp_w2, cmp_b2, slopes):
    B, S, Hkv, G, d = q.shape
    scale = d ** -0.5
    t = jnp.arange(S)
    kc = compress_blocks(k_cmp, cmp_pos[0], cmp_w1[0], cmp_b1[0], cmp_w2[0], cmp_b2[0])
    vc = compress_blocks(v_cmp, cmp_pos[1], cmp_w1[1], cmp_b1[1], cmp_w2[1], cmp_b2[1])
    nc = kc.shape[1]
    cstart = jnp.arange(nc) * CMP_STRIDE
    cvalid = (cstart[None, :] + CMP_BLOCK - 1) <= t[:, None]
    s = jnp.einsum('bqhgd,bchd->bhgqc', q, kc).astype(jnp.float32) * scale
    p_cmp = jax.nn.softmax(jnp.where(cvalid, s, -1e30), axis=-1) * cvalid
    o_cmp = jnp.einsum('bhgqc,bchd->bqhgd', p_cmp.astype(vc.dtype), vc)
    nsb = S // SEL_BLOCK
    sstart = jnp.arange(nsb) * SEL_BLOCK
    overlap = jnp.clip(jnp.minimum(cstart[:, None] + CMP_BLOCK, sstart[None, :] + SEL_BLOCK)
                       - jnp.maximum(cstart[:, None], sstart[None, :]), 0).astype(jnp.float32) / CMP_BLOCK
    imp = jnp.einsum('bhgqc,cn->bhqn', p_cmp, overlap)
    cur = t // SEL_BLOCK
    blk = jnp.arange(nsb)
    causal_blk = blk[None, :] <= cur[:, None]
    forced = (blk[None, :] == 0) | (blk[None, :] == cur[:, None]) | (blk[None, :] == cur[:, None] - 1)
    score = jnp.where(forced, jnp.inf, jnp.where(causal_blk, imp, -jnp.inf))
    n_sel = min(SEL_TOPN, nsb)
    top_s, top_i = lax.top_k(score, n_sel)
    sel_ok = top_s > -jnp.inf
    kb = k_slc.reshape(B, nsb, SEL_BLOCK, Hkv, d).transpose(0, 3, 1, 2, 4)
    vb = v_slc.reshape(B, nsb, SEL_BLOCK, Hkv, d).transpose(0, 3, 1, 2, 4)
    nq = S // SEL_QCHUNK
    qch = q.reshape(B, nq, SEL_QCHUNK, Hkv, G, d).swapaxes(0, 1)
    ich = top_i.reshape(B, Hkv, nq, SEL_QCHUNK, n_sel).transpose(2, 0, 1, 3, 4)
    och = sel_ok.reshape(B, Hkv, nq, SEL_QCHUNK, n_sel).transpose(2, 0, 1, 3, 4)
    bidx = jnp.arange(B)[:, None, None, None]
    hidx = jnp.arange(Hkv)[None, :, None, None]

    def chunk(args):
        qi, ii, oki, cidx = args
        kg = kb[bidx, hidx, ii]
        vg = vb[bidx, hidx, ii]
        sc = jnp.einsum('bqhgd,bhqnld->bhgqnl', qi, kg).astype(jnp.float32) * scale
        tq = cidx * SEL_QCHUNK + jnp.arange(SEL_QCHUNK)
        kpos = ii[..., None] * SEL_BLOCK + jnp.arange(SEL_BLOCK)
        dist = tq[None, None, :, None, None] - kpos
        ok = (dist >= 0) & oki[..., None]
        sc = sc - slopes[None, :, :, None, None, None] * dist[:, :, None].astype(jnp.float32)
        sc = jnp.where(ok[:, :, None], sc, -jnp.inf)
        shp = sc.shape
        pr = jax.nn.softmax(sc.reshape(shp[:4] + (shp[4] * shp[5],)), axis=-1).reshape(shp)
        return jnp.einsum('bhgqnl,bhqnld->bqhgd', pr.astype(vg.dtype), vg)

    o_slc = lax.map(chunk, (qch, ich, och, jnp.arange(nq)))
    o_slc = o_slc.swapaxes(0, 1).reshape(B, S, Hkv, G, d)
    o_win = banded_attention(q, k_win, v_win, NSA_WINDOW, slopes)
    g = jax.nn.sigmoid(gates)
    return g[..., 0:1] * o_cmp + g[..., 1:2] * o_slc + g[..., 2:3] * o_win


def hybrid_mixer(h, w_in, b_in, sinks, diff_lambda, diff_subln_g, cmp_pos, cmp_w1, cmp_b1, cmp_w2, cmp_b2, w_branch, w_out, lam_init):
    B, S, _ = h.shape
    z = h @ w_in + b_in
    offs = np.cumsum(IN_SPLITS)[:-1].tolist()
    (qa, ka, va, qb, kb, vb, qc, kcm, vcm, ksl, vsl, kwn, vwn, g_nsa, g_merge) = jnp.split(z, offs, axis=-1)
    ga = SWA_HEADS // SWA_KV_HEADS
    o_a = banded_attention(qa.reshape(B, S, SWA_KV_HEADS, ga, HEAD_DIM),
                           ka.reshape(B, S, SWA_KV_HEADS, HEAD_DIM), va.reshape(B, S, SWA_KV_HEADS, HEAD_DIM),
                           SWA_WINDOW, alibi_slopes(SWA_HEADS).reshape(SWA_KV_HEADS, ga),
                           sinks.astype(jnp.float32).reshape(SWA_KV_HEADS, ga)).reshape(B, S, BRANCH_WIDTH)
    o_b = diff_attention(qb.reshape(B, S, DIFF_HEADS, 2, HEAD_DIM), kb.reshape(B, S, DIFF_HEADS, 2, HEAD_DIM),
                         vb.reshape(B, S, DIFF_HEADS, 2 * HEAD_DIM), diff_lambda, diff_subln_g,
                         alibi_slopes(DIFF_HEADS), lam_init).reshape(B, S, BRANCH_WIDTH)
    gc = NSA_HEADS // NSA_KV_HEADS
    kv = lambda a: a.reshape(B, S, NSA_KV_HEADS, HEAD_DIM)
    o_c = nsa_attention(qc.reshape(B, S, NSA_KV_HEADS, gc, HEAD_DIM), kv(kcm), kv(vcm), kv(ksl), kv(vsl), kv(kwn), kv(vwn),
                        g_nsa.reshape(B, S, NSA_KV_HEADS, gc, 3), cmp_pos, cmp_w1, cmp_b1, cmp_w2, cmp_b2,
                        alibi_slopes(NSA_HEADS).reshape(NSA_KV_HEADS, gc)).reshape(B, S, BRANCH_WIDTH)
    gm = jax.nn.sigmoid(g_merge.reshape(B, S, N_BRANCHES, D_MODEL))
    merged = gm[:, :, 0] * (o_a @ w_branch[0]) + gm[:, :, 1] * (o_b @ w_branch[1]) + gm[:, :, 2] * (o_c @ w_branch[2])
    return merged @ w_out


def moe_ffn(h, router_w, router_b, w1, b1, w2, b2):
    B, S, D = h.shape
    N = B * S
    xt = h.reshape(N, D)
    logits = (xt @ router_w + router_b).astype(jnp.float32)
    top_v, top_e = lax.top_k(logits, TOP_K)
    gate = jax.nn.softmax(top_v, axis=-1)
    A = N * TOP_K
    e_flat = top_e.reshape(A)
    order = jnp.argsort(e_flat)
    e_sorted = e_flat[order]
    tok_sorted = order // TOP_K
    g_sorted = gate.reshape(A)[order]
    counts = jnp.bincount(e_flat, length=N_EXPERTS)
    group_start = jnp.cumsum(counts) - counts
    padded = (counts + MOE_BLOCK - 1) // MOE_BLOCK * MOE_BLOCK
    pad_end = jnp.cumsum(padded)
    pad_start = pad_end - padded
    dest = pad_start[e_sorted] + (jnp.arange(A) - group_start[e_sorted])
    n_blocks = -(-A // MOE_BLOCK) + N_EXPERTS
    P = n_blocks * MOE_BLOCK
    row_tok = jnp.zeros((P,), jnp.int32).at[dest].set(tok_sorted.astype(jnp.int32))
    row_w = jnp.zeros((P,), jnp.float32).at[dest].set(g_sorted)
    block_expert = jnp.clip(jnp.searchsorted(pad_end, jnp.arange(n_blocks) * MOE_BLOCK, side='right'), 0, N_EXPERTS - 1)

    def expert_block(args):
        rows, e = args
        xb = xt[rows]
        hb = xb @ w1[e] + b1[e]
        g, u = hb[:, :D_EXPERT], hb[:, D_EXPERT:]
        g = jnp.minimum(g, SWIGLU_LIMIT)
        u = jnp.clip(u, -SWIGLU_LIMIT, SWIGLU_LIMIT)
        glu = g * jax.nn.sigmoid(g * SWIGLU_ALPHA)
        return ((u + 1.0) * glu) @ w2[e] + b2[e]

    y = lax.map(expert_block, (row_tok.reshape(n_blocks, MOE_BLOCK), block_expert)).reshape(P, D)
    out = jnp.zeros((N, D), y.dtype).at[row_tok].add(y * row_w[:, None].astype(y.dtype))
    return out.reshape(B, S, D)


def setup_inputs(seed: int = 0) -> dict:
    key = jax.random.key(seed)
    ks = jax.random.split(key, 32)
    L, D, E, F = DEPTH, D_MODEL, N_EXPERTS, D_EXPERT
    nrm = lambda k, shape, s: jax.random.normal(k, shape, jnp.float32) * s
    return {
        'x': nrm(ks[0], (BATCH, SEQ, D), 1.0),
        'c': nrm(ks[1], (BATCH, D), 1.0),
        'mod_w': nrm(ks[2], (L, D, 6 * D), 0.5 * D ** -0.5),
        'mod_b': nrm(ks[3], (L, 6 * D), 0.02),
        'norm1_g': 1.0 + nrm(ks[4], (L, D), 0.1),
        'norm2_g': 1.0 + nrm(ks[5], (L, D), 0.1),
        'w_in': nrm(ks[6], (L, D, IN_WIDTH), D ** -0.5),
        'b_in': nrm(ks[7], (L, IN_WIDTH), 0.02),
        'sinks': nrm(ks[8], (L, SWA_HEADS), 0.5),
        'diff_lambda': nrm(ks[9], (L, 4, HEAD_DIM), 0.1),
        'diff_subln_g': 1.0 + nrm(ks[10], (L, 2 * HEAD_DIM), 0.1),
        'cmp_pos': nrm(ks[11], (L, 2, CMP_BLOCK, HEAD_DIM), 0.1),
        'cmp_w1': nrm(ks[12], (L, 2, CMP_BLOCK * HEAD_DIM, CMP_HIDDEN), (CMP_BLOCK * HEAD_DIM) ** -0.5),
        'cmp_b1': nrm(ks[13], (L, 2, CMP_HIDDEN), 0.02),
        'cmp_w2': nrm(ks[14], (L, 2, CMP_HIDDEN, HEAD_DIM), CMP_HIDDEN ** -0.5),
        'cmp_b2': nrm(ks[15], (L, 2, HEAD_DIM), 0.02),
        'w_branch': nrm(ks[16], (L, N_BRANCHES, BRANCH_WIDTH, D), BRANCH_WIDTH ** -0.5),
        'w_out': nrm(ks[17], (L, D, D), D ** -0.5),
        'router_w': nrm(ks[18], (L, D, E), D ** -0.5),
        'router_b': nrm(ks[19], (L, E), 0.01),
        'exp_w1': nrm(ks[20], (L, E, D, 2 * F), D ** -0.5),
        'exp_b1': nrm(ks[21], (L, E, 2 * F), 0.02),
        'exp_w2': nrm(ks[22], (L, E, F, D), F ** -0.5),
        'exp_b2': nrm(ks[23], (L, E, D), 0.02),
        'final_g': 1.0 + nrm(ks[24], (D,), 0.1),
    }


def reference(x, c, mod_w, mod_b, norm1_g, norm2_g, w_in, b_in, sinks, diff_lambda, diff_subln_g, cmp_pos, cmp_w1, cmp_b1, cmp_w2, cmp_b2, w_branch, w_out, router_w, router_b, exp_w1, exp_b1, exp_w2, exp_b2, final_g):
    cs = jax.nn.silu(c)
    for l in range(DEPTH):
        mod = cs @ mod_w[l] + mod_b[l]
        sh1, sc1, g1, sh2, sc2, g2 = [m[:, None, :] for m in jnp.split(mod, 6, axis=-1)]
        lam_init = 0.8 - 0.6 * math.exp(-0.3 * l)
        h = rms_norm(x, norm1_g[l]) * (1.0 + sc1) + sh1
        x = x + g1 * hybrid_mixer(h, w_in[l], b_in[l], sinks[l], diff_lambda[l], diff_subln_g[l], cmp_pos[l], cmp_w1[l],
                                  cmp_b1[l], cmp_w2[l], cmp_b2[l], w_branch[l], w_out[l], lam_init)
        h = rms_norm(x, norm2_g[l]) * (1.0 + sc2) + sh2
        x = x + g2 * moe_ffn(h, router_w[l], router_b[l], exp_w1[l], exp_b1[l], exp_w2[l], exp_b2[l])
    return rms_norm(x, final_g)
```

```cpp
#include <hip/hip_runtime.h>
#include <stdint.h>
#include <stdio.h>

#define NB      16
#define NS      2048
#define NTOK    (NB * NS)
#define DM      1024
#define NLAYER  2
#define ZW      6912
#define INW     6680
#define C_QA   0
#define C_KA   512
#define C_VA   640
#define C_QB   768
#define C_KB   1280
#define C_VB   1792
#define C_QC   2304
#define C_KCM  2816
#define C_VCM  2944
#define C_KSL  3072
#define C_VSL  3200
#define C_KWN  3328
#define C_VWN  3456
#define C_GM   3584
#define C_GN   6656
#define NEXP   32
#define PMAX   (NTOK * 4 + NEXP * 256)
#define NCMP   127

typedef unsigned short bf16_t;
typedef short bf16x8 __attribute__((ext_vector_type(8)));
typedef short bf16x4 __attribute__((ext_vector_type(4)));
typedef float f32x4 __attribute__((ext_vector_type(4)));
typedef float f32x2 __attribute__((ext_vector_type(2)));
typedef float f32x16 __attribute__((ext_vector_type(16)));
typedef unsigned u32x4 __attribute__((ext_vector_type(4)));
typedef unsigned u32x2 __attribute__((ext_vector_type(2)));

#define LAS __attribute__((address_space(3)))
#define NTHREADS 512
#define LDS_BYTES (160 * 1024)

__device__ __forceinline__ unsigned cvt_pk_bf16(float lo, float hi) { unsigned r; asm volatile("v_cvt_pk_bf16_f32 %0, %1, %2" : "=v"(r) : "v"(lo), "v"(hi)); return r; }
__device__ __forceinline__ bf16_t f2bf(float f) { return (bf16_t)(cvt_pk_bf16(f, 0.f) & 0xffffu); }
__device__ __forceinline__ float bf2f(bf16_t b) { return __uint_as_float(((unsigned)b) << 16); }
__device__ __forceinline__ float bflo(unsigned w) { return __uint_as_float(w << 16); }
__device__ __forceinline__ float bfhi(unsigned w) { return __uint_as_float(w & 0xffff0000u); }
#define LOG2E 1.4426950408889634f
__device__ __forceinline__ float fast_exp2(float x) { return __builtin_amdgcn_exp2f(x); }
__device__ __forceinline__ float fast_rcp(float x) { return __builtin_amdgcn_rcpf(x); }
__device__ __forceinline__ float sigmoidf_(float x) { return fast_rcp(1.0f + fast_exp2(-1.4426950408889634f * x)); }

__device__ __forceinline__ unsigned hidden_bid() { unsigned b = blockIdx.x; asm volatile("" : "+s"(b)); return b; }
__device__ __forceinline__ int hidden_tid() { int t = threadIdx.x; asm volatile("" : "+v"(t)); return t; }

#define XB_TMO      128
#define XB_XCNT(j)  (256  + 64 * (j))
#define XB_XSUB(j)  (1280 + 64 * (j))
#define XB_XGEN(j)  (2304 + 64 * (j))
#define XB_TOP      3328
#define XB_TOPGEN   3392
#define XCD_BAR_WORDS 3456
#define XB_SPIN_CAP (1u << 24)

__device__ __forceinline__ unsigned xb_ld(unsigned* p)              { return __hip_atomic_load(p, __ATOMIC_RELAXED, __HIP_MEMORY_SCOPE_AGENT); }
__device__ __forceinline__ unsigned xb_add(unsigned* p, unsigned v) { return __hip_atomic_fetch_add(p, v, __ATOMIC_RELAXED, __HIP_MEMORY_SCOPE_AGENT); }
__device__ __forceinline__ unsigned xb_xcc_id() { return (unsigned)__builtin_amdgcn_s_getreg((3 << 11) | 20) & 0xFu; }
#define XB_SPIN(cond, bar) do { unsigned _sp = 0; while (cond) { __builtin_amdgcn_s_sleep(1); \
    if ((++_sp & 255u) == 0u) { if (xb_ld(&(bar)[XB_TMO])) break; if (_sp > XB_SPIN_CAP) { atomicAdd(&(bar)[XB_TMO], 1u); break; } } } } while (0)

struct XcdBarrier { unsigned* bar; unsigned x; volatile LAS unsigned* st; };

__device__ __forceinline__ XcdBarrier xcd_barrier_post(unsigned* bar, volatile LAS unsigned* st) {
    XcdBarrier b; b.bar = bar; b.x = xb_xcc_id(); b.st = st;
    if (hidden_tid() == 0) (void)xb_add(&bar[XB_XCNT(b.x)], 1u);
    return b;
}
__device__ __forceinline__ void xcd_barrier_complete(unsigned* bar, unsigned x, unsigned& nloc, unsigned& nx) {
    const unsigned G = gridDim.x * gridDim.y * gridDim.z;
    unsigned sum, cnt, mine, sp = 0u;
    for (;;) {
        sum = 0u; cnt = 0u; mine = 0u;
#pragma unroll
        for (unsigned j = 0; j < 16; ++j) { const unsigned c = xb_ld(&bar[XB_XCNT(j)]); sum += c; cnt += (c > 0u) ? 1u : 0u; mine = (j == x) ? c : mine; }
        if (sum == G) break;
        __builtin_amdgcn_s_sleep(1);
        if ((++sp & 255u) == 0u) { if (xb_ld(&bar[XB_TMO])) break; if (sp > XB_SPIN_CAP) { atomicAdd(&bar[XB_TMO], 1u); break; } }
    }
    nloc = mine > 0u ? mine : 1u; nx = cnt > 0u ? cnt : 1u;
}
__device__ __forceinline__ void xcd_barrier(const XcdBarrier& b) {
    asm volatile("s_waitcnt vmcnt(0)" ::: "memory");
    __syncthreads();
    if (hidden_tid() == 0) {
        unsigned* bar = b.bar;
        __builtin_amdgcn_s_waitcnt(0);
        unsigned nloc = b.st[0], nx = b.st[1];
        if (nloc == 0u) { xcd_barrier_complete(bar, b.x, nloc, nx); b.st[0] = nloc; b.st[1] = nx; }
        const unsigned old = xb_add(&bar[XB_XSUB(b.x)], 1u);
        const unsigned gen = old / nloc;
        if (old + 1u == (gen + 1u) * nloc) {
            __builtin_amdgcn_fence(__ATOMIC_RELEASE, "agent");
            asm volatile("s_waitcnt vmcnt(0)" ::: "memory");
            const unsigned og = xb_add(&bar[XB_TOP], 1u);
            const unsigned tg = og / nx;
            if (og + 1u == (tg + 1u) * nx) xb_add(&bar[XB_TOPGEN], 1u);
            else XB_SPIN(xb_ld(&bar[XB_TOPGEN]) == tg, bar);
            __builtin_amdgcn_fence(__ATOMIC_ACQUIRE, "agent");
            xb_add(&bar[XB_XGEN(b.x)], 1u);
            asm volatile("s_waitcnt vmcnt(0)" ::: "memory");
        } else {
            XB_SPIN(xb_ld(&bar[XB_XGEN(b.x)]) == gen, bar);
            __builtin_amdgcn_fence(__ATOMIC_ACQUIRE, "agent");
            asm volatile("s_waitcnt vmcnt(0)" ::: "memory");
        }
    }
    __syncthreads();
}

constexpr int BM = 256, BK = 64, HALF = 128, HT = HALF * BK;

__device__ __forceinline__ int lds_byte(int r, int c) { int st = (r >> 4) * 2 + (c >> 5), rr = r & 15, cc = c & 31, ob = rr * 64 + cc * 2; return st * 1024 + (ob ^ (((ob >> 9) & 1) << 5)); }
__device__ __forceinline__ void stage_rc(int b, int& R, int& C) { int st = b / 1024, sb = b % 1024, swz = sb ^ (((sb >> 9) & 1) << 5); R = (st >> 1) * 16 + swz / 64; C = (st & 1) * 32 + (swz % 64) / 2; }

struct GemmOperands {
    const char* Abase; unsigned aoff[4]; unsigned kstride;
    const char* Bbase; unsigned boff; int K;
};

__device__ __forceinline__ void gemm_unit(const GemmOperands& g, bf16_t* shm, f32x4 (&acc)[2][2][4][2]) {
#define SA(b,h) (shm + ((b) * 2 + (h)) * HT)
#define SB(b,h) (shm + (4 + (b) * 2 + (h)) * HT)
#define STAGE_A(T, P, hf, kt) do { const char* _ub = g.Abase + (size_t)(kt) * g.kstride; \
    _Pragma("unroll") for (int _i = 0; _i < 2; ++_i) { const int _b = (T) * 16 + _i * 8192; \
      __builtin_amdgcn_global_load_lds((const unsigned*)(_ub + g.aoff[(hf) * 2 + _i]), (unsigned*)((char*)(P) + _b), 16, 0, 0); } } while (0)
#define STAGE_B(T, P, hf, kt) do { \
    _Pragma("unroll") for (int _i = 0; _i < 2; ++_i) { const int _b = (T) * 16 + _i * 8192; \
      const char* _ub = g.Bbase + (size_t)(kt) * (BK * 2) + (size_t)((hf) * 128 + _i * 64) * (size_t)(g.K * 2); \
      __builtin_amdgcn_global_load_lds((const unsigned*)(_ub + g.boff), (unsigned*)((char*)(P) + _b), 16, 0, 0); } } while (0)
#define LDA(dst, b, h) _Pragma("unroll") for (int m = 0; m < 4; ++m) _Pragma("unroll") for (int k = 0; k < 2; ++k) \
    dst[m][k] = *reinterpret_cast<const bf16x8*>((char*)SA(b, h) + lds_byte(wr * 64 + m * 16 + fr, k * 32 + fq * 8))
#define LDB(dst, b, h) _Pragma("unroll") for (int n = 0; n < 2; ++n) _Pragma("unroll") for (int k = 0; k < 2; ++k) \
    dst[n][k] = *reinterpret_cast<const bf16x8*>((char*)SB(b, h) + lds_byte(wc * 32 + n * 16 + fr, k * 32 + fq * 8))
#define MMA(ai, bj, At_, Bt_) do { __builtin_amdgcn_s_setprio(1); \
    _Pragma("unroll") for (int m = 0; m < 4; ++m) _Pragma("unroll") for (int n = 0; n < 2; ++n) _Pragma("unroll") for (int k = 0; k < 2; ++k) \
      acc[ai][bj][m][n] = __builtin_amdgcn_mfma_f32_16x16x32_bf16(Bt_[n][k], At_[m][k], acc[ai][bj][m][n], 0, 0, 0); \
    __builtin_amdgcn_s_setprio(0); } while (0)
#define WAIT_V(n) asm volatile("s_waitcnt vmcnt(" #n ")" ::: "memory")
#define WAIT_L(n) asm volatile("s_waitcnt lgkmcnt(" #n ")" ::: "memory")
#define BAR __builtin_amdgcn_s_barrier()
#define SCHED __builtin_amdgcn_sched_barrier(0)
    int tid = threadIdx.x; asm volatile("" : "+v"(tid));
    int wid = tid >> 6, lane = tid & 63, wr = wid >> 2, wc = wid & 3, fr = lane & 15, fq = lane >> 4;
#pragma unroll
    for (int a = 0; a < 2; ++a)
#pragma unroll
        for (int b = 0; b < 2; ++b)
#pragma unroll
            for (int m = 0; m < 4; ++m)
#pragma unroll
                for (int n = 0; n < 2; ++n) acc[a][b][m][n] = (f32x4){0.f, 0.f, 0.f, 0.f};
    bf16x8 At[4][2], B0[2][2], B1[2][2];
    const int nt = g.K / BK;
    STAGE_B(tid, SB(0, 0), 0, 0); STAGE_A(tid, SA(0, 0), 0, 0);
    STAGE_B(tid, SB(0, 1), 1, 0); STAGE_A(tid, SA(0, 1), 1, 0);
    if (wr == 1) BAR;
    WAIT_V(4); BAR;
    STAGE_B(tid, SB(1, 0), 0, 1); STAGE_A(tid, SA(1, 0), 0, 1); STAGE_B(tid, SB(1, 1), 1, 1);
    WAIT_V(6); BAR;
    for (int t = 0; t < nt - 2; t += 2) {
        LDB(B0, 0, 0); SCHED; LDA(At, 0, 0); STAGE_A(tid, SA(1, 1), 1, t + 1);
        WAIT_L(8); BAR; WAIT_L(0); MMA(0, 0, At, B0); BAR; SCHED;
        LDB(B1, 0, 1); STAGE_B(tid, SB(0, 0), 0, t + 2);
        BAR; WAIT_L(0); MMA(0, 1, At, B1); BAR;
        LDA(At, 0, 1); STAGE_A(tid, SA(0, 0), 0, t + 2);
        BAR; WAIT_L(0); MMA(1, 0, At, B0); BAR; SCHED;
        STAGE_B(tid, SB(0, 1), 1, t + 2);
        WAIT_V(6); BAR; MMA(1, 1, At, B1); BAR;
        LDB(B0, 1, 0); SCHED; LDA(At, 1, 0); STAGE_A(tid, SA(0, 1), 1, t + 2);
        WAIT_L(8); BAR; WAIT_L(0); MMA(0, 0, At, B0); BAR; SCHED;
        LDB(B1, 1, 1); STAGE_B(tid, SB(1, 0), 0, t + 3);
        BAR; WAIT_L(0); MMA(0, 1, At, B1); BAR;
        LDA(At, 1, 1); STAGE_A(tid, SA(1, 0), 0, t + 3);
        BAR; WAIT_L(0); MMA(1, 0, At, B0); BAR; SCHED;
        STAGE_B(tid, SB(1, 1), 1, t + 3);
        WAIT_V(6); BAR; MMA(1, 1, At, B1); BAR;
    }
    { LDB(B0, 0, 0); WAIT_V(0); LDA(At, 0, 0); STAGE_A(tid, SA(1, 1), 1, nt - 1);
      BAR; WAIT_L(0); MMA(0, 0, At, B0); BAR;
      LDB(B1, 0, 1); BAR; WAIT_L(0); MMA(0, 1, At, B1); BAR;
      LDA(At, 0, 1); WAIT_V(4); BAR; WAIT_L(0); MMA(1, 0, At, B0); MMA(1, 1, At, B1); BAR; }
    { LDB(B0, 1, 0); LDA(At, 1, 0); WAIT_V(2); BAR; WAIT_L(0); MMA(0, 0, At, B0); BAR;
      LDB(B1, 1, 1); WAIT_V(0); BAR; WAIT_L(0); MMA(0, 1, At, B1); BAR;
      LDA(At, 1, 1); BAR; WAIT_L(0); MMA(1, 0, At, B0); MMA(1, 1, At, B1); BAR; }
    if (wr == 0) BAR;
#undef SA
#undef SB
}


struct GDesc { const char* A; const char* B; unsigned aoff[4]; };
typedef int i32x8 __attribute__((ext_vector_type(8)));
typedef int i32x4 __attribute__((ext_vector_type(4)));
template <class S, bool FP8 = false, int SCA = 0x7f7f7f7f, int SCB = 0x7f7f7f7f>
__device__ __forceinline__ void gemm_stream(S& s, const int K, const unsigned kstrideA, unsigned char* lds_) {
    const int rowbytes = FP8 ? K : 2 * K;
    bf16_t* shm = (bf16_t*)lds_;
#define SA(b,h) (shm + ((b) * 2 + (h)) * HT)
#define SB(b,h) (shm + (4 + (b) * 2 + (h)) * HT)
#define UNIPTR(ptr) ({ const unsigned long long _u = (unsigned long long)(ptr); (const char*)(((unsigned long long)(unsigned)__builtin_amdgcn_readfirstlane((int)(_u >> 32)) << 32) | (unsigned)__builtin_amdgcn_readfirstlane((int)_u)); })
#define XSTAGE_A(P, hf, kt) do { const char* _ub = UNIPTR(d.A + (size_t)(kt) * kstrideA); \
    _Pragma("unroll") for (int _i = 0; _i < 2; ++_i) { const int _b = tid * 16 + _i * 8192; \
      unsigned _o = d.aoff[(hf) * 2 + _i]; asm volatile("" : "+v"(_o)); \
      __builtin_amdgcn_global_load_lds((const unsigned*)(_ub + _o), (unsigned*)((char*)(P) + _b), 16, 0, 0); } } while (0)
#define XSTAGE_B(P, hf, kt) do { \
    _Pragma("unroll") for (int _i = 0; _i < 2; ++_i) { const int _b = tid * 16 + _i * 8192; \
      const char* _ub = UNIPTR(d.B + (size_t)(kt) * (BK * 2) + (size_t)((hf) * 128 + _i * 64) * (size_t)rowbytes); \
      unsigned _o = boff; asm volatile("" : "+v"(_o)); \
      __builtin_amdgcn_global_load_lds((const unsigned*)(_ub + _o), (unsigned*)((char*)(P) + _b), 16, 0, 0); } } while (0)
    int tid = threadIdx.x; asm volatile("" : "+v"(tid));
    int wid = tid >> 6, lane = tid & 63, wr = wid >> 2, wc = wid & 3, fr = lane & 15, fq = lane >> 4;
    unsigned boff; { int rS, cS; stage_rc(tid * 16, rS, cS); const int rho = rS & 31, i = rho & 15; const int rP = (rS & ~31) + 8 * (i >> 2) + 4 * (rho >> 4) + (i & 3); boff = (unsigned)(rP * rowbytes + cS * 2); }
    const int nt = rowbytes / (BK * 2);
    GDesc d;
    if (!s.first(d)) return;
    f32x4 acc[2][2][4][2];
#pragma unroll
    for (int a = 0; a < 2; ++a)
#pragma unroll
        for (int b = 0; b < 2; ++b)
#pragma unroll
            for (int m = 0; m < 4; ++m)
#pragma unroll
                for (int n = 0; n < 2; ++n) acc[a][b][m][n] = (f32x4){0.f, 0.f, 0.f, 0.f};
    int sca_ = SCA, scb_ = SCB; asm volatile("" : "+v"(sca_), "+v"(scb_));
    struct Frag { bf16x8 f2[2]; };
    Frag At[4], B0[2], B1[2];
#undef LDA
#undef LDB
#undef MMA
#define LDA(dst, b, h) _Pragma("unroll") for (int m = 0; m < 4; ++m) _Pragma("unroll") for (int k = 0; k < 2; ++k) \
    dst[m].f2[k] = *reinterpret_cast<const bf16x8*>((char*)SA(b, h) + lds_byte(wr * 64 + m * 16 + fr, k * 32 + fq * 8))
#define LDB(dst, b, h) _Pragma("unroll") for (int n = 0; n < 2; ++n) _Pragma("unroll") for (int k = 0; k < 2; ++k) \
    dst[n].f2[k] = *reinterpret_cast<const bf16x8*>((char*)SB(b, h) + lds_byte(wc * 32 + n * 16 + fr, k * 32 + fq * 8))
#define MMA(ai, bj, At_, Bt_) do { __builtin_amdgcn_s_setprio(1); \
    _Pragma("unroll") for (int m = 0; m < 4; ++m) _Pragma("unroll") for (int n = 0; n < 2; ++n) { \
      if (FP8) asm volatile("v_mfma_scale_f32_16x16x128_f8f6f4 %0, %1, %2, %0, %3, %4 op_sel_hi:[0,0,0]" : "+v"(acc[ai][bj][m][n]) : "v"(__builtin_bit_cast(i32x8, Bt_[n])), "v"(__builtin_bit_cast(i32x8, At_[m])), "v"(scb_), "v"(sca_)); \
      else { _Pragma("unroll") for (int k = 0; k < 2; ++k) acc[ai][bj][m][n] = __builtin_amdgcn_mfma_f32_16x16x32_bf16(Bt_[n].f2[k], At_[m].f2[k], acc[ai][bj][m][n], 0, 0, 0); } } \
    __builtin_amdgcn_s_setprio(0); } while (0)
    XSTAGE_B(SB(0, 0), 0, 0); XSTAGE_B(SB(0, 1), 1, 0); XSTAGE_A(SA(0, 0), 0, 0); XSTAGE_A(SA(0, 1), 1, 0);
    if (wr == 1) BAR;
    WAIT_V(2); BAR;
    XSTAGE_B(SB(1, 0), 0, 1); XSTAGE_A(SA(1, 0), 0, 1); XSTAGE_B(SB(1, 1), 1, 1);
    WAIT_V(6); BAR;
    asm volatile(".p2align 8");
    for (;;) {
        bool has_next = false;
        for (int t = 0; t < nt; t += 2) {
            if (t == nt - 2) s.prefetch();
            LDB(B0, 0, 0); LDB(B1, 0, 1); SCHED; LDA(At, 0, 0); XSTAGE_A(SA(1, 1), 1, t + 1);
            WAIT_V(8); WAIT_L(0); BAR; MMA(0, 0, At, B0); MMA(0, 1, At, B1); BAR; SCHED;
            int ks = t + 2;
            if (t == nt - 2) { has_next = s.next(d); ks = 0; }
            LDA(At, 0, 1); XSTAGE_B(SB(0, 0), 0, ks); XSTAGE_B(SB(0, 1), 1, ks); XSTAGE_A(SA(0, 0), 0, ks);
            WAIT_V(8); WAIT_L(0); BAR; MMA(1, 0, At, B0); MMA(1, 1, At, B1); BAR; SCHED;
            LDB(B0, 1, 0); LDB(B1, 1, 1); SCHED; LDA(At, 1, 0); XSTAGE_A(SA(0, 1), 1, ks);
            WAIT_V(8); WAIT_L(0); BAR; MMA(0, 0, At, B0); MMA(0, 1, At, B1); BAR; SCHED;
            LDA(At, 1, 1); XSTAGE_B(SB(1, 0), 0, ks + 1); XSTAGE_B(SB(1, 1), 1, ks + 1); XSTAGE_A(SA(1, 0), 0, ks + 1);
            WAIT_V(8); WAIT_L(0); BAR; MMA(1, 0, At, B0); MMA(1, 1, At, B1); BAR; SCHED;
        }
        if (wr == 0) BAR;
        if (FP8) asm volatile("s_nop 15\n\ts_nop 15" ::: "memory");
        s.epilogue(acc);
        if (!has_next) break;
        const bool zr = s.zero_after();
        s.advance();
        if (zr)
#pragma unroll
        for (int a = 0; a < 2; ++a)
#pragma unroll
            for (int b = 0; b < 2; ++b)
#pragma unroll
                for (int m = 0; m < 4; ++m)
#pragma unroll
                    for (int n = 0; n < 2; ++n) acc[a][b][m][n] = (f32x4){0.f, 0.f, 0.f, 0.f};
        if (wr == 1) BAR;
    }
    WAIT_V(0);
    BAR;
#undef SA
#undef SB
#undef XSTAGE_A
#undef XSTAGE_B
}

#define AL4K(x) (((size_t)(x) + 4095) & ~(size_t)4095)
constexpr size_t SZ_CTRL   = 1u << 16;
constexpr size_t OFF_MOD   = SZ_CTRL;
constexpr size_t OFF_CBIAS = OFF_MOD   + AL4K(2 * 16 * 6144 * 4);
constexpr size_t OFF_BIN   = OFF_CBIAS + AL4K(2 * 2 * 4 * 256 * 4);
constexpr size_t OFF_B1P   = OFF_BIN   + AL4K(2 * ZW * 4);
constexpr size_t OFF_WRT   = OFF_B1P   + AL4K(2 * 32 * 2048 * 4);
constexpr size_t OFF_WIN   = OFF_WRT   + AL4K(2 * 2 * 32 * 1024 * 2);
constexpr size_t OFF_WBR   = OFF_WIN   + AL4K((size_t)2 * ZW * 1024 * 2);
constexpr size_t OFF_WOUT  = OFF_WBR   + AL4K((size_t)2 * 3 * 1024 * 512 * 2);
constexpr size_t OFF_W1    = OFF_WOUT  + AL4K((size_t)2 * 1024 * 1024 * 2);
constexpr size_t OFF_W2    = OFF_W1    + AL4K((size_t)2 * 32 * 2048 * 1024 * 2);
constexpr size_t OFF_WC1   = OFF_W2    + AL4K((size_t)2 * 32 * 1024 * 1024 * 2);
constexpr size_t OFF_WC2   = OFF_WC1   + AL4K((size_t)2 * 2 * 256 * 2048 * 2);
constexpr size_t OFF_XR    = OFF_WC2   + AL4K((size_t)2 * 2 * 64 * 256 * 2);
constexpr size_t OFF_HB    = OFF_XR    + AL4K((size_t)NTOK * 1024 * 4);
constexpr size_t OFF_Z     = OFF_HB    + AL4K((size_t)NTOK * 1024 * 2);
constexpr size_t OFF_OABC  = OFF_Z     + AL4K((size_t)NTOK * ZW * 2);
constexpr size_t OFF_OWIN  = OFF_OABC  + AL4K((size_t)3 * NTOK * 512 * 2);
constexpr size_t OFF_KVC   = OFF_OWIN  + AL4K((size_t)NTOK * 512 * 2);
constexpr size_t OFF_MERGED= OFF_KVC   + AL4K((size_t)2 * 16 * 2 * 128 * 64 * 2);
constexpr size_t OFF_MSCR  = OFF_MERGED+ AL4K((size_t)NTOK * 1024 * 2);
constexpr size_t OFF_TOKE  = OFF_MSCR  + AL4K((size_t)256 * 32 * 512 * 16);
constexpr size_t OFF_TOKP  = OFF_TOKE  + AL4K((size_t)NTOK * 4 * 4);
constexpr size_t OFF_TOKG  = OFF_TOKP  + AL4K((size_t)NTOK * 4 * 4);
constexpr size_t OFF_BUCK  = OFF_TOKG  + AL4K((size_t)NTOK * 4 * 4);
constexpr size_t OFF_SELM  = OFF_BUCK  + AL4K((size_t)32 * NTOK * 4);
constexpr size_t OFF_HID   = OFF_SELM  + AL4K((size_t)16 * 2 * 2048 * 4);
constexpr size_t OFF_DELTA = OFF_MSCR;
constexpr size_t OFF_H8    = OFF_HID + AL4K((size_t)PMAX * 1024);
constexpr size_t OFF_Y     = OFF_Z;
constexpr size_t WS_NEED   = OFF_HID   + AL4K((size_t)PMAX * 1024 * 2);
static_assert((size_t)PMAX * 1024 * 2 <= (size_t)NTOK * ZW * 2, "y overlay must fit in z");

#define CW_QCTR(l, q)  (4096 + ((l) * 8 + (q)) * 64)
#define CW_ECNT(l, e)  (8192 + ((l) * 32 + (e)) * 64)
#define CW_LAM         6400

struct Params {
    const float *x, *c, *mod_w, *mod_b, *norm1_g, *norm2_g, *w_in, *b_in, *sinks, *diff_lambda, *diff_subln_g, *cmp_pos, *cmp_w1, *cmp_b1, *cmp_w2, *cmp_b2,
                *w_branch, *w_out, *router_w, *router_b, *exp_w1, *exp_b1, *exp_w2, *exp_b2, *final_g;
    float* out; char* ws; int ph_lo, ph_hi;
};
typedef const Params __attribute__((address_space(4)))* KP;

#ifndef INPROJ_FP8
#define INPROJ_FP8 1
#endif
__device__ __forceinline__ int map_col(int map, int nd) {
    if (map == 1) return nd < 3584 ? nd : (nd < 6656 ? nd + 24 : (nd < 6680 ? nd - 3072 : -1));
    if (map == 2) { const int pn = nd >> 8, r = nd & 255; return r < 128 ? pn * 128 + r : 1024 + pn * 128 + (r - 128); }
    return nd;
}
__device__ __forceinline__ void xpose_load(const float* __restrict__ src, int Nsrc, int k0, int nd0, int map, int ntl, f32x4 (&v)[8], int t) {
    const int n4 = t & 15, kp = t >> 4;
    bool ok[4];
#pragma unroll
    for (int j = 0; j < 4; ++j) { const int ns0 = j < ntl ? map_col(map, nd0 + 64 * j + 4 * n4) : -1; ok[j] = ns0 >= 0; const int nsc = ok[j] ? ns0 : 0;
        v[2 * j] = *(const f32x4*)(src + (size_t)(k0 + 2 * kp) * Nsrc + nsc); v[2 * j + 1] = *(const f32x4*)(src + (size_t)(k0 + 2 * kp + 1) * Nsrc + nsc); }
    __builtin_amdgcn_sched_barrier(0);
    if (map != 0) {
#pragma unroll
        for (int j = 0; j < 4; ++j) if (!ok[j]) { v[2 * j] = (f32x4){0.f, 0.f, 0.f, 0.f}; v[2 * j + 1] = v[2 * j]; } }
}
__device__ __forceinline__ void xpose_store(const f32x4 (&v)[8], bf16_t* __restrict__ dst, int Kdst, int k0, int nd0, int ntl, unsigned char* lds, int t) {
    const int n4 = t & 15, kp = t >> 4;
#pragma unroll
    for (int j = 0; j < 4; ++j)
#pragma unroll
        for (int i = 0; i < 4; ++i) { const int n = 4 * n4 + i; *(unsigned*)(lds + j * 8192 + n * 128 + (((kp >> 2) ^ (n4 & 7)) * 16) + (kp & 3) * 4) = cvt_pk_bf16(v[2 * j][i], v[2 * j + 1][i]); }
    __syncthreads();
    { const int n = t >> 3, ch = t & 7;
#pragma unroll
      for (int j = 0; j < 4; ++j) if (j < ntl) { const u32x4 w = *(const u32x4*)(lds + j * 8192 + n * 128 + ((ch ^ ((n >> 2) & 7)) * 16));
          *(u32x4*)(dst + (size_t)(nd0 + 64 * j + n) * Kdst + k0 + 8 * ch) = w; } }
    __syncthreads();
}
__device__ __forceinline__ void xpose_matrix(const float* src, int K, int Nsrc, bf16_t* dst, int Ndst, int map, unsigned& tbase, unsigned char* lds) {
    const int t = hidden_tid();
    const int nk = K >> 6, nn = Ndst >> 6, ngn = (nn + 3) >> 2, ngrp = nk * ngn; const unsigned G = gridDim.x;
    unsigned gi = (hidden_bid() + G - (tbase % G)) % G;
    f32x4 va[8], vb[8];
    if (gi < (unsigned)ngrp) { const int kt = gi % nk, ng = gi / nk; xpose_load(src, Nsrc, kt * 64, ng * 256, map, min(4, nn - ng * 4), va, t); }
    while (gi < (unsigned)ngrp) {
        const unsigned gn = gi + G; const int kt = gi % nk, ng = gi / nk;
        if (gn < (unsigned)ngrp) { const int kt2 = gn % nk, ng2 = gn / nk; xpose_load(src, Nsrc, kt2 * 64, ng2 * 256, map, min(4, nn - ng2 * 4), vb, t); }
        xpose_store(va, dst, K, kt * 64, ng * 256, min(4, nn - ng * 4), lds, t);
#pragma unroll
        for (int q = 0; q < 8; ++q) va[q] = vb[q];
        gi = gn;
    }
    tbase += ngrp;
}

__device__ __forceinline__ unsigned pk4_fp8(float a, float b, float c, float d) { int w = 0; w = __builtin_amdgcn_cvt_pk_fp8_f32(a, b, w, false); w = __builtin_amdgcn_cvt_pk_fp8_f32(c, d, w, true); return (unsigned)w; }
#define X8T 4
__device__ __forceinline__ unsigned xpose8_load(const float* __restrict__ src, int Nsrc, int k0, int nd0, int map, f32x4 (&v)[4 * X8T], int t) {
    const int n4 = t & 15, kq = t >> 4;
    bool ok[X8T];
#pragma unroll
    for (int j = 0; j < X8T; ++j) { const int ns0 = map_col(map, nd0 + 64 * j + 4 * n4); ok[j] = ns0 >= 0; const int nsc = ok[j] ? ns0 : 0;
#pragma unroll
        for (int q = 0; q < 4; ++q) v[4 * j + q] = __builtin_nontemporal_load((const f32x4*)(src + (size_t)(k0 + 4 * kq + q) * Nsrc + nsc)); }
    __builtin_amdgcn_sched_barrier(0);
    unsigned m = 0;
#pragma unroll
    for (int j = 0; j < X8T; ++j) m |= ok[j] ? (1u << j) : 0u;
    return m;
}
__device__ __forceinline__ void xpose8_store(const f32x4 (&v)[4 * X8T], unsigned char* __restrict__ dst, int Kdst, int k0, int nd0, float scale0, unsigned char* lds, int t, unsigned okm = 0xffffffffu) {
    const int n4 = t & 15, kq = t >> 4;
#pragma unroll
    for (int j = 0; j < X8T; ++j) { const float scale = (okm >> j) & 1u ? scale0 : 0.0f;
#pragma unroll
        for (int i = 0; i < 4; ++i) { const int n = 4 * n4 + i;
            *(unsigned*)(lds + j * 8192 + n * 128 + (((kq >> 2) ^ (n4 & 7)) * 16) + (kq & 3) * 4) = pk4_fp8(v[4 * j][i] * scale, v[4 * j + 1][i] * scale, v[4 * j + 2][i] * scale, v[4 * j + 3][i] * scale); } }
    __syncthreads();
    { const int n = t >> 3, ch = t & 7;
#pragma unroll
      for (int j = 0; j < X8T; ++j) { const u32x4 w = *(const u32x4*)(lds + j * 8192 + n * 128 + ((ch ^ ((n >> 2) & 7)) * 16));
          *(u32x4*)(dst + (size_t)(nd0 + 64 * j + n) * Kdst + k0 + 16 * ch) = w; } }
    __syncthreads();
}
__device__ __forceinline__ void xpose8_matrix(const float* src, int K, int Nsrc, unsigned char* dst, int Ndst, int map, float scale, unsigned& tbase, unsigned char* lds) {
    const int t = hidden_tid();
    const int nk = K >> 7, ngn = Ndst / (64 * X8T), ngrp = nk * ngn; const unsigned G = gridDim.x;
    unsigned gi = (hidden_bid() + G - (tbase % G)) % G;
    f32x4 va[4 * X8T], vb[4 * X8T];
    unsigned ma = 0, mb = 0;
    if (gi < (unsigned)ngrp) ma = xpose8_load(src, Nsrc, (gi % nk) * 128, (gi / nk) * 64 * X8T, map, va, t);
    while (gi < (unsigned)ngrp) {
        const unsigned gn = gi + G;
        if (gn < (unsigned)ngrp) mb = xpose8_load(src, Nsrc, (gn % nk) * 128, (gn / nk) * 64 * X8T, map, vb, t);
        xpose8_store(va, dst, K, (gi % nk) * 128, (gi / nk) * 64 * X8T, scale, lds, t, ma); ma = mb;
#pragma unroll
        for (int q = 0; q < 4 * X8T; ++q) va[q] = vb[q];
        gi = gn;
    }
    tbase += ngrp;
}

#ifndef COSCHED
#define COSCHED 1
#endif
#ifndef XGN
#define XGN 1
#endif
__device__ __forceinline__ void xpose8_gload(KP p, int l, int g, f32x4 (&v)[4 * X8T], int t) {
    const int e = g / 96, r = g - e * 96; const int n4 = t & 15, kq = t >> 4;
    if (r < 64) { const float* b = p->exp_w1 + (size_t)(l * 32 + e) * 1024 * 2048 + (size_t)((r & 7) * 128 + 4 * kq) * 2048 + (r >> 3) * 128 + 4 * n4;
#pragma unroll
        for (int j = 0; j < 4; ++j)
#pragma unroll
            for (int q = 0; q < 4; ++q) v[4 * j + q] = __builtin_nontemporal_load((const f32x4*)(b + q * 2048 + (j >> 1) * 1024 + (j & 1) * 64));
    } else { const float* b = p->exp_w2 + (size_t)(l * 32 + e) * 1024 * 1024 + (size_t)((r & 7) * 128 + 4 * kq) * 1024 + ((r - 64) >> 3) * 256 + 4 * n4;
#pragma unroll
        for (int j = 0; j < 4; ++j)
#pragma unroll
            for (int q = 0; q < 4; ++q) v[4 * j + q] = __builtin_nontemporal_load((const f32x4*)(b + q * 1024 + j * 64));
    }
    __builtin_amdgcn_sched_barrier(0);
}
__device__ __forceinline__ void xpose8_gstore(KP p, int l, int g, const f32x4 (&v)[4 * X8T], unsigned char* lds, int t) {
    const int e = g / 96, r = g - e * 96; char* ws = p->ws;
    if (r < 64) xpose8_store(v, (unsigned char*)(ws + OFF_W1) + (size_t)(l * 32 + e) * 2048 * 1024, 1024, (r & 7) * 128, (r >> 3) * 256, 32.0f, lds, t);
    else xpose8_store(v, (unsigned char*)(ws + OFF_W2) + (size_t)(l * 32 + e) * 1024 * 1024, 1024, (r & 7) * 128, ((r - 64) >> 3) * 256, 32.0f, lds, t);
}
__device__ __forceinline__ void xpose8_group(KP p, int l, int g, unsigned char* lds) {
    if ((g & (XGN - 1)) != XGN - 1) return;
    const int t = hidden_tid(); const int g0 = g - (XGN - 1);
    f32x4 va[4 * X8T], vb[4 * X8T];
    xpose8_gload(p, l, g0, va, t);
    __syncthreads();
#pragma unroll 1
    for (int i = 0; i < XGN; ++i) {
        if (i + 1 < XGN) xpose8_gload(p, l, g0 + i + 1, vb, t);
        xpose8_gstore(p, l, g0 + i, va, lds, t);
#pragma unroll
        for (int q = 0; q < 4 * X8T; ++q) va[q] = vb[q];
    }
}
__device__ __forceinline__ float wave_sum(float v, int lane) {
#pragma unroll
    for (int o = 32; o >= 1; o >>= 1) v += __int_as_float(__builtin_amdgcn_ds_bpermute(((lane ^ o) & 63) << 2, __float_as_int(v)));
    return v;
}
__device__ __forceinline__ void phase_prologue(KP p, unsigned char* lds) {
    const int t = hidden_tid(), bi = hidden_bid();
    char* ws = p->ws;
#ifndef PRO_MODREP
#define PRO_MODREP 1
#endif
#ifndef PRO_XREP
#define PRO_XREP 1
#endif
    for (int rep_ = 0; rep_ < PRO_MODREP; ++rep_) {
        float* cs = (float*)lds;
        f32x4* red = (f32x4*)(lds + 65536);
        for (int i = t; i < 16 * 1024; i += NTHREADS) { const float v = p->c[i]; cs[(i & 1023) * 16 + (i >> 10)] = v * sigmoidf_(v); }
        __syncthreads();
        for (int task = bi; task < 192; task += gridDim.x) {
            const int j0 = task * 64, l = j0 / 6144, c0 = j0 % 6144;
            const int c4 = t & 15, kr = t >> 4, lane = t & 63, wv = t >> 6;
            const float* wp = p->mod_w + (size_t)l * 1024 * 6144 + c0 + 4 * c4;
            f32x4 acc[16];
#pragma unroll
            for (int b = 0; b < 16; ++b) acc[b] = (f32x4){0.f, 0.f, 0.f, 0.f};
#pragma unroll 1
            for (int i0 = 0; i0 < 32; i0 += 4) {
                f32x4 w[4];
#pragma unroll
                for (int i = 0; i < 4; ++i) w[i] = __builtin_nontemporal_load((const f32x4*)(wp + (size_t)(kr + 32 * (i0 + i)) * 6144));
                __builtin_amdgcn_sched_barrier(0);
#pragma unroll
                for (int i = 0; i < 4; ++i) { const float* cr = cs + (kr + 32 * (i0 + i)) * 16;
#pragma unroll
                    for (int b4 = 0; b4 < 4; ++b4) { const f32x4 cv = *(const f32x4*)(cr + 4 * b4);
#pragma unroll
                        for (int q = 0; q < 4; ++q) acc[4 * b4 + q] += cv[q] * w[i]; } }
            }
#pragma unroll
            for (int b = 0; b < 16; ++b)
#pragma unroll
                for (int q = 0; q < 4; ++q) { float v = acc[b][q];
                    v += __int_as_float(__builtin_amdgcn_ds_bpermute(((lane ^ 16) & 63) << 2, __float_as_int(v)));
                    v += __int_as_float(__builtin_amdgcn_ds_bpermute(((lane ^ 32) & 63) << 2, __float_as_int(v)));
                    acc[b][q] = v; }
            if (lane < 16) {
#pragma unroll
                for (int b = 0; b < 16; ++b) red[(wv * 16 + b) * 16 + c4] = acc[b]; }
            __syncthreads();
            if (t < 256) { const int b = t >> 4, c2 = t & 15; f32x4 sum = red[b * 16 + c2];
#pragma unroll
                for (int w2 = 1; w2 < 8; ++w2) sum += red[(w2 * 16 + b) * 16 + c2];
                const int col2 = c0 + 4 * c2;
                *(f32x4*)((float*)(ws + OFF_MOD) + ((size_t)l * 16 + b) * 6144 + col2) = sum + *(const f32x4*)(p->mod_b + l * 6144 + col2); }
            __syncthreads();
        }
    }
    if (bi == 0 && t < 64) {
        for (int l2 = 0; l2 < NLAYER; ++l2) { const float* lp = p->diff_lambda + (size_t)l2 * 256; const float a01 = wave_sum(lp[t] * lp[64 + t], t), a23 = wave_sum(lp[128 + t] * lp[192 + t], t);
            if (t == 0) ((float*)ws)[CW_LAM + l2] = expf(a01) - expf(a23) + (0.8f - 0.6f * expf(-0.3f * (float)l2)); } }
    for (int task = (int)gridDim.x - 1 - bi; task < 16; task += gridDim.x) {
        const int lk = task >> 2, kq = task & 3, nq = t & 63, ks = t >> 6;
        const float* w1 = p->cmp_w1 + (size_t)lk * 2048 * 256; const float* pos = p->cmp_pos + (size_t)lk * 2048;
        f32x4 s4 = (f32x4){0.f, 0.f, 0.f, 0.f};
#pragma unroll 1
        for (int k0 = kq * 512 + ks * 64; k0 < kq * 512 + ks * 64 + 64; k0 += 16) {
            f32x4 w[16]; float pz[16];
#pragma unroll
            for (int i = 0; i < 16; ++i) { w[i] = *(const f32x4*)(w1 + (size_t)(k0 + i) * 256 + 4 * nq); pz[i] = pos[k0 + i]; }
            __builtin_amdgcn_sched_barrier(0);
#pragma unroll
            for (int i = 0; i < 16; ++i) s4 += pz[i] * w[i];
        }
        f32x4* red = (f32x4*)lds; red[t] = s4; __syncthreads();
        if (t < 64) { f32x4 r = red[t];
#pragma unroll
            for (int q = 1; q < 8; ++q) r += red[t + 64 * q];
            *(f32x4*)((float*)(ws + OFF_CBIAS) + (size_t)(lk * 4 + kq) * 256 + 4 * t) = r; }
        __syncthreads();
    }
    for (int i = bi * NTHREADS + t; i < 2 * ZW; i += gridDim.x * NTHREADS) { const int l = i / ZW, nd = i % ZW, ns = map_col(1, nd); ((float*)(ws + OFF_BIN))[i] = ns >= 0 ? p->b_in[l * INW + ns] : 0.f; }
    for (int i = bi * NTHREADS + t; i < 2 * 32 * 2048; i += gridDim.x * NTHREADS) { const int le = i >> 11, j = i & 2047; ((float*)(ws + OFF_B1P))[i] = p->exp_b1[(size_t)le * 2048 + map_col(2, j)]; }
    for (int i = bi * NTHREADS + t; i < 2 * 32 * 1024; i += gridDim.x * NTHREADS) {
        const int l = i >> 15, e = (i >> 10) & 31, k = i & 1023; const float w = p->router_w[((size_t)l * 1024 + k) * 32 + e];
        const bf16_t hi = f2bf(w); const bf16_t lo = f2bf(w - bf2f(hi));
        bf16_t* wr = (bf16_t*)(ws + OFF_WRT); wr[((size_t)(l * 2 + 0) * 32 + e) * 1024 + k] = hi; wr[((size_t)(l * 2 + 1) * 32 + e) * 1024 + k] = lo; }
    __syncthreads();
    for (int rep_ = 0; rep_ < PRO_XREP; ++rep_) {
    unsigned tbase = 0;
    for (int l = 0; l < NLAYER; ++l) {
#if INPROJ_FP8
        xpose8_matrix(p->w_in + (size_t)l * 1024 * INW, 1024, INW, (unsigned char*)(ws + OFF_WIN) + (size_t)l * ZW * 1024, ZW, 1, 32.0f, tbase, lds);
#else
        xpose_matrix(p->w_in + (size_t)l * 1024 * INW, 1024, INW, (bf16_t*)(ws + OFF_WIN) + (size_t)l * ZW * 1024, ZW, 1, tbase, lds);
#endif
        for (int i = 0; i < 3; ++i) xpose_matrix(p->w_branch + (size_t)(l * 3 + i) * 512 * 1024, 512, 1024, (bf16_t*)(ws + OFF_WBR) + (size_t)(l * 3 + i) * 1024 * 512, 1024, 0, tbase, lds);
        xpose_matrix(p->w_out + (size_t)l * 1024 * 1024, 1024, 1024, (bf16_t*)(ws + OFF_WOUT) + (size_t)l * 1024 * 1024, 1024, 0, tbase, lds);
        for (int kv = 0; kv < 2; ++kv) {
            xpose_matrix(p->cmp_w1 + (size_t)(l * 2 + kv) * 2048 * 256, 2048, 256, (bf16_t*)(ws + OFF_WC1) + (size_t)(l * 2 + kv) * 256 * 2048, 256, 0, tbase, lds);
            xpose_matrix(p->cmp_w2 + (size_t)(l * 2 + kv) * 256 * 64, 256, 64, (bf16_t*)(ws + OFF_WC2) + (size_t)(l * 2 + kv) * 64 * 256, 64, 0, tbase, lds);
        }
#if !COSCHED
        for (int e = 0; e < 32; ++e) {
            xpose8_matrix(p->exp_w1 + (size_t)(l * 32 + e) * 1024 * 2048, 1024, 2048, (unsigned char*)(ws + OFF_W1) + (size_t)(l * 32 + e) * 2048 * 1024, 2048, 2, 32.0f, tbase, lds);
            xpose8_matrix(p->exp_w2 + (size_t)(l * 32 + e) * 1024 * 1024, 1024, 1024, (unsigned char*)(ws + OFF_W2) + (size_t)(l * 32 + e) * 1024 * 1024, 1024, 0, 32.0f, tbase, lds);
        }
#endif
    }
}
}


__device__ __forceinline__ void phase_norm_mod(const float* __restrict__ xsrc, const float* __restrict__ g, const float* __restrict__ modl  , int sh_off, int sc_off, bf16_t* __restrict__ hb) {
    const int tid = hidden_tid(), lane = tid & 63, wv = tid >> 6;
    for (int gw = hidden_bid() * 8 + wv; gw < NTOK / 16; gw += gridDim.x * 8) {
        const int row0 = gw * 16, b = row0 >> 11;
        f32x4 gg[4], sc[4], sh[4], xn[4];
#pragma unroll
        for (int j = 0; j < 4; ++j) { const int col = 256 * j + 4 * lane; gg[j] = *(const f32x4*)(g + col); sc[j] = *(const f32x4*)(modl + (size_t)b * 6144 + sc_off + col); sh[j] = *(const f32x4*)(modl + (size_t)b * 6144 + sh_off + col);
            xn[j] = *(const f32x4*)(xsrc + (size_t)row0 * 1024 + col); }
        for (int i = 0; i < 16; ++i) {
            const int row = row0 + i; f32x4 v[4]; float ss = 0.f;
#pragma unroll
            for (int j = 0; j < 4; ++j) { v[j] = xn[j]; ss += v[j][0] * v[j][0] + v[j][1] * v[j][1] + v[j][2] * v[j][2] + v[j][3] * v[j][3]; }
            if (i + 1 < 16) {
#pragma unroll
                for (int j = 0; j < 4; ++j) xn[j] = *(const f32x4*)(xsrc + (size_t)(row + 1) * 1024 + 256 * j + 4 * lane); }
            ss = wave_sum(ss, lane); const float r = 1.0f / sqrtf(ss * (1.0f / 1024.0f) + 1e-5f);
#pragma unroll
            for (int j = 0; j < 4; ++j) { const int col = 256 * j + 4 * lane; float o[4];
#pragma unroll
                for (int q = 0; q < 4; ++q) o[q] = v[j][q] * r * gg[j][q] * (1.0f + sc[j][q]) + sh[j][q];
#if INPROJ_FP8
                *(unsigned*)((unsigned char*)hb + (size_t)row * 1024 + col) = pk4_fp8(o[0], o[1], o[2], o[3]); }
#else
                u32x2 w; w.x = cvt_pk_bf16(o[0], o[1]); w.y = cvt_pk_bf16(o[2], o[3]); *(u32x2*)(hb + (size_t)row * 1024 + col) = w; }
#endif
        }
    }
}

__device__ __forceinline__ bool unit_rc(unsigned L, int nRT, int nN, int& rt, int& pn) {
    const int x = L & 7; const unsigned i = L >> 3; const int nrt_x = (nRT - x + 7) >> 3;
    const unsigned per = 8u * (unsigned)nN, grp = i / per, rem = i % per;
    pn = (int)(rem >> 3); const int rtl = (int)(grp * 8u + (rem & 7u));
    if (rtl >= nrt_x) return false;
    rt = x + 8 * rtl; return true;
}
__device__ __forceinline__ unsigned unit_slots(int nRT, int nN) { const int pr = (nRT + 7) >> 3; return 8u * (unsigned)(((pr + 7) >> 3) * 8 * nN); }
struct SlotIter {
    unsigned L, LM; int nRT, nN;
    __device__ __forceinline__ void init(int nRT_, int nN_) { nRT = nRT_; nN = nN_; LM = unit_slots(nRT_, nN_); L = hidden_bid(); }
    __device__ __forceinline__ bool take(int& rt, int& pn) { while (L < LM) { const unsigned l = L; L += gridDim.x; if (unit_rc(l, nRT, nN, rt, pn)) return true; } return false; }
};

#define GEMM_STAGE_IDS() int rS, cS; { int tz_ = threadIdx.x; asm volatile("" : "+v"(tz_)); stage_rc(tz_ * 16, rS, cS); }
#define GEMM_LANE_IDS() int tid = threadIdx.x; asm volatile("" : "+v"(tid)); const int wid = tid >> 6, lane = tid & 63, wr = wid >> 2, wc = wid & 3, fr = lane & 15, fq = lane >> 4; (void)lane; (void)wr; (void)wc; (void)fr; (void)fq
#define TILE_ROW(i) (((i) >> 1) * 128 + ((i) & 1) * 64 + rS)
typedef f32x4 (&AccRef)[2][2][4][2];

struct InprojS {
    KP p; int l; SlotIter it; int rt, pn, nrt, npn; f32x4 pb[2][2];
    __device__ __forceinline__ bool zero_after() const { return true; }
    __device__ __forceinline__ void load_bias() { GEMM_LANE_IDS(); const float* bias = (const float*)(p->ws + OFF_BIN) + (size_t)l * ZW + pn * 256 + wc * 32 + fq * 8;
#pragma unroll
        for (int bj = 0; bj < 2; ++bj) { pb[bj][0] = *(const f32x4*)(bias + bj * 128); pb[bj][1] = *(const f32x4*)(bias + bj * 128 + 4); } }
    __device__ __forceinline__ void prefetch() { if (!INPROJ_FP8) load_bias(); }
    __device__ __forceinline__ void fill(GDesc& d, int rt_, int pn_) { GEMM_STAGE_IDS(); char* ws = p->ws; d.A = ws + OFF_HB; d.B = ws + OFF_WIN + ((size_t)l * ZW + (size_t)pn_ * 256) * 1024 * (INPROJ_FP8 ? 1 : 2);
#pragma unroll
        for (int i = 0; i < 4; ++i) d.aoff[i] = (unsigned)(((size_t)rt_ * 256 + TILE_ROW(i)) * (INPROJ_FP8 ? 1024 : 2048) + cS * 2); }
    __device__ __forceinline__ bool first(GDesc& d) { it.init(128, 27); if (!it.take(rt, pn)) return false; fill(d, rt, pn); return true; }
    __device__ __forceinline__ bool next(GDesc& d) { int a, b; if (!it.take(a, b)) return false; nrt = a; npn = b; fill(d, a, b); return true; }
    __device__ __forceinline__ void advance() { rt = nrt; pn = npn; }
    __device__ __forceinline__ void epilogue(AccRef acc) {
        if (INPROJ_FP8) load_bias();
        GEMM_LANE_IDS(); char* ws = p->ws;
        bf16_t* z = (bf16_t*)(ws + OFF_Z);
        const bool sig = pn >= 14;
        const float qsc = (pn < 2 || pn == 3 || pn == 4 || pn == 9 || pn == 10) ? 0.125f : 1.0f;
        const int row0 = rt * 256 + wr * 64 + fr, col0 = pn * 256 + wc * 32 + fq * 8;
#pragma unroll
        for (int bj = 0; bj < 2; ++bj) { const int col = col0 + bj * 128; const f32x4 b0 = pb[bj][0], b1 = pb[bj][1];
#pragma unroll
            for (int ai = 0; ai < 2; ++ai)
#pragma unroll
                for (int m = 0; m < 4; ++m) { f32x4 v0 = (acc[ai][bj][m][0] + b0) * qsc, v1 = (acc[ai][bj][m][1] + b1) * qsc;
                    if (sig) {
#pragma unroll
                        for (int j = 0; j < 4; ++j) { v0[j] = sigmoidf_(v0[j]); v1[j] = sigmoidf_(v1[j]); } }
                    u32x4 w; w.x = cvt_pk_bf16(v0[0], v0[1]); w.y = cvt_pk_bf16(v0[2], v0[3]); w.z = cvt_pk_bf16(v1[0], v1[1]); w.w = cvt_pk_bf16(v1[2], v1[3]);
                    *(u32x4*)(z + (size_t)(row0 + ai * 128 + m * 16) * ZW + col) = w; } }
    }
};
__device__ __forceinline__ void phase_inproj(KP p, int l, unsigned char* lds) { InprojS s; s.p = p; s.l = l;
#if INPROJ_FP8
    gemm_stream<InprojS, true, 0x7f7f7f7f, 0x7a7a7a7a>(s, 1024, 128u, lds);
#else
    gemm_stream(s, 1024, 128u, lds);
#endif
}

struct MergeS {
    KP p; int l; SlotIter it; int rt, pn, br, nrt, npn, nbr;
    __device__ __forceinline__ bool zero_after() const { return br == 2; }
    __device__ __forceinline__ void prefetch() {}
    __device__ __forceinline__ void fill(GDesc& d, int rt_, int pn_, int br_) { GEMM_STAGE_IDS(); char* ws = p->ws; d.A = ws + OFF_OABC + (size_t)br_ * NTOK * 512 * 2;
        d.B = ws + OFF_WBR + ((size_t)(l * 3 + br_) * 1024 + (size_t)pn_ * 256) * 512 * 2;
#pragma unroll
        for (int i = 0; i < 4; ++i) d.aoff[i] = (unsigned)(((size_t)rt_ * 256 + TILE_ROW(i)) * 1024 + cS * 2); }
    __device__ __forceinline__ bool first(GDesc& d) { it.init(128, 4); if (!it.take(rt, pn)) return false; br = 0; fill(d, rt, pn, 0); return true; }
    __device__ __forceinline__ bool next(GDesc& d) { if (br < 2) { nrt = rt; npn = pn; nbr = br + 1; } else { int a, b; if (!it.take(a, b)) return false; nrt = a; npn = b; nbr = 0; } fill(d, nrt, npn, nbr); return true; }
    __device__ __forceinline__ void advance() { rt = nrt; pn = npn; br = nbr; }
    __device__ __forceinline__ void epilogue(AccRef acc) {
        GEMM_LANE_IDS(); char* ws = p->ws;
        const bf16_t* z = (const bf16_t*)(ws + OFF_Z); bf16_t* mg = (bf16_t*)(ws + OFF_MERGED);
        const int row0 = rt * 256 + wr * 64 + fr, col0 = pn * 256 + wc * 32 + fq * 8;
#pragma unroll
        for (int ai = 0; ai < 2; ++ai) {
            u32x4 G[2][4], H[2][4];
#pragma unroll
            for (int bj = 0; bj < 2; ++bj)
#pragma unroll
                for (int m = 0; m < 4; ++m) { const bf16_t* gp = z + (size_t)(row0 + ai * 128 + m * 16) * ZW + C_GM + br * 1024 + col0 + bj * 128;
                    G[bj][m] = *(const u32x4*)gp; H[bj][m] = *(const u32x4*)(gp + (br < 2 ? 1024 : 0)); }
            asm volatile("" ::: "memory");
#pragma unroll
            for (int bj = 0; bj < 2; ++bj)
#pragma unroll
                for (int m = 0; m < 4; ++m) {
                    const int row = row0 + ai * 128 + m * 16, col = col0 + bj * 128;
                    const u32x4 gw = G[bj][m], hw = H[bj][m];
                    float g[8] = {bflo(gw.x), bfhi(gw.x), bflo(gw.y), bfhi(gw.y), bflo(gw.z), bfhi(gw.z), bflo(gw.w), bfhi(gw.w)};
                    if (br < 2) { const float hn[8] = {bflo(hw.x), bfhi(hw.x), bflo(hw.y), bfhi(hw.y), bflo(hw.z), bfhi(hw.z), bflo(hw.w), bfhi(hw.w)};
#pragma unroll
                        for (int j = 0; j < 8; ++j) g[j] = fmaxf(g[j], 1e-6f) * fast_rcp(fmaxf(hn[j], 1e-6f));
                    } else {
#pragma unroll
                        for (int j = 0; j < 8; ++j) g[j] = fmaxf(g[j], 1e-6f); }
                    f32x4 v0 = acc[ai][bj][m][0], v1 = acc[ai][bj][m][1];
                    v0[0] *= g[0]; v0[1] *= g[1]; v0[2] *= g[2]; v0[3] *= g[3]; v1[0] *= g[4]; v1[1] *= g[5]; v1[2] *= g[6]; v1[3] *= g[7];
                    if (br < 2) { acc[ai][bj][m][0] = v0; acc[ai][bj][m][1] = v1; }
                    else { u32x4 w; w.x = cvt_pk_bf16(v0[0], v0[1]); w.y = cvt_pk_bf16(v0[2], v0[3]); w.z = cvt_pk_bf16(v1[0], v1[1]); w.w = cvt_pk_bf16(v1[2], v1[3]); *(u32x4*)(mg + (size_t)row * 1024 + col) = w; }
                }
        }
    }
};
__device__ __forceinline__ void phase_merge(KP p, int l, unsigned char* lds) { MergeS s; s.p = p; s.l = l; gemm_stream(s, 512, 128u, lds); }

struct OutprojS {
    KP p; int l; SlotIter it; int rt, pn, nrt, npn; f32x4 pg[2][2];
    __device__ __forceinline__ bool zero_after() const { return true; }
    __device__ __forceinline__ void prefetch() { GEMM_LANE_IDS(); const float* gp = (const float*)(p->ws + OFF_MOD) + ((size_t)l * 16 + (rt >> 3)) * 6144 + 2048 + pn * 256 + wc * 32 + fq * 8;
#pragma unroll
        for (int bj = 0; bj < 2; ++bj) { pg[bj][0] = *(const f32x4*)(gp + bj * 128); pg[bj][1] = *(const f32x4*)(gp + bj * 128 + 4); } }
    __device__ __forceinline__ void fill(GDesc& d, int rt_, int pn_) { GEMM_STAGE_IDS(); char* ws = p->ws; d.A = ws + OFF_MERGED; d.B = ws + OFF_WOUT + ((size_t)l * 1024 + (size_t)pn_ * 256) * 1024 * 2;
#pragma unroll
        for (int i = 0; i < 4; ++i) d.aoff[i] = (unsigned)(((size_t)rt_ * 256 + TILE_ROW(i)) * 2048 + cS * 2); }
    __device__ __forceinline__ bool first(GDesc& d) { it.init(128, 4); if (!it.take(rt, pn)) return false; fill(d, rt, pn); return true; }
    __device__ __forceinline__ bool next(GDesc& d) { int a, b; if (!it.take(a, b)) return false; nrt = a; npn = b; fill(d, a, b); return true; }
    __device__ __forceinline__ void advance() { rt = nrt; pn = npn; }
    __device__ __forceinline__ void epilogue(AccRef acc) {
        GEMM_LANE_IDS(); bf16_t* dl = (bf16_t*)(p->ws + OFF_DELTA);
        const int row0 = rt * 256 + wr * 64 + fr, col0 = pn * 256 + wc * 32 + fq * 8;
#pragma unroll
        for (int bj = 0; bj < 2; ++bj)
#pragma unroll
            for (int ai = 0; ai < 2; ++ai)
#pragma unroll
                for (int m = 0; m < 4; ++m) { const f32x4 v0 = pg[bj][0] * acc[ai][bj][m][0], v1 = pg[bj][1] * acc[ai][bj][m][1];
                    u32x4 w; w.x = cvt_pk_bf16(v0[0], v0[1]); w.y = cvt_pk_bf16(v0[2], v0[3]); w.z = cvt_pk_bf16(v1[0], v1[1]); w.w = cvt_pk_bf16(v1[2], v1[3]);
                    *(u32x4*)(dl + (size_t)(row0 + ai * 128 + m * 16) * 1024 + col0 + bj * 128) = w; }
    }
};
__device__ __forceinline__ void phase_outproj(KP p, int l, unsigned char* lds) { OutprojS s; s.p = p; s.l = l; gemm_stream(s, 1024, 128u, lds); }

__device__ __forceinline__ void moe_tables(KP p, int l, int* tbl) {
    const int t = hidden_tid();
    if (t < 64) {
        const unsigned* ctrl = (const unsigned*)p->ws; const int e = t & 31;
        const int c = (int)ctrl[CW_ECNT(l, e)]; const int nt = (c + 255) >> 8;
        int incl = nt;
#pragma unroll
        for (int o = 1; o < 32; o <<= 1) { const int v = __builtin_amdgcn_ds_bpermute(((t - o) & 63) << 2, incl); if (e >= o) incl += v; }
        if (t < 32) { tbl[e] = incl - nt; tbl[33 + e] = c; if (e == 31) tbl[32] = incl; }
    }
    __syncthreads();
}
#define RFL(x) __builtin_amdgcn_readfirstlane(x)
__device__ __forceinline__ int moe_find(const int* tbl, int rt, int e = 0) {
    while (RFL(tbl[e + 1]) <= rt) ++e;
    while (RFL(tbl[e]) > rt) --e;
    return e; }
#define MOE_TBL(lds) ((int*)((lds) + 131072 + 4096))

#ifndef MOEX
#define MOEX 0
#endif
struct Moe1S {
    KP p; int l; const int* tbl; SlotIter it; int rt, pn, e, nrt, npn, ne; int shadow; f32x4 bg[2], bu[2]; const int* toktab; int ui;
    __device__ __forceinline__ bool zero_after() const { return true; }
    __device__ __forceinline__ void prefetch() {}
    __device__ __forceinline__ void load_bias() { GEMM_LANE_IDS(); const float* bb = (const float*)(p->ws + OFF_B1P) + ((size_t)(l * 32 + e)) * 2048 + pn * 256 + wc * 32 + fq * 8;
#pragma unroll
        for (int n = 0; n < 2; ++n) { bg[n] = *(const f32x4*)(bb + n * 4); bu[n] = *(const f32x4*)(bb + 128 + n * 4); } }
    __device__ __forceinline__ void fill(GDesc& d, int rt_, int pn_, int e_) { GEMM_STAGE_IDS(); char* ws = p->ws; (void)rt_;
        d.A = ws + OFF_H8; d.B = ws + OFF_W1 + (((size_t)(l * 32 + e_)) * 2048 + (size_t)pn_ * 256) * 1024;
#pragma unroll
        for (int i = 0; i < 4; ++i) d.aoff[i] = (unsigned)((size_t)toktab[ui * 256 + TILE_ROW(i)] * 1024 + cS * 2);
        ++ui; }
    __device__ __forceinline__ bool first(GDesc& d) { it.init(RFL(tbl[32]), 8); if (!it.take(rt, pn)) return false; e = moe_find(tbl, rt); fill(d, rt, pn, e); return true; }
    __device__ __forceinline__ bool next(GDesc& d) { int a, b; if (!it.take(a, b)) return false; nrt = a; npn = b; ne = moe_find(tbl, a, e); fill(d, a, b, ne); return true; }
    __device__ __forceinline__ void advance() { rt = nrt; pn = npn; e = ne; }
    __device__ __forceinline__ void epilogue(AccRef acc) {
        if (shadow && MOEX == 2) { asm volatile("" :: "v"(acc[0][0][0][0]), "v"(acc[1][1][3][1])); return; }
        load_bias();
        GEMM_LANE_IDS(); char* ws = p->ws; unsigned char* hid = (unsigned char*)(ws + OFF_HID);
        const size_t prow0 = (size_t)rt * 256 + wr * 64 + fr; const int c0 = wc * 32 + fq * 8;
#pragma unroll
        for (int ai = 0; ai < 2; ++ai)
#pragma unroll
            for (int m = 0; m < 4; ++m) { float o[8];
#pragma unroll
                for (int n = 0; n < 2; ++n) { const f32x4 gq = acc[ai][0][m][n] + bg[n], uq = acc[ai][1][m][n] + bu[n];
#pragma unroll
                    for (int j = 0; j < 4; ++j) { const float gg = fminf(gq[j], 7.0f), uu = __builtin_amdgcn_fmed3f(uq[j], -7.0f, 7.0f); o[n * 4 + j] = (uu + 1.0f) * gg * fast_rcp(1.0f + fast_exp2(-1.702f * LOG2E * gg)); } }
                u32x2 w; w.x = pk4_fp8(4.0f * o[0], 4.0f * o[1], 4.0f * o[2], 4.0f * o[3]); w.y = pk4_fp8(4.0f * o[4], 4.0f * o[5], 4.0f * o[6], 4.0f * o[7]);
                *(u32x2*)(hid + (prow0 + ai * 128 + m * 16) * 1024 + pn * 128 + c0) = w; }
    }
};
__device__ __forceinline__ void phase_moe1(KP p, int l, unsigned char* lds) { int* tbl = MOE_TBL(lds); moe_tables(p, l, tbl);
    int* toktab = (int*)(lds + 131072 + 8192);
    { SlotIter it2; it2.init(RFL(tbl[32]), 8); int a, b, u2 = 0, e2 = 0; const int t = hidden_tid();
      while (it2.take(a, b)) { e2 = moe_find(tbl, a, e2); const int cnt = RFL(tbl[33 + e2]), pos0 = (a - RFL(tbl[e2])) * 256;
          if (t < 256) { int pos = pos0 + t; pos = pos < cnt ? pos : 0; toktab[u2 * 256 + t] = ((const int*)(p->ws + OFF_BUCK))[(size_t)e2 * NTOK + pos]; }
          ++u2; }
      __syncthreads(); }
    for (int rep = 0; rep < (MOEX ? 2 : 1); ++rep) { Moe1S s; s.p = p; s.l = l; s.tbl = tbl; s.shadow = rep; s.toktab = toktab; s.ui = 0; gemm_stream<Moe1S, true, 0x7f7f7f7f, 0x7a7a7a7a>(s, 1024, 128u, lds); __syncthreads(); } }

struct Moe2S {
    KP p; int l; const int* tbl; SlotIter it; int rt, pn, e, nrt, npn, ne; f32x4 pb[2][2];
    __device__ __forceinline__ bool zero_after() const { return true; }
    __device__ __forceinline__ void prefetch() {}
    __device__ __forceinline__ void load_bias() { GEMM_LANE_IDS(); const float* b2 = p->exp_b2 + ((size_t)(l * 32 + e)) * 1024 + pn * 256 + wc * 32 + fq * 8;
#pragma unroll
        for (int bj = 0; bj < 2; ++bj) { pb[bj][0] = *(const f32x4*)(b2 + bj * 128); pb[bj][1] = *(const f32x4*)(b2 + bj * 128 + 4); } }
    __device__ __forceinline__ void fill(GDesc& d, int rt_, int pn_, int e_) { GEMM_STAGE_IDS(); char* ws = p->ws; d.A = ws + OFF_HID; d.B = ws + OFF_W2 + (((size_t)(l * 32 + e_)) * 1024 + (size_t)pn_ * 256) * 1024;
#pragma unroll
        for (int i = 0; i < 4; ++i) d.aoff[i] = (unsigned)(((size_t)rt_ * 256 + TILE_ROW(i)) * 1024 + cS * 2); }
    __device__ __forceinline__ bool first(GDesc& d) { it.init(RFL(tbl[32]), 4); if (!it.take(rt, pn)) return false; e = moe_find(tbl, rt); fill(d, rt, pn, e); return true; }
    __device__ __forceinline__ bool next(GDesc& d) { int a, b; if (!it.take(a, b)) return false; nrt = a; npn = b; ne = moe_find(tbl, a, e); fill(d, a, b, ne); return true; }
    __device__ __forceinline__ void advance() { rt = nrt; pn = npn; e = ne; }
    __device__ __forceinline__ void epilogue(AccRef acc) {
        load_bias();
        GEMM_LANE_IDS(); char* ws = p->ws; bf16_t* y = (bf16_t*)(ws + OFF_Y);
        const size_t row0 = (size_t)rt * 256 + wr * 64 + fr; const int col0 = pn * 256 + wc * 32 + fq * 8;
#pragma unroll
        for (int bj = 0; bj < 2; ++bj) { const int col = col0 + bj * 128; const f32x4 b0 = pb[bj][0], b1 = pb[bj][1];
#pragma unroll
            for (int ai = 0; ai < 2; ++ai)
#pragma unroll
                for (int m = 0; m < 4; ++m) { const f32x4 v0 = acc[ai][bj][m][0] + b0, v1 = acc[ai][bj][m][1] + b1;
                    u32x4 w; w.x = cvt_pk_bf16(v0[0], v0[1]); w.y = cvt_pk_bf16(v0[2], v0[3]); w.z = cvt_pk_bf16(v1[0], v1[1]); w.w = cvt_pk_bf16(v1[2], v1[3]);
                    *(u32x4*)(y + (row0 + ai * 128 + m * 16) * 1024 + col) = w; } }
    }
};
__device__ __forceinline__ void phase_moe2(KP p, int l, unsigned char* lds) { int* tbl = MOE_TBL(lds); moe_tables(p, l, tbl); Moe2S s; s.p = p; s.l = l; s.tbl = tbl; gemm_stream<Moe2S, true, 0x7d7d7d7d, 0x7a7a7a7a>(s, 1024, 128u, lds); __syncthreads(); }

#define AT_MISC 65536


typedef short s16x4 __attribute__((ext_vector_type(4)));
__device__ __forceinline__ int crow(int r, int h) { return (r & 3) + 8 * (r >> 2) + 4 * h; }
__device__ __forceinline__ int kaddr(int key, int c) { return (key >> 1) * 256 + (((((key & 1) << 3) | c) ^ ((key >> 1) & 15)) << 4); }
__device__ __forceinline__ int vaddr64(int key, int c) { return (key >> 1) * 256 + (((key & 1) * 2 + ((c >> 2) ^ ((key >> 1) & 1))) << 6) + ((c & 3) << 4); }
__device__ __forceinline__ int vaddr128(int key, int c) { return key * 256 + (((c >> 2) ^ (key & 3)) << 6) + ((c & 3) << 4); }
__device__ __forceinline__ s16x4 vtr(const unsigned char* p) { return __builtin_bit_cast(s16x4, __builtin_amdgcn_ds_read_tr16_b64_v4i16((LAS s16x4*)(p))); }
__device__ __forceinline__ float swap_max(float v) { auto rr = __builtin_amdgcn_permlane32_swap(__float_as_uint(v), __float_as_uint(v), false, false); return fmaxf(__uint_as_float(rr[0]), __uint_as_float(rr[1])); }
__device__ __forceinline__ float swap_sum(float v) { auto rr = __builtin_amdgcn_permlane32_swap(__float_as_uint(v), __float_as_uint(v), false, false); return __uint_as_float(rr[0]) + __uint_as_float(rr[1]); }
__device__ __forceinline__ float swap_other(float v, int h) { auto rr = __builtin_amdgcn_permlane32_swap(__float_as_uint(v), __float_as_uint(v), false, false); return __uint_as_float(h ? rr[0] : rr[1]); }
#define MFMA32(a, b, c) __builtin_amdgcn_mfma_f32_32x32x16_bf16((a), (b), (c), 0, 0, 0)

struct KVSrc { const char* k; unsigned kstride; const char* v; unsigned vstride; };
__device__ __forceinline__ void kinv(int o, int& key, int& c) { const int sup = o >> 8, x = ((o >> 4) & 15) ^ (sup & 15); key = 2 * sup + (x >> 3); c = x & 7; }
__device__ __forceinline__ void vinv64(int o, int& key, int& c) { const int sup = o >> 8, seg = (o >> 6) & 3; key = 2 * sup + (seg >> 1); c = (((seg & 1) ^ (sup & 1)) << 2) | ((o >> 4) & 3); }
__device__ __forceinline__ void vinv128(int o, int& key, int& c) { key = o >> 8; c = ((((o >> 6) & 3) ^ (key & 3)) << 2) | ((o >> 4) & 3); }
#define RING_NB 4
#define RING_AHEAD 3
template <int KW, int DV> struct KVRing {
    static constexpr int LPT = KW + DV / 64, BUFB = KW * 8192 + DV * 128;
    unsigned kof[KW], vof[DV / 64];
    unsigned kdst[KW], vdst[DV / 64];
    const char* kb; const char* vb; unsigned kstride, vstride;
    __device__ __forceinline__ void init(const KVSrc& s, int tid) {
        kb = s.k; vb = s.v; kstride = s.kstride; vstride = s.vstride;
        const int wv = tid >> 6, lane = tid & 63;
#pragma unroll
        for (int i = 0; i < KW; ++i) { const int o = (i * 8 + wv) * 1024 + lane * 16, img = o >> 13; int key, c; kinv(o & 8191, key, c); kof[i] = (unsigned)key * kstride + (unsigned)(img * 128 + c * 16); kdst[i] = (unsigned)o; }
#pragma unroll
        for (int i = 0; i < DV / 64; ++i) { const int o = (i * 8 + wv) * 1024 + lane * 16; int key, c; if (DV == 64) vinv64(o, key, c); else vinv128(o, key, c);
            vof[i] = (unsigned)key * vstride + (unsigned)(c * 16); vdst[i] = (unsigned)(KW * 8192 + o); }
    }
    __device__ __forceinline__ void issue(int key0, int buf, unsigned char* lds) const {
        const char* kt = UNIPTR(kb + (size_t)key0 * kstride); const char* vt = UNIPTR(vb + (size_t)key0 * vstride);
#pragma unroll
        for (int i = 0; i < KW; ++i) { unsigned o = kof[i]; asm volatile("" : "+v"(o)); __builtin_amdgcn_global_load_lds((const unsigned*)(kt + o), (unsigned*)(lds + buf * BUFB + kdst[i]), 16, 0, 0); }
#pragma unroll
        for (int i = 0; i < DV / 64; ++i) { unsigned o = vof[i]; asm volatile("" : "+v"(o)); __builtin_amdgcn_global_load_lds((const unsigned*)(vt + o), (unsigned*)(lds + buf * BUFB + vdst[i]), 16, 0, 0); }
    }
    __device__ __forceinline__ void wait_bar(int later) const {
        if (later >= 2 && RING_AHEAD >= 3) asm volatile("s_waitcnt vmcnt(%0)" :: "n"(2 * LPT) : "memory");
        else if (later >= 1) asm volatile("s_waitcnt vmcnt(%0)" :: "n"(LPT) : "memory");
        else asm volatile("s_waitcnt vmcnt(0)" ::: "memory");
        __builtin_amdgcn_s_barrier(); asm volatile("" ::: "memory");
    }
    __device__ __forceinline__ const unsigned char* kimg(const unsigned char* lds, int buf, int img) const { return lds + buf * BUFB + img * 8192; }
    __device__ __forceinline__ const unsigned char* vimg(const unsigned char* lds, int buf) const { return lds + buf * BUFB + KW * 8192; }
};

template <int DV> struct WaveAcc { float m, l; f32x16 o[DV / 32]; };
template <int DV> __device__ __forceinline__ void acc_init(WaveAcc<DV>& a) { a.m = -1e30f; a.l = 0.f;
#pragma unroll
    for (int d = 0; d < DV / 32; ++d)
#pragma unroll
        for (int r = 0; r < 16; ++r) a.o[d][r] = 0.f; }

__device__ __forceinline__ f32x16 qk_sub(const bf16x8 (&qf)[4], const unsigned char* kimg, int sub, int lane) {
    const int r32 = lane & 31, h = lane >> 5;
    f32x16 s;
#pragma unroll
    for (int r = 0; r < 16; ++r) s[r] = 0.f;
#pragma unroll
    for (int ks = 0; ks < 4; ++ks) { const bf16x8 kf = *(const bf16x8*)(kimg + kaddr(32 * sub + r32, 2 * ks + h)); s = MFMA32(kf, qf[ks], s); }
    return s;
}
template <int DV> struct VFrag { s16x4 r[2][DV / 32][2]; };
__device__ __forceinline__ void v_read_all(VFrag<64>& f, const unsigned char* vimg, int sub, int lane) {
    const int h = lane >> 5, i16 = lane & 15, qq = i16 >> 2, pp = i16 & 3, g1 = (lane >> 4) & 1, k0 = 32 * sub + 4 * h + qq;
    const unsigned b0 = (unsigned)(uintptr_t)(vimg + vaddr64(k0, 2 * g1 + (pp >> 1)) + (pp & 1) * 8), b1 = (unsigned)(uintptr_t)(vimg + vaddr64(k0, 4 + 2 * g1 + (pp >> 1)) + (pp & 1) * 8);
    asm volatile("ds_read_b64_tr_b16 %0, %8\n\tds_read_b64_tr_b16 %1, %8 offset:1024\n\tds_read_b64_tr_b16 %2, %9\n\tds_read_b64_tr_b16 %3, %9 offset:1024\n\t"
                 "ds_read_b64_tr_b16 %4, %8 offset:2048\n\tds_read_b64_tr_b16 %5, %8 offset:3072\n\tds_read_b64_tr_b16 %6, %9 offset:2048\n\tds_read_b64_tr_b16 %7, %9 offset:3072\n\t"
                 "s_waitcnt lgkmcnt(0)"
                 : "=&v"(f.r[0][0][0]), "=&v"(f.r[0][0][1]), "=&v"(f.r[0][1][0]), "=&v"(f.r[0][1][1]), "=&v"(f.r[1][0][0]), "=&v"(f.r[1][0][1]), "=&v"(f.r[1][1][0]), "=&v"(f.r[1][1][1])
                 : "v"(b0), "v"(b1) : "memory");
}
__device__ __forceinline__ void v_read_all(VFrag<128>& f, const unsigned char* vimg, int sub, int lane) {
    const int h = lane >> 5, i16 = lane & 15, qq = i16 >> 2, pp = i16 & 3, g1 = (lane >> 4) & 1, k0 = 32 * sub + 4 * h + qq;
    unsigned b[4];
#pragma unroll
    for (int db = 0; db < 4; ++db) b[db] = (unsigned)(uintptr_t)(vimg + vaddr128(k0, db * 4 + 2 * g1 + (pp >> 1)) + (pp & 1) * 8);
    asm volatile("ds_read_b64_tr_b16 %0, %16\n\tds_read_b64_tr_b16 %1, %16 offset:2048\n\tds_read_b64_tr_b16 %2, %17\n\tds_read_b64_tr_b16 %3, %17 offset:2048\n\t"
                 "ds_read_b64_tr_b16 %4, %18\n\tds_read_b64_tr_b16 %5, %18 offset:2048\n\tds_read_b64_tr_b16 %6, %19\n\tds_read_b64_tr_b16 %7, %19 offset:2048\n\t"
                 "ds_read_b64_tr_b16 %8, %16 offset:4096\n\tds_read_b64_tr_b16 %9, %16 offset:6144\n\tds_read_b64_tr_b16 %10, %17 offset:4096\n\tds_read_b64_tr_b16 %11, %17 offset:6144\n\t"
                 "ds_read_b64_tr_b16 %12, %18 offset:4096\n\tds_read_b64_tr_b16 %13, %18 offset:6144\n\tds_read_b64_tr_b16 %14, %19 offset:4096\n\tds_read_b64_tr_b16 %15, %19 offset:6144\n\t"
                 "s_waitcnt lgkmcnt(0)"
                 : "=&v"(f.r[0][0][0]), "=&v"(f.r[0][0][1]), "=&v"(f.r[0][1][0]), "=&v"(f.r[0][1][1]), "=&v"(f.r[0][2][0]), "=&v"(f.r[0][2][1]), "=&v"(f.r[0][3][0]), "=&v"(f.r[0][3][1]),
                   "=&v"(f.r[1][0][0]), "=&v"(f.r[1][0][1]), "=&v"(f.r[1][1][0]), "=&v"(f.r[1][1][1]), "=&v"(f.r[1][2][0]), "=&v"(f.r[1][2][1]), "=&v"(f.r[1][3][0]), "=&v"(f.r[1][3][1])
                 : "v"(b[0]), "v"(b[1]), "v"(b[2]), "v"(b[3]) : "memory");
}
template <int DV> __device__ __forceinline__ void pv_sub(const f32x16& pr, const VFrag<DV>& f, f32x16 (&o)[DV / 32]) {
#pragma unroll
    for (int s2 = 0; s2 < 2; ++s2) {
        u32x4 pw; pw.x = cvt_pk_bf16(pr[8 * s2 + 0], pr[8 * s2 + 1]); pw.y = cvt_pk_bf16(pr[8 * s2 + 2], pr[8 * s2 + 3]);
        pw.z = cvt_pk_bf16(pr[8 * s2 + 4], pr[8 * s2 + 5]); pw.w = cvt_pk_bf16(pr[8 * s2 + 6], pr[8 * s2 + 7]);
        const bf16x8 pf = __builtin_bit_cast(bf16x8, pw);
#pragma unroll
        for (int db = 0; db < DV / 32; ++db) { const s16x4 lo = f.r[s2][db][0], hi = f.r[s2][db][1];
            bf16x8 vf; vf[0] = lo[0]; vf[1] = lo[1]; vf[2] = lo[2]; vf[3] = lo[3]; vf[4] = hi[0]; vf[5] = hi[1]; vf[6] = hi[2]; vf[7] = hi[3];
            o[db] = MFMA32(vf, pf, o[db]); }
    }
}
template <int DV> __device__ __forceinline__ void attn_sub_auto(const bf16x8 (&qf)[5], const unsigned char* kimg, const unsigned char* vimg, int sub, int key0, int tqw, int tq, int h,
                                                               int whi, bool lbit, WaveAcc<DV>& a, int lane) {
    f32x16 s = qk_sub(*(const bf16x8 (*)[4])&qf, kimg, sub, lane);
    { const int r32 = lane & 31, tk = key0 + r32; const unsigned hi = __float_as_uint((float)(tk >> 8)) >> 16, lo = __float_as_uint((float)(tk & 255)) & 0xffff0000u;
      u32x4 kw; kw.x = (lane < 32) ? (hi | lo) : 0u; kw.y = 0u; kw.z = 0u; kw.w = 0u;
      s = MFMA32(__builtin_bit_cast(bf16x8, kw), qf[4], s); }
    VFrag<DV> vf; v_read_all(vf, vimg, sub, lane);
    const bool interior = (tqw - (key0 + 31) >= 0) && (tqw + 31 - key0 < whi) && __all(lbit);
    if (!interior) { const int d0 = tq - key0 - 4 * h;
#pragma unroll
        for (int r = 0; r < 16; ++r) { const int dist = d0 - ((r & 3) + 8 * (r >> 2)); s[r] = (lbit && dist >= 0 && dist < whi) ? s[r] : -INFINITY; } }
    float tmax = fmaxf(fmaxf(s[0], s[1]), fmaxf(s[2], s[3]));
#pragma unroll
    for (int r = 4; r < 16; r += 4) tmax = fmaxf(tmax, fmaxf(fmaxf(s[r], s[r + 1]), fmaxf(s[r + 2], s[r + 3])));
    tmax = swap_max(tmax);
    if (!__all(tmax - a.m <= 8.0f)) {
        const float mnew = fmaxf(a.m, tmax), alpha = fast_exp2((a.m - mnew) * LOG2E);
        a.l *= alpha; a.m = mnew;
#pragma unroll
        for (int d = 0; d < DV / 32; ++d)
#pragma unroll
            for (int r = 0; r < 16; ++r) a.o[d][r] *= alpha;
    }
    const float nm = -a.m * LOG2E;
    float rs0 = 0.f, rs1 = 0.f;
#pragma unroll
    for (int r = 0; r < 16; r += 2) { s[r] = fast_exp2(__builtin_fmaf(s[r], LOG2E, nm)); s[r + 1] = fast_exp2(__builtin_fmaf(s[r + 1], LOG2E, nm)); rs0 += s[r]; rs1 += s[r + 1]; }
    a.l += rs0 + rs1;
    pv_sub<DV>(s, vf, a.o);
}
__device__ __forceinline__ void load_q(bf16x8 (&qf)[5], const bf16_t* qp  , float slope, int lane) {
#pragma unroll
    for (int ks = 0; ks < 4; ++ks) qf[ks] = *(const bf16x8*)(qp + 16 * ks);
    u32x4 qw; qw.x = (lane < 32) ? ((__float_as_uint(256.0f * slope) >> 16) | (__float_as_uint(slope) & 0xffff0000u)) : 0u; qw.y = 0u; qw.z = 0u; qw.w = 0u;
    qf[4] = __builtin_bit_cast(bf16x8, qw);
}
template <int DV> __device__ __forceinline__ void store_o(const f32x16 (&o)[DV / 32], float sc, bf16_t* orow, int h) {
#pragma unroll
    for (int db = 0; db < DV / 32; ++db)
#pragma unroll
        for (int rg = 0; rg < 4; ++rg) { u32x2 w; w.x = cvt_pk_bf16(o[db][4 * rg] * sc, o[db][4 * rg + 1] * sc); w.y = cvt_pk_bf16(o[db][4 * rg + 2] * sc, o[db][4 * rg + 3] * sc);
            *(u32x2*)(orow + db * 32 + 8 * rg + 4 * h) = w; }
}


template <bool SINK> __device__ __forceinline__ void attn_window_unit(KP p, int l, int b, int hkv, int qt, int W, int cq, int ck, int cv, bf16_t* outbuf, unsigned char* lds) {
    const int tid = hidden_tid(), lane = tid & 63, wv = __builtin_amdgcn_readfirstlane(tid >> 6), r32 = lane & 31, h = lane >> 5, g = wv & 3, qsub = wv >> 2;
    const int head = hkv * 4 + g, t0 = qt * 64, tqw = t0 + 32 * qsub, tq = tqw + r32;
    const bf16_t* z = (const bf16_t*)(p->ws + OFF_Z);
    const float slope = exp2f(-(float)(head + 1));
    KVSrc src; src.k = (const char*)(z + (size_t)b * NS * ZW + ck + hkv * 64); src.v = (const char*)(z + (size_t)b * NS * ZW + cv + hkv * 64); src.kstride = ZW * 2; src.vstride = ZW * 2;
    int klo = t0 - W + 1; klo = klo < 0 ? 0 : klo; const int kt0 = klo >> 6, kt1 = qt;
    WaveAcc<64> a; acc_init(a);
    KVRing<1, 64> ring; ring.init(src, tid);
    const int nt = kt1 - kt0 + 1;
    for (int j = 0; j < RING_AHEAD && j < nt; ++j) ring.issue((kt1 - j) * 64, j, lds);
    bf16x8 qf[5]; load_q(qf, z + ((size_t)b * NS + tq) * ZW + cq + head * 64 + 8 * h, slope, lane);
    asm volatile("" :: "v"(qf[0]), "v"(qf[1]), "v"(qf[2]), "v"(qf[3]));
    asm volatile(".p2align 8");
    for (int t = 0; t < nt; ++t) {
        const int kt = kt1 - t, buf = t & (RING_NB - 1);
        ring.wait_bar(nt - 1 - t);
        if (t + RING_AHEAD < nt) ring.issue((kt - RING_AHEAD) * 64, (t + RING_AHEAD) & (RING_NB - 1), lds);
        const unsigned char* kimg = ring.kimg(lds, buf, 0); const unsigned char* vimg = ring.vimg(lds, buf);
#pragma unroll
        for (int sr = 0; sr < 2; ++sr) { const int sub = 1 - sr, key0 = kt * 64 + 32 * sub;
            if (key0 <= tqw + 31 && key0 + 31 >= tqw - W + 1) attn_sub_auto<64>(qf, kimg, vimg, sub, key0, tqw, tq, h, W, true, a, lane); }
    }
    __syncthreads();
    float den = swap_sum(a.l);
    if (SINK) den += fast_exp2((p->sinks[l * 8 + head] + slope * (float)tq - a.m) * LOG2E);
    store_o<64>(a.o, 1.0f / den, outbuf + ((size_t)b * NS + tq) * 512 + head * 64, h);
}

#ifndef EXPER
#define EXPER 0
#endif
__device__ __forceinline__ void attn_diff_unit(KP p, int l, int b, int hd, int qt, unsigned char* lds, const int shadow = 0) {
    const int tid = hidden_tid(), lane = tid & 63, wv = __builtin_amdgcn_readfirstlane(tid >> 6), r32 = lane & 31, h = lane >> 5, c = wv & 1, qsub = wv >> 1;
    const int t0 = qt * 128, tqw = t0 + 32 * qsub, tq = tqw + r32;
    const bf16_t* z = (const bf16_t*)(p->ws + OFF_Z);
    KVSrc src; src.k = (const char*)(z + (size_t)b * NS * ZW + C_KB + hd * 128); src.v = (const char*)(z + (size_t)b * NS * ZW + C_VB + hd * 128); src.kstride = ZW * 2; src.vstride = ZW * 2;
    const int kt1 = 2 * qt + 1;
    WaveAcc<128> a; acc_init(a);
    KVRing<2, 128> ring; ring.init(src, tid);
    const int nt = kt1 + 1;
    for (int j = 0; j < RING_AHEAD && j < nt; ++j) ring.issue((kt1 - j) * 64, j, lds);
    bf16x8 qf[5]; load_q(qf, z + ((size_t)b * NS + tq) * ZW + C_QB + hd * 128 + c * 64 + 8 * h, exp2f(-2.0f * (float)(hd + 1)), lane);
    asm volatile("" :: "v"(qf[0]), "v"(qf[1]), "v"(qf[2]), "v"(qf[3]));
    asm volatile(".p2align 8");
    for (int t = 0; t < nt; ++t) {
        const int kt = kt1 - t, buf = t & (RING_NB - 1);
        ring.wait_bar(nt - 1 - t);
        if (t + RING_AHEAD < nt) ring.issue((kt - RING_AHEAD) * 64, (t + RING_AHEAD) & (RING_NB - 1), lds);
        const unsigned char* kimg = ring.kimg(lds, buf, c); const unsigned char* vimg = ring.vimg(lds, buf);
#pragma unroll
        for (int sr = 0; sr < 2; ++sr) { const int sub = 1 - sr, key0 = kt * 64 + 32 * sub;
            if (key0 <= tqw + 31) {
                if (shadow && EXPER == 1) { }
                else attn_sub_auto<128>(qf, kimg, vimg, sub, key0, tqw, tq, h, 1 << 30, true, a, lane); } }
    }
    __syncthreads();
    const float lam_init = 0.8f - 0.6f * expf(-0.3f * (float)l);
    const float lam = ((const float*)p->ws)[CW_LAM + l];
    const float inv = 1.0f / swap_sum(a.l);
    float* ex = (float*)lds;
    if (c == 1) {
#pragma unroll
        for (int db = 0; db < 4; ++db)
#pragma unroll
            for (int r = 0; r < 16; ++r) ex[(qsub * 128 + db * 32 + crow(r, h)) * 32 + r32] = a.o[db][r] * inv;
    }
    __syncthreads();
    if (c == 0) {
        float ss = 0.f;
#pragma unroll
        for (int db = 0; db < 4; ++db)
#pragma unroll
            for (int r = 0; r < 16; ++r) { const float v = a.o[db][r] * inv - lam * ex[(qsub * 128 + db * 32 + crow(r, h)) * 32 + r32]; a.o[db][r] = v; ss += v * v; }
        ss = swap_sum(ss);
        const float rn = (1.0f - lam_init) / sqrtf(ss * (1.0f / 128.0f) + 1e-5f);
        const float* sg = p->diff_subln_g + (size_t)l * 128;
        bf16_t* orow = (shadow ? (bf16_t*)(p->ws + OFF_MSCR) : (bf16_t*)(p->ws + OFF_OABC) + (size_t)1 * NTOK * 512) + ((size_t)b * NS + tq) * 512 + hd * 128;
#pragma unroll
        for (int db = 0; db < 4; ++db)
#pragma unroll
            for (int rg = 0; rg < 4; ++rg) { const int d = db * 32 + 8 * rg + 4 * h; const f32x4 gv = *(const f32x4*)(sg + d);
                u32x2 w; w.x = cvt_pk_bf16(a.o[db][4 * rg] * rn * gv[0], a.o[db][4 * rg + 1] * rn * gv[1]); w.y = cvt_pk_bf16(a.o[db][4 * rg + 2] * rn * gv[2], a.o[db][4 * rg + 3] * rn * gv[3]);
                *(u32x2*)(orow + d) = w; }
    }
    __syncthreads();
}

#define AT_IMP   (AT_MISC)
#define AT_SELM  (AT_MISC + 34816)
__device__ __forceinline__ void attn_nsa_unit(KP p, int l, int b, int hkv, int qt, unsigned char* lds) {
    const int tid = hidden_tid(), lane = tid & 63, wv = __builtin_amdgcn_readfirstlane(tid >> 6), r32 = lane & 31, h = lane >> 5, g = wv & 3, qsub = wv >> 2;
    const int head = hkv * 4 + g, t0 = qt * 64, tqw = t0 + 32 * qsub, tq = tqw + r32;
    const bf16_t* z = (const bf16_t*)(p->ws + OFF_Z);
    bf16x8 qf[5]; load_q(qf, z + ((size_t)b * NS + tq) * ZW + C_QC + head * 64 + 8 * h, exp2f(-(float)(head + 1)), lane);
    float* imp = (float*)(lds + AT_IMP); unsigned* selm = (unsigned*)(lds + AT_SELM);
    KVRing<1, 64> ring;
    f32x16 ocmp[2];
    {
        const bf16_t* kvc = (const bf16_t*)(p->ws + OFF_KVC);
        KVSrc cs; cs.k = (const char*)(kvc + ((size_t)(0 * 16 + b) * 2 + hkv) * 128 * 64); cs.v = (const char*)(kvc + ((size_t)(1 * 16 + b) * 2 + hkv) * 128 * 64); cs.kstride = 128; cs.vstride = 128;
        ring.init(cs, tid); ring.issue(0, 0, lds); ring.issue(64, 1, lds);
        if (tid == 0) selm[64] = 0u;
        ring.wait_bar(0);
        f32x16 sc[4];
#pragma unroll
        for (int st = 0; st < 4; ++st) sc[st] = qk_sub(*(const bf16x8 (*)[4])&qf, ring.kimg(lds, st >> 1, 0), st & 1, lane);
        const int nvalid = tq >= 31 ? min(127, ((tq - 31) >> 4) + 1) : 0;
        float mx = -1e30f;
#pragma unroll
        for (int st = 0; st < 4; ++st)
#pragma unroll
            for (int r = 0; r < 16; ++r) { const int cidx = 32 * st + crow(r, h); const float v = cidx < nvalid ? sc[st][r] * LOG2E : -INFINITY; sc[st][r] = v; mx = fmaxf(mx, v); }
        mx = swap_max(mx);
        float ls = 0.f;
#pragma unroll
        for (int st = 0; st < 4; ++st)
#pragma unroll
            for (int r = 0; r < 16; ++r) { sc[st][r] = fast_exp2(sc[st][r] - mx); ls += sc[st][r]; }
        ls = swap_sum(ls); const float inv = ls > 0.f ? 1.0f / ls : 0.f;
        float Bv[4][4];
#pragma unroll
        for (int st = 0; st < 4; ++st)
#pragma unroll
            for (int r = 0; r < 16; ++r) sc[st][r] *= inv;
#pragma unroll
        for (int st = 0; st < 4; ++st)
#pragma unroll
            for (int g4 = 0; g4 < 4; ++g4) Bv[st][g4] = swap_other(sc[st][4 * g4 + 3], h);
#pragma unroll
        for (int st = 0; st < 4; ++st)
#pragma unroll
            for (int g4 = 0; g4 < 4; ++g4) {
                const float A = sc[st][4 * g4] + sc[st][4 * g4 + 1] + sc[st][4 * g4 + 2] + 0.5f * sc[st][4 * g4 + 3];
                const float prevlo = g4 > 0 ? Bv[st][g4 - 1] : (st > 0 ? Bv[st - 1][3] : 0.f);
                const float prev = h ? Bv[st][g4] : prevlo;
                imp[(g * 64 + qsub * 32 + r32) * 33 + 8 * st + 2 * g4 + h] = A + 0.5f * prev;
            }
#pragma unroll
        for (int d = 0; d < 2; ++d)
#pragma unroll
            for (int r = 0; r < 16; ++r) ocmp[d][r] = 0.f;
#pragma unroll
        for (int st = 0; st < 4; ++st) { VFrag<64> vf; v_read_all(vf, ring.vimg(lds, st >> 1), st & 1, lane); pv_sub<64>(sc[st], vf, ocmp); }
    }
    __syncthreads();
    const int cur = qt;
    for (int i = tid; i < 64 * 32; i += NTHREADS) { const int q = i >> 5, n = i & 31; imp[q * 33 + n] = (imp[q * 33 + n] + imp[(64 + q) * 33 + n]) + (imp[(128 + q) * 33 + n] + imp[(192 + q) * 33 + n]); }
    __syncthreads();
#pragma unroll 1
    for (int ps = 0; ps < 4; ++ps) {
        const int i = ps * NTHREADS + tid, q = i >> 5, n = i & 31;
        const bool forced = (n == 0) | (n == cur) | (n == cur - 1);
        const float kn = forced ? INFINITY : imp[q * 33 + n];
        int rank = 0;
#pragma unroll
        for (int m2 = 0; m2 < 32; ++m2) { const float km = __int_as_float(__builtin_amdgcn_ds_bpermute(((lane & 32) + m2) << 2, __float_as_int(kn)));
            rank += (m2 <= cur) && (m2 != n) && ((km > kn) || (km == kn && m2 < n)); }
        const bool sel = (n <= cur) && (rank < 16);
        const unsigned long long bal = __ballot(sel);
        if ((lane & 31) == 0) { const unsigned mk = (unsigned)(lane ? (bal >> 32) : bal); selm[q] = mk; atomicOr(&selm[64], mk); }
    }
    __syncthreads();
    const unsigned mymask = selm[qsub * 32 + r32]; unsigned um = __builtin_amdgcn_readfirstlane(selm[64]);
    WaveAcc<64> a; acc_init(a);
    {
        KVSrc src; src.k = (const char*)(z + (size_t)b * NS * ZW + C_KSL + hkv * 64); src.v = (const char*)(z + (size_t)b * NS * ZW + C_VSL + hkv * 64); src.kstride = ZW * 2; src.vstride = ZW * 2;
        ring.init(src, tid);
        unsigned m_issue = um; int nis = 0, ncp = 0; const int ntl = __popc(um);
        for (int j = 0; j < RING_AHEAD && m_issue; ++j) { const int kt = 31 - __clz((int)m_issue); m_issue &= ~(1u << kt); ring.issue(kt * 64, nis & (RING_NB - 1), lds); ++nis; }
    asm volatile(".p2align 8");
        while (um) {
            const int kt = 31 - __clz((int)um); um &= ~(1u << kt); const int buf = ncp & (RING_NB - 1);
            ring.wait_bar(nis - 1 - ncp);
            if (m_issue) { const int ktn = 31 - __clz((int)m_issue); m_issue &= ~(1u << ktn); ring.issue(ktn * 64, nis & (RING_NB - 1), lds); ++nis; }
            const bool lbit = (mymask >> kt) & 1u;
            if (__any(lbit)) {
                const unsigned char* kimg = ring.kimg(lds, buf, 0); const unsigned char* vimg = ring.vimg(lds, buf);
#pragma unroll
                for (int sr = 0; sr < 2; ++sr) { const int sub = 1 - sr, key0 = kt * 64 + 32 * sub;
                    if (key0 <= tqw + 31) attn_sub_auto<64>(qf, kimg, vimg, sub, key0, tqw, tq, h, 1 << 30, lbit, a, lane); }
            }
            ++ncp;
        }
        (void)ntl;
    }
    {
        const size_t tok = (size_t)b * NS + tq;
        const bf16_t* gp = z + tok * ZW + C_GN + head * 3;
        const float gc = bf2f(gp[0]), gs = bf2f(gp[1]) / swap_sum(a.l), gw = bf2f(gp[2]);
        const bf16_t* ow = (const bf16_t*)(p->ws + OFF_OWIN) + tok * 512 + head * 64;
        bf16_t* oc = (bf16_t*)(p->ws + OFF_OABC) + (size_t)2 * NTOK * 512 + tok * 512 + head * 64;
#pragma unroll
        for (int db = 0; db < 2; ++db)
#pragma unroll
            for (int rg = 0; rg < 4; ++rg) { const int d = db * 32 + 8 * rg + 4 * h; const u32x2 wv2 = *(const u32x2*)(ow + d);
                const float o0 = gc * ocmp[db][4 * rg] + gs * a.o[db][4 * rg] + gw * bflo(wv2.x), o1 = gc * ocmp[db][4 * rg + 1] + gs * a.o[db][4 * rg + 1] + gw * bfhi(wv2.x);
                const float o2 = gc * ocmp[db][4 * rg + 2] + gs * a.o[db][4 * rg + 2] + gw * bflo(wv2.y), o3 = gc * ocmp[db][4 * rg + 3] + gs * a.o[db][4 * rg + 3] + gw * bfhi(wv2.y);
                u32x2 w; w.x = cvt_pk_bf16(o0, o1); w.y = cvt_pk_bf16(o2, o3); *(u32x2*)(oc + d) = w; }
    }
    __syncthreads();
}

__device__ __forceinline__ void compress_unit(KP p, int l, int u, unsigned char* lds) {
    char* ws = p->ws;
    const int kv = u >> 4, rt = u & 15;
    GemmOperands g; g.Abase = ws + OFF_Z; g.kstride = ZW * 2; g.K = 2048; g.Bbase = ws + OFF_WC1 + ((size_t)(l * 2 + kv) * 256) * 2048 * 2;
GEMM_STAGE_IDS();
#pragma unroll
    for (int i = 0; i < 4; ++i) { const int row = rt * 256 + TILE_ROW(i), bh = row >> 7, b = bh >> 1, hk = bh & 1; int c = row & 127; c = c > 126 ? 126 : c;
        g.aoff[i] = (unsigned)((((size_t)b * NS + 16 * c) * ZW + (kv ? C_VCM : C_KCM) + hk * 64 + cS) * 2); } g.boff = (unsigned)((rS * 2048 + cS) * 2);
    f32x4 acc[2][2][4][2];
    gemm_unit(g, (bf16_t*)lds, acc);
    GEMM_LANE_IDS();
    const float* cb = (const float*)(ws + OFF_CBIAS) + (size_t)(l * 2 + kv) * 4 * 256; const float* cb1 = p->cmp_b1 + (l * 2 + kv) * 256;
#pragma unroll
    for (int bj = 0; bj < 2; ++bj)
#pragma unroll
        for (int n = 0; n < 2; ++n) { const int col = bj * 128 + wc * 32 + n * 16 + fq * 4; const f32x4 bv = (*(const f32x4*)(cb + col) + *(const f32x4*)(cb + 256 + col)) + (*(const f32x4*)(cb + 512 + col) + *(const f32x4*)(cb + 768 + col)) + *(const f32x4*)(cb1 + col);
#pragma unroll
            for (int ai = 0; ai < 2; ++ai)
#pragma unroll
                for (int m = 0; m < 4; ++m) { const int row = ai * 128 + wr * 64 + m * 16 + fr; f32x4 v = acc[ai][bj][m][n] + bv;
#pragma unroll
                    for (int j = 0; j < 4; ++j) { const float x = v[j]; v[j] = x * sigmoidf_(1.5957691216057308f * (x + 0.044715f * x * x * x)); }
                    u32x2 w; w.x = cvt_pk_bf16(v[0], v[1]); w.y = cvt_pk_bf16(v[2], v[3]); *(u32x2*)(lds + row * 528 + col * 2) = w; } }
    __syncthreads();
    {
        const bf16_t* w2 = (const bf16_t*)(ws + OFF_WC2) + (size_t)(l * 2 + kv) * 64 * 256;
        f32x4 c2[2][4];
#pragma unroll
        for (int mt = 0; mt < 2; ++mt)
#pragma unroll
            for (int nt = 0; nt < 4; ++nt) c2[mt][nt] = (f32x4){0.f, 0.f, 0.f, 0.f};
#pragma unroll
        for (int ks = 0; ks < 8; ++ks) {
            bf16x8 af[2], bfr[4];
#pragma unroll
            for (int mt = 0; mt < 2; ++mt) af[mt] = *(const bf16x8*)(lds + (wid * 32 + mt * 16 + fr) * 528 + (ks * 32 + fq * 8) * 2);
#pragma unroll
            for (int nt = 0; nt < 4; ++nt) bfr[nt] = *(const bf16x8*)(w2 + (size_t)(nt * 16 + fr) * 256 + ks * 32 + fq * 8);
#pragma unroll
            for (int mt = 0; mt < 2; ++mt)
#pragma unroll
                for (int nt = 0; nt < 4; ++nt) c2[mt][nt] = __builtin_amdgcn_mfma_f32_16x16x32_bf16(af[mt], bfr[nt], c2[mt][nt], 0, 0, 0);
        }
        bf16_t* kvc = (bf16_t*)(ws + OFF_KVC) + (size_t)kv * 16 * 2 * 128 * 64;
        const float* b2 = p->cmp_b2 + (l * 2 + kv) * 64;
#pragma unroll
        for (int mt = 0; mt < 2; ++mt)
#pragma unroll
            for (int nt = 0; nt < 4; ++nt)
#pragma unroll
                for (int r = 0; r < 4; ++r) { const int row = rt * 256 + wid * 32 + mt * 16 + 4 * fq + r, col = nt * 16 + fr;
                    kvc[(size_t)row * 64 + col] = f2bf(c2[mt][nt][r] + b2[col]); }
    }
    __syncthreads();
}

#define RT_HS    0
#define RT_LG    132096
#define RT_HIST  (RT_LG + 8448)
#ifndef REPN2
#define REPN2 1
#endif
__device__ __forceinline__ void phase_norm2_router(KP p, int l, unsigned char* lds) {
  for (int shadow = 0; shadow < REPN2; ++shadow) {
    char* ws = p->ws; const int tid = hidden_tid(), lane = tid & 63, wv = __builtin_amdgcn_readfirstlane(tid >> 6);
    const float* modl = (const float*)(ws + OFF_MOD) + (size_t)l * 16 * 6144; const float* g = p->norm2_g + (size_t)l * 1024;
    const float* xin = p->x; bf16_t* xrb = (bf16_t*)(ws + OFF_XR); const bf16_t* dl = (const bf16_t*)(ws + OFF_DELTA); bf16_t* hb = (bf16_t*)(ws + OFF_HB);
    float* LG = (float*)(lds + RT_LG); int* hist = (int*)(lds + RT_HIST); int* basep = hist + 32;
    unsigned* ctrl = (unsigned*)ws;
    const bf16_t* wrt = (const bf16_t*)(ws + OFF_WRT) + (size_t)l * 2 * 32 * 1024;
    for (int chunk = hidden_bid(); chunk < NTOK / 64; chunk += gridDim.x) {
        if (tid < 32) hist[tid] = 0;
        {
            const int rowa = chunk * 64 + wv * 8, b = rowa >> 11;
            f32x4 gg[4], sc[4], sh[4], xn[4]; u32x2 dn[4];
#pragma unroll
            for (int j = 0; j < 4; ++j) { const int col = 256 * j + 4 * lane; gg[j] = *(const f32x4*)(g + col); sc[j] = *(const f32x4*)(modl + (size_t)b * 6144 + 4096 + col); sh[j] = *(const f32x4*)(modl + (size_t)b * 6144 + 3072 + col);
                if (l == 0) xn[j] = *(const f32x4*)(xin + (size_t)rowa * 1024 + col); else { const u32x2 xw = *(const u32x2*)(xrb + (size_t)rowa * 1024 + col); xn[j] = (f32x4){bflo(xw.x), bfhi(xw.x), bflo(xw.y), bfhi(xw.y)}; }
                dn[j] = *(const u32x2*)(dl + (size_t)rowa * 1024 + col); }
            for (int i = 0; i < 8; ++i) {
                const int rl = wv * 8 + i, row = rowa + i;
                f32x4 v[4]; float ss = 0.f;
#pragma unroll
                for (int j = 0; j < 4; ++j) { v[j] = xn[j] + (f32x4){bflo(dn[j].x), bfhi(dn[j].x), bflo(dn[j].y), bfhi(dn[j].y)};
                    ss += v[j][0] * v[j][0] + v[j][1] * v[j][1] + v[j][2] * v[j][2] + v[j][3] * v[j][3]; }
                if (i + 1 < 8) {
#pragma unroll
                    for (int j = 0; j < 4; ++j) { const int col = 256 * j + 4 * lane;
                        if (l == 0) xn[j] = *(const f32x4*)(xin + (size_t)(row + 1) * 1024 + col); else { const u32x2 xw = *(const u32x2*)(xrb + (size_t)(row + 1) * 1024 + col); xn[j] = (f32x4){bflo(xw.x), bfhi(xw.x), bflo(xw.y), bfhi(xw.y)}; }
                        dn[j] = *(const u32x2*)(dl + (size_t)(row + 1) * 1024 + col); } }
                ss = wave_sum(ss, lane); const float r = 1.0f / sqrtf(ss * (1.0f / 1024.0f) + 1e-5f);
#pragma unroll
                for (int j = 0; j < 4; ++j) { const int col = 256 * j + 4 * lane;
                    if (!shadow) { u32x2 xw; xw.x = cvt_pk_bf16(v[j][0], v[j][1]); xw.y = cvt_pk_bf16(v[j][2], v[j][3]); *(u32x2*)(xrb + (size_t)row * 1024 + col) = xw; }
                    float o[4];
#pragma unroll
                    for (int q = 0; q < 4; ++q) o[q] = v[j][q] * r * gg[j][q] * (1.0f + sc[j][q]) + sh[j][q];
                    u32x2 w; w.x = cvt_pk_bf16(o[0], o[1]); w.y = cvt_pk_bf16(o[2], o[3]);
                    if (!shadow) *(unsigned*)((unsigned char*)(ws + OFF_H8) + (size_t)row * 1024 + col) = pk4_fp8(o[0], o[1], o[2], o[3]);
                    *(u32x2*)(lds + RT_HS + rl * 2064 + col * 2) = w; }
            }
        }
        __syncthreads();
        {
            const int mt = wv & 3, nt = wv >> 2, fr = lane & 15, fq = lane >> 4;
            f32x4 acc = (f32x4){0.f, 0.f, 0.f, 0.f};
            const bf16_t* wh = wrt + (size_t)(nt * 16 + fr) * 1024 + fq * 8; const bf16_t* wl = wh + 32 * 1024;
            const unsigned char* ap = lds + RT_HS + (mt * 16 + fr) * 2064 + fq * 16;
#pragma unroll 4
            for (int ks = 0; ks < 32; ++ks) { const bf16x8 a = *(const bf16x8*)(ap + ks * 64); const bf16x8 bh = *(const bf16x8*)(wh + ks * 32), bl = *(const bf16x8*)(wl + ks * 32);
                acc = __builtin_amdgcn_mfma_f32_16x16x32_bf16(a, bh, acc, 0, 0, 0); acc = __builtin_amdgcn_mfma_f32_16x16x32_bf16(a, bl, acc, 0, 0, 0); }
            const float rb = p->router_b[l * 32 + nt * 16 + fr];
#pragma unroll
            for (int r = 0; r < 4; ++r) LG[(mt * 16 + 4 * fq + r) * 33 + nt * 16 + fr] = acc[r] + rb;
        }
        __syncthreads();
        int se[4], sp[4]; float sg[4];
        if (tid < 64) {
            unsigned taken = 0u; float tv[4];
#pragma unroll
            for (int k = 0; k < 4; ++k) { float best = -INFINITY; int bi = 0;
#pragma unroll 4
                for (int e = 0; e < 32; ++e) { const float v = LG[tid * 33 + e]; if (!((taken >> e) & 1u) && v > best) { best = v; bi = e; } }
                taken |= 1u << bi; se[k] = bi; tv[k] = best; }
            float den = 0.f;
#pragma unroll
            for (int k = 0; k < 4; ++k) { sg[k] = __expf(tv[k] - tv[0]); den += sg[k]; }
#pragma unroll
            for (int k = 0; k < 4; ++k) { sg[k] /= den; sp[k] = atomicAdd(&hist[se[k]], 1); }
        }
        __syncthreads();
        if (tid < 32) { const int c = hist[tid]; basep[tid] = (c && !shadow) ? (int)atomicAdd(&ctrl[CW_ECNT(l, tid)], (unsigned)c) : 0; }
        __syncthreads();
        if (tid < 64 && !shadow) { const int tok = chunk * 64 + tid;
#pragma unroll
            for (int k = 0; k < 4; ++k) { const int pos = basep[se[k]] + sp[k];
                ((int*)(ws + OFF_TOKE))[tok * 4 + k] = se[k]; ((int*)(ws + OFF_TOKP))[tok * 4 + k] = pos; ((float*)(ws + OFF_TOKG))[tok * 4 + k] = sg[k];
                ((int*)(ws + OFF_BUCK))[(size_t)se[k] * NTOK + pos] = tok; } }
        __syncthreads();
    }
}
  __syncthreads(); }


__device__ __forceinline__ void phase_combine(KP p, int l, unsigned char* lds) {
    char* ws = p->ws; const int tid = hidden_tid(), lane = tid & 63, wv = tid >> 6;
    int* tbl = (int*)lds; moe_tables(p, l, tbl);
    bf16_t* xr = (bf16_t*)(ws + OFF_XR); const bf16_t* y = (const bf16_t*)(ws + OFF_Y); bf16_t* hb = (bf16_t*)(ws + OFF_HB);
    const bool last = (l + 1 == NLAYER);
    for (int gw = hidden_bid() * 8 + wv; gw < NTOK / 16; gw += gridDim.x * 8) {
        const int row0 = gw * 16, b = row0 >> 11;
        const float* modl = (const float*)(ws + OFF_MOD) + ((size_t)l * 16 + b) * 6144;
        const float* gn = last ? p->final_g : p->norm1_g + (size_t)(l + 1) * 1024;
        const float* modn = (const float*)(ws + OFF_MOD) + ((size_t)(last ? l : l + 1) * 16 + b) * 6144;
        f32x4 g2[4], gg[4], sc[4], sh[4];
#pragma unroll
        for (int j = 0; j < 4; ++j) { const int col = 256 * j + 4 * lane; g2[j] = *(const f32x4*)(modl + 5120 + col); gg[j] = *(const f32x4*)(gn + col);
            sc[j] = last ? (f32x4){0.f, 0.f, 0.f, 0.f} : *(const f32x4*)(modn + 1024 + col); sh[j] = last ? (f32x4){0.f, 0.f, 0.f, 0.f} : *(const f32x4*)(modn + col); }
        typedef int i32x4_ __attribute__((ext_vector_type(4)));
        i32x4_ te = *(const i32x4_*)((const int*)(ws + OFF_TOKE) + (size_t)row0 * 4), tp = *(const i32x4_*)((const int*)(ws + OFF_TOKP) + (size_t)row0 * 4);
        f32x4 tg = *(const f32x4*)((const float*)(ws + OFF_TOKG) + (size_t)row0 * 4);
        u32x2 xin[4]; u32x2 yin[4][4]; float gk[4];
        auto load_row = [&](int row, const i32x4_& e4, const i32x4_& p4, const f32x4& g4) {
#pragma unroll
            for (int k = 0; k < 4; ++k) { const bf16_t* yr = y + ((size_t)tbl[e4[k]] * 256 + p4[k]) * 1024; gk[k] = g4[k];
#pragma unroll
                for (int j = 0; j < 4; ++j) yin[k][j] = *(const u32x2*)(yr + 256 * j + 4 * lane); }
#pragma unroll
            for (int j = 0; j < 4; ++j) xin[j] = *(const u32x2*)(xr + (size_t)row * 1024 + 256 * j + 4 * lane);
        };
        load_row(row0, te, tp, tg);
        if (16 > 1) { te = *(const i32x4_*)((const int*)(ws + OFF_TOKE) + (size_t)(row0 + 1) * 4); tp = *(const i32x4_*)((const int*)(ws + OFF_TOKP) + (size_t)(row0 + 1) * 4); tg = *(const f32x4*)((const float*)(ws + OFF_TOKG) + (size_t)(row0 + 1) * 4); }
        for (int i = 0; i < 16; ++i) {
            const int row = row0 + i;
            f32x4 v[4]; float ss = 0.f;
#pragma unroll
            for (int j = 0; j < 4; ++j) { f32x4 m = (f32x4){0.f, 0.f, 0.f, 0.f};
#pragma unroll
                for (int k = 0; k < 4; ++k) { const u32x2 w = yin[k][j]; m[0] += gk[k] * bflo(w.x); m[1] += gk[k] * bfhi(w.x); m[2] += gk[k] * bflo(w.y); m[3] += gk[k] * bfhi(w.y); }
                v[j] = (f32x4){bflo(xin[j].x), bfhi(xin[j].x), bflo(xin[j].y), bfhi(xin[j].y)} + g2[j] * m;
                ss += v[j][0] * v[j][0] + v[j][1] * v[j][1] + v[j][2] * v[j][2] + v[j][3] * v[j][3]; }
            if (i + 1 < 16) { load_row(row + 1, te, tp, tg);
                if (i + 2 < 16) { te = *(const i32x4_*)((const int*)(ws + OFF_TOKE) + (size_t)(row + 2) * 4); tp = *(const i32x4_*)((const int*)(ws + OFF_TOKP) + (size_t)(row + 2) * 4); tg = *(const f32x4*)((const float*)(ws + OFF_TOKG) + (size_t)(row + 2) * 4); } }
            ss = wave_sum(ss, lane); const float r = 1.0f / sqrtf(ss * (1.0f / 1024.0f) + 1e-5f);
#pragma unroll
            for (int j = 0; j < 4; ++j) { const int col = 256 * j + 4 * lane;
                if (last) { *(f32x4*)(p->out + (size_t)row * 1024 + col) = v[j] * r * gg[j]; }
                else { u32x2 xw; xw.x = cvt_pk_bf16(v[j][0], v[j][1]); xw.y = cvt_pk_bf16(v[j][2], v[j][3]); *(u32x2*)(xr + (size_t)row * 1024 + col) = xw; float o[4];
#pragma unroll
                    for (int q = 0; q < 4; ++q) o[q] = v[j][q] * r * gg[j][q] * (1.0f + sc[j][q]) + sh[j][q];
#if INPROJ_FP8
                    *(unsigned*)((unsigned char*)hb + (size_t)row * 1024 + col) = pk4_fp8(o[0], o[1], o[2], o[3]); }
#else
                    u32x2 w; w.x = cvt_pk_bf16(o[0], o[1]); w.y = cvt_pk_bf16(o[2], o[3]); *(u32x2*)(hb + (size_t)row * 1024 + col) = w; }
#endif
            }
        }
    }
}

#ifndef SWA_IN_AT2
#define SWA_IN_AT2 1
#endif
#define LDS_QSLOT (LDS_BYTES - 64)
#define LDS_BARW  (LDS_BYTES - 16)
__device__ __forceinline__ int q_next(unsigned* ctr, unsigned char* lds) {
    __syncthreads();
    if (hidden_tid() == 0) *(int*)(lds + LDS_QSLOT) = (int)__hip_atomic_fetch_add(ctr, 1u, __ATOMIC_RELAXED, __HIP_MEMORY_SCOPE_AGENT);
    __syncthreads();
    return __builtin_amdgcn_readfirstlane(*(int*)(lds + LDS_QSLOT));
}
__device__ __forceinline__ void phase_at1(KP p, int lq, unsigned char* lds) {
    unsigned* ctrl = (unsigned*)p->ws; const int l = lq & 1;
#ifndef SUB
#define SUB -1
#endif
#ifndef DBLSUB
#define DBLSUB -1
#endif
#ifndef REP0
#define REP0 1
#endif
#ifndef REP1
#define REP1 1
#endif
#ifndef REP2
#define REP2 1
#endif
#ifndef REP3
#define REP3 1
#endif
#ifndef REP4
#define REP4 1
#endif
#define SUBON(k) ((SUB < 0 || SUB == (k)) && (lq < 2 || DBLSUB < 0 || DBLSUB == (k)))
    if (SUBON(0)) for (int rep = 0; rep < REP0; ++rep) for (;;) { const int u = q_next(ctrl + CW_QCTR(lq + 2 * rep, 0), lds); if (u >= 32) break; compress_unit(p, l, u, lds); }
    if (SUBON(1)) for (int rep = 0; rep < REP1; ++rep) for (;;) { const int u = q_next(ctrl + CW_QCTR(lq + 2 * rep, 1), lds); if (u >= 1024) break; attn_diff_unit(p, l, (u & 63) >> 2, u & 3, 15 - (u >> 6), lds, rep); if (COSCHED && rep == 0) xpose8_group(p, l, u, lds); }
    if (SUBON(2)) for (int rep = 0; rep < REP2; ++rep) for (;;) { const int u = q_next(ctrl + CW_QCTR(lq + 2 * rep, 2), lds); if (u >= 1024) break;
        attn_window_unit<false>(p, l, (u & 31) >> 1, u & 1, 31 - (u >> 5), 512, C_QC, C_KWN, C_VWN, (bf16_t*)(p->ws + OFF_OWIN), lds); if (COSCHED && rep == 0) xpose8_group(p, l, 1024 + u, lds); }
#if !SWA_IN_AT2
    if (SUBON(3)) for (int rep = 0; rep < REP3; ++rep) for (;;) { const int u = q_next(ctrl + CW_QCTR(lq + 2 * rep, 3), lds); if (u >= 1024) break;
        attn_window_unit<true>(p, l, (u & 31) >> 1, u & 1, 31 - (u >> 5), 128, C_QA, C_KA, C_VA, (bf16_t*)(p->ws + OFF_OABC), lds); if (COSCHED && rep == 0) xpose8_group(p, l, 2048 + u, lds); }
#endif
}
__device__ __forceinline__ void phase_at2(KP p, int lq, unsigned char* lds) {
    unsigned* ctrl = (unsigned*)p->ws; const int l = lq & 1;
    for (int rep = 0; rep < REP4; ++rep) for (;;) { const int u = q_next(ctrl + CW_QCTR(lq + 2 * rep, 4), lds); if (u >= 1024) break; attn_nsa_unit(p, l, (u & 31) >> 1, u & 1, 31 - (u >> 5), lds); }
#if SWA_IN_AT2
    for (int rep = 0; rep < REP3; ++rep) for (;;) { const int u = q_next(ctrl + CW_QCTR(lq + 2 * rep, 3), lds); if (u >= 1024) break;
        attn_window_unit<true>(p, l, (u & 31) >> 1, u & 1, 31 - (u >> 5), 128, C_QA, C_KA, C_VA, (bf16_t*)(p->ws + OFF_OABC), lds); if (COSCHED && rep == 0) xpose8_group(p, l, 2048 + u, lds); }
#endif
}

#define NPHASE 20
__global__ void __launch_bounds__(NTHREADS, 2) mega(Params pv_unused) {
    KP p0 = (KP)__builtin_amdgcn_kernarg_segment_ptr();
    extern __shared__ __attribute__((aligned(16))) unsigned char lds0[];
    volatile LAS unsigned* st = (volatile LAS unsigned*)(lds0 + LDS_BARW);
    if (hidden_tid() == 0) { st[0] = 0u; st[1] = 0u; st[2] = 0u; st[3] = 0u; }
    __syncthreads();
    XcdBarrier bar = xcd_barrier_post((unsigned*)p0->ws, st);
    int ph = 0;
#ifndef DBL
#define DBL -1
#endif
    int qrep = 0; (void)qrep;
#define PHASE(body) { KP p = p0; asm volatile("" : "+s"(p)); unsigned char* lds = lds0; (void)lds; if (ph >= p->ph_lo && ph <= p->ph_hi) { body; if (ph < p->ph_hi) xcd_barrier(bar); } ++ph; }
#ifndef ONLY
#define ONLY -1
#endif
#ifndef DBLL
#define DBLL -1
#endif
    int lcur = -1; (void)lcur;
#define SEL(n, body) { if (ONLY < 0 || ONLY == (n)) { body; if (DBL == (n) && (DBLL < 0 || DBLL == lcur)) { xcd_barrier(bar); qrep = 2; body; qrep = 0; } } }
    PHASE(SEL(0, phase_prologue(p, lds)));
    PHASE(SEL(1, phase_norm_mod(p->x, p->norm1_g, (const float*)(p->ws + OFF_MOD), 0, 1024, (bf16_t*)(p->ws + OFF_HB))));
#pragma unroll
    for (int l = 0; l < NLAYER; ++l) { lcur = l;
        PHASE(SEL(2, phase_inproj(p, l, lds)));
        PHASE(SEL(3, phase_at1(p, l + qrep, lds)));
        PHASE(SEL(4, phase_at2(p, l + qrep, lds)));
        PHASE(SEL(5, phase_merge(p, l, lds)));
        PHASE(SEL(6, phase_outproj(p, l, lds)));
        PHASE(SEL(7, phase_norm2_router(p, l, lds)));
        PHASE(SEL(8, phase_moe1(p, l, lds)));
        PHASE(SEL(9, phase_moe2(p, l, lds)));
        PHASE(SEL(10, phase_combine(p, l, lds)));
    }
}

#ifndef MK_LAUNCHES
#define MK_LAUNCHES 1
#endif
extern "C" void kernel_launch(void* const* d_in, const int* in_sizes, int n_in, void* d_out, int out_size, void* d_ws, size_t ws_size, hipStream_t stream) {
    if (ws_size < WS_NEED) { fprintf(stderr, "workspace too small: %zu < %zu\n", ws_size, (size_t)WS_NEED); return; }
    static bool attr_done = false;
    if (!attr_done) { hipFuncSetAttribute((const void*)mega, hipFuncAttributeMaxDynamicSharedMemorySize, LDS_BYTES); attr_done = true; }
    Params p{};
    const float** f = (const float**)&p;
    for (int i = 0; i < 25; ++i) f[i] = (const float*)d_in[i];
    p.out = (float*)d_out; p.ws = (char*)d_ws;
    hipMemsetAsync(d_ws, 0, SZ_CTRL, stream);
    int dev = 0, cus = 0; hipGetDevice(&dev); hipDeviceGetAttribute(&cus, hipDeviceAttributeMultiprocessorCount, dev);
    const int grid = cus > 0 ? cus : 256;
#if MK_LAUNCHES == 1
    p.ph_lo = 0; p.ph_hi = NPHASE - 1;
    hipLaunchKernelGGL(mega, dim3(grid), dim3(NTHREADS), LDS_BYTES, stream, p);
#else
    for (int k = 0; k < NPHASE; ++k) { p.ph_lo = k; p.ph_hi = k; hipLaunchKernelGGL(mega, dim3(grid), dim3(NTHREADS), LDS_BYTES, stream, p); }
#endif
}
```

```cpp
#include <hip/hip_runtime.h>
#include <stdint.h>
#include <stdio.h>

#define NB      16
#define NS      2048
#define NTOK    (NB * NS)
#define DM      1024
#define NLAYER  2
#define ZW      6912
#define INW     6680
#define C_QA   0
#define C_KA   512
#define C_VA   640
#define C_QB   768
#define C_KB   1280
#define C_VB   1792
#define C_QC   2304
#define C_KCM  2816
#define C_VCM  2944
#define C_KSL  3072
#define C_VSL  3200
#define C_KWN  3328
#define C_VWN  3456
#define C_GM   3584
#define C_GN   6656
#define NEXP   32
#define PMAX   (NTOK * 4 + NEXP * 256)
#define NCMP   127

typedef unsigned short bf16_t;
typedef short bf16x8 __attribute__((ext_vector_type(8)));
typedef short bf16x4 __attribute__((ext_vector_type(4)));
typedef float f32x4 __attribute__((ext_vector_type(4)));
typedef float f32x2 __attribute__((ext_vector_type(2)));
typedef float f32x16 __attribute__((ext_vector_type(16)));
typedef unsigned u32x4 __attribute__((ext_vector_type(4)));
typedef unsigned u32x2 __attribute__((ext_vector_type(2)));

#define LAS __attribute__((address_space(3)))
#define NTHREADS 512
#define LDS_BYTES (160 * 1024)

__device__ __forceinline__ unsigned cvt_pk_bf16(float lo, float hi) { unsigned r; asm volatile("v_cvt_pk_bf16_f32 %0, %1, %2" : "=v"(r) : "v"(lo), "v"(hi)); return r; }
__device__ __forceinline__ bf16_t f2bf(float f) { return (bf16_t)(cvt_pk_bf16(f, 0.f) & 0xffffu); }
__device__ __forceinline__ float bf2f(bf16_t b) { return __uint_as_float(((unsigned)b) << 16); }
__device__ __forceinline__ float bflo(unsigned w) { return __uint_as_float(w << 16); }
__device__ __forceinline__ float bfhi(unsigned w) { return __uint_as_float(w & 0xffff0000u); }
#define LOG2E 1.4426950408889634f
__device__ __forceinline__ float fast_exp2(float x) { return __builtin_amdgcn_exp2f(x); }
__device__ __forceinline__ float fast_rcp(float x) { return __builtin_amdgcn_rcpf(x); }
__device__ __forceinline__ float sigmoidf_(float x) { return fast_rcp(1.0f + fast_exp2(-1.4426950408889634f * x)); }

__device__ __forceinline__ unsigned hidden_bid() { unsigned b = blockIdx.x; asm volatile("" : "+s"(b)); return b; }
__device__ __forceinline__ int hidden_tid() { int t = threadIdx.x; asm volatile("" : "+v"(t)); return t; }

#define XB_TMO      128
#define XB_XCNT(j)  (256  + 64 * (j))
#define XB_XSUB(j)  (1280 + 64 * (j))
#define XB_XGEN(j)  (2304 + 64 * (j))
#define XB_TOP      3328
#define XB_TOPGEN   3392
#define XCD_BAR_WORDS 3456
#define XB_SPIN_CAP (1u << 24)

__device__ __forceinline__ unsigned xb_ld(unsigned* p)              { return __hip_atomic_load(p, __ATOMIC_RELAXED, __HIP_MEMORY_SCOPE_AGENT); }
__device__ __forceinline__ unsigned xb_add(unsigned* p, unsigned v) { return __hip_atomic_fetch_add(p, v, __ATOMIC_RELAXED, __HIP_MEMORY_SCOPE_AGENT); }
__device__ __forceinline__ unsigned xb_xcc_id() { return (unsigned)__builtin_amdgcn_s_getreg((3 << 11) | 20) & 0xFu; }
#define XB_SPIN(cond, bar) do { unsigned _sp = 0; while (cond) { __builtin_amdgcn_s_sleep(1); \
    if ((++_sp & 255u) == 0u) { if (xb_ld(&(bar)[XB_TMO])) break; if (_sp > XB_SPIN_CAP) { atomicAdd(&(bar)[XB_TMO], 1u); break; } } } } while (0)

struct XcdBarrier { unsigned* bar; unsigned x; volatile LAS unsigned* st; };

__device__ __forceinline__ XcdBarrier xcd_barrier_post(unsigned* bar, volatile LAS unsigned* st) {
    XcdBarrier b; b.bar = bar; b.x = xb_xcc_id(); b.st = st;
    if (hidden_tid() == 0) (void)xb_add(&bar[XB_XCNT(b.x)], 1u);
    return b;
}
__device__ __forceinline__ void xcd_barrier_complete(unsigned* bar, unsigned x, unsigned& nloc, unsigned& nx) {
    const unsigned G = gridDim.x * gridDim.y * gridDim.z;
    unsigned sum, cnt, mine, sp = 0u;
    for (;;) {
        sum = 0u; cnt = 0u; mine = 0u;
#pragma unroll
        for (unsigned j = 0; j < 16; ++j) { const unsigned c = xb_ld(&bar[XB_XCNT(j)]); sum += c; cnt += (c > 0u) ? 1u : 0u; mine = (j == x) ? c : mine; }
        if (sum == G) break;
        __builtin_amdgcn_s_sleep(1);
        if ((++sp & 255u) == 0u) { if (xb_ld(&bar[XB_TMO])) break; if (sp > XB_SPIN_CAP) { atomicAdd(&bar[XB_TMO], 1u); break; } }
    }
    nloc = mine > 0u ? mine : 1u; nx = cnt > 0u ? cnt : 1u;
}
__device__ __forceinline__ void xcd_barrier(const XcdBarrier& b) {
    asm volatile("s_waitcnt vmcnt(0)" ::: "memory");
    __syncthreads();
    if (hidden_tid() == 0) {
        unsigned* bar = b.bar;
        __builtin_amdgcn_s_waitcnt(0);
        unsigned nloc = b.st[0], nx = b.st[1];
        if (nloc == 0u) { xcd_barrier_complete(bar, b.x, nloc, nx); b.st[0] = nloc; b.st[1] = nx; }
        const unsigned old = xb_add(&bar[XB_XSUB(b.x)], 1u);
        const unsigned gen = old / nloc;
        if (old + 1u == (gen + 1u) * nloc) {
            __builtin_amdgcn_fence(__ATOMIC_RELEASE, "agent");
            asm volatile("s_waitcnt vmcnt(0)" ::: "memory");
            const unsigned og = xb_add(&bar[XB_TOP], 1u);
            const unsigned tg = og / nx;
            if (og + 1u == (tg + 1u) * nx) xb_add(&bar[XB_TOPGEN], 1u);
            else XB_SPIN(xb_ld(&bar[XB_TOPGEN]) == tg, bar);
            __builtin_amdgcn_fence(__ATOMIC_ACQUIRE, "agent");
            xb_add(&bar[XB_XGEN(b.x)], 1u);
            asm volatile("s_waitcnt vmcnt(0)" ::: "memory");
        } else {
            XB_SPIN(xb_ld(&bar[XB_XGEN(b.x)]) == gen, bar);
            __builtin_amdgcn_fence(__ATOMIC_ACQUIRE, "agent");
            asm volatile("s_waitcnt vmcnt(0)" ::: "memory");
        }
    }
    __syncthreads();
}

constexpr int BM = 256, BK = 64, HALF = 128, HT = HALF * BK;

__device__ __forceinline__ int lds_byte(int r, int c) { int st = (r >> 4) * 2 + (c >> 5), rr = r & 15, cc = c & 31, ob = rr * 64 + cc * 2; return st * 1024 + (ob ^ (((ob >> 9) & 1) << 5)); }
__device__ __forceinline__ void stage_rc(int b, int& R, int& C) { int st = b / 1024, sb = b % 1024, swz = sb ^ (((sb >> 9) & 1) << 5); R = (st >> 1) * 16 + swz / 64; C = (st & 1) * 32 + (swz % 64) / 2; }

struct GemmOperands {
    const char* Abase; unsigned aoff[4]; unsigned kstride;
    const char* Bbase; unsigned boff; int K;
};

__device__ __forceinline__ void gemm_unit(const GemmOperands& g, bf16_t* shm, f32x4 (&acc)[2][2][4][2]) {
#define SA(b,h) (shm + ((b) * 2 + (h)) * HT)
#define SB(b,h) (shm + (4 + (b) * 2 + (h)) * HT)
#define STAGE_A(T, P, hf, kt) do { const char* _ub = g.Abase + (size_t)(kt) * g.kstride; \
    _Pragma("unroll") for (int _i = 0; _i < 2; ++_i) { const int _b = (T) * 16 + _i * 8192; \
      __builtin_amdgcn_global_load_lds((const unsigned*)(_ub + g.aoff[(hf) * 2 + _i]), (unsigned*)((char*)(P) + _b), 16, 0, 0); } } while (0)
#define STAGE_B(T, P, hf, kt) do { \
    _Pragma("unroll") for (int _i = 0; _i < 2; ++_i) { const int _b = (T) * 16 + _i * 8192; \
      const char* _ub = g.Bbase + (size_t)(kt) * (BK * 2) + (size_t)((hf) * 128 + _i * 64) * (size_t)(g.K * 2); \
      __builtin_amdgcn_global_load_lds((const unsigned*)(_ub + g.boff), (unsigned*)((char*)(P) + _b), 16, 0, 0); } } while (0)
#define LDA(dst, b, h) _Pragma("unroll") for (int m = 0; m < 4; ++m) _Pragma("unroll") for (int k = 0; k < 2; ++k) \
    dst[m][k] = *reinterpret_cast<const bf16x8*>((char*)SA(b, h) + lds_byte(wr * 64 + m * 16 + fr, k * 32 + fq * 8))
#define LDB(dst, b, h) _Pragma("unroll") for (int n = 0; n < 2; ++n) _Pragma("unroll") for (int k = 0; k < 2; ++k) \
    dst[n][k] = *reinterpret_cast<const bf16x8*>((char*)SB(b, h) + lds_byte(wc * 32 + n * 16 + fr, k * 32 + fq * 8))
#define MMA(ai, bj, At_, Bt_) do { __builtin_amdgcn_s_setprio(1); \
    _Pragma("unroll") for (int m = 0; m < 4; ++m) _Pragma("unroll") for (int n = 0; n < 2; ++n) _Pragma("unroll") for (int k = 0; k < 2; ++k) \
      acc[ai][bj][m][n] = __builtin_amdgcn_mfma_f32_16x16x32_bf16(Bt_[n][k], At_[m][k], acc[ai][bj][m][n], 0, 0, 0); \
    __builtin_amdgcn_s_setprio(0); } while (0)
#define WAIT_V(n) asm volatile("s_waitcnt vmcnt(" #n ")" ::: "memory")
#define WAIT_L(n) asm volatile("s_waitcnt lgkmcnt(" #n ")" ::: "memory")
#define BAR __builtin_amdgcn_s_barrier()
#define SCHED __builtin_amdgcn_sched_barrier(0)
    int tid = threadIdx.x; asm volatile("" : "+v"(tid));
    int wid = tid >> 6, lane = tid & 63, wr = wid >> 2, wc = wid & 3, fr = lane & 15, fq = lane >> 4;
#pragma unroll
    for (int a = 0; a < 2; ++a)
#pragma unroll
        for (int b = 0; b < 2; ++b)
#pragma unroll
            for (int m = 0; m < 4; ++m)
#pragma unroll
                for (int n = 0; n < 2; ++n) acc[a][b][m][n] = (f32x4){0.f, 0.f, 0.f, 0.f};
    bf16x8 At[4][2], B0[2][2], B1[2][2];
    const int nt = g.K / BK;
    STAGE_B(tid, SB(0, 0), 0, 0); STAGE_A(tid, SA(0, 0), 0, 0);
    STAGE_B(tid, SB(0, 1), 1, 0); STAGE_A(tid, SA(0, 1), 1, 0);
    if (wr == 1) BAR;
    WAIT_V(4); BAR;
    STAGE_B(tid, SB(1, 0), 0, 1); STAGE_A(tid, SA(1, 0), 0, 1); STAGE_B(tid, SB(1, 1), 1, 1);
    WAIT_V(6); BAR;
    for (int t = 0; t < nt - 2; t += 2) {
        LDB(B0, 0, 0); SCHED; LDA(At, 0, 0); STAGE_A(tid, SA(1, 1), 1, t + 1);
        WAIT_L(8); BAR; WAIT_L(0); MMA(0, 0, At, B0); BAR; SCHED;
        LDB(B1, 0, 1); STAGE_B(tid, SB(0, 0), 0, t + 2);
        BAR; WAIT_L(0); MMA(0, 1, At, B1); BAR;
        LDA(At, 0, 1); STAGE_A(tid, SA(0, 0), 0, t + 2);
        BAR; WAIT_L(0); MMA(1, 0, At, B0); BAR; SCHED;
        STAGE_B(tid, SB(0, 1), 1, t + 2);
        WAIT_V(6); BAR; MMA(1, 1, At, B1); BAR;
        LDB(B0, 1, 0); SCHED; LDA(At, 1, 0); STAGE_A(tid, SA(0, 1), 1, t + 2);
        WAIT_L(8); BAR; WAIT_L(0); MMA(0, 0, At, B0); BAR; SCHED;
        LDB(B1, 1, 1); STAGE_B(tid, SB(1, 0), 0, t + 3);
        BAR; WAIT_L(0); MMA(0, 1, At, B1); BAR;
        LDA(At, 1, 1); STAGE_A(tid, SA(1, 0), 0, t + 3);
        BAR; WAIT_L(0); MMA(1, 0, At, B0); BAR; SCHED;
        STAGE_B(tid, SB(1, 1), 1, t + 3);
        WAIT_V(6); BAR; MMA(1, 1, At, B1); BAR;
    }
    { LDB(B0, 0, 0); WAIT_V(0); LDA(At, 0, 0); STAGE_A(tid, SA(1, 1), 1, nt - 1);
      BAR; WAIT_L(0); MMA(0, 0, At, B0); BAR;
      LDB(B1, 0, 1); BAR; WAIT_L(0); MMA(0, 1, At, B1); BAR;
      LDA(At, 0, 1); WAIT_V(4); BAR; WAIT_L(0); MMA(1, 0, At, B0); MMA(1, 1, At, B1); BAR; }
    { LDB(B0, 1, 0); LDA(At, 1, 0); WAIT_V(2); BAR; WAIT_L(0); MMA(0, 0, At, B0); BAR;
      LDB(B1, 1, 1); WAIT_V(0); BAR; WAIT_L(0); MMA(0, 1, At, B1); BAR;
      LDA(At, 1, 1); BAR; WAIT_L(0); MMA(1, 0, At, B0); MMA(1, 1, At, B1); BAR; }
    if (wr == 0) BAR;
#undef SA
#undef SB
}


struct GDesc { const char* A; const char* B; unsigned aoff[4]; };
typedef int i32x8 __attribute__((ext_vector_type(8)));
typedef int i32x4 __attribute__((ext_vector_type(4)));
template <class S, bool FP8 = false, int SCA = 0x7f7f7f7f, int SCB = 0x7f7f7f7f>
__device__ __forceinline__ void gemm_stream(S& s, const int K, const unsigned kstrideA, unsigned char* lds_) {
    const int rowbytes = FP8 ? K : 2 * K;
    bf16_t* shm = (bf16_t*)lds_;
#define SA(b,h) (shm + ((b) * 2 + (h)) * HT)
#define SB(b,h) (shm + (4 + (b) * 2 + (h)) * HT)
#define UNIPTR(ptr) ({ const unsigned long long _u = (unsigned long long)(ptr); (const char*)(((unsigned long long)(unsigned)__builtin_amdgcn_readfirstlane((int)(_u >> 32)) << 32) | (unsigned)__builtin_amdgcn_readfirstlane((int)_u)); })
#define XSTAGE_A(P, hf, kt) do { const char* _ub = UNIPTR(d.A + (size_t)(kt) * kstrideA); \
    _Pragma("unroll") for (int _i = 0; _i < 2; ++_i) { const int _b = tid * 16 + _i * 8192; \
      unsigned _o = d.aoff[(hf) * 2 + _i]; asm volatile("" : "+v"(_o)); \
      __builtin_amdgcn_global_load_lds((const unsigned*)(_ub + _o), (unsigned*)((char*)(P) + _b), 16, 0, 0); } } while (0)
#define XSTAGE_B(P, hf, kt) do { \
    _Pragma("unroll") for (int _i = 0; _i < 2; ++_i) { const int _b = tid * 16 + _i * 8192; \
      const char* _ub = UNIPTR(d.B + (size_t)(kt) * (BK * 2) + (size_t)((hf) * 128 + _i * 64) * (size_t)rowbytes); \
      unsigned _o = boff; asm volatile("" : "+v"(_o)); \
      __builtin_amdgcn_global_load_lds((const unsigned*)(_ub + _o), (unsigned*)((char*)(P) + _b), 16, 0, 0); } } while (0)
    int tid = threadIdx.x; asm volatile("" : "+v"(tid));
    int wid = tid >> 6, lane = tid & 63, wr = wid >> 2, wc = wid & 3, fr = lane & 15, fq = lane >> 4;
    unsigned boff; { int rS, cS; stage_rc(tid * 16, rS, cS); const int rho = rS & 31, i = rho & 15; const int rP = (rS & ~31) + 8 * (i >> 2) + 4 * (rho >> 4) + (i & 3); boff = (unsigned)(rP * rowbytes + cS * 2); }
    const int nt = rowbytes / (BK * 2);
    GDesc d;
    if (!s.first(d)) return;
    f32x4 acc[2][2][4][2];
#pragma unroll
    for (int a = 0; a < 2; ++a)
#pragma unroll
        for (int b = 0; b < 2; ++b)
#pragma unroll
            for (int m = 0; m < 4; ++m)
#pragma unroll
                for (int n = 0; n < 2; ++n) acc[a][b][m][n] = (f32x4){0.f, 0.f, 0.f, 0.f};
    int sca_ = SCA, scb_ = SCB; asm volatile("" : "+v"(sca_), "+v"(scb_));
    struct Frag { bf16x8 f2[2]; };
    Frag At[4], B0[2], B1[2];
#undef LDA
#undef LDB
#undef MMA
#define LDA(dst, b, h) _Pragma("unroll") for (int m = 0; m < 4; ++m) _Pragma("unroll") for (int k = 0; k < 2; ++k) \
    dst[m].f2[k] = *reinterpret_cast<const bf16x8*>((char*)SA(b, h) + lds_byte(wr * 64 + m * 16 + fr, k * 32 + fq * 8))
#define LDB(dst, b, h) _Pragma("unroll") for (int n = 0; n < 2; ++n) _Pragma("unroll") for (int k = 0; k < 2; ++k) \
    dst[n].f2[k] = *reinterpret_cast<const bf16x8*>((char*)SB(b, h) + lds_byte(wc * 32 + n * 16 + fr, k * 32 + fq * 8))
#define MMA(ai, bj, At_, Bt_) do { __builtin_amdgcn_s_setprio(1); \
    _Pragma("unroll") for (int m = 0; m < 4; ++m) _Pragma("unroll") for (int n = 0; n < 2; ++n) { \
      if (FP8) asm volatile("v_mfma_scale_f32_16x16x128_f8f6f4 %0, %1, %2, %0, %3, %4 op_sel_hi:[0,0,0]" : "+v"(acc[ai][bj][m][n]) : "v"(__builtin_bit_cast(i32x8, Bt_[n])), "v"(__builtin_bit_cast(i32x8, At_[m])), "v"(scb_), "v"(sca_)); \
      else { _Pragma("unroll") for (int k = 0; k < 2; ++k) acc[ai][bj][m][n] = __builtin_amdgcn_mfma_f32_16x16x32_bf16(Bt_[n].f2[k], At_[m].f2[k], acc[ai][bj][m][n], 0, 0, 0); } } \
    __builtin_amdgcn_s_setprio(0); } while (0)
    XSTAGE_B(SB(0, 0), 0, 0); XSTAGE_B(SB(0, 1), 1, 0); XSTAGE_A(SA(0, 0), 0, 0); XSTAGE_A(SA(0, 1), 1, 0);
    if (wr == 1) BAR;
    WAIT_V(2); BAR;
    XSTAGE_B(SB(1, 0), 0, 1); XSTAGE_A(SA(1, 0), 0, 1); XSTAGE_B(SB(1, 1), 1, 1);
    WAIT_V(6); BAR;
    asm volatile(".p2align 8");
    for (;;) {
        bool has_next = false;
        for (int t = 0; t < nt; t += 2) {
            if (t == nt - 2) s.prefetch();
            LDB(B0, 0, 0); LDB(B1, 0, 1); SCHED; LDA(At, 0, 0); XSTAGE_A(SA(1, 1), 1, t + 1);
            WAIT_V(8); WAIT_L(0); BAR; MMA(0, 0, At, B0); MMA(0, 1, At, B1); BAR; SCHED;
            int ks = t + 2;
            if (t == nt - 2) { has_next = s.next(d); ks = 0; }
            LDA(At, 0, 1); XSTAGE_B(SB(0, 0), 0, ks); XSTAGE_B(SB(0, 1), 1, ks); XSTAGE_A(SA(0, 0), 0, ks);
            WAIT_V(8); WAIT_L(0); BAR; MMA(1, 0, At, B0); MMA(1, 1, At, B1); BAR; SCHED;
            LDB(B0, 1, 0); LDB(B1, 1, 1); SCHED; LDA(At, 1, 0); XSTAGE_A(SA(0, 1), 1, ks);
            WAIT_V(8); WAIT_L(0); BAR; MMA(0, 0, At, B0); MMA(0, 1, At, B1); BAR; SCHED;
            LDA(At, 1, 1); XSTAGE_B(SB(1, 0), 0, ks + 1); XSTAGE_B(SB(1, 1), 1, ks + 1); XSTAGE_A(SA(1, 0), 0, ks + 1);
            WAIT_V(8); WAIT_L(0); BAR; MMA(1, 0, At, B0); MMA(1, 1, At, B1); BAR; SCHED;
        }
        if (wr == 0) BAR;
        if (FP8) asm volatile("s_nop 15\n\ts_nop 15" ::: "memory");
        s.epilogue(acc);
        if (!has_next) break;
        const bool zr = s.zero_after();
        s.advance();
        if (zr)
#pragma unroll
        for (int a = 0; a < 2; ++a)
#pragma unroll
            for (int b = 0; b < 2; ++b)
#pragma unroll
                for (int m = 0; m < 4; ++m)
#pragma unroll
                    for (int n = 0; n < 2; ++n) acc[a][b][m][n] = (f32x4){0.f, 0.f, 0.f, 0.f};
        if (wr == 1) BAR;
    }
    WAIT_V(0);
    BAR;
#undef SA
#undef SB
#undef XSTAGE_A
#undef XSTAGE_B
}

#define AL4K(x) (((size_t)(x) + 4095) & ~(size_t)4095)
constexpr size_t SZ_CTRL   = 1u << 16;
constexpr size_t OFF_MOD   = SZ_CTRL;
constexpr size_t OFF_CBIAS = OFF_MOD   + AL4K(2 * 16 * 6144 * 4);
constexpr size_t OFF_BIN   = OFF_CBIAS + AL4K(2 * 2 * 4 * 256 * 4);
constexpr size_t OFF_B1P   = OFF_BIN   + AL4K(2 * ZW * 4);
constexpr size_t OFF_WRT   = OFF_B1P   + AL4K(2 * 32 * 2048 * 4);
constexpr size_t OFF_WIN   = OFF_WRT   + AL4K(2 * 2 * 32 * 1024 * 2);
constexpr size_t OFF_WBR   = OFF_WIN   + AL4K((size_t)2 * ZW * 1024 * 2);
constexpr size_t OFF_WOUT  = OFF_WBR   + AL4K((size_t)2 * 3 * 1024 * 512 * 2);
constexpr size_t OFF_W1    = OFF_WOUT  + AL4K((size_t)2 * 1024 * 1024 * 2);
constexpr size_t OFF_W2    = OFF_W1    + AL4K((size_t)2 * 32 * 2048 * 1024 * 2);
constexpr size_t OFF_WC1   = OFF_W2    + AL4K((size_t)2 * 32 * 1024 * 1024 * 2);
constexpr size_t OFF_WC2   = OFF_WC1   + AL4K((size_t)2 * 2 * 256 * 2048 * 2);
constexpr size_t OFF_XR    = OFF_WC2   + AL4K((size_t)2 * 2 * 64 * 256 * 2);
constexpr size_t OFF_HB    = OFF_XR    + AL4K((size_t)NTOK * 1024 * 4);
constexpr size_t OFF_Z     = OFF_HB    + AL4K((size_t)NTOK * 1024 * 2);
constexpr size_t OFF_OABC  = OFF_Z     + AL4K((size_t)NTOK * ZW * 2);
constexpr size_t OFF_OWIN  = OFF_OABC  + AL4K((size_t)3 * NTOK * 512 * 2);
constexpr size_t OFF_KVC   = OFF_OWIN  + AL4K((size_t)NTOK * 512 * 2);
constexpr size_t OFF_MERGED= OFF_KVC   + AL4K((size_t)2 * 16 * 2 * 128 * 64 * 2);
constexpr size_t OFF_MSCR  = OFF_MERGED+ AL4K((size_t)NTOK * 1024 * 2);
constexpr size_t OFF_TOKE  = OFF_MSCR  + AL4K((size_t)256 * 32 * 512 * 16);
constexpr size_t OFF_TOKP  = OFF_TOKE  + AL4K((size_t)NTOK * 4 * 4);
constexpr size_t OFF_TOKG  = OFF_TOKP  + AL4K((size_t)NTOK * 4 * 4);
constexpr size_t OFF_BUCK  = OFF_TOKG  + AL4K((size_t)NTOK * 4 * 4);
constexpr size_t OFF_SELM  = OFF_BUCK  + AL4K((size_t)32 * NTOK * 4);
constexpr size_t OFF_HID   = OFF_SELM  + AL4K((size_t)16 * 2 * 2048 * 4);
constexpr size_t OFF_DELTA = OFF_MSCR;
constexpr size_t OFF_H8    = OFF_HID + AL4K((size_t)PMAX * 1024);
constexpr size_t OFF_Y     = OFF_Z;
constexpr size_t WS_NEED   = OFF_HID   + AL4K((size_t)PMAX * 1024 * 2);
static_assert((size_t)PMAX * 1024 * 2 <= (size_t)NTOK * ZW * 2, "y overlay must fit in z");

#define CW_QCTR(l, q)  (4096 + ((l) * 8 + (q)) * 64)
#define CW_ECNT(l, e)  (8192 + ((l) * 32 + (e)) * 64)
#define CW_LAM         6400

struct Params {
    const float *x, *c, *mod_w, *mod_b, *norm1_g, *norm2_g, *w_in, *b_in, *sinks, *diff_lambda, *diff_subln_g, *cmp_pos, *cmp_w1, *cmp_b1, *cmp_w2, *cmp_b2,
                *w_branch, *w_out, *router_w, *router_b, *exp_w1, *exp_b1, *exp_w2, *exp_b2, *final_g;
    float* out; char* ws; int ph_lo, ph_hi;
};
typedef const Params __attribute__((address_space(4)))* KP;

#ifndef INPROJ_FP8
#define INPROJ_FP8 1
#endif
__device__ __forceinline__ int map_col(int map, int nd) {
    if (map == 1) return nd < 3584 ? nd : (nd < 6656 ? nd + 24 : (nd < 6680 ? nd - 3072 : -1));
    if (map == 2) { const int pn = nd >> 8, r = nd & 255; return r < 128 ? pn * 128 + r : 1024 + pn * 128 + (r - 128); }
    return nd;
}
__device__ __forceinline__ void xpose_load(const float* __restrict__ src, int Nsrc, int k0, int nd0, int map, int ntl, f32x4 (&v)[8], int t) {
    const int n4 = t & 15, kp = t >> 4;
    bool ok[4];
#pragma unroll
    for (int j = 0; j < 4; ++j) { const int ns0 = j < ntl ? map_col(map, nd0 + 64 * j + 4 * n4) : -1; ok[j] = ns0 >= 0; const int nsc = ok[j] ? ns0 : 0;
        v[2 * j] = *(const f32x4*)(src + (size_t)(k0 + 2 * kp) * Nsrc + nsc); v[2 * j + 1] = *(const f32x4*)(src + (size_t)(k0 + 2 * kp + 1) * Nsrc + nsc); }
    __builtin_amdgcn_sched_barrier(0);
    if (map != 0) {
#pragma unroll
        for (int j = 0; j < 4; ++j) if (!ok[j]) { v[2 * j] = (f32x4){0.f, 0.f, 0.f, 0.f}; v[2 * j + 1] = v[2 * j]; } }
}
__device__ __forceinline__ void xpose_store(const f32x4 (&v)[8], bf16_t* __restrict__ dst, int Kdst, int k0, int nd0, int ntl, unsigned char* lds, int t) {
    const int n4 = t & 15, kp = t >> 4;
#pragma unroll
    for (int j = 0; j < 4; ++j)
#pragma unroll
        for (int i = 0; i < 4; ++i) { const int n = 4 * n4 + i; *(unsigned*)(lds + j * 8192 + n * 128 + (((kp >> 2) ^ (n4 & 7)) * 16) + (kp & 3) * 4) = cvt_pk_bf16(v[2 * j][i], v[2 * j + 1][i]); }
    __syncthreads();
    { const int n = t >> 3, ch = t & 7;
#pragma unroll
      for (int j = 0; j < 4; ++j) if (j < ntl) { const u32x4 w = *(const u32x4*)(lds + j * 8192 + n * 128 + ((ch ^ ((n >> 2) & 7)) * 16));
          *(u32x4*)(dst + (size_t)(nd0 + 64 * j + n) * Kdst + k0 + 8 * ch) = w; } }
    __syncthreads();
}
__device__ __forceinline__ void xpose_matrix(const float* src, int K, int Nsrc, bf16_t* dst, int Ndst, int map, unsigned& tbase, unsigned char* lds) {
    const int t = hidden_tid();
    const int nk = K >> 6, nn = Ndst >> 6, ngn = (nn + 3) >> 2, ngrp = nk * ngn; const unsigned G = gridDim.x;
    unsigned gi = (hidden_bid() + G - (tbase % G)) % G;
    f32x4 va[8], vb[8];
    if (gi < (unsigned)ngrp) { const int kt = gi % nk, ng = gi / nk; xpose_load(src, Nsrc, kt * 64, ng * 256, map, min(4, nn - ng * 4), va, t); }
    while (gi < (unsigned)ngrp) {
        const unsigned gn = gi + G; const int kt = gi % nk, ng = gi / nk;
        if (gn < (unsigned)ngrp) { const int kt2 = gn % nk, ng2 = gn / nk; xpose_load(src, Nsrc, kt2 * 64, ng2 * 256, map, min(4, nn - ng2 * 4), vb, t); }
        xpose_store(va, dst, K, kt * 64, ng * 256, min(4, nn - ng * 4), lds, t);
#pragma unroll
        for (int q = 0; q < 8; ++q) va[q] = vb[q];
        gi = gn;
    }
    tbase += ngrp;
}

__device__ __forceinline__ unsigned pk4_fp8(float a, float b, float c, float d) { int w = 0; w = __builtin_amdgcn_cvt_pk_fp8_f32(a, b, w, false); w = __builtin_amdgcn_cvt_pk_fp8_f32(c, d, w, true); return (unsigned)w; }
#define X8T 4
__device__ __forceinline__ unsigned xpose8_load(const float* __restrict__ src, int Nsrc, int k0, int nd0, int map, f32x4 (&v)[4 * X8T], int t) {
    const int n4 = t & 15, kq = t >> 4;
    bool ok[X8T];
#pragma unroll
    for (int j = 0; j < X8T; ++j) { const int ns0 = map_col(map, nd0 + 64 * j + 4 * n4); ok[j] = ns0 >= 0; const int nsc = ok[j] ? ns0 : 0;
#pragma unroll
        for (int q = 0; q < 4; ++q) v[4 * j + q] = __builtin_nontemporal_load((const f32x4*)(src + (size_t)(k0 + 4 * kq + q) * Nsrc + nsc)); }
    __builtin_amdgcn_sched_barrier(0);
    unsigned m = 0;
#pragma unroll
    for (int j = 0; j < X8T; ++j) m |= ok[j] ? (1u << j) : 0u;
    return m;
}
__device__ __forceinline__ void xpose8_store(const f32x4 (&v)[4 * X8T], unsigned char* __restrict__ dst, int Kdst, int k0, int nd0, float scale0, unsigned char* lds, int t, unsigned okm = 0xffffffffu) {
    const int n4 = t & 15, kq = t >> 4;
#pragma unroll
    for (int j = 0; j < X8T; ++j) { const float scale = (okm >> j) & 1u ? scale0 : 0.0f;
#pragma unroll
        for (int i = 0; i < 4; ++i) { const int n = 4 * n4 + i;
            *(unsigned*)(lds + j * 8192 + n * 128 + (((kq >> 2) ^ (n4 & 7)) * 16) + (kq & 3) * 4) = pk4_fp8(v[4 * j][i] * scale, v[4 * j + 1][i] * scale, v[4 * j + 2][i] * scale, v[4 * j + 3][i] * scale); } }
    __syncthreads();
    { const int n = t >> 3, ch = t & 7;
#pragma unroll
      for (int j = 0; j < X8T; ++j) { const u32x4 w = *(const u32x4*)(lds + j * 8192 + n * 128 + ((ch ^ ((n >> 2) & 7)) * 16));
          *(u32x4*)(dst + (size_t)(nd0 + 64 * j + n) * Kdst + k0 + 16 * ch) = w; } }
    __syncthreads();
}
__device__ __forceinline__ void xpose8_matrix(const float* src, int K, int Nsrc, unsigned char* dst, int Ndst, int map, float scale, unsigned& tbase, unsigned char* lds) {
    const int t = hidden_tid();
    const int nk = K >> 7, ngn = Ndst / (64 * X8T), ngrp = nk * ngn; const unsigned G = gridDim.x;
    unsigned gi = (hidden_bid() + G - (tbase % G)) % G;
    f32x4 va[4 * X8T], vb[4 * X8T];
    unsigned ma = 0, mb = 0;
    if (gi < (unsigned)ngrp) ma = xpose8_load(src, Nsrc, (gi % nk) * 128, (gi / nk) * 64 * X8T, map, va, t);
    while (gi < (unsigned)ngrp) {
        const unsigned gn = gi + G;
        if (gn < (unsigned)ngrp) mb = xpose8_load(src, Nsrc, (gn % nk) * 128, (gn / nk) * 64 * X8T, map, vb, t);
        xpose8_store(va, dst, K, (gi % nk) * 128, (gi / nk) * 64 * X8T, scale, lds, t, ma); ma = mb;
#pragma unroll
        for (int q = 0; q < 4 * X8T; ++q) va[q] = vb[q];
        gi = gn;
    }
    tbase += ngrp;
}

#ifndef COSCHED
#define COSCHED 1
#endif
#ifndef XGN
#define XGN 1
#endif
__device__ __forceinline__ void xpose8_gload(KP p, int l, int g, f32x4 (&v)[4 * X8T], int t) {
    const int e = g / 96, r = g - e * 96; const int n4 = t & 15, kq = t >> 4;
    if (r < 64) { const float* b = p->exp_w1 + (size_t)(l * 32 + e) * 1024 * 2048 + (size_t)((r & 7) * 128 + 4 * kq) * 2048 + (r >> 3) * 128 + 4 * n4;
#pragma unroll
        for (int j = 0; j < 4; ++j)
#pragma unroll
            for (int q = 0; q < 4; ++q) v[4 * j + q] = __builtin_nontemporal_load((const f32x4*)(b + q * 2048 + (j >> 1) * 1024 + (j & 1) * 64));
    } else { const float* b = p->exp_w2 + (size_t)(l * 32 + e) * 1024 * 1024 + (size_t)((r & 7) * 128 + 4 * kq) * 1024 + ((r - 64) >> 3) * 256 + 4 * n4;
#pragma unroll
        for (int j = 0; j < 4; ++j)
#pragma unroll
            for (int q = 0; q < 4; ++q) v[4 * j + q] = __builtin_nontemporal_load((const f32x4*)(b + q * 1024 + j * 64));
    }
    __builtin_amdgcn_sched_barrier(0);
}
__device__ __forceinline__ void xpose8_gstore(KP p, int l, int g, const f32x4 (&v)[4 * X8T], unsigned char* lds, int t) {
    const int e = g / 96, r = g - e * 96; char* ws = p->ws;
    if (r < 64) xpose8_store(v, (unsigned char*)(ws + OFF_W1) + (size_t)(l * 32 + e) * 2048 * 1024, 1024, (r & 7) * 128, (r >> 3) * 256, 32.0f, lds, t);
    else xpose8_store(v, (unsigned char*)(ws + OFF_W2) + (size_t)(l * 32 + e) * 1024 * 1024, 1024, (r & 7) * 128, ((r - 64) >> 3) * 256, 32.0f, lds, t);
}
__device__ __forceinline__ void xpose8_group(KP p, int l, int g, unsigned char* lds) {
    if ((g & (XGN - 1)) != XGN - 1) return;
    const int t = hidden_tid(); const int g0 = g - (XGN - 1);
    f32x4 va[4 * X8T], vb[4 * X8T];
    xpose8_gload(p, l, g0, va, t);
    __syncthreads();
#pragma unroll 1
    for (int i = 0; i < XGN; ++i) {
        if (i + 1 < XGN) xpose8_gload(p, l, g0 + i + 1, vb, t);
        xpose8_gstore(p, l, g0 + i, va, lds, t);
#pragma unroll
        for (int q = 0; q < 4 * X8T; ++q) va[q] = vb[q];
    }
}
__device__ __forceinline__ float wave_sum(float v, int lane) {
#pragma unroll
    for (int o = 32; o >= 1; o >>= 1) v += __int_as_float(__builtin_amdgcn_ds_bpermute(((lane ^ o) & 63) << 2, __float_as_int(v)));
    return v;
}
__device__ __forceinline__ void phase_prologue(KP p, unsigned char* lds) {
    const int t = hidden_tid(), bi = hidden_bid();
    char* ws = p->ws;
#ifndef PRO_MODREP
#define PRO_MODREP 1
#endif
#ifndef PRO_XREP
#define PRO_XREP 1
#endif
    for (int rep_ = 0; rep_ < PRO_MODREP; ++rep_) {
        float* cs = (float*)lds;
        f32x4* red = (f32x4*)(lds + 65536);
        for (int i = t; i < 16 * 1024; i += NTHREADS) { const float v = p->c[i]; cs[(i & 1023) * 16 + (i >> 10)] = v * sigmoidf_(v); }
        __syncthreads();
        for (int task = bi; task < 192; task += gridDim.x) {
            const int j0 = task * 64, l = j0 / 6144, c0 = j0 % 6144;
            const int c4 = t & 15, kr = t >> 4, lane = t & 63, wv = t >> 6;
            const float* wp = p->mod_w + (size_t)l * 1024 * 6144 + c0 + 4 * c4;
            f32x4 acc[16];
#pragma unroll
            for (int b = 0; b < 16; ++b) acc[b] = (f32x4){0.f, 0.f, 0.f, 0.f};
#pragma unroll 1
            for (int i0 = 0; i0 < 32; i0 += 4) {
                f32x4 w[4];
#pragma unroll
                for (int i = 0; i < 4; ++i) w[i] = __builtin_nontemporal_load((const f32x4*)(wp + (size_t)(kr + 32 * (i0 + i)) * 6144));
                __builtin_amdgcn_sched_barrier(0);
#pragma unroll
                for (int i = 0; i < 4; ++i) { const float* cr = cs + (kr + 32 * (i0 + i)) * 16;
#pragma unroll
                    for (int b4 = 0; b4 < 4; ++b4) { const f32x4 cv = *(const f32x4*)(cr + 4 * b4);
#pragma unroll
                        for (int q = 0; q < 4; ++q) acc[4 * b4 + q] += cv[q] * w[i]; } }
            }
#pragma unroll
            for (int b = 0; b < 16; ++b)
#pragma unroll
                for (int q = 0; q < 4; ++q) { float v = acc[b][q];
                    v += __int_as_float(__builtin_amdgcn_ds_bpermute(((lane ^ 16) & 63) << 2, __float_as_int(v)));
                    v += __int_as_float(__builtin_amdgcn_ds_bpermute(((lane ^ 32) & 63) << 2, __float_as_int(v)));
                    acc[b][q] = v; }
            if (lane < 16) {
#pragma unroll
                for (int b = 0; b < 16; ++b) red[(wv * 16 + b) * 16 + c4] = acc[b]; }
            __syncthreads();
            if (t < 256) { const int b = t >> 4, c2 = t & 15; f32x4 sum = red[b * 16 + c2];
#pragma unroll
                for (int w2 = 1; w2 < 8; ++w2) sum += red[(w2 * 16 + b) * 16 + c2];
                const int col2 = c0 + 4 * c2;
                *(f32x4*)((float*)(ws + OFF_MOD) + ((size_t)l * 16 + b) * 6144 + col2) = sum + *(const f32x4*)(p->mod_b + l * 6144 + col2); }
            __syncthreads();
        }
    }
    if (bi == 0 && t < 64) {
        for (int l2 = 0; l2 < NLAYER; ++l2) { const float* lp = p->diff_lambda + (size_t)l2 * 256; const float a01 = wave_sum(lp[t] * lp[64 + t], t), a23 = wave_sum(lp[128 + t] * lp[192 + t], t);
            if (t == 0) ((float*)ws)[CW_LAM + l2] = expf(a01) - expf(a23) + (0.8f - 0.6f * expf(-0.3f * (float)l2)); } }
    for (int task = (int)gridDim.x - 1 - bi; task < 16; task += gridDim.x) {
        const int lk = task >> 2, kq = task & 3, nq = t & 63, ks = t >> 6;
        const float* w1 = p->cmp_w1 + (size_t)lk * 2048 * 256; const float* pos = p->cmp_pos + (size_t)lk * 2048;
        f32x4 s4 = (f32x4){0.f, 0.f, 0.f, 0.f};
#pragma unroll 1
        for (int k0 = kq * 512 + ks * 64; k0 < kq * 512 + ks * 64 + 64; k0 += 16) {
            f32x4 w[16]; float pz[16];
#pragma unroll
            for (int i = 0; i < 16; ++i) { w[i] = *(const f32x4*)(w1 + (size_t)(k0 + i) * 256 + 4 * nq); pz[i] = pos[k0 + i]; }
            __builtin_amdgcn_sched_barrier(0);
#pragma unroll
            for (int i = 0; i < 16; ++i) s4 += pz[i] * w[i];
        }
        f32x4* red = (f32x4*)lds; red[t] = s4; __syncthreads();
        if (t < 64) { f32x4 r = red[t];
#pragma unroll
            for (int q = 1; q < 8; ++q) r += red[t + 64 * q];
            *(f32x4*)((float*)(ws + OFF_CBIAS) + (size_t)(lk * 4 + kq) * 256 + 4 * t) = r; }
        __syncthreads();
    }
    for (int i = bi * NTHREADS + t; i < 2 * ZW; i += gridDim.x * NTHREADS) { const int l = i / ZW, nd = i % ZW, ns = map_col(1, nd); ((float*)(ws + OFF_BIN))[i] = ns >= 0 ? p->b_in[l * INW + ns] : 0.f; }
    for (int i = bi * NTHREADS + t; i < 2 * 32 * 2048; i += gridDim.x * NTHREADS) { const int le = i >> 11, j = i & 2047; ((float*)(ws + OFF_B1P))[i] = p->exp_b1[(size_t)le * 2048 + map_col(2, j)]; }
    for (int i = bi * NTHREADS + t; i < 2 * 32 * 1024; i += gridDim.x * NTHREADS) {
        const int l = i >> 15, e = (i >> 10) & 31, k = i & 1023; const float w = p->router_w[((size_t)l * 1024 + k) * 32 + e];
        const bf16_t hi = f2bf(w); const bf16_t lo = f2bf(w - bf2f(hi));
        bf16_t* wr = (bf16_t*)(ws + OFF_WRT); wr[((size_t)(l * 2 + 0) * 32 + e) * 1024 + k] = hi; wr[((size_t)(l * 2 + 1) * 32 + e) * 1024 + k] = lo; }
    __syncthreads();
    for (int rep_ = 0; rep_ < PRO_XREP; ++rep_) {
    unsigned tbase = 0;
    for (int l = 0; l < NLAYER; ++l) {
#if INPROJ_FP8
        xpose8_matrix(p->w_in + (size_t)l * 1024 * INW, 1024, INW, (unsigned char*)(ws + OFF_WIN) + (size_t)l * ZW * 1024, ZW, 1, 32.0f, tbase, lds);
#else
        xpose_matrix(p->w_in + (size_t)l * 1024 * INW, 1024, INW, (bf16_t*)(ws + OFF_WIN) + (size_t)l * ZW * 1024, ZW, 1, tbase, lds);
#endif
        for (int i = 0; i < 3; ++i) xpose_matrix(p->w_branch + (size_t)(l * 3 + i) * 512 * 1024, 512, 1024, (bf16_t*)(ws + OFF_WBR) + (size_t)(l * 3 + i) * 1024 * 512, 1024, 0, tbase, lds);
        xpose_matrix(p->w_out + (size_t)l * 1024 * 1024, 1024, 1024, (bf16_t*)(ws + OFF_WOUT) + (size_t)l * 1024 * 1024, 1024, 0, tbase, lds);
        for (int kv = 0; kv < 2; ++kv) {
            xpose_matrix(p->cmp_w1 + (size_t)(l * 2 + kv) * 2048 * 256, 2048, 256, (bf16_t*)(ws + OFF_WC1) + (size_t)(l * 2 + kv) * 256 * 2048, 256, 0, tbase, lds);
            xpose_matrix(p->cmp_w2 + (size_t)(l * 2 + kv) * 256 * 64, 256, 64, (bf16_t*)(ws + OFF_WC2) + (size_t)(l * 2 + kv) * 64 * 256, 64, 0, tbase, lds);
        }
#if !COSCHED
        for (int e = 0; e < 32; ++e) {
            xpose8_matrix(p->exp_w1 + (size_t)(l * 32 + e) * 1024 * 2048, 1024, 2048, (unsigned char*)(ws + OFF_W1) + (size_t)(l * 32 + e) * 2048 * 1024, 2048, 2, 32.0f, tbase, lds);
            xpose8_matrix(p->exp_w2 + (size_t)(l * 32 + e) * 1024 * 1024, 1024, 1024, (unsigned char*)(ws + OFF_W2) + (size_t)(l * 32 + e) * 1024 * 1024, 1024, 0, 32.0f, tbase, lds);
        }
#endif
    }
}
}


__device__ __forceinline__ void phase_norm_mod(const float* __restrict__ xsrc, const float* __restrict__ g, const float* __restrict__ modl  , int sh_off, int sc_off, bf16_t* __restrict__ hb) {
    const int tid = hidden_tid(), lane = tid & 63, wv = tid >> 6;
    for (int gw = hidden_bid() * 8 + wv; gw < NTOK / 16; gw += gridDim.x * 8) {
        const int row0 = gw * 16, b = row0 >> 11;
        f32x4 gg[4], sc[4], sh[4], xn[4];
#pragma unroll
        for (int j = 0; j < 4; ++j) { const int col = 256 * j + 4 * lane; gg[j] = *(const f32x4*)(g + col); sc[j] = *(const f32x4*)(modl + (size_t)b * 6144 + sc_off + col); sh[j] = *(const f32x4*)(modl + (size_t)b * 6144 + sh_off + col);
            xn[j] = *(const f32x4*)(xsrc + (size_t)row0 * 1024 + col); }
        for (int i = 0; i < 16; ++i) {
            const int row = row0 + i; f32x4 v[4]; float ss = 0.f;
#pragma unroll
            for (int j = 0; j < 4; ++j) { v[j] = xn[j]; ss += v[j][0] * v[j][0] + v[j][1] * v[j][1] + v[j][2] * v[j][2] + v[j][3] * v[j][3]; }
            if (i + 1 < 16) {
#pragma unroll
                for (int j = 0; j < 4; ++j) xn[j] = *(const f32x4*)(xsrc + (size_t)(row + 1) * 1024 + 256 * j + 4 * lane); }
            ss = wave_sum(ss, lane); const float r = 1.0f / sqrtf(ss * (1.0f / 1024.0f) + 1e-5f);
#pragma unroll
            for (int j = 0; j < 4; ++j) { const int col = 256 * j + 4 * lane; float o[4];
#pragma unroll
                for (int q = 0; q < 4; ++q) o[q] = v[j][q] * r * gg[j][q] * (1.0f + sc[j][q]) + sh[j][q];
#if INPROJ_FP8
                *(unsigned*)((unsigned char*)hb + (size_t)row * 1024 + col) = pk4_fp8(o[0], o[1], o[2], o[3]); }
#else
                u32x2 w; w.x = cvt_pk_bf16(o[0], o[1]); w.y = cvt_pk_bf16(o[2], o[3]); *(u32x2*)(hb + (size_t)row * 1024 + col) = w; }
#endif
        }
    }
}

__device__ __forceinline__ bool unit_rc(unsigned L, int nRT, int nN, int& rt, int& pn) {
    const int x = L & 7; const unsigned i = L >> 3; const int nrt_x = (nRT - x + 7) >> 3;
    const unsigned per = 8u * (unsigned)nN, grp = i / per, rem = i % per;
    pn = (int)(rem >> 3); const int rtl = (int)(grp * 8u + (rem & 7u));
    if (rtl >= nrt_x) return false;
    rt = x + 8 * rtl; return true;
}
__device__ __forceinline__ unsigned unit_slots(int nRT, int nN) { const int pr = (nRT + 7) >> 3; return 8u * (unsigned)(((pr + 7) >> 3) * 8 * nN); }
struct SlotIter {
    unsigned L, LM; int nRT, nN;
    __device__ __forceinline__ void init(int nRT_, int nN_) { nRT = nRT_; nN = nN_; LM = unit_slots(nRT_, nN_); L = hidden_bid(); }
    __device__ __forceinline__ bool take(int& rt, int& pn) { while (L < LM) { const unsigned l = L; L += gridDim.x; if (unit_rc(l, nRT, nN, rt, pn)) return true; } return false; }
};

#define GEMM_STAGE_IDS() int rS, cS; { int tz_ = threadIdx.x; asm volatile("" : "+v"(tz_)); stage_rc(tz_ * 16, rS, cS); }
#define GEMM_LANE_IDS() int tid = threadIdx.x; asm volatile("" : "+v"(tid)); const int wid = tid >> 6, lane = tid & 63, wr = wid >> 2, wc = wid & 3, fr = lane & 15, fq = lane >> 4; (void)lane; (void)wr; (void)wc; (void)fr; (void)fq
#define TILE_ROW(i) (((i) >> 1) * 128 + ((i) & 1) * 64 + rS)
typedef f32x4 (&AccRef)[2][2][4][2];

struct InprojS {
    KP p; int l; SlotIter it; int rt, pn, nrt, npn; f32x4 pb[2][2];
    __device__ __forceinline__ bool zero_after() const { return true; }
    __device__ __forceinline__ void load_bias() { GEMM_LANE_IDS(); const float* bias = (const float*)(p->ws + OFF_BIN) + (size_t)l * ZW + pn * 256 + wc * 32 + fq * 8;
#pragma unroll
        for (int bj = 0; bj < 2; ++bj) { pb[bj][0] = *(const f32x4*)(bias + bj * 128); pb[bj][1] = *(const f32x4*)(bias + bj * 128 + 4); } }
    __device__ __forceinline__ void prefetch() { if (!INPROJ_FP8) load_bias(); }
    __device__ __forceinline__ void fill(GDesc& d, int rt_, int pn_) { GEMM_STAGE_IDS(); char* ws = p->ws; d.A = ws + OFF_HB; d.B = ws + OFF_WIN + ((size_t)l * ZW + (size_t)pn_ * 256) * 1024 * (INPROJ_FP8 ? 1 : 2);
#pragma unroll
        for (int i = 0; i < 4; ++i) d.aoff[i] = (unsigned)(((size_t)rt_ * 256 + TILE_ROW(i)) * (INPROJ_FP8 ? 1024 : 2048) + cS * 2); }
    __device__ __forceinline__ bool first(GDesc& d) { it.init(128, 27); if (!it.take(rt, pn)) return false; fill(d, rt, pn); return true; }
    __device__ __forceinline__ bool next(GDesc& d) { int a, b; if (!it.take(a, b)) return false; nrt = a; npn = b; fill(d, a, b); return true; }
    __device__ __forceinline__ void advance() { rt = nrt; pn = npn; }
    __device__ __forceinline__ void epilogue(AccRef acc) {
        if (INPROJ_FP8) load_bias();
        GEMM_LANE_IDS(); char* ws = p->ws;
        bf16_t* z = (bf16_t*)(ws + OFF_Z);
        const bool sig = pn >= 14;
        const float qsc = (pn < 2 || pn == 3 || pn == 4 || pn == 9 || pn == 10) ? 0.125f : 1.0f;
        const int row0 = rt * 256 + wr * 64 + fr, col0 = pn * 256 + wc * 32 + fq * 8;
#pragma unroll
        for (int bj = 0; bj < 2; ++bj) { const int col = col0 + bj * 128; const f32x4 b0 = pb[bj][0], b1 = pb[bj][1];
#pragma unroll
            for (int ai = 0; ai < 2; ++ai)
#pragma unroll
                for (int m = 0; m < 4; ++m) { f32x4 v0 = (acc[ai][bj][m][0] + b0) * qsc, v1 = (acc[ai][bj][m][1] + b1) * qsc;
                    if (sig) {
#pragma unroll
                        for (int j = 0; j < 4; ++j) { v0[j] = sigmoidf_(v0[j]); v1[j] = sigmoidf_(v1[j]); } }
                    u32x4 w; w.x = cvt_pk_bf16(v0[0], v0[1]); w.y = cvt_pk_bf16(v0[2], v0[3]); w.z = cvt_pk_bf16(v1[0], v1[1]); w.w = cvt_pk_bf16(v1[2], v1[3]);
                    *(u32x4*)(z + (size_t)(row0 + ai * 128 + m * 16) * ZW + col) = w; } }
    }
};
__device__ __forceinline__ void phase_inproj(KP p, int l, unsigned char* lds) { InprojS s; s.p = p; s.l = l;
#if INPROJ_FP8
    gemm_stream<InprojS, true, 0x7f7f7f7f, 0x7a7a7a7a>(s, 1024, 128u, lds);
#else
    gemm_stream(s, 1024, 128u, lds);
#endif
}

struct MergeS {
    KP p; int l; SlotIter it; int rt, pn, br, nrt, npn, nbr;
    __device__ __forceinline__ bool zero_after() const { return br == 2; }
    __device__ __forceinline__ void prefetch() {}
    __device__ __forceinline__ void fill(GDesc& d, int rt_, int pn_, int br_) { GEMM_STAGE_IDS(); char* ws = p->ws; d.A = ws + OFF_OABC + (size_t)br_ * NTOK * 512 * 2;
        d.B = ws + OFF_WBR + ((size_t)(l * 3 + br_) * 1024 + (size_t)pn_ * 256) * 512 * 2;
#pragma unroll
        for (int i = 0; i < 4; ++i) d.aoff[i] = (unsigned)(((size_t)rt_ * 256 + TILE_ROW(i)) * 1024 + cS * 2); }
    __device__ __forceinline__ bool first(GDesc& d) { it.init(128, 4); if (!it.take(rt, pn)) return false; br = 0; fill(d, rt, pn, 0); return true; }
    __device__ __forceinline__ bool next(GDesc& d) { if (br < 2) { nrt = rt; npn = pn; nbr = br + 1; } else { int a, b; if (!it.take(a, b)) return false; nrt = a; npn = b; nbr = 0; } fill(d, nrt, npn, nbr); return true; }
    __device__ __forceinline__ void advance() { rt = nrt; pn = npn; br = nbr; }
    __device__ __forceinline__ void epilogue(AccRef acc) {
        GEMM_LANE_IDS(); char* ws = p->ws;
        const bf16_t* z = (const bf16_t*)(ws + OFF_Z); bf16_t* mg = (bf16_t*)(ws + OFF_MERGED);
        const int row0 = rt * 256 + wr * 64 + fr, col0 = pn * 256 + wc * 32 + fq * 8;
#pragma unroll
        for (int ai = 0; ai < 2; ++ai) {
            u32x4 G[2][4], H[2][4];
#pragma unroll
            for (int bj = 0; bj < 2; ++bj)
#pragma unroll
                for (int m = 0; m < 4; ++m) { const bf16_t* gp = z + (size_t)(row0 + ai * 128 + m * 16) * ZW + C_GM + br * 1024 + col0 + bj * 128;
                    G[bj][m] = *(const u32x4*)gp; H[bj][m] = *(const u32x4*)(gp + (br < 2 ? 1024 : 0)); }
            asm volatile("" ::: "memory");
#pragma unroll
            for (int bj = 0; bj < 2; ++bj)
#pragma unroll
                for (int m = 0; m < 4; ++m) {
                    const int row = row0 + ai * 128 + m * 16, col = col0 + bj * 128;
                    const u32x4 gw = G[bj][m], hw = H[bj][m];
                    float g[8] = {bflo(gw.x), bfhi(gw.x), bflo(gw.y), bfhi(gw.y), bflo(gw.z), bfhi(gw.z), bflo(gw.w), bfhi(gw.w)};
                    if (br < 2) { const float hn[8] = {bflo(hw.x), bfhi(hw.x), bflo(hw.y), bfhi(hw.y), bflo(hw.z), bfhi(hw.z), bflo(hw.w), bfhi(hw.w)};
#pragma unroll
                        for (int j = 0; j < 8; ++j) g[j] = fmaxf(g[j], 1e-6f) * fast_rcp(fmaxf(hn[j], 1e-6f));
                    } else {
#pragma unroll
                        for (int j = 0; j < 8; ++j) g[j] = fmaxf(g[j], 1e-6f); }
                    f32x4 v0 = acc[ai][bj][m][0], v1 = acc[ai][bj][m][1];
                    v0[0] *= g[0]; v0[1] *= g[1]; v0[2] *= g[2]; v0[3] *= g[3]; v1[0] *= g[4]; v1[1] *= g[5]; v1[2] *= g[6]; v1[3] *= g[7];
                    if (br < 2) { acc[ai][bj][m][0] = v0; acc[ai][bj][m][1] = v1; }
                    else { u32x4 w; w.x = cvt_pk_bf16(v0[0], v0[1]); w.y = cvt_pk_bf16(v0[2], v0[3]); w.z = cvt_pk_bf16(v1[0], v1[1]); w.w = cvt_pk_bf16(v1[2], v1[3]); *(u32x4*)(mg + (size_t)row * 1024 + col) = w; }
                }
        }
    }
};
__device__ __forceinline__ void phase_merge(KP p, int l, unsigned char* lds) { MergeS s; s.p = p; s.l = l; gemm_stream(s, 512, 128u, lds); }

struct OutprojS {
    KP p; int l; SlotIter it; int rt, pn, nrt, npn; f32x4 pg[2][2];
    __device__ __forceinline__ bool zero_after() const { return true; }
    __device__ __forceinline__ void prefetch() { GEMM_LANE_IDS(); const float* gp = (const float*)(p->ws + OFF_MOD) + ((size_t)l * 16 + (rt >> 3)) * 6144 + 2048 + pn * 256 + wc * 32 + fq * 8;
#pragma unroll
        for (int bj = 0; bj < 2; ++bj) { pg[bj][0] = *(const f32x4*)(gp + bj * 128); pg[bj][1] = *(const f32x4*)(gp + bj * 128 + 4); } }
    __device__ __forceinline__ void fill(GDesc& d, int rt_, int pn_) { GEMM_STAGE_IDS(); char* ws = p->ws; d.A = ws + OFF_MERGED; d.B = ws + OFF_WOUT + ((size_t)l * 1024 + (size_t)pn_ * 256) * 1024 * 2;
#pragma unroll
        for (int i = 0; i < 4; ++i) d.aoff[i] = (unsigned)(((size_t)rt_ * 256 + TILE_ROW(i)) * 2048 + cS * 2); }
    __device__ __forceinline__ bool first(GDesc& d) { it.init(128, 4); if (!it.take(rt, pn)) return false; fill(d, rt, pn); return true; }
    __device__ __forceinline__ bool next(GDesc& d) { int a, b; if (!it.take(a, b)) return false; nrt = a; npn = b; fill(d, a, b); return true; }
    __device__ __forceinline__ void advance() { rt = nrt; pn = npn; }
    __device__ __forceinline__ void epilogue(AccRef acc) {
        GEMM_LANE_IDS(); bf16_t* xrb = (bf16_t*)(p->ws + OFF_XR); const float* xin = p->x;
        const int row0 = rt * 256 + wr * 64 + fr, col0 = pn * 256 + wc * 32 + fq * 8;
#pragma unroll
        for (int ai = 0; ai < 2; ++ai) {
            if (l == 0) {
#pragma unroll
                for (int bj = 0; bj < 2; ++bj) {
                    f32x4 X[4][2];
#pragma unroll
                    for (int m = 0; m < 4; ++m) { const float* xp = xin + (size_t)(row0 + ai * 128 + m * 16) * 1024 + col0 + bj * 128; X[m][0] = *(const f32x4*)xp; X[m][1] = *(const f32x4*)(xp + 4); }
                    asm volatile("" ::: "memory");
#pragma unroll
                    for (int m = 0; m < 4; ++m) { const f32x4 v0 = X[m][0] + pg[bj][0] * acc[ai][bj][m][0], v1 = X[m][1] + pg[bj][1] * acc[ai][bj][m][1];
                        u32x4 w; w.x = cvt_pk_bf16(v0[0], v0[1]); w.y = cvt_pk_bf16(v0[2], v0[3]); w.z = cvt_pk_bf16(v1[0], v1[1]); w.w = cvt_pk_bf16(v1[2], v1[3]);
                        *(u32x4*)(xrb + (size_t)(row0 + ai * 128 + m * 16) * 1024 + col0 + bj * 128) = w; }
                }
            } else {
                u32x4 X[2][4];
#pragma unroll
                for (int bj = 0; bj < 2; ++bj)
#pragma unroll
                    for (int m = 0; m < 4; ++m) X[bj][m] = *(const u32x4*)(xrb + (size_t)(row0 + ai * 128 + m * 16) * 1024 + col0 + bj * 128);
                asm volatile("" ::: "memory");
#pragma unroll
                for (int bj = 0; bj < 2; ++bj)
#pragma unroll
                    for (int m = 0; m < 4; ++m) { const u32x4 xw = X[bj][m];
                        const f32x4 v0 = (f32x4){bflo(xw.x), bfhi(xw.x), bflo(xw.y), bfhi(xw.y)} + pg[bj][0] * acc[ai][bj][m][0], v1 = (f32x4){bflo(xw.z), bfhi(xw.z), bflo(xw.w), bfhi(xw.w)} + pg[bj][1] * acc[ai][bj][m][1];
                        u32x4 w; w.x = cvt_pk_bf16(v0[0], v0[1]); w.y = cvt_pk_bf16(v0[2], v0[3]); w.z = cvt_pk_bf16(v1[0], v1[1]); w.w = cvt_pk_bf16(v1[2], v1[3]);
                        *(u32x4*)(xrb + (size_t)(row0 + ai * 128 + m * 16) * 1024 + col0 + bj * 128) = w; }
            }
        }
    }
};
__device__ __forceinline__ void phase_outproj(KP p, int l, unsigned char* lds) { OutprojS s; s.p = p; s.l = l; gemm_stream(s, 1024, 128u, lds); }

__device__ __forceinline__ void moe_tables(KP p, int l, int* tbl) {
    const int t = hidden_tid();
    if (t < 64) {
        const unsigned* ctrl = (const unsigned*)p->ws; const int e = t & 31;
        const int c = (int)ctrl[CW_ECNT(l, e)]; const int nt = (c + 255) >> 8;
        int incl = nt;
#pragma unroll
        for (int o = 1; o < 32; o <<= 1) { const int v = __builtin_amdgcn_ds_bpermute(((t - o) & 63) << 2, incl); if (e >= o) incl += v; }
        if (t < 32) { tbl[e] = incl - nt; tbl[33 + e] = c; if (e == 31) tbl[32] = incl; }
    }
    __syncthreads();
}
#define RFL(x) __builtin_amdgcn_readfirstlane(x)
__device__ __forceinline__ int moe_find(const int* tbl, int rt, int e = 0) {
    while (RFL(tbl[e + 1]) <= rt) ++e;
    while (RFL(tbl[e]) > rt) --e;
    return e; }
#define MOE_TBL(lds) ((int*)((lds) + 131072 + 4096))

#ifndef MOEX
#define MOEX 0
#endif
struct Moe1S {
    KP p; int l; const int* tbl; SlotIter it; int rt, pn, e, nrt, npn, ne; int shadow; f32x4 bg[2], bu[2]; const int* toktab; int ui;
    __device__ __forceinline__ bool zero_after() const { return true; }
    __device__ __forceinline__ void prefetch() {}
    __device__ __forceinline__ void load_bias() { GEMM_LANE_IDS(); const float* bb = (const float*)(p->ws + OFF_B1P) + ((size_t)(l * 32 + e)) * 2048 + pn * 256 + wc * 32 + fq * 8;
#pragma unroll
        for (int n = 0; n < 2; ++n) { bg[n] = *(const f32x4*)(bb + n * 4); bu[n] = *(const f32x4*)(bb + 128 + n * 4); } }
    __device__ __forceinline__ void fill(GDesc& d, int rt_, int pn_, int e_) { GEMM_STAGE_IDS(); char* ws = p->ws; (void)rt_;
        d.A = ws + OFF_H8; d.B = ws + OFF_W1 + (((size_t)(l * 32 + e_)) * 2048 + (size_t)pn_ * 256) * 1024;
#pragma unroll
        for (int i = 0; i < 4; ++i) d.aoff[i] = (unsigned)((size_t)toktab[ui * 256 + TILE_ROW(i)] * 1024 + cS * 2);
        ++ui; }
    __device__ __forceinline__ bool first(GDesc& d) { it.init(RFL(tbl[32]), 8); if (!it.take(rt, pn)) return false; e = moe_find(tbl, rt); fill(d, rt, pn, e); return true; }
    __device__ __forceinline__ bool next(GDesc& d) { int a, b; if (!it.take(a, b)) return false; nrt = a; npn = b; ne = moe_find(tbl, a, e); fill(d, a, b, ne); return true; }
    __device__ __forceinline__ void advance() { rt = nrt; pn = npn; e = ne; }
    __device__ __forceinline__ void epilogue(AccRef acc) {
        if (shadow && MOEX == 2) { asm volatile("" :: "v"(acc[0][0][0][0]), "v"(acc[1][1][3][1])); return; }
        load_bias();
        GEMM_LANE_IDS(); char* ws = p->ws; unsigned char* hid = (unsigned char*)(ws + OFF_HID);
        const size_t prow0 = (size_t)rt * 256 + wr * 64 + fr; const int c0 = wc * 32 + fq * 8;
#pragma unroll
        for (int ai = 0; ai < 2; ++ai)
#pragma unroll
            for (int m = 0; m < 4; ++m) { float o[8];
#pragma unroll
                for (int n = 0; n < 2; ++n) { const f32x4 gq = acc[ai][0][m][n] + bg[n], uq = acc[ai][1][m][n] + bu[n];
#pragma unroll
                    for (int j = 0; j < 4; ++j) { const float gg = fminf(gq[j], 7.0f), uu = __builtin_amdgcn_fmed3f(uq[j], -7.0f, 7.0f); o[n * 4 + j] = (uu + 1.0f) * gg * fast_rcp(1.0f + fast_exp2(-1.702f * LOG2E * gg)); } }
                u32x2 w; w.x = pk4_fp8(4.0f * o[0], 4.0f * o[1], 4.0f * o[2], 4.0f * o[3]); w.y = pk4_fp8(4.0f * o[4], 4.0f * o[5], 4.0f * o[6], 4.0f * o[7]);
                *(u32x2*)(hid + (prow0 + ai * 128 + m * 16) * 1024 + pn * 128 + c0) = w; }
    }
};
__device__ __forceinline__ void phase_moe1(KP p, int l, unsigned char* lds) { int* tbl = MOE_TBL(lds); moe_tables(p, l, tbl);
    int* toktab = (int*)(lds + 131072 + 8192);
    { SlotIter it2; it2.init(RFL(tbl[32]), 8); int a, b, u2 = 0, e2 = 0; const int t = hidden_tid();
      while (it2.take(a, b)) { e2 = moe_find(tbl, a, e2); const int cnt = RFL(tbl[33 + e2]), pos0 = (a - RFL(tbl[e2])) * 256;
          if (t < 256) { int pos = pos0 + t; pos = pos < cnt ? pos : 0; toktab[u2 * 256 + t] = ((const int*)(p->ws + OFF_BUCK))[(size_t)e2 * NTOK + pos]; }
          ++u2; }
      __syncthreads(); }
    for (int rep = 0; rep < (MOEX ? 2 : 1); ++rep) { Moe1S s; s.p = p; s.l = l; s.tbl = tbl; s.shadow = rep; s.toktab = toktab; s.ui = 0; gemm_stream<Moe1S, true, 0x7f7f7f7f, 0x7a7a7a7a>(s, 1024, 128u, lds); __syncthreads(); } }

struct Moe2S {
    KP p; int l; const int* tbl; SlotIter it; int rt, pn, e, nrt, npn, ne; f32x4 pb[2][2];
    __device__ __forceinline__ bool zero_after() const { return true; }
    __device__ __forceinline__ void prefetch() {}
    __device__ __forceinline__ void load_bias() { GEMM_LANE_IDS(); const float* b2 = p->exp_b2 + ((size_t)(l * 32 + e)) * 1024 + pn * 256 + wc * 32 + fq * 8;
#pragma unroll
        for (int bj = 0; bj < 2; ++bj) { pb[bj][0] = *(const f32x4*)(b2 + bj * 128); pb[bj][1] = *(const f32x4*)(b2 + bj * 128 + 4); } }
    __device__ __forceinline__ void fill(GDesc& d, int rt_, int pn_, int e_) { GEMM_STAGE_IDS(); char* ws = p->ws; d.A = ws + OFF_HID; d.B = ws + OFF_W2 + (((size_t)(l * 32 + e_)) * 1024 + (size_t)pn_ * 256) * 1024;
#pragma unroll
        for (int i = 0; i < 4; ++i) d.aoff[i] = (unsigned)(((size_t)rt_ * 256 + TILE_ROW(i)) * 1024 + cS * 2); }
    __device__ __forceinline__ bool first(GDesc& d) { it.init(RFL(tbl[32]), 4); if (!it.take(rt, pn)) return false; e = moe_find(tbl, rt); fill(d, rt, pn, e); return true; }
    __device__ __forceinline__ bool next(GDesc& d) { int a, b; if (!it.take(a, b)) return false; nrt = a; npn = b; ne = moe_find(tbl, a, e); fill(d, a, b, ne); return true; }
    __device__ __forceinline__ void advance() { rt = nrt; pn = npn; e = ne; }
    __device__ __forceinline__ void epilogue(AccRef acc) {
        load_bias();
        GEMM_LANE_IDS(); char* ws = p->ws; bf16_t* y = (bf16_t*)(ws + OFF_Y);
        const size_t row0 = (size_t)rt * 256 + wr * 64 + fr; const int col0 = pn * 256 + wc * 32 + fq * 8;
#pragma unroll
        for (int bj = 0; bj < 2; ++bj) { const int col = col0 + bj * 128; const f32x4 b0 = pb[bj][0], b1 = pb[bj][1];
#pragma unroll
            for (int ai = 0; ai < 2; ++ai)
#pragma unroll
                for (int m = 0; m < 4; ++m) { const f32x4 v0 = acc[ai][bj][m][0] + b0, v1 = acc[ai][bj][m][1] + b1;
                    u32x4 w; w.x = cvt_pk_bf16(v0[0], v0[1]); w.y = cvt_pk_bf16(v0[2], v0[3]); w.z = cvt_pk_bf16(v1[0], v1[1]); w.w = cvt_pk_bf16(v1[2], v1[3]);
                    *(u32x4*)(y + (row0 + ai * 128 + m * 16) * 1024 + col) = w; } }
    }
};
__device__ __forceinline__ void phase_moe2(KP p, int l, unsigned char* lds) { int* tbl = MOE_TBL(lds); moe_tables(p, l, tbl); Moe2S s; s.p = p; s.l = l; s.tbl = tbl; gemm_stream<Moe2S, true, 0x7d7d7d7d, 0x7a7a7a7a>(s, 1024, 128u, lds); __syncthreads(); }

#define AT_MISC 65536


typedef short s16x4 __attribute__((ext_vector_type(4)));
__device__ __forceinline__ int crow(int r, int h) { return (r & 3) + 8 * (r >> 2) + 4 * h; }
__device__ __forceinline__ int kaddr(int key, int c) { return (key >> 1) * 256 + (((((key & 1) << 3) | c) ^ ((key >> 1) & 15)) << 4); }
__device__ __forceinline__ int vaddr64(int key, int c) { return (key >> 1) * 256 + (((key & 1) * 2 + ((c >> 2) ^ ((key >> 1) & 1))) << 6) + ((c & 3) << 4); }
__device__ __forceinline__ int vaddr128(int key, int c) { return key * 256 + (((c >> 2) ^ (key & 3)) << 6) + ((c & 3) << 4); }
__device__ __forceinline__ s16x4 vtr(const unsigned char* p) { return __builtin_bit_cast(s16x4, __builtin_amdgcn_ds_read_tr16_b64_v4i16((LAS s16x4*)(p))); }
__device__ __forceinline__ float swap_max(float v) { auto rr = __builtin_amdgcn_permlane32_swap(__float_as_uint(v), __float_as_uint(v), false, false); return fmaxf(__uint_as_float(rr[0]), __uint_as_float(rr[1])); }
__device__ __forceinline__ float swap_sum(float v) { auto rr = __builtin_amdgcn_permlane32_swap(__float_as_uint(v), __float_as_uint(v), false, false); return __uint_as_float(rr[0]) + __uint_as_float(rr[1]); }
__device__ __forceinline__ float swap_other(float v, int h) { auto rr = __builtin_amdgcn_permlane32_swap(__float_as_uint(v), __float_as_uint(v), false, false); return __uint_as_float(h ? rr[0] : rr[1]); }
#define MFMA32(a, b, c) __builtin_amdgcn_mfma_f32_32x32x16_bf16((a), (b), (c), 0, 0, 0)

struct KVSrc { const char* k; unsigned kstride; const char* v; unsigned vstride; };
__device__ __forceinline__ void kinv(int o, int& key, int& c) { const int sup = o >> 8, x = ((o >> 4) & 15) ^ (sup & 15); key = 2 * sup + (x >> 3); c = x & 7; }
__device__ __forceinline__ void vinv64(int o, int& key, int& c) { const int sup = o >> 8, seg = (o >> 6) & 3; key = 2 * sup + (seg >> 1); c = (((seg & 1) ^ (sup & 1)) << 2) | ((o >> 4) & 3); }
__device__ __forceinline__ void vinv128(int o, int& key, int& c) { key = o >> 8; c = ((((o >> 6) & 3) ^ (key & 3)) << 2) | ((o >> 4) & 3); }
#define RING_NB 4
#define RING_AHEAD 3
template <int KW, int DV> struct KVRing {
    static constexpr int LPT = KW + DV / 64, BUFB = KW * 8192 + DV * 128;
    unsigned kof[KW], vof[DV / 64];
    unsigned kdst[KW], vdst[DV / 64];
    const char* kb; const char* vb; unsigned kstride, vstride;
    __device__ __forceinline__ void init(const KVSrc& s, int tid) {
        kb = s.k; vb = s.v; kstride = s.kstride; vstride = s.vstride;
        const int wv = tid >> 6, lane = tid & 63;
#pragma unroll
        for (int i = 0; i < KW; ++i) { const int o = (i * 8 + wv) * 1024 + lane * 16, img = o >> 13; int key, c; kinv(o & 8191, key, c); kof[i] = (unsigned)key * kstride + (unsigned)(img * 128 + c * 16); kdst[i] = (unsigned)o; }
#pragma unroll
        for (int i = 0; i < DV / 64; ++i) { const int o = (i * 8 + wv) * 1024 + lane * 16; int key, c; if (DV == 64) vinv64(o, key, c); else vinv128(o, key, c);
            vof[i] = (unsigned)key * vstride + (unsigned)(c * 16); vdst[i] = (unsigned)(KW * 8192 + o); }
    }
    __device__ __forceinline__ void issue(int key0, int buf, unsigned char* lds) const {
        const char* kt = UNIPTR(kb + (size_t)key0 * kstride); const char* vt = UNIPTR(vb + (size_t)key0 * vstride);
#pragma unroll
        for (int i = 0; i < KW; ++i) { unsigned o = kof[i]; asm volatile("" : "+v"(o)); __builtin_amdgcn_global_load_lds((const unsigned*)(kt + o), (unsigned*)(lds + buf * BUFB + kdst[i]), 16, 0, 0); }
#pragma unroll
        for (int i = 0; i < DV / 64; ++i) { unsigned o = vof[i]; asm volatile("" : "+v"(o)); __builtin_amdgcn_global_load_lds((const unsigned*)(vt + o), (unsigned*)(lds + buf * BUFB + vdst[i]), 16, 0, 0); }
    }
    __device__ __forceinline__ void wait_bar(int later) const {
        if (later >= 2 && RING_AHEAD >= 3) asm volatile("s_waitcnt vmcnt(%0)" :: "n"(2 * LPT) : "memory");
        else if (later >= 1) asm volatile("s_waitcnt vmcnt(%0)" :: "n"(LPT) : "memory");
        else asm volatile("s_waitcnt vmcnt(0)" ::: "memory");
        __builtin_amdgcn_s_barrier(); asm volatile("" ::: "memory");
    }
    __device__ __forceinline__ const unsigned char* kimg(const unsigned char* lds, int buf, int img) const { return lds + buf * BUFB + img * 8192; }
    __device__ __forceinline__ const unsigned char* vimg(const unsigned char* lds, int buf) const { return lds + buf * BUFB + KW * 8192; }
};

template <int DV> struct WaveAcc { float m, l; f32x16 o[DV / 32]; };
template <int DV> __device__ __forceinline__ void acc_init(WaveAcc<DV>& a) { a.m = -1e30f; a.l = 0.f;
#pragma unroll
    for (int d = 0; d < DV / 32; ++d)
#pragma unroll
        for (int r = 0; r < 16; ++r) a.o[d][r] = 0.f; }

__device__ __forceinline__ f32x16 qk_sub(const bf16x8 (&qf)[4], const unsigned char* kimg, int sub, int lane) {
    const int r32 = lane & 31, h = lane >> 5;
    f32x16 s;
#pragma unroll
    for (int r = 0; r < 16; ++r) s[r] = 0.f;
#pragma unroll
    for (int ks = 0; ks < 4; ++ks) { const bf16x8 kf = *(const bf16x8*)(kimg + kaddr(32 * sub + r32, 2 * ks + h)); s = MFMA32(kf, qf[ks], s); }
    return s;
}
template <int DV> struct VFrag { s16x4 r[2][DV / 32][2]; };
__device__ __forceinline__ void v_read_all(VFrag<64>& f, const unsigned char* vimg, int sub, int lane) {
    const int h = lane >> 5, i16 = lane & 15, qq = i16 >> 2, pp = i16 & 3, g1 = (lane >> 4) & 1, k0 = 32 * sub + 4 * h + qq;
    const unsigned b0 = (unsigned)(uintptr_t)(vimg + vaddr64(k0, 2 * g1 + (pp >> 1)) + (pp & 1) * 8), b1 = (unsigned)(uintptr_t)(vimg + vaddr64(k0, 4 + 2 * g1 + (pp >> 1)) + (pp & 1) * 8);
    asm volatile("ds_read_b64_tr_b16 %0, %8\n\tds_read_b64_tr_b16 %1, %8 offset:1024\n\tds_read_b64_tr_b16 %2, %9\n\tds_read_b64_tr_b16 %3, %9 offset:1024\n\t"
                 "ds_read_b64_tr_b16 %4, %8 offset:2048\n\tds_read_b64_tr_b16 %5, %8 offset:3072\n\tds_read_b64_tr_b16 %6, %9 offset:2048\n\tds_read_b64_tr_b16 %7, %9 offset:3072\n\t"
                 "s_waitcnt lgkmcnt(0)"
                 : "=&v"(f.r[0][0][0]), "=&v"(f.r[0][0][1]), "=&v"(f.r[0][1][0]), "=&v"(f.r[0][1][1]), "=&v"(f.r[1][0][0]), "=&v"(f.r[1][0][1]), "=&v"(f.r[1][1][0]), "=&v"(f.r[1][1][1])
                 : "v"(b0), "v"(b1) : "memory");
}
__device__ __forceinline__ void v_read_all(VFrag<128>& f, const unsigned char* vimg, int sub, int lane) {
    const int h = lane >> 5, i16 = lane & 15, qq = i16 >> 2, pp = i16 & 3, g1 = (lane >> 4) & 1, k0 = 32 * sub + 4 * h + qq;
    unsigned b[4];
#pragma unroll
    for (int db = 0; db < 4; ++db) b[db] = (unsigned)(uintptr_t)(vimg + vaddr128(k0, db * 4 + 2 * g1 + (pp >> 1)) + (pp & 1) * 8);
    asm volatile("ds_read_b64_tr_b16 %0, %16\n\tds_read_b64_tr_b16 %1, %16 offset:2048\n\tds_read_b64_tr_b16 %2, %17\n\tds_read_b64_tr_b16 %3, %17 offset:2048\n\t"
                 "ds_read_b64_tr_b16 %4, %18\n\tds_read_b64_tr_b16 %5, %18 offset:2048\n\tds_read_b64_tr_b16 %6, %19\n\tds_read_b64_tr_b16 %7, %19 offset:2048\n\t"
                 "ds_read_b64_tr_b16 %8, %16 offset:4096\n\tds_read_b64_tr_b16 %9, %16 offset:6144\n\tds_read_b64_tr_b16 %10, %17 offset:4096\n\tds_read_b64_tr_b16 %11, %17 offset:6144\n\t"
                 "ds_read_b64_tr_b16 %12, %18 offset:4096\n\tds_read_b64_tr_b16 %13, %18 offset:6144\n\tds_read_b64_tr_b16 %14, %19 offset:4096\n\tds_read_b64_tr_b16 %15, %19 offset:6144\n\t"
                 "s_waitcnt lgkmcnt(0)"
                 : "=&v"(f.r[0][0][0]), "=&v"(f.r[0][0][1]), "=&v"(f.r[0][1][0]), "=&v"(f.r[0][1][1]), "=&v"(f.r[0][2][0]), "=&v"(f.r[0][2][1]), "=&v"(f.r[0][3][0]), "=&v"(f.r[0][3][1]),
                   "=&v"(f.r[1][0][0]), "=&v"(f.r[1][0][1]), "=&v"(f.r[1][1][0]), "=&v"(f.r[1][1][1]), "=&v"(f.r[1][2][0]), "=&v"(f.r[1][2][1]), "=&v"(f.r[1][3][0]), "=&v"(f.r[1][3][1])
                 : "v"(b[0]), "v"(b[1]), "v"(b[2]), "v"(b[3]) : "memory");
}
template <int DV> __device__ __forceinline__ void pv_sub(const f32x16& pr, const VFrag<DV>& f, f32x16 (&o)[DV / 32]) {
#pragma unroll
    for (int s2 = 0; s2 < 2; ++s2) {
        u32x4 pw; pw.x = cvt_pk_bf16(pr[8 * s2 + 0], pr[8 * s2 + 1]); pw.y = cvt_pk_bf16(pr[8 * s2 + 2], pr[8 * s2 + 3]);
        pw.z = cvt_pk_bf16(pr[8 * s2 + 4], pr[8 * s2 + 5]); pw.w = cvt_pk_bf16(pr[8 * s2 + 6], pr[8 * s2 + 7]);
        const bf16x8 pf = __builtin_bit_cast(bf16x8, pw);
#pragma unroll
        for (int db = 0; db < DV / 32; ++db) { const s16x4 lo = f.r[s2][db][0], hi = f.r[s2][db][1];
            bf16x8 vf; vf[0] = lo[0]; vf[1] = lo[1]; vf[2] = lo[2]; vf[3] = lo[3]; vf[4] = hi[0]; vf[5] = hi[1]; vf[6] = hi[2]; vf[7] = hi[3];
            o[db] = MFMA32(vf, pf, o[db]); }
    }
}
template <int DV> __device__ __forceinline__ void attn_sub_auto(const bf16x8 (&qf)[5], const unsigned char* kimg, const unsigned char* vimg, int sub, int key0, int tqw, int tq, int h,
                                                               int whi, bool lbit, WaveAcc<DV>& a, int lane) {
    f32x16 s = qk_sub(*(const bf16x8 (*)[4])&qf, kimg, sub, lane);
    { const int r32 = lane & 31, tk = key0 + r32; const unsigned hi = __float_as_uint((float)(tk >> 8)) >> 16, lo = __float_as_uint((float)(tk & 255)) & 0xffff0000u;
      u32x4 kw; kw.x = (lane < 32) ? (hi | lo) : 0u; kw.y = 0u; kw.z = 0u; kw.w = 0u;
      s = MFMA32(__builtin_bit_cast(bf16x8, kw), qf[4], s); }
    VFrag<DV> vf; v_read_all(vf, vimg, sub, lane);
    const bool interior = (tqw - (key0 + 31) >= 0) && (tqw + 31 - key0 < whi) && __all(lbit);
    if (!interior) { const int d0 = tq - key0 - 4 * h;
#pragma unroll
        for (int r = 0; r < 16; ++r) { const int dist = d0 - ((r & 3) + 8 * (r >> 2)); s[r] = (lbit && dist >= 0 && dist < whi) ? s[r] : -INFINITY; } }
    float tmax = fmaxf(fmaxf(s[0], s[1]), fmaxf(s[2], s[3]));
#pragma unroll
    for (int r = 4; r < 16; r += 4) tmax = fmaxf(tmax, fmaxf(fmaxf(s[r], s[r + 1]), fmaxf(s[r + 2], s[r + 3])));
    tmax = swap_max(tmax);
    if (!__all(tmax - a.m <= 8.0f)) {
        const float mnew = fmaxf(a.m, tmax), alpha = fast_exp2((a.m - mnew) * LOG2E);
        a.l *= alpha; a.m = mnew;
#pragma unroll
        for (int d = 0; d < DV / 32; ++d)
#pragma unroll
            for (int r = 0; r < 16; ++r) a.o[d][r] *= alpha;
    }
    const float nm = -a.m * LOG2E;
    float rs0 = 0.f, rs1 = 0.f;
#pragma unroll
    for (int r = 0; r < 16; r += 2) { s[r] = fast_exp2(__builtin_fmaf(s[r], LOG2E, nm)); s[r + 1] = fast_exp2(__builtin_fmaf(s[r + 1], LOG2E, nm)); rs0 += s[r]; rs1 += s[r + 1]; }
    a.l += rs0 + rs1;
    pv_sub<DV>(s, vf, a.o);
}
__device__ __forceinline__ void load_q(bf16x8 (&qf)[5], const bf16_t* qp  , float slope, int lane) {
#pragma unroll
    for (int ks = 0; ks < 4; ++ks) qf[ks] = *(const bf16x8*)(qp + 16 * ks);
    u32x4 qw; qw.x = (lane < 32) ? ((__float_as_uint(256.0f * slope) >> 16) | (__float_as_uint(slope) & 0xffff0000u)) : 0u; qw.y = 0u; qw.z = 0u; qw.w = 0u;
    qf[4] = __builtin_bit_cast(bf16x8, qw);
}
template <int DV> __device__ __forceinline__ void store_o(const f32x16 (&o)[DV / 32], float sc, bf16_t* orow, int h) {
#pragma unroll
    for (int db = 0; db < DV / 32; ++db)
#pragma unroll
        for (int rg = 0; rg < 4; ++rg) { u32x2 w; w.x = cvt_pk_bf16(o[db][4 * rg] * sc, o[db][4 * rg + 1] * sc); w.y = cvt_pk_bf16(o[db][4 * rg + 2] * sc, o[db][4 * rg + 3] * sc);
            *(u32x2*)(orow + db * 32 + 8 * rg + 4 * h) = w; }
}


template <bool SINK> __device__ __forceinline__ void attn_window_unit(KP p, int l, int b, int hkv, int qt, int W, int cq, int ck, int cv, bf16_t* outbuf, unsigned char* lds) {
    const int tid = hidden_tid(), lane = tid & 63, wv = __builtin_amdgcn_readfirstlane(tid >> 6), r32 = lane & 31, h = lane >> 5, g = wv & 3, qsub = wv >> 2;
    const int head = hkv * 4 + g, t0 = qt * 64, tqw = t0 + 32 * qsub, tq = tqw + r32;
    const bf16_t* z = (const bf16_t*)(p->ws + OFF_Z);
    const float slope = exp2f(-(float)(head + 1));
    KVSrc src; src.k = (const char*)(z + (size_t)b * NS * ZW + ck + hkv * 64); src.v = (const char*)(z + (size_t)b * NS * ZW + cv + hkv * 64); src.kstride = ZW * 2; src.vstride = ZW * 2;
    int klo = t0 - W + 1; klo = klo < 0 ? 0 : klo; const int kt0 = klo >> 6, kt1 = qt;
    WaveAcc<64> a; acc_init(a);
    KVRing<1, 64> ring; ring.init(src, tid);
    const int nt = kt1 - kt0 + 1;
    for (int j = 0; j < RING_AHEAD && j < nt; ++j) ring.issue((kt1 - j) * 64, j, lds);
    bf16x8 qf[5]; load_q(qf, z + ((size_t)b * NS + tq) * ZW + cq + head * 64 + 8 * h, slope, lane);
    asm volatile("" :: "v"(qf[0]), "v"(qf[1]), "v"(qf[2]), "v"(qf[3]));
    asm volatile(".p2align 8");
    for (int t = 0; t < nt; ++t) {
        const int kt = kt1 - t, buf = t & (RING_NB - 1);
        ring.wait_bar(nt - 1 - t);
        if (t + RING_AHEAD < nt) ring.issue((kt - RING_AHEAD) * 64, (t + RING_AHEAD) & (RING_NB - 1), lds);
        const unsigned char* kimg = ring.kimg(lds, buf, 0); const unsigned char* vimg = ring.vimg(lds, buf);
#pragma unroll
        for (int sr = 0; sr < 2; ++sr) { const int sub = 1 - sr, key0 = kt * 64 + 32 * sub;
            if (key0 <= tqw + 31 && key0 + 31 >= tqw - W + 1) attn_sub_auto<64>(qf, kimg, vimg, sub, key0, tqw, tq, h, W, true, a, lane); }
    }
    __syncthreads();
    float den = swap_sum(a.l);
    if (SINK) den += fast_exp2((p->sinks[l * 8 + head] + slope * (float)tq - a.m) * LOG2E);
    store_o<64>(a.o, 1.0f / den, outbuf + ((size_t)b * NS + tq) * 512 + head * 64, h);
}

#ifndef EXPER
#define EXPER 0
#endif
__device__ __forceinline__ void attn_diff_unit(KP p, int l, int b, int hd, int qt, unsigned char* lds, const int shadow = 0) {
    const int tid = hidden_tid(), lane = tid & 63, wv = __builtin_amdgcn_readfirstlane(tid >> 6), r32 = lane & 31, h = lane >> 5, c = wv & 1, qsub = wv >> 1;
    const int t0 = qt * 128, tqw = t0 + 32 * qsub, tq = tqw + r32;
    const bf16_t* z = (const bf16_t*)(p->ws + OFF_Z);
    KVSrc src; src.k = (const char*)(z + (size_t)b * NS * ZW + C_KB + hd * 128); src.v = (const char*)(z + (size_t)b * NS * ZW + C_VB + hd * 128); src.kstride = ZW * 2; src.vstride = ZW * 2;
    const int kt1 = 2 * qt + 1;
    WaveAcc<128> a; acc_init(a);
    KVRing<2, 128> ring; ring.init(src, tid);
    const int nt = kt1 + 1;
    for (int j = 0; j < RING_AHEAD && j < nt; ++j) ring.issue((kt1 - j) * 64, j, lds);
    bf16x8 qf[5]; load_q(qf, z + ((size_t)b * NS + tq) * ZW + C_QB + hd * 128 + c * 64 + 8 * h, exp2f(-2.0f * (float)(hd + 1)), lane);
    asm volatile("" :: "v"(qf[0]), "v"(qf[1]), "v"(qf[2]), "v"(qf[3]));
    asm volatile(".p2align 8");
    for (int t = 0; t < nt; ++t) {
        const int kt = kt1 - t, buf = t & (RING_NB - 1);
        ring.wait_bar(nt - 1 - t);
        if (t + RING_AHEAD < nt) ring.issue((kt - RING_AHEAD) * 64, (t + RING_AHEAD) & (RING_NB - 1), lds);
        const unsigned char* kimg = ring.kimg(lds, buf, c); const unsigned char* vimg = ring.vimg(lds, buf);
#pragma unroll
        for (int sr = 0; sr < 2; ++sr) { const int sub = 1 - sr, key0 = kt * 64 + 32 * sub;
            if (key0 <= tqw + 31) {
                if (shadow && EXPER == 1) { }
                else attn_sub_auto<128>(qf, kimg, vimg, sub, key0, tqw, tq, h, 1 << 30, true, a, lane); } }
    }
    __syncthreads();
    const float lam_init = 0.8f - 0.6f * expf(-0.3f * (float)l);
    const float lam = ((const float*)p->ws)[CW_LAM + l];
    const float inv = 1.0f / swap_sum(a.l);
    float* ex = (float*)lds;
    if (c == 1) {
#pragma unroll
        for (int db = 0; db < 4; ++db)
#pragma unroll
            for (int r = 0; r < 16; ++r) ex[(qsub * 128 + db * 32 + crow(r, h)) * 32 + r32] = a.o[db][r] * inv;
    }
    __syncthreads();
    if (c == 0) {
        float ss = 0.f;
#pragma unroll
        for (int db = 0; db < 4; ++db)
#pragma unroll
            for (int r = 0; r < 16; ++r) { const float v = a.o[db][r] * inv - lam * ex[(qsub * 128 + db * 32 + crow(r, h)) * 32 + r32]; a.o[db][r] = v; ss += v * v; }
        ss = swap_sum(ss);
        const float rn = (1.0f - lam_init) / sqrtf(ss * (1.0f / 128.0f) + 1e-5f);
        const float* sg = p->diff_subln_g + (size_t)l * 128;
        bf16_t* orow = (shadow ? (bf16_t*)(p->ws + OFF_MSCR) : (bf16_t*)(p->ws + OFF_OABC) + (size_t)1 * NTOK * 512) + ((size_t)b * NS + tq) * 512 + hd * 128;
#pragma unroll
        for (int db = 0; db < 4; ++db)
#pragma unroll
            for (int rg = 0; rg < 4; ++rg) { const int d = db * 32 + 8 * rg + 4 * h; const f32x4 gv = *(const f32x4*)(sg + d);
                u32x2 w; w.x = cvt_pk_bf16(a.o[db][4 * rg] * rn * gv[0], a.o[db][4 * rg + 1] * rn * gv[1]); w.y = cvt_pk_bf16(a.o[db][4 * rg + 2] * rn * gv[2], a.o[db][4 * rg + 3] * rn * gv[3]);
                *(u32x2*)(orow + d) = w; }
    }
    __syncthreads();
}

#define AT_IMP   (AT_MISC)
#define AT_SELM  (AT_MISC + 34816)
__device__ __forceinline__ void attn_nsa_unit(KP p, int l, int b, int hkv, int qt, unsigned char* lds) {
    const int tid = hidden_tid(), lane = tid & 63, wv = __builtin_amdgcn_readfirstlane(tid >> 6), r32 = lane & 31, h = lane >> 5, g = wv & 3, qsub = wv >> 2;
    const int head = hkv * 4 + g, t0 = qt * 64, tqw = t0 + 32 * qsub, tq = tqw + r32;
    const bf16_t* z = (const bf16_t*)(p->ws + OFF_Z);
    bf16x8 qf[5]; load_q(qf, z + ((size_t)b * NS + tq) * ZW + C_QC + head * 64 + 8 * h, exp2f(-(float)(head + 1)), lane);
    float* imp = (float*)(lds + AT_IMP); unsigned* selm = (unsigned*)(lds + AT_SELM);
    KVRing<1, 64> ring;
    f32x16 ocmp[2];
    {
        const bf16_t* kvc = (const bf16_t*)(p->ws + OFF_KVC);
        KVSrc cs; cs.k = (const char*)(kvc + ((size_t)(0 * 16 + b) * 2 + hkv) * 128 * 64); cs.v = (const char*)(kvc + ((size_t)(1 * 16 + b) * 2 + hkv) * 128 * 64); cs.kstride = 128; cs.vstride = 128;
        ring.init(cs, tid); ring.issue(0, 0, lds); ring.issue(64, 1, lds);
        if (tid == 0) selm[64] = 0u;
        ring.wait_bar(0);
        f32x16 sc[4];
#pragma unroll
        for (int st = 0; st < 4; ++st) sc[st] = qk_sub(*(const bf16x8 (*)[4])&qf, ring.kimg(lds, st >> 1, 0), st & 1, lane);
        const int nvalid = tq >= 31 ? min(127, ((tq - 31) >> 4) + 1) : 0;
        float mx = -1e30f;
#pragma unroll
        for (int st = 0; st < 4; ++st)
#pragma unroll
            for (int r = 0; r < 16; ++r) { const int cidx = 32 * st + crow(r, h); const float v = cidx < nvalid ? sc[st][r] * LOG2E : -INFINITY; sc[st][r] = v; mx = fmaxf(mx, v); }
        mx = swap_max(mx);
        float ls = 0.f;
#pragma unroll
        for (int st = 0; st < 4; ++st)
#pragma unroll
            for (int r = 0; r < 16; ++r) { sc[st][r] = fast_exp2(sc[st][r] - mx); ls += sc[st][r]; }
        ls = swap_sum(ls); const float inv = ls > 0.f ? 1.0f / ls : 0.f;
        float Bv[4][4];
#pragma unroll
        for (int st = 0; st < 4; ++st)
#pragma unroll
            for (int r = 0; r < 16; ++r) sc[st][r] *= inv;
#pragma unroll
        for (int st = 0; st < 4; ++st)
#pragma unroll
            for (int g4 = 0; g4 < 4; ++g4) Bv[st][g4] = swap_other(sc[st][4 * g4 + 3], h);
#pragma unroll
        for (int st = 0; st < 4; ++st)
#pragma unroll
            for (int g4 = 0; g4 < 4; ++g4) {
                const float A = sc[st][4 * g4] + sc[st][4 * g4 + 1] + sc[st][4 * g4 + 2] + 0.5f * sc[st][4 * g4 + 3];
                const float prevlo = g4 > 0 ? Bv[st][g4 - 1] : (st > 0 ? Bv[st - 1][3] : 0.f);
                const float prev = h ? Bv[st][g4] : prevlo;
                imp[(g * 64 + qsub * 32 + r32) * 33 + 8 * st + 2 * g4 + h] = A + 0.5f * prev;
            }
#pragma unroll
        for (int d = 0; d < 2; ++d)
#pragma unroll
            for (int r = 0; r < 16; ++r) ocmp[d][r] = 0.f;
#pragma unroll
        for (int st = 0; st < 4; ++st) { VFrag<64> vf; v_read_all(vf, ring.vimg(lds, st >> 1), st & 1, lane); pv_sub<64>(sc[st], vf, ocmp); }
    }
    __syncthreads();
    const int cur = qt;
    for (int i = tid; i < 64 * 32; i += NTHREADS) { const int q = i >> 5, n = i & 31; imp[q * 33 + n] = (imp[q * 33 + n] + imp[(64 + q) * 33 + n]) + (imp[(128 + q) * 33 + n] + imp[(192 + q) * 33 + n]); }
    __syncthreads();
#pragma unroll 1
    for (int ps = 0; ps < 4; ++ps) {
        const int i = ps * NTHREADS + tid, q = i >> 5, n = i & 31;
        const bool forced = (n == 0) | (n == cur) | (n == cur - 1);
        const float kn = forced ? INFINITY : imp[q * 33 + n];
        int rank = 0;
#pragma unroll
        for (int m2 = 0; m2 < 32; ++m2) { const float km = __int_as_float(__builtin_amdgcn_ds_bpermute(((lane & 32) + m2) << 2, __float_as_int(kn)));
            rank += (m2 <= cur) && (m2 != n) && ((km > kn) || (km == kn && m2 < n)); }
        const bool sel = (n <= cur) && (rank < 16);
        const unsigned long long bal = __ballot(sel);
        if ((lane & 31) == 0) { const unsigned mk = (unsigned)(lane ? (bal >> 32) : bal); selm[q] = mk; atomicOr(&selm[64], mk); }
    }
    __syncthreads();
    const unsigned mymask = selm[qsub * 32 + r32]; unsigned um = __builtin_amdgcn_readfirstlane(selm[64]);
    WaveAcc<64> a; acc_init(a);
    {
        KVSrc src; src.k = (const char*)(z + (size_t)b * NS * ZW + C_KSL + hkv * 64); src.v = (const char*)(z + (size_t)b * NS * ZW + C_VSL + hkv * 64); src.kstride = ZW * 2; src.vstride = ZW * 2;
        ring.init(src, tid);
        unsigned m_issue = um; int nis = 0, ncp = 0; const int ntl = __popc(um);
        for (int j = 0; j < RING_AHEAD && m_issue; ++j) { const int kt = 31 - __clz((int)m_issue); m_issue &= ~(1u << kt); ring.issue(kt * 64, nis & (RING_NB - 1), lds); ++nis; }
    asm volatile(".p2align 8");
        while (um) {
            const int kt = 31 - __clz((int)um); um &= ~(1u << kt); const int buf = ncp & (RING_NB - 1);
            ring.wait_bar(nis - 1 - ncp);
            if (m_issue) { const int ktn = 31 - __clz((int)m_issue); m_issue &= ~(1u << ktn); ring.issue(ktn * 64, nis & (RING_NB - 1), lds); ++nis; }
            const bool lbit = (mymask >> kt) & 1u;
            if (__any(lbit)) {
                const unsigned char* kimg = ring.kimg(lds, buf, 0); const unsigned char* vimg = ring.vimg(lds, buf);
#pragma unroll
                for (int sr = 0; sr < 2; ++sr) { const int sub = 1 - sr, key0 = kt * 64 + 32 * sub;
                    if (key0 <= tqw + 31) attn_sub_auto<64>(qf, kimg, vimg, sub, key0, tqw, tq, h, 1 << 30, lbit, a, lane); }
            }
            ++ncp;
        }
        (void)ntl;
    }
    {
        const size_t tok = (size_t)b * NS + tq;
        const bf16_t* gp = z + tok * ZW + C_GN + head * 3;
        const float gc = bf2f(gp[0]), gs = bf2f(gp[1]) / swap_sum(a.l), gw = bf2f(gp[2]);
        const bf16_t* ow = (const bf16_t*)(p->ws + OFF_OWIN) + tok * 512 + head * 64;
        bf16_t* oc = (bf16_t*)(p->ws + OFF_OABC) + (size_t)2 * NTOK * 512 + tok * 512 + head * 64;
#pragma unroll
        for (int db = 0; db < 2; ++db)
#pragma unroll
            for (int rg = 0; rg < 4; ++rg) { const int d = db * 32 + 8 * rg + 4 * h; const u32x2 wv2 = *(const u32x2*)(ow + d);
                const float o0 = gc * ocmp[db][4 * rg] + gs * a.o[db][4 * rg] + gw * bflo(wv2.x), o1 = gc * ocmp[db][4 * rg + 1] + gs * a.o[db][4 * rg + 1] + gw * bfhi(wv2.x);
                const float o2 = gc * ocmp[db][4 * rg + 2] + gs * a.o[db][4 * rg + 2] + gw * bflo(wv2.y), o3 = gc * ocmp[db][4 * rg + 3] + gs * a.o[db][4 * rg + 3] + gw * bfhi(wv2.y);
                u32x2 w; w.x = cvt_pk_bf16(o0, o1); w.y = cvt_pk_bf16(o2, o3); *(u32x2*)(oc + d) = w; }
    }
    __syncthreads();
}

__device__ __forceinline__ void compress_unit(KP p, int l, int u, unsigned char* lds) {
    char* ws = p->ws;
    const int kv = u >> 4, rt = u & 15;
    GemmOperands g; g.Abase = ws + OFF_Z; g.kstride = ZW * 2; g.K = 2048; g.Bbase = ws + OFF_WC1 + ((size_t)(l * 2 + kv) * 256) * 2048 * 2;
GEMM_STAGE_IDS();
#pragma unroll
    for (int i = 0; i < 4; ++i) { const int row = rt * 256 + TILE_ROW(i), bh = row >> 7, b = bh >> 1, hk = bh & 1; int c = row & 127; c = c > 126 ? 126 : c;
        g.aoff[i] = (unsigned)((((size_t)b * NS + 16 * c) * ZW + (kv ? C_VCM : C_KCM) + hk * 64 + cS) * 2); } g.boff = (unsigned)((rS * 2048 + cS) * 2);
    f32x4 acc[2][2][4][2];
    gemm_unit(g, (bf16_t*)lds, acc);
    GEMM_LANE_IDS();
    const float* cb = (const float*)(ws + OFF_CBIAS) + (size_t)(l * 2 + kv) * 4 * 256; const float* cb1 = p->cmp_b1 + (l * 2 + kv) * 256;
#pragma unroll
    for (int bj = 0; bj < 2; ++bj)
#pragma unroll
        for (int n = 0; n < 2; ++n) { const int col = bj * 128 + wc * 32 + n * 16 + fq * 4; const f32x4 bv = (*(const f32x4*)(cb + col) + *(const f32x4*)(cb + 256 + col)) + (*(const f32x4*)(cb + 512 + col) + *(const f32x4*)(cb + 768 + col)) + *(const f32x4*)(cb1 + col);
#pragma unroll
            for (int ai = 0; ai < 2; ++ai)
#pragma unroll
                for (int m = 0; m < 4; ++m) { const int row = ai * 128 + wr * 64 + m * 16 + fr; f32x4 v = acc[ai][bj][m][n] + bv;
#pragma unroll
                    for (int j = 0; j < 4; ++j) { const float x = v[j]; v[j] = x * sigmoidf_(1.5957691216057308f * (x + 0.044715f * x * x * x)); }
                    u32x2 w; w.x = cvt_pk_bf16(v[0], v[1]); w.y = cvt_pk_bf16(v[2], v[3]); *(u32x2*)(lds + row * 528 + col * 2) = w; } }
    __syncthreads();
    {
        const bf16_t* w2 = (const bf16_t*)(ws + OFF_WC2) + (size_t)(l * 2 + kv) * 64 * 256;
        f32x4 c2[2][4];
#pragma unroll
        for (int mt = 0; mt < 2; ++mt)
#pragma unroll
            for (int nt = 0; nt < 4; ++nt) c2[mt][nt] = (f32x4){0.f, 0.f, 0.f, 0.f};
#pragma unroll
        for (int ks = 0; ks < 8; ++ks) {
            bf16x8 af[2], bfr[4];
#pragma unroll
            for (int mt = 0; mt < 2; ++mt) af[mt] = *(const bf16x8*)(lds + (wid * 32 + mt * 16 + fr) * 528 + (ks * 32 + fq * 8) * 2);
#pragma unroll
            for (int nt = 0; nt < 4; ++nt) bfr[nt] = *(const bf16x8*)(w2 + (size_t)(nt * 16 + fr) * 256 + ks * 32 + fq * 8);
#pragma unroll
            for (int mt = 0; mt < 2; ++mt)
#pragma unroll
                for (int nt = 0; nt < 4; ++nt) c2[mt][nt] = __builtin_amdgcn_mfma_f32_16x16x32_bf16(af[mt], bfr[nt], c2[mt][nt], 0, 0, 0);
        }
        bf16_t* kvc = (bf16_t*)(ws + OFF_KVC) + (size_t)kv * 16 * 2 * 128 * 64;
        const float* b2 = p->cmp_b2 + (l * 2 + kv) * 64;
#pragma unroll
        for (int mt = 0; mt < 2; ++mt)
#pragma unroll
            for (int nt = 0; nt < 4; ++nt)
#pragma unroll
                for (int r = 0; r < 4; ++r) { const int row = rt * 256 + wid * 32 + mt * 16 + 4 * fq + r, col = nt * 16 + fr;
                    kvc[(size_t)row * 64 + col] = f2bf(c2[mt][nt][r] + b2[col]); }
    }
    __syncthreads();
}

#define RT_HS    0
#define RT_LG    132096
#define RT_HIST  (RT_LG + 8448)
#ifndef REPN2
#define REPN2 1
#endif
__device__ __forceinline__ void phase_norm2_router(KP p, int l, unsigned char* lds) {
  for (int shadow = 0; shadow < REPN2; ++shadow) {
    char* ws = p->ws; const int tid = hidden_tid(), lane = tid & 63, wv = __builtin_amdgcn_readfirstlane(tid >> 6);
    const float* modl = (const float*)(ws + OFF_MOD) + (size_t)l * 16 * 6144; const float* g = p->norm2_g + (size_t)l * 1024;
    const bf16_t* xrb = (const bf16_t*)(ws + OFF_XR);
    float* LG = (float*)(lds + RT_LG); int* hist = (int*)(lds + RT_HIST); int* basep = hist + 32;
    unsigned* ctrl = (unsigned*)ws;
    const bf16_t* wrt = (const bf16_t*)(ws + OFF_WRT) + (size_t)l * 2 * 32 * 1024;
    for (int chunk = hidden_bid(); chunk < NTOK / 64; chunk += gridDim.x) {
        if (tid < 32) hist[tid] = 0;
        {
            const int rowa = chunk * 64 + wv * 8, b = rowa >> 11;
            f32x4 gg[4], sc[4], sh[4]; u32x2 xn[4];
#pragma unroll
            for (int j = 0; j < 4; ++j) { const int col = 256 * j + 4 * lane; gg[j] = *(const f32x4*)(g + col); sc[j] = *(const f32x4*)(modl + (size_t)b * 6144 + 4096 + col); sh[j] = *(const f32x4*)(modl + (size_t)b * 6144 + 3072 + col);
                xn[j] = *(const u32x2*)(xrb + (size_t)rowa * 1024 + col); }
            for (int i = 0; i < 8; ++i) {
                const int rl = wv * 8 + i, row = rowa + i;
                f32x4 v[4]; float ss = 0.f;
#pragma unroll
                for (int j = 0; j < 4; ++j) { v[j] = (f32x4){bflo(xn[j].x), bfhi(xn[j].x), bflo(xn[j].y), bfhi(xn[j].y)};
                    ss += v[j][0] * v[j][0] + v[j][1] * v[j][1] + v[j][2] * v[j][2] + v[j][3] * v[j][3]; }
                if (i + 1 < 8) {
#pragma unroll
                    for (int j = 0; j < 4; ++j) { const int col = 256 * j + 4 * lane; xn[j] = *(const u32x2*)(xrb + (size_t)(row + 1) * 1024 + col); } }
                ss = wave_sum(ss, lane); const float r = 1.0f / sqrtf(ss * (1.0f / 1024.0f) + 1e-5f);
#pragma unroll
                for (int j = 0; j < 4; ++j) { const int col = 256 * j + 4 * lane;
                    float o[4];
#pragma unroll
                    for (int q = 0; q < 4; ++q) o[q] = v[j][q] * r * gg[j][q] * (1.0f + sc[j][q]) + sh[j][q];
                    u32x2 w; w.x = cvt_pk_bf16(o[0], o[1]); w.y = cvt_pk_bf16(o[2], o[3]);
                    if (!shadow) *(unsigned*)((unsigned char*)(ws + OFF_H8) + (size_t)row * 1024 + col) = pk4_fp8(o[0], o[1], o[2], o[3]);
                    *(u32x2*)(lds + RT_HS + rl * 2064 + col * 2) = w; }
            }
        }
        __syncthreads();
        {
            const int mt = wv & 3, nt = wv >> 2, fr = lane & 15, fq = lane >> 4;
            f32x4 acc = (f32x4){0.f, 0.f, 0.f, 0.f};
            const bf16_t* wh = wrt + (size_t)(nt * 16 + fr) * 1024 + fq * 8; const bf16_t* wl = wh + 32 * 1024;
            const unsigned char* ap = lds + RT_HS + (mt * 16 + fr) * 2064 + fq * 16;
#pragma unroll 4
            for (int ks = 0; ks < 32; ++ks) { const bf16x8 a = *(const bf16x8*)(ap + ks * 64); const bf16x8 bh = *(const bf16x8*)(wh + ks * 32), bl = *(const bf16x8*)(wl + ks * 32);
                acc = __builtin_amdgcn_mfma_f32_16x16x32_bf16(a, bh, acc, 0, 0, 0); acc = __builtin_amdgcn_mfma_f32_16x16x32_bf16(a, bl, acc, 0, 0, 0); }
            const float rb = p->router_b[l * 32 + nt * 16 + fr];
#pragma unroll
            for (int r = 0; r < 4; ++r) LG[(mt * 16 + 4 * fq + r) * 33 + nt * 16 + fr] = acc[r] + rb;
        }
        __syncthreads();
        int se[4], sp[4]; float sg[4];
        if (tid < 64) {
            unsigned taken = 0u; float tv[4];
#pragma unroll
            for (int k = 0; k < 4; ++k) { float best = -INFINITY; int bi = 0;
#pragma unroll 4
                for (int e = 0; e < 32; ++e) { const float v = LG[tid * 33 + e]; if (!((taken >> e) & 1u) && v > best) { best = v; bi = e; } }
                taken |= 1u << bi; se[k] = bi; tv[k] = best; }
            float den = 0.f;
#pragma unroll
            for (int k = 0; k < 4; ++k) { sg[k] = __expf(tv[k] - tv[0]); den += sg[k]; }
#pragma unroll
            for (int k = 0; k < 4; ++k) { sg[k] /= den; sp[k] = atomicAdd(&hist[se[k]], 1); }
        }
        __syncthreads();
        if (tid < 32) { const int c = hist[tid]; basep[tid] = (c && !shadow) ? (int)atomicAdd(&ctrl[CW_ECNT(l, tid)], (unsigned)c) : 0; }
        __syncthreads();
        if (tid < 64 && !shadow) { const int tok = chunk * 64 + tid;
#pragma unroll
            for (int k = 0; k < 4; ++k) { const int pos = basep[se[k]] + sp[k];
                ((int*)(ws + OFF_TOKE))[tok * 4 + k] = se[k]; ((int*)(ws + OFF_TOKP))[tok * 4 + k] = pos; ((float*)(ws + OFF_TOKG))[tok * 4 + k] = sg[k];
                ((int*)(ws + OFF_BUCK))[(size_t)se[k] * NTOK + pos] = tok; } }
        __syncthreads();
    }
}
  __syncthreads(); }


__device__ __forceinline__ void phase_combine(KP p, int l, unsigned char* lds) {
    char* ws = p->ws; const int tid = hidden_tid(), lane = tid & 63, wv = tid >> 6;
    int* tbl = (int*)lds; moe_tables(p, l, tbl);
    bf16_t* xr = (bf16_t*)(ws + OFF_XR); const bf16_t* y = (const bf16_t*)(ws + OFF_Y); bf16_t* hb = (bf16_t*)(ws + OFF_HB);
    const bool last = (l + 1 == NLAYER);
    for (int gw = hidden_bid() * 8 + wv; gw < NTOK / 16; gw += gridDim.x * 8) {
        const int row0 = gw * 16, b = row0 >> 11;
        const float* modl = (const float*)(ws + OFF_MOD) + ((size_t)l * 16 + b) * 6144;
        const float* gn = last ? p->final_g : p->norm1_g + (size_t)(l + 1) * 1024;
        const float* modn = (const float*)(ws + OFF_MOD) + ((size_t)(last ? l : l + 1) * 16 + b) * 6144;
        f32x4 g2[4], gg[4], sc[4], sh[4];
#pragma unroll
        for (int j = 0; j < 4; ++j) { const int col = 256 * j + 4 * lane; g2[j] = *(const f32x4*)(modl + 5120 + col); gg[j] = *(const f32x4*)(gn + col);
            sc[j] = last ? (f32x4){0.f, 0.f, 0.f, 0.f} : *(const f32x4*)(modn + 1024 + col); sh[j] = last ? (f32x4){0.f, 0.f, 0.f, 0.f} : *(const f32x4*)(modn + col); }
        typedef int i32x4_ __attribute__((ext_vector_type(4)));
        i32x4_ te = *(const i32x4_*)((const int*)(ws + OFF_TOKE) + (size_t)row0 * 4), tp = *(const i32x4_*)((const int*)(ws + OFF_TOKP) + (size_t)row0 * 4);
        f32x4 tg = *(const f32x4*)((const float*)(ws + OFF_TOKG) + (size_t)row0 * 4);
        u32x2 xin[4]; u32x2 yin[4][4]; float gk[4];
        auto load_row = [&](int row, const i32x4_& e4, const i32x4_& p4, const f32x4& g4) {
#pragma unroll
            for (int k = 0; k < 4; ++k) { const bf16_t* yr = y + ((size_t)tbl[e4[k]] * 256 + p4[k]) * 1024; gk[k] = g4[k];
#pragma unroll
                for (int j = 0; j < 4; ++j) yin[k][j] = *(const u32x2*)(yr + 256 * j + 4 * lane); }
#pragma unroll
            for (int j = 0; j < 4; ++j) xin[j] = *(const u32x2*)(xr + (size_t)row * 1024 + 256 * j + 4 * lane);
        };
        load_row(row0, te, tp, tg);
        if (16 > 1) { te = *(const i32x4_*)((const int*)(ws + OFF_TOKE) + (size_t)(row0 + 1) * 4); tp = *(const i32x4_*)((const int*)(ws + OFF_TOKP) + (size_t)(row0 + 1) * 4); tg = *(const f32x4*)((const float*)(ws + OFF_TOKG) + (size_t)(row0 + 1) * 4); }
        for (int i = 0; i < 16; ++i) {
            const int row = row0 + i;
            f32x4 v[4]; float ss = 0.f;
#pragma unroll
            for (int j = 0; j < 4; ++j) { f32x4 m = (f32x4){0.f, 0.f, 0.f, 0.f};
#pragma unroll
                for (int k = 0; k < 4; ++k) { const u32x2 w = yin[k][j]; m[0] += gk[k] * bflo(w.x); m[1] += gk[k] * bfhi(w.x); m[2] += gk[k] * bflo(w.y); m[3] += gk[k] * bfhi(w.y); }
                v[j] = (f32x4){bflo(xin[j].x), bfhi(xin[j].x), bflo(xin[j].y), bfhi(xin[j].y)} + g2[j] * m;
                ss += v[j][0] * v[j][0] + v[j][1] * v[j][1] + v[j][2] * v[j][2] + v[j][3] * v[j][3]; }
            if (i + 1 < 16) { load_row(row + 1, te, tp, tg);
                if (i + 2 < 16) { te = *(const i32x4_*)((const int*)(ws + OFF_TOKE) + (size_t)(row + 2) * 4); tp = *(const i32x4_*)((const int*)(ws + OFF_TOKP) + (size_t)(row + 2) * 4); tg = *(const f32x4*)((const float*)(ws + OFF_TOKG) + (size_t)(row + 2) * 4); } }
            ss = wave_sum(ss, lane); const float r = 1.0f / sqrtf(ss * (1.0f / 1024.0f) + 1e-5f);
#pragma unroll
            for (int j = 0; j < 4; ++j) { const int col = 256 * j + 4 * lane;
                if (last) { *(f32x4*)(p->out + (size_t)row * 1024 + col) = v[j] * r * gg[j]; }
                else { u32x2 xw; xw.x = cvt_pk_bf16(v[j][0], v[j][1]); xw.y = cvt_pk_bf16(v[j][2], v[j][3]); *(u32x2*)(xr + (size_t)row * 1024 + col) = xw; float o[4];
#pragma unroll
                    for (int q = 0; q < 4; ++q) o[q] = v[j][q] * r * gg[j][q] * (1.0f + sc[j][q]) + sh[j][q];
#if INPROJ_FP8
                    *(unsigned*)((unsigned char*)hb + (size_t)row * 1024 + col) = pk4_fp8(o[0], o[1], o[2], o[3]); }
#else
                    u32x2 w; w.x = cvt_pk_bf16(o[0], o[1]); w.y = cvt_pk_bf16(o[2], o[3]); *(u32x2*)(hb + (size_t)row * 1024 + col) = w; }
#endif
            }
        }
    }
}

#ifndef SWA_IN_AT2
#define SWA_IN_AT2 1
#endif
#define LDS_QSLOT (LDS_BYTES - 64)
#define LDS_BARW  (LDS_BYTES - 16)
__device__ __forceinline__ int q_next(unsigned* ctr, unsigned char* lds) {
    __syncthreads();
    if (hidden_tid() == 0) *(int*)(lds + LDS_QSLOT) = (int)__hip_atomic_fetch_add(ctr, 1u, __ATOMIC_RELAXED, __HIP_MEMORY_SCOPE_AGENT);
    __syncthreads();
    return __builtin_amdgcn_readfirstlane(*(int*)(lds + LDS_QSLOT));
}
__device__ __forceinline__ void phase_at1(KP p, int lq, unsigned char* lds) {
    unsigned* ctrl = (unsigned*)p->ws; const int l = lq & 1;
#ifndef SUB
#define SUB -1
#endif
#ifndef DBLSUB
#define DBLSUB -1
#endif
#ifndef REP0
#define REP0 1
#endif
#ifndef REP1
#define REP1 1
#endif
#ifndef REP2
#define REP2 1
#endif
#ifndef REP3
#define REP3 1
#endif
#ifndef REP4
#define REP4 1
#endif
#define SUBON(k) ((SUB < 0 || SUB == (k)) && (lq < 2 || DBLSUB < 0 || DBLSUB == (k)))
    if (SUBON(0)) for (int rep = 0; rep < REP0; ++rep) for (;;) { const int u = q_next(ctrl + CW_QCTR(lq + 2 * rep, 0), lds); if (u >= 32) break; compress_unit(p, l, u, lds); }
    if (SUBON(1)) for (int rep = 0; rep < REP1; ++rep) for (;;) { const int u = q_next(ctrl + CW_QCTR(lq + 2 * rep, 1), lds); if (u >= 1024) break; attn_diff_unit(p, l, (u & 63) >> 2, u & 3, 15 - (u >> 6), lds, rep); if (COSCHED && rep == 0) xpose8_group(p, l, u, lds); }
    if (SUBON(2)) for (int rep = 0; rep < REP2; ++rep) for (;;) { const int u = q_next(ctrl + CW_QCTR(lq + 2 * rep, 2), lds); if (u >= 1024) break;
        attn_window_unit<false>(p, l, (u & 31) >> 1, u & 1, 31 - (u >> 5), 512, C_QC, C_KWN, C_VWN, (bf16_t*)(p->ws + OFF_OWIN), lds); if (COSCHED && rep == 0) xpose8_group(p, l, 1024 + u, lds); }
#if !SWA_IN_AT2
    if (SUBON(3)) for (int rep = 0; rep < REP3; ++rep) for (;;) { const int u = q_next(ctrl + CW_QCTR(lq + 2 * rep, 3), lds); if (u >= 1024) break;
        attn_window_unit<true>(p, l, (u & 31) >> 1, u & 1, 31 - (u >> 5), 128, C_QA, C_KA, C_VA, (bf16_t*)(p->ws + OFF_OABC), lds); if (COSCHED && rep == 0) xpose8_group(p, l, 2048 + u, lds); }
#endif
}
__device__ __forceinline__ void phase_at2(KP p, int lq, unsigned char* lds) {
    unsigned* ctrl = (unsigned*)p->ws; const int l = lq & 1;
    for (int rep = 0; rep < REP4; ++rep) for (;;) { const int u = q_next(ctrl + CW_QCTR(lq + 2 * rep, 4), lds); if (u >= 1024) break; attn_nsa_unit(p, l, (u & 31) >> 1, u & 1, 31 - (u >> 5), lds); }
#if SWA_IN_AT2
    for (int rep = 0; rep < REP3; ++rep) for (;;) { const int u = q_next(ctrl + CW_QCTR(lq + 2 * rep, 3), lds); if (u >= 1024) break;
        attn_window_unit<true>(p, l, (u & 31) >> 1, u & 1, 31 - (u >> 5), 128, C_QA, C_KA, C_VA, (bf16_t*)(p->ws + OFF_OABC), lds); if (COSCHED && rep == 0) xpose8_group(p, l, 2048 + u, lds); }
#endif
}

#define NPHASE 20
__global__ void __launch_bounds__(NTHREADS, 2) mega(Params pv_unused) {
    KP p0 = (KP)__builtin_amdgcn_kernarg_segment_ptr();
    extern __shared__ __attribute__((aligned(16))) unsigned char lds0[];
    volatile LAS unsigned* st = (volatile LAS unsigned*)(lds0 + LDS_BARW);
    if (hidden_tid() == 0) { st[0] = 0u; st[1] = 0u; st[2] = 0u; st[3] = 0u; }
    __syncthreads();
    XcdBarrier bar = xcd_barrier_post((unsigned*)p0->ws, st);
    int ph = 0;
#ifndef DBL
#define DBL -1
#endif
    int qrep = 0; (void)qrep;
#define PHASE(body) { KP p = p0; asm volatile("" : "+s"(p)); unsigned char* lds = lds0; (void)lds; if (ph >= p->ph_lo && ph <= p->ph_hi) { body; if (ph < p->ph_hi) xcd_barrier(bar); } ++ph; }
#ifndef ONLY
#define ONLY -1
#endif
#ifndef DBLL
#define DBLL -1
#endif
    int lcur = -1; (void)lcur;
#define SEL(n, body) { if (ONLY < 0 || ONLY == (n)) { body; if (DBL == (n) && (DBLL < 0 || DBLL == lcur)) { xcd_barrier(bar); qrep = 2; body; qrep = 0; } } }
    PHASE(SEL(0, phase_prologue(p, lds)));
    PHASE(SEL(1, phase_norm_mod(p->x, p->norm1_g, (const float*)(p->ws + OFF_MOD), 0, 1024, (bf16_t*)(p->ws + OFF_HB))));
#pragma unroll
    for (int l = 0; l < NLAYER; ++l) { lcur = l;
        PHASE(SEL(2, phase_inproj(p, l, lds)));
        PHASE(SEL(3, phase_at1(p, l + qrep, lds)));
        PHASE(SEL(4, phase_at2(p, l + qrep, lds)));
        PHASE(SEL(5, phase_merge(p, l, lds)));
        PHASE(SEL(6, phase_outproj(p, l, lds)));
        PHASE(SEL(7, phase_norm2_router(p, l, lds)));
        PHASE(SEL(8, phase_moe1(p, l, lds)));
        PHASE(SEL(9, phase_moe2(p, l, lds)));
        PHASE(SEL(10, phase_combine(p, l, lds)));
    }
}

#ifndef MK_LAUNCHES
#define MK_LAUNCHES 1
#endif
extern "C" void kernel_launch(void* const* d_in, const int* in_sizes, int n_in, void* d_out, int out_size, void* d_ws, size_t ws_size, hipStream_t stream) {
    if (ws_size < WS_NEED) { fprintf(stderr, "workspace too small: %zu < %zu\n", ws_size, (size_t)WS_NEED); return; }
    static bool attr_done = false;
    if (!attr_done) { hipFuncSetAttribute((const void*)mega, hipFuncAttributeMaxDynamicSharedMemorySize, LDS_BYTES); attr_done = true; }
    Params p{};
    const float** f = (const float**)&p;
    for (int i = 0; i < 25; ++i) f[i] = (const float*)d_in[i];
    p.out = (float*)d_out; p.ws = (char*)d_ws;
    hipMemsetAsync(d_ws, 0, SZ_CTRL, stream);
    int dev = 0, cus = 0; hipGetDevice(&dev); hipDeviceGetAttribute(&cus, hipDeviceAttributeMultiprocessorCount, dev);
    const int grid = cus > 0 ? cus : 256;
#if MK_LAUNCHES == 1
    p.ph_lo = 0; p.ph_hi = NPHASE - 1;
    hipLaunchKernelGGL(mega, dim3(grid), dim3(NTHREADS), LDS_BYTES, stream, p);
#else
    for (int k = 0; k < NPHASE; ++k) { p.ph_lo = k; p.ph_hi = k; hipLaunchKernelGGL(mega, dim3(grid), dim3(NTHREADS), LDS_BYTES, stream, p); }
#endif
}
```

```cpp
#include <hip/hip_runtime.h>
#include <stdint.h>
#include <stdio.h>

#define NB      16
#define NS      2048
#define NTOK    (NB * NS)
#define DM      1024
#define NLAYER  2
#define ZW      6912
#define INW     6680
#define C_QA   0
#define C_KA   512
#define C_VA   640
#define C_QB   768
#define C_KB   1280
#define C_VB   1792
#define C_QC   2304
#define C_KCM  2816
#define C_VCM  2944
#define C_KSL  3072
#define C_VSL  3200
#define C_KWN  3328
#define C_VWN  3456
#define C_GM   3584
#define C_GN   6656
#define NEXP   32
#define PMAX   (NTOK * 4 + NEXP * 256)
#define NCMP   127

typedef unsigned short bf16_t;
typedef short bf16x8 __attribute__((ext_vector_type(8)));
typedef short bf16x4 __attribute__((ext_vector_type(4)));
typedef float f32x4 __attribute__((ext_vector_type(4)));
typedef float f32x2 __attribute__((ext_vector_type(2)));
typedef float f32x16 __attribute__((ext_vector_type(16)));
typedef unsigned u32x4 __attribute__((ext_vector_type(4)));
typedef unsigned u32x2 __attribute__((ext_vector_type(2)));

#define LAS __attribute__((address_space(3)))
#define NTHREADS 512
#define LDS_BYTES (160 * 1024)

__device__ __forceinline__ unsigned cvt_pk_bf16(float lo, float hi) { unsigned r; asm volatile("v_cvt_pk_bf16_f32 %0, %1, %2" : "=v"(r) : "v"(lo), "v"(hi)); return r; }
__device__ __forceinline__ bf16_t f2bf(float f) { return (bf16_t)(cvt_pk_bf16(f, 0.f) & 0xffffu); }
__device__ __forceinline__ float bf2f(bf16_t b) { return __uint_as_float(((unsigned)b) << 16); }
__device__ __forceinline__ float bflo(unsigned w) { return __uint_as_float(w << 16); }
__device__ __forceinline__ float bfhi(unsigned w) { return __uint_as_float(w & 0xffff0000u); }
#define LOG2E 1.4426950408889634f
__device__ __forceinline__ float fast_exp2(float x) { return __builtin_amdgcn_exp2f(x); }
__device__ __forceinline__ float fast_rcp(float x) { return __builtin_amdgcn_rcpf(x); }
__device__ __forceinline__ float sigmoidf_(float x) { return fast_rcp(1.0f + fast_exp2(-1.4426950408889634f * x)); }

__device__ __forceinline__ unsigned hidden_bid() { unsigned b = blockIdx.x; asm volatile("" : "+s"(b)); return b; }
__device__ __forceinline__ int hidden_tid() { int t = threadIdx.x; asm volatile("" : "+v"(t)); return t; }

#define XB_TMO      128
#define XB_XCNT(j)  (256  + 64 * (j))
#define XB_XSUB(j)  (1280 + 64 * (j))
#define XB_XGEN(j)  (2304 + 64 * (j))
#define XB_TOP      3328
#define XB_TOPGEN   3392
#define XCD_BAR_WORDS 3456
#define XB_SPIN_CAP (1u << 24)

__device__ __forceinline__ unsigned xb_ld(unsigned* p)              { return __hip_atomic_load(p, __ATOMIC_RELAXED, __HIP_MEMORY_SCOPE_AGENT); }
__device__ __forceinline__ unsigned xb_add(unsigned* p, unsigned v) { return __hip_atomic_fetch_add(p, v, __ATOMIC_RELAXED, __HIP_MEMORY_SCOPE_AGENT); }
__device__ __forceinline__ unsigned xb_xcc_id() { return (unsigned)__builtin_amdgcn_s_getreg((3 << 11) | 20) & 0xFu; }
#define XB_SPIN(cond, bar) do { unsigned _sp = 0; while (cond) { __builtin_amdgcn_s_sleep(1); \
    if ((++_sp & 255u) == 0u) { if (xb_ld(&(bar)[XB_TMO])) break; if (_sp > XB_SPIN_CAP) { atomicAdd(&(bar)[XB_TMO], 1u); break; } } } } while (0)

struct XcdBarrier { unsigned* bar; unsigned x; volatile LAS unsigned* st; };

__device__ __forceinline__ XcdBarrier xcd_barrier_post(unsigned* bar, volatile LAS unsigned* st) {
    XcdBarrier b; b.bar = bar; b.x = xb_xcc_id(); b.st = st;
    if (hidden_tid() == 0) (void)xb_add(&bar[XB_XCNT(b.x)], 1u);
    return b;
}
__device__ __forceinline__ void xcd_barrier_complete(unsigned* bar, unsigned x, unsigned& nloc, unsigned& nx) {
    const unsigned G = gridDim.x * gridDim.y * gridDim.z;
    unsigned sum, cnt, mine, sp = 0u;
    for (;;) {
        sum = 0u; cnt = 0u; mine = 0u;
#pragma unroll
        for (unsigned j = 0; j < 16; ++j) { const unsigned c = xb_ld(&bar[XB_XCNT(j)]); sum += c; cnt += (c > 0u) ? 1u : 0u; mine = (j == x) ? c : mine; }
        if (sum == G) break;
        __builtin_amdgcn_s_sleep(1);
        if ((++sp & 255u) == 0u) { if (xb_ld(&bar[XB_TMO])) break; if (sp > XB_SPIN_CAP) { atomicAdd(&bar[XB_TMO], 1u); break; } }
    }
    nloc = mine > 0u ? mine : 1u; nx = cnt > 0u ? cnt : 1u;
}
__device__ __forceinline__ void xcd_barrier(const XcdBarrier& b) {
    asm volatile("s_waitcnt vmcnt(0)" ::: "memory");
    __syncthreads();
    if (hidden_tid() == 0) {
        unsigned* bar = b.bar;
        __builtin_amdgcn_s_waitcnt(0);
        unsigned nloc = b.st[0], nx = b.st[1];
        if (nloc == 0u) { xcd_barrier_complete(bar, b.x, nloc, nx); b.st[0] = nloc; b.st[1] = nx; }
        const unsigned old = xb_add(&bar[XB_XSUB(b.x)], 1u);
        const unsigned gen = old / nloc;
        if (old + 1u == (gen + 1u) * nloc) {
            __builtin_amdgcn_fence(__ATOMIC_RELEASE, "agent");
            asm volatile("s_waitcnt vmcnt(0)" ::: "memory");
            const unsigned og = xb_add(&bar[XB_TOP], 1u);
            const unsigned tg = og / nx;
            if (og + 1u == (tg + 1u) * nx) xb_add(&bar[XB_TOPGEN], 1u);
            else XB_SPIN(xb_ld(&bar[XB_TOPGEN]) == tg, bar);
            __builtin_amdgcn_fence(__ATOMIC_ACQUIRE, "agent");
            xb_add(&bar[XB_XGEN(b.x)], 1u);
            asm volatile("s_waitcnt vmcnt(0)" ::: "memory");
        } else {
            XB_SPIN(xb_ld(&bar[XB_XGEN(b.x)]) == gen, bar);
            __builtin_amdgcn_fence(__ATOMIC_ACQUIRE, "agent");
            asm volatile("s_waitcnt vmcnt(0)" ::: "memory");
        }
    }
    __syncthreads();
}

constexpr int BM = 256, BK = 64, HALF = 128, HT = HALF * BK;

__device__ __forceinline__ int lds_byte(int r, int c) { int st = (r >> 4) * 2 + (c >> 5), rr = r & 15, cc = c & 31, ob = rr * 64 + cc * 2; return st * 1024 + (ob ^ (((ob >> 9) & 1) << 5)); }
__device__ __forceinline__ void stage_rc(int b, int& R, int& C) { int st = b / 1024, sb = b % 1024, swz = sb ^ (((sb >> 9) & 1) << 5); R = (st >> 1) * 16 + swz / 64; C = (st & 1) * 32 + (swz % 64) / 2; }

struct GemmOperands {
    const char* Abase; unsigned aoff[4]; unsigned kstride;
    const char* Bbase; unsigned boff; int K;
};

__device__ __forceinline__ void gemm_unit(const GemmOperands& g, bf16_t* shm, f32x4 (&acc)[2][2][4][2]) {
#define SA(b,h) (shm + ((b) * 2 + (h)) * HT)
#define SB(b,h) (shm + (4 + (b) * 2 + (h)) * HT)
#define STAGE_A(T, P, hf, kt) do { const char* _ub = g.Abase + (size_t)(kt) * g.kstride; \
    _Pragma("unroll") for (int _i = 0; _i < 2; ++_i) { const int _b = (T) * 16 + _i * 8192; \
      __builtin_amdgcn_global_load_lds((const unsigned*)(_ub + g.aoff[(hf) * 2 + _i]), (unsigned*)((char*)(P) + _b), 16, 0, 0); } } while (0)
#define STAGE_B(T, P, hf, kt) do { \
    _Pragma("unroll") for (int _i = 0; _i < 2; ++_i) { const int _b = (T) * 16 + _i * 8192; \
      const char* _ub = g.Bbase + (size_t)(kt) * (BK * 2) + (size_t)((hf) * 128 + _i * 64) * (size_t)(g.K * 2); \
      __builtin_amdgcn_global_load_lds((const unsigned*)(_ub + g.boff), (unsigned*)((char*)(P) + _b), 16, 0, 0); } } while (0)
#define LDA(dst, b, h) _Pragma("unroll") for (int m = 0; m < 4; ++m) _Pragma("unroll") for (int k = 0; k < 2; ++k) \
    dst[m][k] = *reinterpret_cast<const bf16x8*>((char*)SA(b, h) + lds_byte(wr * 64 + m * 16 + fr, k * 32 + fq * 8))
#define LDB(dst, b, h) _Pragma("unroll") for (int n = 0; n < 2; ++n) _Pragma("unroll") for (int k = 0; k < 2; ++k) \
    dst[n][k] = *reinterpret_cast<const bf16x8*>((char*)SB(b, h) + lds_byte(wc * 32 + n * 16 + fr, k * 32 + fq * 8))
#define MMA(ai, bj, At_, Bt_) do { __builtin_amdgcn_s_setprio(1); \
    _Pragma("unroll") for (int m = 0; m < 4; ++m) _Pragma("unroll") for (int n = 0; n < 2; ++n) _Pragma("unroll") for (int k = 0; k < 2; ++k) \
      acc[ai][bj][m][n] = __builtin_amdgcn_mfma_f32_16x16x32_bf16(Bt_[n][k], At_[m][k], acc[ai][bj][m][n], 0, 0, 0); \
    __builtin_amdgcn_s_setprio(0); } while (0)
#define WAIT_V(n) asm volatile("s_waitcnt vmcnt(" #n ")" ::: "memory")
#define WAIT_L(n) asm volatile("s_waitcnt lgkmcnt(" #n ")" ::: "memory")
#define BAR __builtin_amdgcn_s_barrier()
#define SCHED __builtin_amdgcn_sched_barrier(0)
    int tid = threadIdx.x; asm volatile("" : "+v"(tid));
    int wid = tid >> 6, lane = tid & 63, wr = wid >> 2, wc = wid & 3, fr = lane & 15, fq = lane >> 4;
#pragma unroll
    for (int a = 0; a < 2; ++a)
#pragma unroll
        for (int b = 0; b < 2; ++b)
#pragma unroll
            for (int m = 0; m < 4; ++m)
#pragma unroll
                for (int n = 0; n < 2; ++n) acc[a][b][m][n] = (f32x4){0.f, 0.f, 0.f, 0.f};
    bf16x8 At[4][2], B0[2][2], B1[2][2];
    const int nt = g.K / BK;
    STAGE_B(tid, SB(0, 0), 0, 0); STAGE_A(tid, SA(0, 0), 0, 0);
    STAGE_B(tid, SB(0, 1), 1, 0); STAGE_A(tid, SA(0, 1), 1, 0);
    if (wr == 1) BAR;
    WAIT_V(4); BAR;
    STAGE_B(tid, SB(1, 0), 0, 1); STAGE_A(tid, SA(1, 0), 0, 1); STAGE_B(tid, SB(1, 1), 1, 1);
    WAIT_V(6); BAR;
    for (int t = 0; t < nt - 2; t += 2) {
        LDB(B0, 0, 0); SCHED; LDA(At, 0, 0); STAGE_A(tid, SA(1, 1), 1, t + 1);
        WAIT_L(8); BAR; WAIT_L(0); MMA(0, 0, At, B0); BAR; SCHED;
        LDB(B1, 0, 1); STAGE_B(tid, SB(0, 0), 0, t + 2);
        BAR; WAIT_L(0); MMA(0, 1, At, B1); BAR;
        LDA(At, 0, 1); STAGE_A(tid, SA(0, 0), 0, t + 2);
        BAR; WAIT_L(0); MMA(1, 0, At, B0); BAR; SCHED;
        STAGE_B(tid, SB(0, 1), 1, t + 2);
        WAIT_V(6); BAR; MMA(1, 1, At, B1); BAR;
        LDB(B0, 1, 0); SCHED; LDA(At, 1, 0); STAGE_A(tid, SA(0, 1), 1, t + 2);
        WAIT_L(8); BAR; WAIT_L(0); MMA(0, 0, At, B0); BAR; SCHED;
        LDB(B1, 1, 1); STAGE_B(tid, SB(1, 0), 0, t + 3);
        BAR; WAIT_L(0); MMA(0, 1, At, B1); BAR;
        LDA(At, 1, 1); STAGE_A(tid, SA(1, 0), 0, t + 3);
        BAR; WAIT_L(0); MMA(1, 0, At, B0); BAR; SCHED;
        STAGE_B(tid, SB(1, 1), 1, t + 3);
        WAIT_V(6); BAR; MMA(1, 1, At, B1); BAR;
    }
    { LDB(B0, 0, 0); WAIT_V(0); LDA(At, 0, 0); STAGE_A(tid, SA(1, 1), 1, nt - 1);
      BAR; WAIT_L(0); MMA(0, 0, At, B0); BAR;
      LDB(B1, 0, 1); BAR; WAIT_L(0); MMA(0, 1, At, B1); BAR;
      LDA(At, 0, 1); WAIT_V(4); BAR; WAIT_L(0); MMA(1, 0, At, B0); MMA(1, 1, At, B1); BAR; }
    { LDB(B0, 1, 0); LDA(At, 1, 0); WAIT_V(2); BAR; WAIT_L(0); MMA(0, 0, At, B0); BAR;
      LDB(B1, 1, 1); WAIT_V(0); BAR; WAIT_L(0); MMA(0, 1, At, B1); BAR;
      LDA(At, 1, 1); BAR; WAIT_L(0); MMA(1, 0, At, B0); MMA(1, 1, At, B1); BAR; }
    if (wr == 0) BAR;
#undef SA
#undef SB
}


struct GDesc { const char* A; const char* B; unsigned aoff[4]; };
typedef int i32x8 __attribute__((ext_vector_type(8)));
typedef int i32x4 __attribute__((ext_vector_type(4)));
template <class S, bool FP8 = false, int SCA = 0x7f7f7f7f, int SCB = 0x7f7f7f7f>
__device__ __forceinline__ void gemm_stream(S& s, const int K, const unsigned kstrideA, unsigned char* lds_) {
    const int rowbytes = FP8 ? K : 2 * K;
    bf16_t* shm = (bf16_t*)lds_;
#define SA(b,h) (shm + ((b) * 2 + (h)) * HT)
#define SB(b,h) (shm + (4 + (b) * 2 + (h)) * HT)
#define UNIPTR(ptr) ({ const unsigned long long _u = (unsigned long long)(ptr); (const char*)(((unsigned long long)(unsigned)__builtin_amdgcn_readfirstlane((int)(_u >> 32)) << 32) | (unsigned)__builtin_amdgcn_readfirstlane((int)_u)); })
#define XSTAGE_A(P, hf, kt) do { const char* _ub = UNIPTR(d.A + (size_t)(kt) * kstrideA); \
    _Pragma("unroll") for (int _i = 0; _i < 2; ++_i) { const int _b = tid * 16 + _i * 8192; \
      unsigned _o = d.aoff[(hf) * 2 + _i]; asm volatile("" : "+v"(_o)); \
      __builtin_amdgcn_global_load_lds((const unsigned*)(_ub + _o), (unsigned*)((char*)(P) + _b), 16, 0, 0); } } while (0)
#define XSTAGE_B(P, hf, kt) do { \
    _Pragma("unroll") for (int _i = 0; _i < 2; ++_i) { const int _b = tid * 16 + _i * 8192; \
      const char* _ub = UNIPTR(d.B + (size_t)(kt) * (BK * 2) + (size_t)((hf) * 128 + _i * 64) * (size_t)rowbytes); \
      unsigned _o = boff; asm volatile("" : "+v"(_o)); \
      __builtin_amdgcn_global_load_lds((const unsigned*)(_ub + _o), (unsigned*)((char*)(P) + _b), 16, 0, 0); } } while (0)
    int tid = threadIdx.x; asm volatile("" : "+v"(tid));
    int wid = tid >> 6, lane = tid & 63, wr = wid >> 2, wc = wid & 3, fr = lane & 15, fq = lane >> 4;
    unsigned boff; { int rS, cS; stage_rc(tid * 16, rS, cS); const int rho = rS & 31, i = rho & 15; const int rP = (rS & ~31) + 8 * (i >> 2) + 4 * (rho >> 4) + (i & 3); boff = (unsigned)(rP * rowbytes + cS * 2); }
    const int nt = rowbytes / (BK * 2);
    GDesc d;
    if (!s.first(d)) return;
    f32x4 acc[2][2][4][2];
    if (S::BIAS_INIT) { s.load_bias_first(); s.init_acc(acc); }
    else
#pragma unroll
    for (int a = 0; a < 2; ++a)
#pragma unroll
        for (int b = 0; b < 2; ++b)
#pragma unroll
            for (int m = 0; m < 4; ++m)
#pragma unroll
                for (int n = 0; n < 2; ++n) acc[a][b][m][n] = (f32x4){0.f, 0.f, 0.f, 0.f};
    int sca_ = SCA, scb_ = SCB; asm volatile("" : "+v"(sca_), "+v"(scb_));
    struct Frag { bf16x8 f2[2]; };
    Frag At[4], B0[2], B1[2];
#undef LDA
#undef LDB
#undef MMA
#define LDA(dst, b, h) _Pragma("unroll") for (int m = 0; m < 4; ++m) _Pragma("unroll") for (int k = 0; k < 2; ++k) \
    dst[m].f2[k] = *reinterpret_cast<const bf16x8*>((char*)SA(b, h) + lds_byte(wr * 64 + m * 16 + fr, k * 32 + fq * 8))
#define LDB(dst, b, h) _Pragma("unroll") for (int n = 0; n < 2; ++n) _Pragma("unroll") for (int k = 0; k < 2; ++k) \
    dst[n].f2[k] = *reinterpret_cast<const bf16x8*>((char*)SB(b, h) + lds_byte(wc * 32 + n * 16 + fr, k * 32 + fq * 8))
#define MMA(ai, bj, At_, Bt_) do { __builtin_amdgcn_s_setprio(1); \
    _Pragma("unroll") for (int m = 0; m < 4; ++m) _Pragma("unroll") for (int n = 0; n < 2; ++n) { \
      if (FP8) asm volatile("v_mfma_scale_f32_16x16x128_f8f6f4 %0, %1, %2, %0, %3, %4 op_sel_hi:[0,0,0]" : "+v"(acc[ai][bj][m][n]) : "v"(__builtin_bit_cast(i32x8, Bt_[n])), "v"(__builtin_bit_cast(i32x8, At_[m])), "v"(scb_), "v"(sca_)); \
      else { _Pragma("unroll") for (int k = 0; k < 2; ++k) acc[ai][bj][m][n] = __builtin_amdgcn_mfma_f32_16x16x32_bf16(Bt_[n].f2[k], At_[m].f2[k], acc[ai][bj][m][n], 0, 0, 0); } } \
    __builtin_amdgcn_s_setprio(0); } while (0)
    XSTAGE_B(SB(0, 0), 0, 0); XSTAGE_B(SB(0, 1), 1, 0); XSTAGE_A(SA(0, 0), 0, 0); XSTAGE_A(SA(0, 1), 1, 0);
    if (wr == 1) BAR;
    WAIT_V(2); BAR;
    XSTAGE_B(SB(1, 0), 0, 1); XSTAGE_A(SA(1, 0), 0, 1); XSTAGE_B(SB(1, 1), 1, 1);
    WAIT_V(6); BAR;
    asm volatile(".p2align 8");
    for (;;) {
        bool has_next = false;
        for (int t = 0; t < nt; t += 2) {
            if (t == nt - 2) s.prefetch();
            LDB(B0, 0, 0); LDB(B1, 0, 1); SCHED; LDA(At, 0, 0); XSTAGE_A(SA(1, 1), 1, t + 1);
            WAIT_V(8); WAIT_L(0); BAR; MMA(0, 0, At, B0); MMA(0, 1, At, B1); BAR; SCHED;
            int ks = t + 2;
            if (t == nt - 2) { has_next = s.next(d); ks = 0; }
            LDA(At, 0, 1); XSTAGE_B(SB(0, 0), 0, ks); XSTAGE_B(SB(0, 1), 1, ks); XSTAGE_A(SA(0, 0), 0, ks);
            WAIT_V(8); WAIT_L(0); BAR; MMA(1, 0, At, B0); MMA(1, 1, At, B1); BAR; SCHED;
            LDB(B0, 1, 0); LDB(B1, 1, 1); SCHED; LDA(At, 1, 0); XSTAGE_A(SA(0, 1), 1, ks);
            WAIT_V(8); WAIT_L(0); BAR; MMA(0, 0, At, B0); MMA(0, 1, At, B1); BAR; SCHED;
            LDA(At, 1, 1); XSTAGE_B(SB(1, 0), 0, ks + 1); XSTAGE_B(SB(1, 1), 1, ks + 1); XSTAGE_A(SA(1, 0), 0, ks + 1);
            WAIT_V(8); WAIT_L(0); BAR; MMA(1, 0, At, B0); MMA(1, 1, At, B1); BAR; SCHED;
        }
        if (wr == 0) BAR;
        if (FP8) asm volatile("s_nop 15\n\ts_nop 15" ::: "memory");
        s.hn = has_next;
        s.epilogue(acc);
        if (!has_next) break;
        const bool zr = s.zero_after();
        s.advance();
        if (S::BIAS_INIT) s.init_acc(acc);
        else if (zr)
#pragma unroll
        for (int a = 0; a < 2; ++a)
#pragma unroll
            for (int b = 0; b < 2; ++b)
#pragma unroll
                for (int m = 0; m < 4; ++m)
#pragma unroll
                    for (int n = 0; n < 2; ++n) acc[a][b][m][n] = (f32x4){0.f, 0.f, 0.f, 0.f};
        if (wr == 1) BAR;
    }
    WAIT_V(0);
    BAR;
#undef SA
#undef SB
#undef XSTAGE_A
#undef XSTAGE_B
}

#define AL4K(x) (((size_t)(x) + 4095) & ~(size_t)4095)
constexpr size_t SZ_CTRL   = 1u << 16;
constexpr size_t OFF_MOD   = SZ_CTRL;
constexpr size_t OFF_CBIAS = OFF_MOD   + AL4K(2 * 16 * 6144 * 4);
constexpr size_t OFF_BIN   = OFF_CBIAS + AL4K(2 * 2 * 4 * 256 * 4);
constexpr size_t OFF_B1P   = OFF_BIN   + AL4K(2 * ZW * 4);
constexpr size_t OFF_WRT   = OFF_B1P   + AL4K(2 * 32 * 2048 * 4);
constexpr size_t OFF_WIN   = OFF_WRT   + AL4K(2 * 2 * 32 * 1024 * 2);
constexpr size_t OFF_WBR   = OFF_WIN   + AL4K((size_t)2 * ZW * 1024 * 2);
constexpr size_t OFF_WOUT  = OFF_WBR   + AL4K((size_t)2 * 3 * 1024 * 512 * 2);
constexpr size_t OFF_W1    = OFF_WOUT  + AL4K((size_t)2 * 1024 * 1024 * 2);
constexpr size_t OFF_W2    = OFF_W1    + AL4K((size_t)2 * 32 * 2048 * 1024 * 2);
constexpr size_t OFF_WC1   = OFF_W2    + AL4K((size_t)2 * 32 * 1024 * 1024 * 2);
constexpr size_t OFF_WC2   = OFF_WC1   + AL4K((size_t)2 * 2 * 256 * 2048 * 2);
constexpr size_t OFF_XR    = OFF_WC2   + AL4K((size_t)2 * 2 * 64 * 256 * 2);
constexpr size_t OFF_HB    = OFF_XR    + AL4K((size_t)NTOK * 1024 * 4);
constexpr size_t OFF_Z     = OFF_HB    + AL4K((size_t)NTOK * 1024 * 2);
constexpr size_t OFF_OABC  = OFF_Z     + AL4K((size_t)NTOK * ZW * 2);
constexpr size_t OFF_OWIN  = OFF_OABC  + AL4K((size_t)3 * NTOK * 512 * 2);
constexpr size_t OFF_KVC   = OFF_OWIN  + AL4K((size_t)NTOK * 512 * 2);
constexpr size_t OFF_MERGED= OFF_KVC   + AL4K((size_t)2 * 16 * 2 * 128 * 64 * 2);
constexpr size_t OFF_MSCR  = OFF_MERGED+ AL4K((size_t)NTOK * 1024 * 2);
constexpr size_t OFF_TOKE  = OFF_MSCR  + AL4K((size_t)256 * 32 * 512 * 16);
constexpr size_t OFF_TOKP  = OFF_TOKE  + AL4K((size_t)NTOK * 4 * 4);
constexpr size_t OFF_TOKG  = OFF_TOKP  + AL4K((size_t)NTOK * 4 * 4);
constexpr size_t OFF_BUCK  = OFF_TOKG  + AL4K((size_t)NTOK * 4 * 4);
constexpr size_t OFF_SELM  = OFF_BUCK  + AL4K((size_t)32 * NTOK * 4);
constexpr size_t OFF_HID   = OFF_SELM  + AL4K((size_t)16 * 2 * 2048 * 4);
constexpr size_t OFF_DELTA = OFF_MSCR;
constexpr size_t OFF_H8    = OFF_HID + AL4K((size_t)PMAX * 1024);
constexpr size_t OFF_Y     = OFF_Z;
constexpr size_t WS_NEED   = OFF_HID   + AL4K((size_t)PMAX * 1024 * 2);
static_assert((size_t)PMAX * 1024 * 2 <= (size_t)NTOK * ZW * 2, "y overlay must fit in z");

#define CW_QCTR(l, q)  (4096 + ((l) * 8 + (q)) * 64)
#define CW_ECNT(l, e)  (8192 + ((l) * 32 + (e)) * 64)
#define CW_LAM         6400

struct Params {
    const float *x, *c, *mod_w, *mod_b, *norm1_g, *norm2_g, *w_in, *b_in, *sinks, *diff_lambda, *diff_subln_g, *cmp_pos, *cmp_w1, *cmp_b1, *cmp_w2, *cmp_b2,
                *w_branch, *w_out, *router_w, *router_b, *exp_w1, *exp_b1, *exp_w2, *exp_b2, *final_g;
    float* out; char* ws; int ph_lo, ph_hi;
};
typedef const Params __attribute__((address_space(4)))* KP;

#ifndef INPROJ_FP8
#define INPROJ_FP8 1
#endif
__device__ __forceinline__ int map_col(int map, int nd) {
    if (map == 1) return nd < 3584 ? nd : (nd < 6656 ? nd + 24 : (nd < 6680 ? nd - 3072 : -1));
    if (map == 2) { const int pn = nd >> 8, r = nd & 255; return r < 128 ? pn * 128 + r : 1024 + pn * 128 + (r - 128); }
    return nd;
}
__device__ __forceinline__ void xpose_load(const float* __restrict__ src, int Nsrc, int k0, int nd0, int map, int ntl, f32x4 (&v)[8], int t) {
    const int n4 = t & 15, kp = t >> 4;
    bool ok[4];
#pragma unroll
    for (int j = 0; j < 4; ++j) { const int ns0 = j < ntl ? map_col(map, nd0 + 64 * j + 4 * n4) : -1; ok[j] = ns0 >= 0; const int nsc = ok[j] ? ns0 : 0;
        v[2 * j] = *(const f32x4*)(src + (size_t)(k0 + 2 * kp) * Nsrc + nsc); v[2 * j + 1] = *(const f32x4*)(src + (size_t)(k0 + 2 * kp + 1) * Nsrc + nsc); }
    __builtin_amdgcn_sched_barrier(0);
    if (map != 0) {
#pragma unroll
        for (int j = 0; j < 4; ++j) if (!ok[j]) { v[2 * j] = (f32x4){0.f, 0.f, 0.f, 0.f}; v[2 * j + 1] = v[2 * j]; } }
}
__device__ __forceinline__ void xpose_store(const f32x4 (&v)[8], bf16_t* __restrict__ dst, int Kdst, int k0, int nd0, int ntl, unsigned char* lds, int t) {
    const int n4 = t & 15, kp = t >> 4;
#pragma unroll
    for (int j = 0; j < 4; ++j)
#pragma unroll
        for (int i = 0; i < 4; ++i) { const int n = 4 * n4 + i; *(unsigned*)(lds + j * 8192 + n * 128 + (((kp >> 2) ^ (n4 & 7)) * 16) + (kp & 3) * 4) = cvt_pk_bf16(v[2 * j][i], v[2 * j + 1][i]); }
    __syncthreads();
    { const int n = t >> 3, ch = t & 7;
#pragma unroll
      for (int j = 0; j < 4; ++j) if (j < ntl) { const u32x4 w = *(const u32x4*)(lds + j * 8192 + n * 128 + ((ch ^ ((n >> 2) & 7)) * 16));
          *(u32x4*)(dst + (size_t)(nd0 + 64 * j + n) * Kdst + k0 + 8 * ch) = w; } }
    __syncthreads();
}
__device__ __forceinline__ void xpose_matrix(const float* src, int K, int Nsrc, bf16_t* dst, int Ndst, int map, unsigned& tbase, unsigned char* lds) {
    const int t = hidden_tid();
    const int nk = K >> 6, nn = Ndst >> 6, ngn = (nn + 3) >> 2, ngrp = nk * ngn; const unsigned G = gridDim.x;
    unsigned gi = (hidden_bid() + G - (tbase % G)) % G;
    f32x4 va[8], vb[8];
    if (gi < (unsigned)ngrp) { const int kt = gi % nk, ng = gi / nk; xpose_load(src, Nsrc, kt * 64, ng * 256, map, min(4, nn - ng * 4), va, t); }
    while (gi < (unsigned)ngrp) {
        const unsigned gn = gi + G; const int kt = gi % nk, ng = gi / nk;
        if (gn < (unsigned)ngrp) { const int kt2 = gn % nk, ng2 = gn / nk; xpose_load(src, Nsrc, kt2 * 64, ng2 * 256, map, min(4, nn - ng2 * 4), vb, t); }
        xpose_store(va, dst, K, kt * 64, ng * 256, min(4, nn - ng * 4), lds, t);
#pragma unroll
        for (int q = 0; q < 8; ++q) va[q] = vb[q];
        gi = gn;
    }
    tbase += ngrp;
}

__device__ __forceinline__ unsigned pk4_fp8(float a, float b, float c, float d) { int w = 0; w = __builtin_amdgcn_cvt_pk_fp8_f32(a, b, w, false); w = __builtin_amdgcn_cvt_pk_fp8_f32(c, d, w, true); return (unsigned)w; }
#define X8T 4
__device__ __forceinline__ unsigned xpose8_load(const float* __restrict__ src, int Nsrc, int k0, int nd0, int map, f32x4 (&v)[4 * X8T], int t) {
    const int n4 = t & 15, kq = t >> 4;
    bool ok[X8T];
#pragma unroll
    for (int j = 0; j < X8T; ++j) { const int ns0 = map_col(map, nd0 + 64 * j + 4 * n4); ok[j] = ns0 >= 0; const int nsc = ok[j] ? ns0 : 0;
#pragma unroll
        for (int q = 0; q < 4; ++q) v[4 * j + q] = __builtin_nontemporal_load((const f32x4*)(src + (size_t)(k0 + 4 * kq + q) * Nsrc + nsc)); }
    __builtin_amdgcn_sched_barrier(0);
    unsigned m = 0;
#pragma unroll
    for (int j = 0; j < X8T; ++j) m |= ok[j] ? (1u << j) : 0u;
    return m;
}
__device__ __forceinline__ void xpose8_store(const f32x4 (&v)[4 * X8T], unsigned char* __restrict__ dst, int Kdst, int k0, int nd0, float scale0, unsigned char* lds, int t, unsigned okm = 0xffffffffu) {
    const int n4 = t & 15, kq = t >> 4;
#pragma unroll
    for (int j = 0; j < X8T; ++j) { const float scale = (okm >> j) & 1u ? scale0 : 0.0f;
#pragma unroll
        for (int i = 0; i < 4; ++i) { const int n = 4 * n4 + i;
            *(unsigned*)(lds + j * 8192 + n * 128 + (((kq >> 2) ^ (n4 & 7)) * 16) + (kq & 3) * 4) = pk4_fp8(v[4 * j][i] * scale, v[4 * j + 1][i] * scale, v[4 * j + 2][i] * scale, v[4 * j + 3][i] * scale); } }
    __syncthreads();
    { const int n = t >> 3, ch = t & 7;
#pragma unroll
      for (int j = 0; j < X8T; ++j) { const u32x4 w = *(const u32x4*)(lds + j * 8192 + n * 128 + ((ch ^ ((n >> 2) & 7)) * 16));
          *(u32x4*)(dst + (size_t)(nd0 + 64 * j + n) * Kdst + k0 + 16 * ch) = w; } }
    __syncthreads();
}
__device__ __forceinline__ void xpose8_matrix(const float* src, int K, int Nsrc, unsigned char* dst, int Ndst, int map, float scale, unsigned& tbase, unsigned char* lds) {
    const int t = hidden_tid();
    const int nk = K >> 7, ngn = Ndst / (64 * X8T), ngrp = nk * ngn; const unsigned G = gridDim.x;
    unsigned gi = (hidden_bid() + G - (tbase % G)) % G;
    f32x4 va[4 * X8T], vb[4 * X8T];
    unsigned ma = 0, mb = 0;
    if (gi < (unsigned)ngrp) ma = xpose8_load(src, Nsrc, (gi % nk) * 128, (gi / nk) * 64 * X8T, map, va, t);
    while (gi < (unsigned)ngrp) {
        const unsigned gn = gi + G;
        if (gn < (unsigned)ngrp) mb = xpose8_load(src, Nsrc, (gn % nk) * 128, (gn / nk) * 64 * X8T, map, vb, t);
        xpose8_store(va, dst, K, (gi % nk) * 128, (gi / nk) * 64 * X8T, scale, lds, t, ma); ma = mb;
#pragma unroll
        for (int q = 0; q < 4 * X8T; ++q) va[q] = vb[q];
        gi = gn;
    }
    tbase += ngrp;
}

#ifndef COSCHED
#define COSCHED 1
#endif
#ifndef XGN
#define XGN 1
#endif
__device__ __forceinline__ void xpose8_gload(KP p, int l, int g, f32x4 (&v)[4 * X8T], int t) {
    const int e = g / 96, r = g - e * 96; const int n4 = t & 15, kq = t >> 4;
    if (r < 64) { const float* b = p->exp_w1 + (size_t)(l * 32 + e) * 1024 * 2048 + (size_t)((r & 7) * 128 + 4 * kq) * 2048 + (r >> 3) * 128 + 4 * n4;
#pragma unroll
        for (int j = 0; j < 4; ++j)
#pragma unroll
            for (int q = 0; q < 4; ++q) v[4 * j + q] = __builtin_nontemporal_load((const f32x4*)(b + q * 2048 + (j >> 1) * 1024 + (j & 1) * 64));
    } else { const float* b = p->exp_w2 + (size_t)(l * 32 + e) * 1024 * 1024 + (size_t)((r & 7) * 128 + 4 * kq) * 1024 + ((r - 64) >> 3) * 256 + 4 * n4;
#pragma unroll
        for (int j = 0; j < 4; ++j)
#pragma unroll
            for (int q = 0; q < 4; ++q) v[4 * j + q] = __builtin_nontemporal_load((const f32x4*)(b + q * 1024 + j * 64));
    }
    __builtin_amdgcn_sched_barrier(0);
}
__device__ __forceinline__ void xpose8_gstore(KP p, int l, int g, const f32x4 (&v)[4 * X8T], unsigned char* lds, int t) {
    const int e = g / 96, r = g - e * 96; char* ws = p->ws;
    if (r < 64) xpose8_store(v, (unsigned char*)(ws + OFF_W1) + (size_t)(l * 32 + e) * 2048 * 1024, 1024, (r & 7) * 128, (r >> 3) * 256, 32.0f, lds, t);
    else xpose8_store(v, (unsigned char*)(ws + OFF_W2) + (size_t)(l * 32 + e) * 1024 * 1024, 1024, (r & 7) * 128, ((r - 64) >> 3) * 256, 32.0f, lds, t);
}
__device__ __forceinline__ void xpose8_group(KP p, int l, int g, unsigned char* lds) {
    if ((g & (XGN - 1)) != XGN - 1) return;
    const int t = hidden_tid(); const int g0 = g - (XGN - 1);
    f32x4 va[4 * X8T], vb[4 * X8T];
    xpose8_gload(p, l, g0, va, t);
    __syncthreads();
#pragma unroll 1
    for (int i = 0; i < XGN; ++i) {
        if (i + 1 < XGN) xpose8_gload(p, l, g0 + i + 1, vb, t);
        xpose8_gstore(p, l, g0 + i, va, lds, t);
#pragma unroll
        for (int q = 0; q < 4 * X8T; ++q) va[q] = vb[q];
    }
}
__device__ __forceinline__ float wave_sum(float v, int lane) {
#pragma unroll
    for (int o = 32; o >= 1; o >>= 1) v += __int_as_float(__builtin_amdgcn_ds_bpermute(((lane ^ o) & 63) << 2, __float_as_int(v)));
    return v;
}
__device__ __forceinline__ void phase_prologue(KP p, unsigned char* lds) {
    const int t = hidden_tid(), bi = hidden_bid();
    char* ws = p->ws;
#ifndef PRO_MODREP
#define PRO_MODREP 1
#endif
#ifndef PRO_XREP
#define PRO_XREP 1
#endif
    for (int rep_ = 0; rep_ < PRO_MODREP; ++rep_) {
        float* cs = (float*)lds;
        f32x4* red = (f32x4*)(lds + 65536);
        for (int i = t; i < 16 * 1024; i += NTHREADS) { const float v = p->c[i]; cs[(i & 1023) * 16 + (i >> 10)] = v * sigmoidf_(v); }
        __syncthreads();
        for (int task = bi; task < 192; task += gridDim.x) {
            const int j0 = task * 64, l = j0 / 6144, c0 = j0 % 6144;
            const int c4 = t & 15, kr = t >> 4, lane = t & 63, wv = t >> 6;
            const float* wp = p->mod_w + (size_t)l * 1024 * 6144 + c0 + 4 * c4;
            f32x4 acc[16];
#pragma unroll
            for (int b = 0; b < 16; ++b) acc[b] = (f32x4){0.f, 0.f, 0.f, 0.f};
#pragma unroll 1
            for (int i0 = 0; i0 < 32; i0 += 4) {
                f32x4 w[4];
#pragma unroll
                for (int i = 0; i < 4; ++i) w[i] = __builtin_nontemporal_load((const f32x4*)(wp + (size_t)(kr + 32 * (i0 + i)) * 6144));
                __builtin_amdgcn_sched_barrier(0);
#pragma unroll
                for (int i = 0; i < 4; ++i) { const float* cr = cs + (kr + 32 * (i0 + i)) * 16;
#pragma unroll
                    for (int b4 = 0; b4 < 4; ++b4) { const f32x4 cv = *(const f32x4*)(cr + 4 * b4);
#pragma unroll
                        for (int q = 0; q < 4; ++q) acc[4 * b4 + q] += cv[q] * w[i]; } }
            }
#pragma unroll
            for (int b = 0; b < 16; ++b)
#pragma unroll
                for (int q = 0; q < 4; ++q) { float v = acc[b][q];
                    v += __int_as_float(__builtin_amdgcn_ds_bpermute(((lane ^ 16) & 63) << 2, __float_as_int(v)));
                    v += __int_as_float(__builtin_amdgcn_ds_bpermute(((lane ^ 32) & 63) << 2, __float_as_int(v)));
                    acc[b][q] = v; }
            if (lane < 16) {
#pragma unroll
                for (int b = 0; b < 16; ++b) red[(wv * 16 + b) * 16 + c4] = acc[b]; }
            __syncthreads();
            if (t < 256) { const int b = t >> 4, c2 = t & 15; f32x4 sum = red[b * 16 + c2];
#pragma unroll
                for (int w2 = 1; w2 < 8; ++w2) sum += red[(w2 * 16 + b) * 16 + c2];
                const int col2 = c0 + 4 * c2;
                *(f32x4*)((float*)(ws + OFF_MOD) + ((size_t)l * 16 + b) * 6144 + col2) = sum + *(const f32x4*)(p->mod_b + l * 6144 + col2); }
            __syncthreads();
        }
    }
    if (bi == 0 && t < 64) {
        for (int l2 = 0; l2 < NLAYER; ++l2) { const float* lp = p->diff_lambda + (size_t)l2 * 256; const float a01 = wave_sum(lp[t] * lp[64 + t], t), a23 = wave_sum(lp[128 + t] * lp[192 + t], t);
            if (t == 0) ((float*)ws)[CW_LAM + l2] = expf(a01) - expf(a23) + (0.8f - 0.6f * expf(-0.3f * (float)l2)); } }
    for (int task = (int)gridDim.x - 1 - bi; task < 16; task += gridDim.x) {
        const int lk = task >> 2, kq = task & 3, nq = t & 63, ks = t >> 6;
        const float* w1 = p->cmp_w1 + (size_t)lk * 2048 * 256; const float* pos = p->cmp_pos + (size_t)lk * 2048;
        f32x4 s4 = (f32x4){0.f, 0.f, 0.f, 0.f};
#pragma unroll 1
        for (int k0 = kq * 512 + ks * 64; k0 < kq * 512 + ks * 64 + 64; k0 += 16) {
            f32x4 w[16]; float pz[16];
#pragma unroll
            for (int i = 0; i < 16; ++i) { w[i] = *(const f32x4*)(w1 + (size_t)(k0 + i) * 256 + 4 * nq); pz[i] = pos[k0 + i]; }
            __builtin_amdgcn_sched_barrier(0);
#pragma unroll
            for (int i = 0; i < 16; ++i) s4 += pz[i] * w[i];
        }
        f32x4* red = (f32x4*)lds; red[t] = s4; __syncthreads();
        if (t < 64) { f32x4 r = red[t];
#pragma unroll
            for (int q = 1; q < 8; ++q) r += red[t + 64 * q];
            *(f32x4*)((float*)(ws + OFF_CBIAS) + (size_t)(lk * 4 + kq) * 256 + 4 * t) = r; }
        __syncthreads();
    }
    for (int i = bi * NTHREADS + t; i < 2 * ZW; i += gridDim.x * NTHREADS) { const int l = i / ZW, nd = i % ZW, ns = map_col(1, nd); ((float*)(ws + OFF_BIN))[i] = ns >= 0 ? p->b_in[l * INW + ns] : 0.f; }
    for (int i = bi * NTHREADS + t; i < 2 * 32 * 2048; i += gridDim.x * NTHREADS) { const int le = i >> 11, j = i & 2047; ((float*)(ws + OFF_B1P))[i] = p->exp_b1[(size_t)le * 2048 + map_col(2, j)]; }
    for (int i = bi * NTHREADS + t; i < 2 * 32 * 1024; i += gridDim.x * NTHREADS) {
        const int l = i >> 15, e = (i >> 10) & 31, k = i & 1023; const float w = p->router_w[((size_t)l * 1024 + k) * 32 + e];
        const bf16_t hi = f2bf(w); const bf16_t lo = f2bf(w - bf2f(hi));
        bf16_t* wr = (bf16_t*)(ws + OFF_WRT); wr[((size_t)(l * 2 + 0) * 32 + e) * 1024 + k] = hi; wr[((size_t)(l * 2 + 1) * 32 + e) * 1024 + k] = lo; }
    __syncthreads();
    for (int rep_ = 0; rep_ < PRO_XREP; ++rep_) {
    unsigned tbase = 0;
    for (int l = 0; l < (COSCHED ? 1 : NLAYER); ++l) {
#if INPROJ_FP8
        xpose8_matrix(p->w_in + (size_t)l * 1024 * INW, 1024, INW, (unsigned char*)(ws + OFF_WIN) + (size_t)l * ZW * 1024, ZW, 1, 32.0f, tbase, lds);
#else
        xpose_matrix(p->w_in + (size_t)l * 1024 * INW, 1024, INW, (bf16_t*)(ws + OFF_WIN) + (size_t)l * ZW * 1024, ZW, 1, tbase, lds);
#endif
        for (int kv = 0; kv < 2; ++kv) {
            xpose_matrix(p->cmp_w1 + (size_t)(l * 2 + kv) * 2048 * 256, 2048, 256, (bf16_t*)(ws + OFF_WC1) + (size_t)(l * 2 + kv) * 256 * 2048, 256, 0, tbase, lds);
            xpose_matrix(p->cmp_w2 + (size_t)(l * 2 + kv) * 256 * 64, 256, 64, (bf16_t*)(ws + OFF_WC2) + (size_t)(l * 2 + kv) * 64 * 256, 64, 0, tbase, lds);
        }
#if !COSCHED
        for (int i = 0; i < 3; ++i) xpose_matrix(p->w_branch + (size_t)(l * 3 + i) * 512 * 1024, 512, 1024, (bf16_t*)(ws + OFF_WBR) + (size_t)(l * 3 + i) * 1024 * 512, 1024, 0, tbase, lds);
        xpose_matrix(p->w_out + (size_t)l * 1024 * 1024, 1024, 1024, (bf16_t*)(ws + OFF_WOUT) + (size_t)l * 1024 * 1024, 1024, 0, tbase, lds);
        for (int e = 0; e < 32; ++e) {
            xpose8_matrix(p->exp_w1 + (size_t)(l * 32 + e) * 1024 * 2048, 1024, 2048, (unsigned char*)(ws + OFF_W1) + (size_t)(l * 32 + e) * 2048 * 1024, 2048, 2, 32.0f, tbase, lds);
            xpose8_matrix(p->exp_w2 + (size_t)(l * 32 + e) * 1024 * 1024, 1024, 1024, (unsigned char*)(ws + OFF_W2) + (size_t)(l * 32 + e) * 1024 * 1024, 1024, 0, 32.0f, tbase, lds);
        }
#endif
    }
}
}

__device__ __forceinline__ void xpose_one(const float* src, int K, int Nsrc, bf16_t* dst, int Ndst, int gi, unsigned char* lds) {
    const int t = hidden_tid(); const int nk = K >> 6, nn = Ndst >> 6, kt = gi % nk, ng = gi / nk, ntl = min(4, nn - ng * 4);
    f32x4 va[8];
    xpose_load(src, Nsrc, kt * 64, ng * 256, 0, ntl, va, t);
    __syncthreads();
    xpose_store(va, dst, K, kt * 64, ng * 256, ntl, lds, t);
}
__device__ __forceinline__ void xpose8_one(const float* src, int K, int Nsrc, unsigned char* dst, int map, float scale, int gi, unsigned char* lds) {
    const int t = hidden_tid(); const int nk = K >> 7;
    f32x4 va[4 * X8T];
    const unsigned m = xpose8_load(src, Nsrc, (gi % nk) * 128, (gi / nk) * 64 * X8T, map, va, t);
    __syncthreads();
    xpose8_store(va, dst, K, (gi % nk) * 128, (gi / nk) * 64 * X8T, scale, lds, t, m);
}
#define MISC_GROUPS 608
__device__ __forceinline__ void misc_group(KP p, int idx, unsigned char* lds) {
    char* ws = p->ws;
    if (idx < 216) {
#if INPROJ_FP8
        xpose8_one(p->w_in + (size_t)1024 * INW, 1024, INW, (unsigned char*)(ws + OFF_WIN) + (size_t)ZW * 1024, 1, 32.0f, idx, lds);
#endif
    } else if (idx < 312 || (idx >= 448 && idx < 544)) { const int l = idx < 312 ? 1 : 0, r = idx - (l ? 216 : 448), i = r >> 5;
        xpose_one(p->w_branch + (size_t)(l * 3 + i) * 512 * 1024, 512, 1024, (bf16_t*)(ws + OFF_WBR) + (size_t)(l * 3 + i) * 1024 * 512, 1024, r & 31, lds);
    } else if (idx < 376 || idx >= 544) { const int l = idx < 376 ? 1 : 0, r = idx - (l ? 312 : 544);
        xpose_one(p->w_out + (size_t)l * 1024 * 1024, 1024, 1024, (bf16_t*)(ws + OFF_WOUT) + (size_t)l * 1024 * 1024, 1024, r, lds);
    } else if (idx < 440) { const int r = idx - 376, kv = r >> 5;
        xpose_one(p->cmp_w1 + (size_t)(2 + kv) * 2048 * 256, 2048, 256, (bf16_t*)(ws + OFF_WC1) + (size_t)(2 + kv) * 256 * 2048, 256, r & 31, lds);
    } else { const int r = idx - 440, kv = r >> 2;
        xpose_one(p->cmp_w2 + (size_t)(2 + kv) * 256 * 64, 256, 64, (bf16_t*)(ws + OFF_WC2) + (size_t)(2 + kv) * 64 * 256, 64, r & 3, lds);
    }
}

__device__ __forceinline__ void phase_norm_mod(const float* __restrict__ xsrc, const float* __restrict__ g, const float* __restrict__ modl  , int sh_off, int sc_off, bf16_t* __restrict__ hb) {
    const int tid = hidden_tid(), lane = tid & 63, wv = tid >> 6;
    for (int gw = hidden_bid() * 8 + wv; gw < NTOK / 16; gw += gridDim.x * 8) {
        const int row0 = gw * 16, b = row0 >> 11;
        f32x4 gg[4], sc[4], sh[4], xn[4];
#pragma unroll
        for (int j = 0; j < 4; ++j) { const int col = 256 * j + 4 * lane; gg[j] = *(const f32x4*)(g + col); sc[j] = *(const f32x4*)(modl + (size_t)b * 6144 + sc_off + col); sh[j] = *(const f32x4*)(modl + (size_t)b * 6144 + sh_off + col);
            xn[j] = *(const f32x4*)(xsrc + (size_t)row0 * 1024 + col); }
        for (int i = 0; i < 16; ++i) {
            const int row = row0 + i; f32x4 v[4]; float ss = 0.f;
#pragma unroll
            for (int j = 0; j < 4; ++j) { v[j] = xn[j]; ss += v[j][0] * v[j][0] + v[j][1] * v[j][1] + v[j][2] * v[j][2] + v[j][3] * v[j][3]; }
            if (i + 1 < 16) {
#pragma unroll
                for (int j = 0; j < 4; ++j) xn[j] = *(const f32x4*)(xsrc + (size_t)(row + 1) * 1024 + 256 * j + 4 * lane); }
            ss = wave_sum(ss, lane); const float r = 1.0f / sqrtf(ss * (1.0f / 1024.0f) + 1e-5f);
#pragma unroll
            for (int j = 0; j < 4; ++j) { const int col = 256 * j + 4 * lane; float o[4];
#pragma unroll
                for (int q = 0; q < 4; ++q) o[q] = v[j][q] * r * gg[j][q] * (1.0f + sc[j][q]) + sh[j][q];
#if INPROJ_FP8
                *(unsigned*)((unsigned char*)hb + (size_t)row * 1024 + col) = pk4_fp8(o[0], o[1], o[2], o[3]); }
#else
                u32x2 w; w.x = cvt_pk_bf16(o[0], o[1]); w.y = cvt_pk_bf16(o[2], o[3]); *(u32x2*)(hb + (size_t)row * 1024 + col) = w; }
#endif
        }
    }
}

__device__ __forceinline__ bool unit_rc(unsigned L, int nRT, int nN, int& rt, int& pn) {
    const int x = L & 7; const unsigned i = L >> 3; const int nrt_x = (nRT - x + 7) >> 3;
    const unsigned per = 8u * (unsigned)nN, grp = i / per, rem = i % per;
    pn = (int)(rem >> 3); const int rtl = (int)(grp * 8u + (rem & 7u));
    if (rtl >= nrt_x) return false;
    rt = x + 8 * rtl; return true;
}
__device__ __forceinline__ unsigned unit_slots(int nRT, int nN) { const int pr = (nRT + 7) >> 3; return 8u * (unsigned)(((pr + 7) >> 3) * 8 * nN); }
struct SlotIter {
    unsigned L, LM; int nRT, nN;
    __device__ __forceinline__ void init(int nRT_, int nN_) { nRT = nRT_; nN = nN_; LM = unit_slots(nRT_, nN_); L = hidden_bid(); }
    __device__ __forceinline__ bool take(int& rt, int& pn) { while (L < LM) { const unsigned l = L; L += gridDim.x; if (unit_rc(l, nRT, nN, rt, pn)) return true; } return false; }
};

#define GEMM_STAGE_IDS() int rS, cS; { int tz_ = threadIdx.x; asm volatile("" : "+v"(tz_)); stage_rc(tz_ * 16, rS, cS); }
#define GEMM_LANE_IDS() int tid = threadIdx.x; asm volatile("" : "+v"(tid)); const int wid = tid >> 6, lane = tid & 63, wr = wid >> 2, wc = wid & 3, fr = lane & 15, fq = lane >> 4; (void)lane; (void)wr; (void)wc; (void)fr; (void)fq
#define TILE_ROW(i) (((i) >> 1) * 128 + ((i) & 1) * 64 + rS)
typedef f32x4 (&AccRef)[2][2][4][2];

struct InprojS {
    KP p; int l; SlotIter it; int rt, pn, nrt, npn; f32x4 pb[2][2]; bool hn;
    static constexpr bool BIAS_INIT = true;
    __device__ __forceinline__ bool zero_after() const { return true; }
    __device__ __forceinline__ void load_bias(int pn_) { GEMM_LANE_IDS(); const float* bias = (const float*)(p->ws + OFF_BIN) + (size_t)l * ZW + pn_ * 256 + wc * 32 + fq * 8;
#pragma unroll
        for (int bj = 0; bj < 2; ++bj) { pb[bj][0] = *(const f32x4*)(bias + bj * 128); pb[bj][1] = *(const f32x4*)(bias + bj * 128 + 4); } }
    __device__ __forceinline__ void load_bias_first() { load_bias(pn); }
    __device__ __forceinline__ void init_acc(AccRef acc) {
#pragma unroll
        for (int ai = 0; ai < 2; ++ai)
#pragma unroll
            for (int bj = 0; bj < 2; ++bj)
#pragma unroll
                for (int m = 0; m < 4; ++m) { acc[ai][bj][m][0] = pb[bj][0]; acc[ai][bj][m][1] = pb[bj][1]; } }
    __device__ __forceinline__ void prefetch() {}
    __device__ __forceinline__ void fill(GDesc& d, int rt_, int pn_) { GEMM_STAGE_IDS(); char* ws = p->ws; d.A = ws + OFF_HB; d.B = ws + OFF_WIN + ((size_t)l * ZW + (size_t)pn_ * 256) * 1024 * (INPROJ_FP8 ? 1 : 2);
#pragma unroll
        for (int i = 0; i < 4; ++i) d.aoff[i] = (unsigned)(((size_t)rt_ * 256 + TILE_ROW(i)) * (INPROJ_FP8 ? 1024 : 2048) + cS * 2); }
    __device__ __forceinline__ bool first(GDesc& d) { it.init(128, 27); if (!it.take(rt, pn)) return false; fill(d, rt, pn); return true; }
    __device__ __forceinline__ bool next(GDesc& d) { int a, b; if (!it.take(a, b)) return false; nrt = a; npn = b; fill(d, a, b); return true; }
    __device__ __forceinline__ void advance() { rt = nrt; pn = npn; }
    __device__ __forceinline__ void epilogue(AccRef acc) {
        if (hn) load_bias(npn);
        GEMM_LANE_IDS(); char* ws = p->ws;
        bf16_t* z = (bf16_t*)(ws + OFF_Z);
        const bool sig = pn >= 14;
        const float qsc = (pn < 2 || pn == 3 || pn == 4 || pn == 9 || pn == 10) ? 0.125f : 1.0f;
        const int row0 = rt * 256 + wr * 64 + fr, col0 = pn * 256 + wc * 32 + fq * 8;
#pragma unroll
        for (int bj = 0; bj < 2; ++bj) { const int col = col0 + bj * 128;
#pragma unroll
            for (int ai = 0; ai < 2; ++ai)
#pragma unroll
                for (int m = 0; m < 4; ++m) { f32x4 v0 = acc[ai][bj][m][0] * qsc, v1 = acc[ai][bj][m][1] * qsc;
                    if (sig) {
#pragma unroll
                        for (int j = 0; j < 4; ++j) { v0[j] = sigmoidf_(v0[j]); v1[j] = sigmoidf_(v1[j]); } }
                    u32x4 w; w.x = cvt_pk_bf16(v0[0], v0[1]); w.y = cvt_pk_bf16(v0[2], v0[3]); w.z = cvt_pk_bf16(v1[0], v1[1]); w.w = cvt_pk_bf16(v1[2], v1[3]);
                    *(u32x4*)(z + (size_t)(row0 + ai * 128 + m * 16) * ZW + col) = w; } }
    }
};
__device__ __forceinline__ void phase_inproj(KP p, int l, unsigned char* lds) { InprojS s; s.p = p; s.l = l;
#if INPROJ_FP8
    gemm_stream<InprojS, true, 0x7f7f7f7f, 0x7a7a7a7a>(s, 1024, 128u, lds);
#else
    gemm_stream(s, 1024, 128u, lds);
#endif
}

struct MergeS {
    KP p; int l; SlotIter it; int rt, pn, br, nrt, npn, nbr; bool hn;
    static constexpr bool BIAS_INIT = false;
    __device__ __forceinline__ void load_bias_first() {}
    __device__ __forceinline__ void init_acc(AccRef) {}
    __device__ __forceinline__ bool zero_after() const { return br == 2; }
    __device__ __forceinline__ void prefetch() {}
    __device__ __forceinline__ void fill(GDesc& d, int rt_, int pn_, int br_) { GEMM_STAGE_IDS(); char* ws = p->ws; d.A = ws + OFF_OABC + (size_t)br_ * NTOK * 512 * 2;
        d.B = ws + OFF_WBR + ((size_t)(l * 3 + br_) * 1024 + (size_t)pn_ * 256) * 512 * 2;
#pragma unroll
        for (int i = 0; i < 4; ++i) d.aoff[i] = (unsigned)(((size_t)rt_ * 256 + TILE_ROW(i)) * 1024 + cS * 2); }
    __device__ __forceinline__ bool first(GDesc& d) { it.init(128, 4); if (!it.take(rt, pn)) return false; br = 0; fill(d, rt, pn, 0); return true; }
    __device__ __forceinline__ bool next(GDesc& d) { if (br < 2) { nrt = rt; npn = pn; nbr = br + 1; } else { int a, b; if (!it.take(a, b)) return false; nrt = a; npn = b; nbr = 0; } fill(d, nrt, npn, nbr); return true; }
    __device__ __forceinline__ void advance() { rt = nrt; pn = npn; br = nbr; }
    __device__ __forceinline__ void epilogue(AccRef acc) {
        GEMM_LANE_IDS(); char* ws = p->ws;
        const bf16_t* z = (const bf16_t*)(ws + OFF_Z); bf16_t* mg = (bf16_t*)(ws + OFF_MERGED);
        const int row0 = rt * 256 + wr * 64 + fr, col0 = pn * 256 + wc * 32 + fq * 8;
#pragma unroll
        for (int ai = 0; ai < 2; ++ai) {
            u32x4 G[2][4], H[2][4];
#pragma unroll
            for (int bj = 0; bj < 2; ++bj)
#pragma unroll
                for (int m = 0; m < 4; ++m) { const bf16_t* gp = z + (size_t)(row0 + ai * 128 + m * 16) * ZW + C_GM + br * 1024 + col0 + bj * 128;
                    G[bj][m] = *(const u32x4*)gp; H[bj][m] = *(const u32x4*)(gp + (br < 2 ? 1024 : 0)); }
            asm volatile("" ::: "memory");
#pragma unroll
            for (int bj = 0; bj < 2; ++bj)
#pragma unroll
                for (int m = 0; m < 4; ++m) {
                    const int row = row0 + ai * 128 + m * 16, col = col0 + bj * 128;
                    const u32x4 gw = G[bj][m], hw = H[bj][m];
                    float g[8] = {bflo(gw.x), bfhi(gw.x), bflo(gw.y), bfhi(gw.y), bflo(gw.z), bfhi(gw.z), bflo(gw.w), bfhi(gw.w)};
                    if (br < 2) { const float hn[8] = {bflo(hw.x), bfhi(hw.x), bflo(hw.y), bfhi(hw.y), bflo(hw.z), bfhi(hw.z), bflo(hw.w), bfhi(hw.w)};
#pragma unroll
                        for (int j = 0; j < 8; ++j) g[j] = fmaxf(g[j], 1e-6f) * fast_rcp(fmaxf(hn[j], 1e-6f));
                    } else {
#pragma unroll
                        for (int j = 0; j < 8; ++j) g[j] = fmaxf(g[j], 1e-6f); }
                    f32x4 v0 = acc[ai][bj][m][0], v1 = acc[ai][bj][m][1];
                    v0[0] *= g[0]; v0[1] *= g[1]; v0[2] *= g[2]; v0[3] *= g[3]; v1[0] *= g[4]; v1[1] *= g[5]; v1[2] *= g[6]; v1[3] *= g[7];
                    if (br < 2) { acc[ai][bj][m][0] = v0; acc[ai][bj][m][1] = v1; }
                    else { u32x4 w; w.x = cvt_pk_bf16(v0[0], v0[1]); w.y = cvt_pk_bf16(v0[2], v0[3]); w.z = cvt_pk_bf16(v1[0], v1[1]); w.w = cvt_pk_bf16(v1[2], v1[3]); *(u32x4*)(mg + (size_t)row * 1024 + col) = w; }
                }
        }
    }
};
__device__ __forceinline__ void phase_merge(KP p, int l, unsigned char* lds) { MergeS s; s.p = p; s.l = l; gemm_stream(s, 512, 128u, lds); }

struct OutprojS {
    KP p; int l; SlotIter it; int rt, pn, nrt, npn; f32x4 pg[2][2]; bool hn;
    static constexpr bool BIAS_INIT = false;
    __device__ __forceinline__ void load_bias_first() {}
    __device__ __forceinline__ void init_acc(AccRef) {}
    __device__ __forceinline__ bool zero_after() const { return true; }
    __device__ __forceinline__ void prefetch() { GEMM_LANE_IDS(); const float* gp = (const float*)(p->ws + OFF_MOD) + ((size_t)l * 16 + (rt >> 3)) * 6144 + 2048 + pn * 256 + wc * 32 + fq * 8;
#pragma unroll
        for (int bj = 0; bj < 2; ++bj) { pg[bj][0] = *(const f32x4*)(gp + bj * 128); pg[bj][1] = *(const f32x4*)(gp + bj * 128 + 4); } }
    __device__ __forceinline__ void fill(GDesc& d, int rt_, int pn_) { GEMM_STAGE_IDS(); char* ws = p->ws; d.A = ws + OFF_MERGED; d.B = ws + OFF_WOUT + ((size_t)l * 1024 + (size_t)pn_ * 256) * 1024 * 2;
#pragma unroll
        for (int i = 0; i < 4; ++i) d.aoff[i] = (unsigned)(((size_t)rt_ * 256 + TILE_ROW(i)) * 2048 + cS * 2); }
    __device__ __forceinline__ bool first(GDesc& d) { it.init(128, 4); if (!it.take(rt, pn)) return false; fill(d, rt, pn); return true; }
    __device__ __forceinline__ bool next(GDesc& d) { int a, b; if (!it.take(a, b)) return false; nrt = a; npn = b; fill(d, a, b); return true; }
    __device__ __forceinline__ void advance() { rt = nrt; pn = npn; }
    __device__ __forceinline__ void epilogue(AccRef acc) {
        GEMM_LANE_IDS(); bf16_t* xrb = (bf16_t*)(p->ws + OFF_XR); const float* xin = p->x;
        const int row0 = rt * 256 + wr * 64 + fr, col0 = pn * 256 + wc * 32 + fq * 8;
#pragma unroll
        for (int ai = 0; ai < 2; ++ai) {
            if (l == 0) {
#pragma unroll
                for (int bj = 0; bj < 2; ++bj) {
                    f32x4 X[4][2];
#pragma unroll
                    for (int m = 0; m < 4; ++m) { const float* xp = xin + (size_t)(row0 + ai * 128 + m * 16) * 1024 + col0 + bj * 128; X[m][0] = *(const f32x4*)xp; X[m][1] = *(const f32x4*)(xp + 4); }
                    asm volatile("" ::: "memory");
#pragma unroll
                    for (int m = 0; m < 4; ++m) { const f32x4 v0 = X[m][0] + pg[bj][0] * acc[ai][bj][m][0], v1 = X[m][1] + pg[bj][1] * acc[ai][bj][m][1];
                        u32x4 w; w.x = cvt_pk_bf16(v0[0], v0[1]); w.y = cvt_pk_bf16(v0[2], v0[3]); w.z = cvt_pk_bf16(v1[0], v1[1]); w.w = cvt_pk_bf16(v1[2], v1[3]);
                        *(u32x4*)(xrb + (size_t)(row0 + ai * 128 + m * 16) * 1024 + col0 + bj * 128) = w; }
                }
            } else {
                u32x4 X[2][4];
#pragma unroll
                for (int bj = 0; bj < 2; ++bj)
#pragma unroll
                    for (int m = 0; m < 4; ++m) X[bj][m] = *(const u32x4*)(xrb + (size_t)(row0 + ai * 128 + m * 16) * 1024 + col0 + bj * 128);
                asm volatile("" ::: "memory");
#pragma unroll
                for (int bj = 0; bj < 2; ++bj)
#pragma unroll
                    for (int m = 0; m < 4; ++m) { const u32x4 xw = X[bj][m];
                        const f32x4 v0 = (f32x4){bflo(xw.x), bfhi(xw.x), bflo(xw.y), bfhi(xw.y)} + pg[bj][0] * acc[ai][bj][m][0], v1 = (f32x4){bflo(xw.z), bfhi(xw.z), bflo(xw.w), bfhi(xw.w)} + pg[bj][1] * acc[ai][bj][m][1];
                        u32x4 w; w.x = cvt_pk_bf16(v0[0], v0[1]); w.y = cvt_pk_bf16(v0[2], v0[3]); w.z = cvt_pk_bf16(v1[0], v1[1]); w.w = cvt_pk_bf16(v1[2], v1[3]);
                        *(u32x4*)(xrb + (size_t)(row0 + ai * 128 + m * 16) * 1024 + col0 + bj * 128) = w; }
            }
        }
    }
};
__device__ __forceinline__ void phase_outproj(KP p, int l, unsigned char* lds) { OutprojS s; s.p = p; s.l = l; gemm_stream(s, 1024, 128u, lds); }

__device__ __forceinline__ void moe_tables(KP p, int l, int* tbl) {
    const int t = hidden_tid();
    if (t < 64) {
        const unsigned* ctrl = (const unsigned*)p->ws; const int e = t & 31;
        const int c = (int)ctrl[CW_ECNT(l, e)]; const int nt = (c + 255) >> 8;
        int incl = nt;
#pragma unroll
        for (int o = 1; o < 32; o <<= 1) { const int v = __builtin_amdgcn_ds_bpermute(((t - o) & 63) << 2, incl); if (e >= o) incl += v; }
        if (t < 32) { tbl[e] = incl - nt; tbl[33 + e] = c; if (e == 31) tbl[32] = incl; }
    }
    __syncthreads();
}
#define RFL(x) __builtin_amdgcn_readfirstlane(x)
__device__ __forceinline__ int moe_find(const int* tbl, int rt, int e = 0) {
    while (RFL(tbl[e + 1]) <= rt) ++e;
    while (RFL(tbl[e]) > rt) --e;
    return e; }
#define MOE_TBL(lds) ((int*)((lds) + 131072 + 4096))

#ifndef MOEX
#define MOEX 0
#endif
struct Moe1S {
    KP p; int l; const int* tbl; SlotIter it; int rt, pn, e, nrt, npn, ne; int shadow; f32x4 bg[2], bu[2]; const int* toktab; int ui; bool hn;
    static constexpr bool BIAS_INIT = true;
    __device__ __forceinline__ bool zero_after() const { return true; }
    __device__ __forceinline__ void prefetch() {}
    __device__ __forceinline__ void load_bias(int pn_, int e_) { GEMM_LANE_IDS(); const float* bb = (const float*)(p->ws + OFF_B1P) + ((size_t)(l * 32 + e_)) * 2048 + pn_ * 256 + wc * 32 + fq * 8;
#pragma unroll
        for (int n = 0; n < 2; ++n) { bg[n] = *(const f32x4*)(bb + n * 4); bu[n] = *(const f32x4*)(bb + 128 + n * 4); } }
    __device__ __forceinline__ void load_bias_first() { load_bias(pn, e); }
    __device__ __forceinline__ void init_acc(AccRef acc) {
#pragma unroll
        for (int ai = 0; ai < 2; ++ai)
#pragma unroll
            for (int m = 0; m < 4; ++m)
#pragma unroll
                for (int n = 0; n < 2; ++n) { acc[ai][0][m][n] = bg[n]; acc[ai][1][m][n] = bu[n]; } }
    __device__ __forceinline__ void fill(GDesc& d, int rt_, int pn_, int e_) { GEMM_STAGE_IDS(); char* ws = p->ws; (void)rt_;
        d.A = ws + OFF_H8; d.B = ws + OFF_W1 + (((size_t)(l * 32 + e_)) * 2048 + (size_t)pn_ * 256) * 1024;
#pragma unroll
        for (int i = 0; i < 4; ++i) d.aoff[i] = (unsigned)((size_t)toktab[ui * 256 + TILE_ROW(i)] * 1024 + cS * 2);
        ++ui; }
    __device__ __forceinline__ bool first(GDesc& d) { it.init(RFL(tbl[32]), 8); if (!it.take(rt, pn)) return false; e = moe_find(tbl, rt); fill(d, rt, pn, e); return true; }
    __device__ __forceinline__ bool next(GDesc& d) { int a, b; if (!it.take(a, b)) return false; nrt = a; npn = b; ne = moe_find(tbl, a, e); fill(d, a, b, ne); return true; }
    __device__ __forceinline__ void advance() { rt = nrt; pn = npn; e = ne; }
    __device__ __forceinline__ void epilogue(AccRef acc) {
        if (shadow && MOEX == 2) { asm volatile("" :: "v"(acc[0][0][0][0]), "v"(acc[1][1][3][1])); return; }
        if (hn) load_bias(npn, ne);
        GEMM_LANE_IDS(); char* ws = p->ws; unsigned char* hid = (unsigned char*)(ws + OFF_HID);
        const size_t prow0 = (size_t)rt * 256 + wr * 64 + fr; const int c0 = wc * 32 + fq * 8;
#pragma unroll
        for (int ai = 0; ai < 2; ++ai)
#pragma unroll
            for (int m = 0; m < 4; ++m) { float o[8];
#pragma unroll
                for (int n = 0; n < 2; ++n) { const f32x4 gq = acc[ai][0][m][n], uq = acc[ai][1][m][n];
#pragma unroll
                    for (int j = 0; j < 4; ++j) { const float gg = fminf(gq[j], 7.0f), uu = __builtin_amdgcn_fmed3f(uq[j], -7.0f, 7.0f); o[n * 4 + j] = __builtin_fmaf(uu, 4.0f, 4.0f) * gg * fast_rcp(1.0f + fast_exp2(-1.702f * LOG2E * gg)); } }
                u32x2 w; w.x = pk4_fp8(o[0], o[1], o[2], o[3]); w.y = pk4_fp8(o[4], o[5], o[6], o[7]);
                *(u32x2*)(hid + (prow0 + ai * 128 + m * 16) * 1024 + pn * 128 + c0) = w; }
    }
};
__device__ __forceinline__ void phase_moe1(KP p, int l, unsigned char* lds) { int* tbl = MOE_TBL(lds); moe_tables(p, l, tbl);
    int* toktab = (int*)(lds + 131072 + 8192);
    { SlotIter it2; it2.init(RFL(tbl[32]), 8); int a, b, u2 = 0, e2 = 0; const int t = hidden_tid();
      while (it2.take(a, b)) { e2 = moe_find(tbl, a, e2); const int cnt = RFL(tbl[33 + e2]), pos0 = (a - RFL(tbl[e2])) * 256;
          if (t < 256) { int pos = pos0 + t; pos = pos < cnt ? pos : 0; toktab[u2 * 256 + t] = ((const int*)(p->ws + OFF_BUCK))[(size_t)e2 * NTOK + pos]; }
          ++u2; }
      __syncthreads(); }
    for (int rep = 0; rep < (MOEX ? 2 : 1); ++rep) { Moe1S s; s.p = p; s.l = l; s.tbl = tbl; s.shadow = rep; s.toktab = toktab; s.ui = 0; gemm_stream<Moe1S, true, 0x7f7f7f7f, 0x7a7a7a7a>(s, 1024, 128u, lds); __syncthreads(); } }

struct Moe2S {
    KP p; int l; const int* tbl; SlotIter it; int rt, pn, e, nrt, npn, ne; f32x4 pb[2][2]; bool hn;
    static constexpr bool BIAS_INIT = true;
    __device__ __forceinline__ bool zero_after() const { return true; }
    __device__ __forceinline__ void prefetch() {}
    __device__ __forceinline__ void load_bias(int pn_, int e_) { GEMM_LANE_IDS(); const float* b2 = p->exp_b2 + ((size_t)(l * 32 + e_)) * 1024 + pn_ * 256 + wc * 32 + fq * 8;
#pragma unroll
        for (int bj = 0; bj < 2; ++bj) { pb[bj][0] = *(const f32x4*)(b2 + bj * 128); pb[bj][1] = *(const f32x4*)(b2 + bj * 128 + 4); } }
    __device__ __forceinline__ void load_bias_first() { load_bias(pn, e); }
    __device__ __forceinline__ void init_acc(AccRef acc) {
#pragma unroll
        for (int ai = 0; ai < 2; ++ai)
#pragma unroll
            for (int bj = 0; bj < 2; ++bj)
#pragma unroll
                for (int m = 0; m < 4; ++m) { acc[ai][bj][m][0] = pb[bj][0]; acc[ai][bj][m][1] = pb[bj][1]; } }
    __device__ __forceinline__ void fill(GDesc& d, int rt_, int pn_, int e_) { GEMM_STAGE_IDS(); char* ws = p->ws; d.A = ws + OFF_HID; d.B = ws + OFF_W2 + (((size_t)(l * 32 + e_)) * 1024 + (size_t)pn_ * 256) * 1024;
#pragma unroll
        for (int i = 0; i < 4; ++i) d.aoff[i] = (unsigned)(((size_t)rt_ * 256 + TILE_ROW(i)) * 1024 + cS * 2); }
    __device__ __forceinline__ bool first(GDesc& d) { it.init(RFL(tbl[32]), 4); if (!it.take(rt, pn)) return false; e = moe_find(tbl, rt); fill(d, rt, pn, e); return true; }
    __device__ __forceinline__ bool next(GDesc& d) { int a, b; if (!it.take(a, b)) return false; nrt = a; npn = b; ne = moe_find(tbl, a, e); fill(d, a, b, ne); return true; }
    __device__ __forceinline__ void advance() { rt = nrt; pn = npn; e = ne; }
    __device__ __forceinline__ void epilogue(AccRef acc) {
        if (hn) load_bias(npn, ne);
        GEMM_LANE_IDS(); char* ws = p->ws; bf16_t* y = (bf16_t*)(ws + OFF_Y);
        const size_t row0 = (size_t)rt * 256 + wr * 64 + fr; const int col0 = pn * 256 + wc * 32 + fq * 8;
#pragma unroll
        for (int bj = 0; bj < 2; ++bj) { const int col = col0 + bj * 128;
#pragma unroll
            for (int ai = 0; ai < 2; ++ai)
#pragma unroll
                for (int m = 0; m < 4; ++m) { const f32x4 v0 = acc[ai][bj][m][0], v1 = acc[ai][bj][m][1];
                    u32x4 w; w.x = cvt_pk_bf16(v0[0], v0[1]); w.y = cvt_pk_bf16(v0[2], v0[3]); w.z = cvt_pk_bf16(v1[0], v1[1]); w.w = cvt_pk_bf16(v1[2], v1[3]);
                    *(u32x4*)(y + (row0 + ai * 128 + m * 16) * 1024 + col) = w; } }
    }
};
__device__ __forceinline__ void phase_moe2(KP p, int l, unsigned char* lds) { int* tbl = MOE_TBL(lds); moe_tables(p, l, tbl); Moe2S s; s.p = p; s.l = l; s.tbl = tbl; gemm_stream<Moe2S, true, 0x7d7d7d7d, 0x7a7a7a7a>(s, 1024, 128u, lds); __syncthreads(); }

#define AT_MISC 65536


typedef short s16x4 __attribute__((ext_vector_type(4)));
__device__ __forceinline__ int crow(int r, int h) { return (r & 3) + 8 * (r >> 2) + 4 * h; }
__device__ __forceinline__ int kaddr(int key, int c) { return (key >> 1) * 256 + (((((key & 1) << 3) | c) ^ ((key >> 1) & 15)) << 4); }
__device__ __forceinline__ int vaddr64(int key, int c) { return (key >> 1) * 256 + (((key & 1) * 2 + ((c >> 2) ^ ((key >> 1) & 1))) << 6) + ((c & 3) << 4); }
__device__ __forceinline__ int vaddr128(int key, int c) { return key * 256 + (((c >> 2) ^ (key & 3)) << 6) + ((c & 3) << 4); }
__device__ __forceinline__ s16x4 vtr(const unsigned char* p) { return __builtin_bit_cast(s16x4, __builtin_amdgcn_ds_read_tr16_b64_v4i16((LAS s16x4*)(p))); }
__device__ __forceinline__ float swap_max(float v) { auto rr = __builtin_amdgcn_permlane32_swap(__float_as_uint(v), __float_as_uint(v), false, false); return fmaxf(__uint_as_float(rr[0]), __uint_as_float(rr[1])); }
__device__ __forceinline__ float swap_sum(float v) { auto rr = __builtin_amdgcn_permlane32_swap(__float_as_uint(v), __float_as_uint(v), false, false); return __uint_as_float(rr[0]) + __uint_as_float(rr[1]); }
__device__ __forceinline__ float swap_other(float v, int h) { auto rr = __builtin_amdgcn_permlane32_swap(__float_as_uint(v), __float_as_uint(v), false, false); return __uint_as_float(h ? rr[0] : rr[1]); }
#define MFMA32(a, b, c) __builtin_amdgcn_mfma_f32_32x32x16_bf16((a), (b), (c), 0, 0, 0)

struct KVSrc { const char* k; unsigned kstride; const char* v; unsigned vstride; };
__device__ __forceinline__ void kinv(int o, int& key, int& c) { const int sup = o >> 8, x = ((o >> 4) & 15) ^ (sup & 15); key = 2 * sup + (x >> 3); c = x & 7; }
__device__ __forceinline__ void vinv64(int o, int& key, int& c) { const int sup = o >> 8, seg = (o >> 6) & 3; key = 2 * sup + (seg >> 1); c = (((seg & 1) ^ (sup & 1)) << 2) | ((o >> 4) & 3); }
__device__ __forceinline__ void vinv128(int o, int& key, int& c) { key = o >> 8; c = ((((o >> 6) & 3) ^ (key & 3)) << 2) | ((o >> 4) & 3); }
#define RING_NB 4
#define RING_AHEAD 3
template <int KW, int DV> struct KVRing {
    static constexpr int LPT = KW + DV / 64, BUFB = KW * 8192 + DV * 128;
    unsigned kof[KW], vof[DV / 64];
    unsigned kdst[KW], vdst[DV / 64];
    const char* kb; const char* vb; unsigned kstride, vstride;
    __device__ __forceinline__ void init(const KVSrc& s, int tid) {
        kb = s.k; vb = s.v; kstride = s.kstride; vstride = s.vstride;
        const int wv = tid >> 6, lane = tid & 63;
#pragma unroll
        for (int i = 0; i < KW; ++i) { const int o = (i * 8 + wv) * 1024 + lane * 16, img = o >> 13; int key, c; kinv(o & 8191, key, c); kof[i] = (unsigned)key * kstride + (unsigned)(img * 128 + c * 16); kdst[i] = (unsigned)o; }
#pragma unroll
        for (int i = 0; i < DV / 64; ++i) { const int o = (i * 8 + wv) * 1024 + lane * 16; int key, c; if (DV == 64) vinv64(o, key, c); else vinv128(o, key, c);
            vof[i] = (unsigned)key * vstride + (unsigned)(c * 16); vdst[i] = (unsigned)(KW * 8192 + o); }
    }
    __device__ __forceinline__ void issue(int key0, int buf, unsigned char* lds) const {
        const char* kt = UNIPTR(kb + (size_t)key0 * kstride); const char* vt = UNIPTR(vb + (size_t)key0 * vstride);
#pragma unroll
        for (int i = 0; i < KW; ++i) { unsigned o = kof[i]; asm volatile("" : "+v"(o)); __builtin_amdgcn_global_load_lds((const unsigned*)(kt + o), (unsigned*)(lds + buf * BUFB + kdst[i]), 16, 0, 0); }
#pragma unroll
        for (int i = 0; i < DV / 64; ++i) { unsigned o = vof[i]; asm volatile("" : "+v"(o)); __builtin_amdgcn_global_load_lds((const unsigned*)(vt + o), (unsigned*)(lds + buf * BUFB + vdst[i]), 16, 0, 0); }
    }
    __device__ __forceinline__ void wait_bar(int later) const {
        if (later >= 2 && RING_AHEAD >= 3) asm volatile("s_waitcnt vmcnt(%0)" :: "n"(2 * LPT) : "memory");
        else if (later >= 1) asm volatile("s_waitcnt vmcnt(%0)" :: "n"(LPT) : "memory");
        else asm volatile("s_waitcnt vmcnt(0)" ::: "memory");
        __builtin_amdgcn_s_barrier(); asm volatile("" ::: "memory");
    }
    __device__ __forceinline__ const unsigned char* kimg(const unsigned char* lds, int buf, int img) const { return lds + buf * BUFB + img * 8192; }
    __device__ __forceinline__ const unsigned char* vimg(const unsigned char* lds, int buf) const { return lds + buf * BUFB + KW * 8192; }
};

template <int DV> struct WaveAcc { float m, l; f32x16 o[DV / 32]; };
template <int DV> __device__ __forceinline__ void acc_init(WaveAcc<DV>& a) { a.m = -1e30f; a.l = 0.f;
#pragma unroll
    for (int d = 0; d < DV / 32; ++d)
#pragma unroll
        for (int r = 0; r < 16; ++r) a.o[d][r] = 0.f; }

__device__ __forceinline__ f32x16 qk_sub(const bf16x8 (&qf)[4], const unsigned char* kimg, int sub, int lane) {
    const int r32 = lane & 31, h = lane >> 5;
    f32x16 s;
#pragma unroll
    for (int r = 0; r < 16; ++r) s[r] = 0.f;
#pragma unroll
    for (int ks = 0; ks < 4; ++ks) { const bf16x8 kf = *(const bf16x8*)(kimg + kaddr(32 * sub + r32, 2 * ks + h)); s = MFMA32(kf, qf[ks], s); }
    return s;
}
template <int DV> struct VFrag { s16x4 r[2][DV / 32][2]; };
__device__ __forceinline__ void v_read_all(VFrag<64>& f, const unsigned char* vimg, int sub, int lane) {
    const int h = lane >> 5, i16 = lane & 15, qq = i16 >> 2, pp = i16 & 3, g1 = (lane >> 4) & 1, k0 = 32 * sub + 4 * h + qq;
    const unsigned b0 = (unsigned)(uintptr_t)(vimg + vaddr64(k0, 2 * g1 + (pp >> 1)) + (pp & 1) * 8), b1 = (unsigned)(uintptr_t)(vimg + vaddr64(k0, 4 + 2 * g1 + (pp >> 1)) + (pp & 1) * 8);
    asm volatile("ds_read_b64_tr_b16 %0, %8\n\tds_read_b64_tr_b16 %1, %8 offset:1024\n\tds_read_b64_tr_b16 %2, %9\n\tds_read_b64_tr_b16 %3, %9 offset:1024\n\t"
                 "ds_read_b64_tr_b16 %4, %8 offset:2048\n\tds_read_b64_tr_b16 %5, %8 offset:3072\n\tds_read_b64_tr_b16 %6, %9 offset:2048\n\tds_read_b64_tr_b16 %7, %9 offset:3072\n\t"
                 "s_waitcnt lgkmcnt(0)"
                 : "=&v"(f.r[0][0][0]), "=&v"(f.r[0][0][1]), "=&v"(f.r[0][1][0]), "=&v"(f.r[0][1][1]), "=&v"(f.r[1][0][0]), "=&v"(f.r[1][0][1]), "=&v"(f.r[1][1][0]), "=&v"(f.r[1][1][1])
                 : "v"(b0), "v"(b1) : "memory");
}
__device__ __forceinline__ void v_read_all(VFrag<128>& f, const unsigned char* vimg, int sub, int lane) {
    const int h = lane >> 5, i16 = lane & 15, qq = i16 >> 2, pp = i16 & 3, g1 = (lane >> 4) & 1, k0 = 32 * sub + 4 * h + qq;
    unsigned b[4];
#pragma unroll
    for (int db = 0; db < 4; ++db) b[db] = (unsigned)(uintptr_t)(vimg + vaddr128(k0, db * 4 + 2 * g1 + (pp >> 1)) + (pp & 1) * 8);
    asm volatile("ds_read_b64_tr_b16 %0, %16\n\tds_read_b64_tr_b16 %1, %16 offset:2048\n\tds_read_b64_tr_b16 %2, %17\n\tds_read_b64_tr_b16 %3, %17 offset:2048\n\t"
                 "ds_read_b64_tr_b16 %4, %18\n\tds_read_b64_tr_b16 %5, %18 offset:2048\n\tds_read_b64_tr_b16 %6, %19\n\tds_read_b64_tr_b16 %7, %19 offset:2048\n\t"
                 "ds_read_b64_tr_b16 %8, %16 offset:4096\n\tds_read_b64_tr_b16 %9, %16 offset:6144\n\tds_read_b64_tr_b16 %10, %17 offset:4096\n\tds_read_b64_tr_b16 %11, %17 offset:6144\n\t"
                 "ds_read_b64_tr_b16 %12, %18 offset:4096\n\tds_read_b64_tr_b16 %13, %18 offset:6144\n\tds_read_b64_tr_b16 %14, %19 offset:4096\n\tds_read_b64_tr_b16 %15, %19 offset:6144\n\t"
                 "s_waitcnt lgkmcnt(0)"
                 : "=&v"(f.r[0][0][0]), "=&v"(f.r[0][0][1]), "=&v"(f.r[0][1][0]), "=&v"(f.r[0][1][1]), "=&v"(f.r[0][2][0]), "=&v"(f.r[0][2][1]), "=&v"(f.r[0][3][0]), "=&v"(f.r[0][3][1]),
                   "=&v"(f.r[1][0][0]), "=&v"(f.r[1][0][1]), "=&v"(f.r[1][1][0]), "=&v"(f.r[1][1][1]), "=&v"(f.r[1][2][0]), "=&v"(f.r[1][2][1]), "=&v"(f.r[1][3][0]), "=&v"(f.r[1][3][1])
                 : "v"(b[0]), "v"(b[1]), "v"(b[2]), "v"(b[3]) : "memory");
}
template <int DV> __device__ __forceinline__ void pv_sub(const f32x16& pr, const VFrag<DV>& f, f32x16 (&o)[DV / 32]) {
#pragma unroll
    for (int s2 = 0; s2 < 2; ++s2) {
        u32x4 pw; pw.x = cvt_pk_bf16(pr[8 * s2 + 0], pr[8 * s2 + 1]); pw.y = cvt_pk_bf16(pr[8 * s2 + 2], pr[8 * s2 + 3]);
        pw.z = cvt_pk_bf16(pr[8 * s2 + 4], pr[8 * s2 + 5]); pw.w = cvt_pk_bf16(pr[8 * s2 + 6], pr[8 * s2 + 7]);
        const bf16x8 pf = __builtin_bit_cast(bf16x8, pw);
#pragma unroll
        for (int db = 0; db < DV / 32; ++db) { const s16x4 lo = f.r[s2][db][0], hi = f.r[s2][db][1];
            bf16x8 vf; vf[0] = lo[0]; vf[1] = lo[1]; vf[2] = lo[2]; vf[3] = lo[3]; vf[4] = hi[0]; vf[5] = hi[1]; vf[6] = hi[2]; vf[7] = hi[3];
            o[db] = MFMA32(vf, pf, o[db]); }
    }
}
template <int DV> __device__ __forceinline__ void attn_sub_auto(const bf16x8 (&qf)[5], const unsigned char* kimg, const unsigned char* vimg, int sub, int key0, int tqw, int tq, int h,
                                                               int whi, bool lbit, WaveAcc<DV>& a, int lane) {
    f32x16 s = qk_sub(*(const bf16x8 (*)[4])&qf, kimg, sub, lane);
    { const int r32 = lane & 31, tk = key0 + r32; const unsigned hi = __float_as_uint((float)(tk >> 8)) >> 16, lo = __float_as_uint((float)(tk & 255)) & 0xffff0000u;
      u32x4 kw; kw.x = (lane < 32) ? (hi | lo) : 0u; kw.y = 0u; kw.z = 0u; kw.w = 0u;
      s = MFMA32(__builtin_bit_cast(bf16x8, kw), qf[4], s); }
    VFrag<DV> vf; v_read_all(vf, vimg, sub, lane);
    const bool interior = (tqw - (key0 + 31) >= 0) && (tqw + 31 - key0 < whi) && __all(lbit);
    if (!interior) { const int d0 = tq - key0 - 4 * h;
#pragma unroll
        for (int r = 0; r < 16; ++r) { const int dist = d0 - ((r & 3) + 8 * (r >> 2)); s[r] = (lbit && dist >= 0 && dist < whi) ? s[r] : -INFINITY; } }
    float tmax = fmaxf(fmaxf(s[0], s[1]), fmaxf(s[2], s[3]));
#pragma unroll
    for (int r = 4; r < 16; r += 4) tmax = fmaxf(tmax, fmaxf(fmaxf(s[r], s[r + 1]), fmaxf(s[r + 2], s[r + 3])));
    tmax = swap_max(tmax);
    if (!__all(tmax - a.m <= 8.0f)) {
        const float mnew = fmaxf(a.m, tmax), alpha = fast_exp2((a.m - mnew) * LOG2E);
        a.l *= alpha; a.m = mnew;
#pragma unroll
        for (int d = 0; d < DV / 32; ++d)
#pragma unroll
            for (int r = 0; r < 16; ++r) a.o[d][r] *= alpha;
    }
    const float nm = -a.m * LOG2E;
    float rs0 = 0.f, rs1 = 0.f;
#pragma unroll
    for (int r = 0; r < 16; r += 2) { s[r] = fast_exp2(__builtin_fmaf(s[r], LOG2E, nm)); s[r + 1] = fast_exp2(__builtin_fmaf(s[r + 1], LOG2E, nm)); rs0 += s[r]; rs1 += s[r + 1]; }
    a.l += rs0 + rs1;
    pv_sub<DV>(s, vf, a.o);
}
__device__ __forceinline__ void load_q(bf16x8 (&qf)[5], const bf16_t* qp  , float slope, int lane) {
#pragma unroll
    for (int ks = 0; ks < 4; ++ks) qf[ks] = *(const bf16x8*)(qp + 16 * ks);
    u32x4 qw; qw.x = (lane < 32) ? ((__float_as_uint(256.0f * slope) >> 16) | (__float_as_uint(slope) & 0xffff0000u)) : 0u; qw.y = 0u; qw.z = 0u; qw.w = 0u;
    qf[4] = __builtin_bit_cast(bf16x8, qw);
}
template <int DV> __device__ __forceinline__ void store_o(const f32x16 (&o)[DV / 32], float sc, bf16_t* orow, int h) {
#pragma unroll
    for (int db = 0; db < DV / 32; ++db)
#pragma unroll
        for (int rg = 0; rg < 4; ++rg) { u32x2 w; w.x = cvt_pk_bf16(o[db][4 * rg] * sc, o[db][4 * rg + 1] * sc); w.y = cvt_pk_bf16(o[db][4 * rg + 2] * sc, o[db][4 * rg + 3] * sc);
            *(u32x2*)(orow + db * 32 + 8 * rg + 4 * h) = w; }
}


template <bool SINK> __device__ __forceinline__ void attn_window_unit(KP p, int l, int b, int hkv, int qt, int W, int cq, int ck, int cv, bf16_t* outbuf, unsigned char* lds) {
    const int tid = hidden_tid(), lane = tid & 63, wv = __builtin_amdgcn_readfirstlane(tid >> 6), r32 = lane & 31, h = lane >> 5, g = wv & 3, qsub = wv >> 2;
    const int head = hkv * 4 + g, t0 = qt * 64, tqw = t0 + 32 * qsub, tq = tqw + r32;
    const bf16_t* z = (const bf16_t*)(p->ws + OFF_Z);
    const float slope = exp2f(-(float)(head + 1));
    KVSrc src; src.k = (const char*)(z + (size_t)b * NS * ZW + ck + hkv * 64); src.v = (const char*)(z + (size_t)b * NS * ZW + cv + hkv * 64); src.kstride = ZW * 2; src.vstride = ZW * 2;
    int klo = t0 - W + 1; klo = klo < 0 ? 0 : klo; const int kt0 = klo >> 6, kt1 = qt;
    WaveAcc<64> a; acc_init(a);
    KVRing<1, 64> ring; ring.init(src, tid);
    const int nt = kt1 - kt0 + 1;
    for (int j = 0; j < RING_AHEAD && j < nt; ++j) ring.issue((kt1 - j) * 64, j, lds);
    bf16x8 qf[5]; load_q(qf, z + ((size_t)b * NS + tq) * ZW + cq + head * 64 + 8 * h, slope, lane);
    asm volatile("" :: "v"(qf[0]), "v"(qf[1]), "v"(qf[2]), "v"(qf[3]));
    asm volatile(".p2align 8");
    for (int t = 0; t < nt; ++t) {
        const int kt = kt1 - t, buf = t & (RING_NB - 1);
        ring.wait_bar(nt - 1 - t);
        if (t + RING_AHEAD < nt) ring.issue((kt - RING_AHEAD) * 64, (t + RING_AHEAD) & (RING_NB - 1), lds);
        const unsigned char* kimg = ring.kimg(lds, buf, 0); const unsigned char* vimg = ring.vimg(lds, buf);
#pragma unroll
        for (int sr = 0; sr < 2; ++sr) { const int sub = 1 - sr, key0 = kt * 64 + 32 * sub;
            if (key0 <= tqw + 31 && key0 + 31 >= tqw - W + 1) attn_sub_auto<64>(qf, kimg, vimg, sub, key0, tqw, tq, h, W, true, a, lane); }
    }
    __syncthreads();
    float den = swap_sum(a.l);
    if (SINK) den += fast_exp2((p->sinks[l * 8 + head] + slope * (float)tq - a.m) * LOG2E);
    store_o<64>(a.o, 1.0f / den, outbuf + ((size_t)b * NS + tq) * 512 + head * 64, h);
}

#ifndef EXPER
#define EXPER 0
#endif
__device__ __forceinline__ void attn_diff_unit(KP p, int l, int b, int hd, int qt, unsigned char* lds, const int shadow = 0) {
    const int tid = hidden_tid(), lane = tid & 63, wv = __builtin_amdgcn_readfirstlane(tid >> 6), r32 = lane & 31, h = lane >> 5, c = wv & 1, qsub = wv >> 1;
    const int t0 = qt * 128, tqw = t0 + 32 * qsub, tq = tqw + r32;
    const bf16_t* z = (const bf16_t*)(p->ws + OFF_Z);
    KVSrc src; src.k = (const char*)(z + (size_t)b * NS * ZW + C_KB + hd * 128); src.v = (const char*)(z + (size_t)b * NS * ZW + C_VB + hd * 128); src.kstride = ZW * 2; src.vstride = ZW * 2;
    const int kt1 = 2 * qt + 1;
    WaveAcc<128> a; acc_init(a);
    KVRing<2, 128> ring; ring.init(src, tid);
    const int nt = kt1 + 1;
    for (int j = 0; j < RING_AHEAD && j < nt; ++j) ring.issue((kt1 - j) * 64, j, lds);
    bf16x8 qf[5]; load_q(qf, z + ((size_t)b * NS + tq) * ZW + C_QB + hd * 128 + c * 64 + 8 * h, exp2f(-2.0f * (float)(hd + 1)), lane);
    asm volatile("" :: "v"(qf[0]), "v"(qf[1]), "v"(qf[2]), "v"(qf[3]));
    asm volatile(".p2align 8");
    for (int t = 0; t < nt; ++t) {
        const int kt = kt1 - t, buf = t & (RING_NB - 1);
        ring.wait_bar(nt - 1 - t);
        if (t + RING_AHEAD < nt) ring.issue((kt - RING_AHEAD) * 64, (t + RING_AHEAD) & (RING_NB - 1), lds);
        const unsigned char* kimg = ring.kimg(lds, buf, c); const unsigned char* vimg = ring.vimg(lds, buf);
#pragma unroll
        for (int sr = 0; sr < 2; ++sr) { const int sub = 1 - sr, key0 = kt * 64 + 32 * sub;
            if (key0 <= tqw + 31) {
                if (shadow && EXPER == 1) { }
                else attn_sub_auto<128>(qf, kimg, vimg, sub, key0, tqw, tq, h, 1 << 30, true, a, lane); } }
    }
    __syncthreads();
    const float lam_init = 0.8f - 0.6f * expf(-0.3f * (float)l);
    const float lam = ((const float*)p->ws)[CW_LAM + l];
    const float inv = 1.0f / swap_sum(a.l);
    float* ex = (float*)lds;
    if (c == 1) {
#pragma unroll
        for (int db = 0; db < 4; ++db)
#pragma unroll
            for (int r = 0; r < 16; ++r) ex[(qsub * 128 + db * 32 + crow(r, h)) * 32 + r32] = a.o[db][r] * inv;
    }
    __syncthreads();
    if (c == 0) {
        float ss = 0.f;
#pragma unroll
        for (int db = 0; db < 4; ++db)
#pragma unroll
            for (int r = 0; r < 16; ++r) { const float v = a.o[db][r] * inv - lam * ex[(qsub * 128 + db * 32 + crow(r, h)) * 32 + r32]; a.o[db][r] = v; ss += v * v; }
        ss = swap_sum(ss);
        const float rn = (1.0f - lam_init) / sqrtf(ss * (1.0f / 128.0f) + 1e-5f);
        const float* sg = p->diff_subln_g + (size_t)l * 128;
        bf16_t* orow = (shadow ? (bf16_t*)(p->ws + OFF_MSCR) : (bf16_t*)(p->ws + OFF_OABC) + (size_t)1 * NTOK * 512) + ((size_t)b * NS + tq) * 512 + hd * 128;
#pragma unroll
        for (int db = 0; db < 4; ++db)
#pragma unroll
            for (int rg = 0; rg < 4; ++rg) { const int d = db * 32 + 8 * rg + 4 * h; const f32x4 gv = *(const f32x4*)(sg + d);
                u32x2 w; w.x = cvt_pk_bf16(a.o[db][4 * rg] * rn * gv[0], a.o[db][4 * rg + 1] * rn * gv[1]); w.y = cvt_pk_bf16(a.o[db][4 * rg + 2] * rn * gv[2], a.o[db][4 * rg + 3] * rn * gv[3]);
                *(u32x2*)(orow + d) = w; }
    }
    __syncthreads();
}

#define AT_IMP   (AT_MISC)
#define AT_SELM  (AT_MISC + 34816)
__device__ __forceinline__ void attn_nsa_unit(KP p, int l, int b, int hkv, int qt, unsigned char* lds) {
    const int tid = hidden_tid(), lane = tid & 63, wv = __builtin_amdgcn_readfirstlane(tid >> 6), r32 = lane & 31, h = lane >> 5, g = wv & 3, qsub = wv >> 2;
    const int head = hkv * 4 + g, t0 = qt * 64, tqw = t0 + 32 * qsub, tq = tqw + r32;
    const bf16_t* z = (const bf16_t*)(p->ws + OFF_Z);
    bf16x8 qf[5]; load_q(qf, z + ((size_t)b * NS + tq) * ZW + C_QC + head * 64 + 8 * h, exp2f(-(float)(head + 1)), lane);
    float* imp = (float*)(lds + AT_IMP); unsigned* selm = (unsigned*)(lds + AT_SELM);
    KVRing<1, 64> ring;
    f32x16 ocmp[2];
    {
        const bf16_t* kvc = (const bf16_t*)(p->ws + OFF_KVC);
        KVSrc cs; cs.k = (const char*)(kvc + ((size_t)(0 * 16 + b) * 2 + hkv) * 128 * 64); cs.v = (const char*)(kvc + ((size_t)(1 * 16 + b) * 2 + hkv) * 128 * 64); cs.kstride = 128; cs.vstride = 128;
        ring.init(cs, tid); ring.issue(0, 0, lds); ring.issue(64, 1, lds);
        if (tid == 0) selm[64] = 0u;
        ring.wait_bar(0);
        f32x16 sc[4];
#pragma unroll
        for (int st = 0; st < 4; ++st) sc[st] = qk_sub(*(const bf16x8 (*)[4])&qf, ring.kimg(lds, st >> 1, 0), st & 1, lane);
        const int nvalid = tq >= 31 ? min(127, ((tq - 31) >> 4) + 1) : 0;
        float mx = -1e30f;
#pragma unroll
        for (int st = 0; st < 4; ++st)
#pragma unroll
            for (int r = 0; r < 16; ++r) { const int cidx = 32 * st + crow(r, h); const float v = cidx < nvalid ? sc[st][r] * LOG2E : -INFINITY; sc[st][r] = v; mx = fmaxf(mx, v); }
        mx = swap_max(mx);
        float ls = 0.f;
#pragma unroll
        for (int st = 0; st < 4; ++st)
#pragma unroll
            for (int r = 0; r < 16; ++r) { sc[st][r] = fast_exp2(sc[st][r] - mx); ls += sc[st][r]; }
        ls = swap_sum(ls); const float inv = ls > 0.f ? 1.0f / ls : 0.f;
        float Bv[4][4];
#pragma unroll
        for (int st = 0; st < 4; ++st)
#pragma unroll
            for (int r = 0; r < 16; ++r) sc[st][r] *= inv;
#pragma unroll
        for (int st = 0; st < 4; ++st)
#pragma unroll
            for (int g4 = 0; g4 < 4; ++g4) Bv[st][g4] = swap_other(sc[st][4 * g4 + 3], h);
#pragma unroll
        for (int st = 0; st < 4; ++st)
#pragma unroll
            for (int g4 = 0; g4 < 4; ++g4) {
                const float A = sc[st][4 * g4] + sc[st][4 * g4 + 1] + sc[st][4 * g4 + 2] + 0.5f * sc[st][4 * g4 + 3];
                const float prevlo = g4 > 0 ? Bv[st][g4 - 1] : (st > 0 ? Bv[st - 1][3] : 0.f);
                const float prev = h ? Bv[st][g4] : prevlo;
                imp[(g * 64 + qsub * 32 + r32) * 33 + 8 * st + 2 * g4 + h] = A + 0.5f * prev;
            }
#pragma unroll
        for (int d = 0; d < 2; ++d)
#pragma unroll
            for (int r = 0; r < 16; ++r) ocmp[d][r] = 0.f;
#pragma unroll
        for (int st = 0; st < 4; ++st) { VFrag<64> vf; v_read_all(vf, ring.vimg(lds, st >> 1), st & 1, lane); pv_sub<64>(sc[st], vf, ocmp); }
    }
    __syncthreads();
    const int cur = qt;
    for (int i = tid; i < 64 * 32; i += NTHREADS) { const int q = i >> 5, n = i & 31; imp[q * 33 + n] = (imp[q * 33 + n] + imp[(64 + q) * 33 + n]) + (imp[(128 + q) * 33 + n] + imp[(192 + q) * 33 + n]); }
    __syncthreads();
#pragma unroll 1
    for (int ps = 0; ps < 4; ++ps) {
        const int i = ps * NTHREADS + tid, q = i >> 5, n = i & 31;
        const bool forced = (n == 0) | (n == cur) | (n == cur - 1);
        const float kn = forced ? INFINITY : imp[q * 33 + n];
        int rank = 0;
#pragma unroll
        for (int m2 = 0; m2 < 32; ++m2) { const float km = __int_as_float(__builtin_amdgcn_ds_bpermute(((lane & 32) + m2) << 2, __float_as_int(kn)));
            rank += (m2 <= cur) && (m2 != n) && ((km > kn) || (km == kn && m2 < n)); }
        const bool sel = (n <= cur) && (rank < 16);
        const unsigned long long bal = __ballot(sel);
        if ((lane & 31) == 0) { const unsigned mk = (unsigned)(lane ? (bal >> 32) : bal); selm[q] = mk; atomicOr(&selm[64], mk); }
    }
    __syncthreads();
    const unsigned mymask = selm[qsub * 32 + r32]; unsigned um = __builtin_amdgcn_readfirstlane(selm[64]);
    WaveAcc<64> a; acc_init(a);
    {
        KVSrc src; src.k = (const char*)(z + (size_t)b * NS * ZW + C_KSL + hkv * 64); src.v = (const char*)(z + (size_t)b * NS * ZW + C_VSL + hkv * 64); src.kstride = ZW * 2; src.vstride = ZW * 2;
        ring.init(src, tid);
        unsigned m_issue = um; int nis = 0, ncp = 0; const int ntl = __popc(um);
        for (int j = 0; j < RING_AHEAD && m_issue; ++j) { const int kt = 31 - __clz((int)m_issue); m_issue &= ~(1u << kt); ring.issue(kt * 64, nis & (RING_NB - 1), lds); ++nis; }
    asm volatile(".p2align 8");
        while (um) {
            const int kt = 31 - __clz((int)um); um &= ~(1u << kt); const int buf = ncp & (RING_NB - 1);
            ring.wait_bar(nis - 1 - ncp);
            if (m_issue) { const int ktn = 31 - __clz((int)m_issue); m_issue &= ~(1u << ktn); ring.issue(ktn * 64, nis & (RING_NB - 1), lds); ++nis; }
            const bool lbit = (mymask >> kt) & 1u;
            if (__any(lbit)) {
                const unsigned char* kimg = ring.kimg(lds, buf, 0); const unsigned char* vimg = ring.vimg(lds, buf);
#pragma unroll
                for (int sr = 0; sr < 2; ++sr) { const int sub = 1 - sr, key0 = kt * 64 + 32 * sub;
                    if (key0 <= tqw + 31) attn_sub_auto<64>(qf, kimg, vimg, sub, key0, tqw, tq, h, 1 << 30, lbit, a, lane); }
            }
            ++ncp;
        }
        (void)ntl;
    }
    {
        const size_t tok = (size_t)b * NS + tq;
        const bf16_t* gp = z + tok * ZW + C_GN + head * 3;
        const float gc = bf2f(gp[0]), gs = bf2f(gp[1]) / swap_sum(a.l), gw = bf2f(gp[2]);
        const bf16_t* ow = (const bf16_t*)(p->ws + OFF_OWIN) + tok * 512 + head * 64;
        bf16_t* oc = (bf16_t*)(p->ws + OFF_OABC) + (size_t)2 * NTOK * 512 + tok * 512 + head * 64;
#pragma unroll
        for (int db = 0; db < 2; ++db)
#pragma unroll
            for (int rg = 0; rg < 4; ++rg) { const int d = db * 32 + 8 * rg + 4 * h; const u32x2 wv2 = *(const u32x2*)(ow + d);
                const float o0 = gc * ocmp[db][4 * rg] + gs * a.o[db][4 * rg] + gw * bflo(wv2.x), o1 = gc * ocmp[db][4 * rg + 1] + gs * a.o[db][4 * rg + 1] + gw * bfhi(wv2.x);
                const float o2 = gc * ocmp[db][4 * rg + 2] + gs * a.o[db][4 * rg + 2] + gw * bflo(wv2.y), o3 = gc * ocmp[db][4 * rg + 3] + gs * a.o[db][4 * rg + 3] + gw * bfhi(wv2.y);
                u32x2 w; w.x = cvt_pk_bf16(o0, o1); w.y = cvt_pk_bf16(o2, o3); *(u32x2*)(oc + d) = w; }
    }
    __syncthreads();
}

__device__ __forceinline__ void compress_unit(KP p, int l, int u, unsigned char* lds) {
    char* ws = p->ws;
    const int kv = u >> 4, rt = u & 15;
    GemmOperands g; g.Abase = ws + OFF_Z; g.kstride = ZW * 2; g.K = 2048; g.Bbase = ws + OFF_WC1 + ((size_t)(l * 2 + kv) * 256) * 2048 * 2;
GEMM_STAGE_IDS();
#pragma unroll
    for (int i = 0; i < 4; ++i) { const int row = rt * 256 + TILE_ROW(i), bh = row >> 7, b = bh >> 1, hk = bh & 1; int c = row & 127; c = c > 126 ? 126 : c;
        g.aoff[i] = (unsigned)((((size_t)b * NS + 16 * c) * ZW + (kv ? C_VCM : C_KCM) + hk * 64 + cS) * 2); } g.boff = (unsigned)((rS * 2048 + cS) * 2);
    f32x4 acc[2][2][4][2];
    gemm_unit(g, (bf16_t*)lds, acc);
    GEMM_LANE_IDS();
    const float* cb = (const float*)(ws + OFF_CBIAS) + (size_t)(l * 2 + kv) * 4 * 256; const float* cb1 = p->cmp_b1 + (l * 2 + kv) * 256;
#pragma unroll
    for (int bj = 0; bj < 2; ++bj)
#pragma unroll
        for (int n = 0; n < 2; ++n) { const int col = bj * 128 + wc * 32 + n * 16 + fq * 4; const f32x4 bv = (*(const f32x4*)(cb + col) + *(const f32x4*)(cb + 256 + col)) + (*(const f32x4*)(cb + 512 + col) + *(const f32x4*)(cb + 768 + col)) + *(const f32x4*)(cb1 + col);
#pragma unroll
            for (int ai = 0; ai < 2; ++ai)
#pragma unroll
                for (int m = 0; m < 4; ++m) { const int row = ai * 128 + wr * 64 + m * 16 + fr; f32x4 v = acc[ai][bj][m][n] + bv;
#pragma unroll
                    for (int j = 0; j < 4; ++j) { const float x = v[j]; v[j] = x * sigmoidf_(1.5957691216057308f * (x + 0.044715f * x * x * x)); }
                    u32x2 w; w.x = cvt_pk_bf16(v[0], v[1]); w.y = cvt_pk_bf16(v[2], v[3]); *(u32x2*)(lds + row * 528 + col * 2) = w; } }
    __syncthreads();
    {
        const bf16_t* w2 = (const bf16_t*)(ws + OFF_WC2) + (size_t)(l * 2 + kv) * 64 * 256;
        f32x4 c2[2][4];
#pragma unroll
        for (int mt = 0; mt < 2; ++mt)
#pragma unroll
            for (int nt = 0; nt < 4; ++nt) c2[mt][nt] = (f32x4){0.f, 0.f, 0.f, 0.f};
#pragma unroll
        for (int ks = 0; ks < 8; ++ks) {
            bf16x8 af[2], bfr[4];
#pragma unroll
            for (int mt = 0; mt < 2; ++mt) af[mt] = *(const bf16x8*)(lds + (wid * 32 + mt * 16 + fr) * 528 + (ks * 32 + fq * 8) * 2);
#pragma unroll
            for (int nt = 0; nt < 4; ++nt) bfr[nt] = *(const bf16x8*)(w2 + (size_t)(nt * 16 + fr) * 256 + ks * 32 + fq * 8);
#pragma unroll
            for (int mt = 0; mt < 2; ++mt)
#pragma unroll
                for (int nt = 0; nt < 4; ++nt) c2[mt][nt] = __builtin_amdgcn_mfma_f32_16x16x32_bf16(af[mt], bfr[nt], c2[mt][nt], 0, 0, 0);
        }
        bf16_t* kvc = (bf16_t*)(ws + OFF_KVC) + (size_t)kv * 16 * 2 * 128 * 64;
        const float* b2 = p->cmp_b2 + (l * 2 + kv) * 64;
#pragma unroll
        for (int mt = 0; mt < 2; ++mt)
#pragma unroll
            for (int nt = 0; nt < 4; ++nt)
#pragma unroll
                for (int r = 0; r < 4; ++r) { const int row = rt * 256 + wid * 32 + mt * 16 + 4 * fq + r, col = nt * 16 + fr;
                    kvc[(size_t)row * 64 + col] = f2bf(c2[mt][nt][r] + b2[col]); }
    }
    __syncthreads();
}

#define RT_HS    0
#define RT_LG    132096
#define RT_HIST  (RT_LG + 8448)
#ifndef REPN2
#define REPN2 1
#endif
__device__ __forceinline__ void phase_norm2_router(KP p, int l, unsigned char* lds) {
  for (int shadow = 0; shadow < REPN2; ++shadow) {
    char* ws = p->ws; const int tid = hidden_tid(), lane = tid & 63, wv = __builtin_amdgcn_readfirstlane(tid >> 6);
    const float* modl = (const float*)(ws + OFF_MOD) + (size_t)l * 16 * 6144; const float* g = p->norm2_g + (size_t)l * 1024;
    const bf16_t* xrb = (const bf16_t*)(ws + OFF_XR);
    float* LG = (float*)(lds + RT_LG); int* hist = (int*)(lds + RT_HIST); int* basep = hist + 32;
    unsigned* ctrl = (unsigned*)ws;
    const bf16_t* wrt = (const bf16_t*)(ws + OFF_WRT) + (size_t)l * 2 * 32 * 1024;
    for (int chunk = hidden_bid(); chunk < NTOK / 64; chunk += gridDim.x) {
        if (tid < 32) hist[tid] = 0;
        {
            const int rowa = chunk * 64 + wv * 8, b = rowa >> 11;
            f32x4 gg[4], sc[4], sh[4]; u32x2 xn[4];
#pragma unroll
            for (int j = 0; j < 4; ++j) { const int col = 256 * j + 4 * lane; gg[j] = *(const f32x4*)(g + col); sc[j] = *(const f32x4*)(modl + (size_t)b * 6144 + 4096 + col); sh[j] = *(const f32x4*)(modl + (size_t)b * 6144 + 3072 + col);
                xn[j] = *(const u32x2*)(xrb + (size_t)rowa * 1024 + col); }
            for (int i = 0; i < 8; ++i) {
                const int rl = wv * 8 + i, row = rowa + i;
                f32x4 v[4]; float ss = 0.f;
#pragma unroll
                for (int j = 0; j < 4; ++j) { v[j] = (f32x4){bflo(xn[j].x), bfhi(xn[j].x), bflo(xn[j].y), bfhi(xn[j].y)};
                    ss += v[j][0] * v[j][0] + v[j][1] * v[j][1] + v[j][2] * v[j][2] + v[j][3] * v[j][3]; }
                if (i + 1 < 8) {
#pragma unroll
                    for (int j = 0; j < 4; ++j) { const int col = 256 * j + 4 * lane; xn[j] = *(const u32x2*)(xrb + (size_t)(row + 1) * 1024 + col); } }
                ss = wave_sum(ss, lane); const float r = 1.0f / sqrtf(ss * (1.0f / 1024.0f) + 1e-5f);
#pragma unroll
                for (int j = 0; j < 4; ++j) { const int col = 256 * j + 4 * lane;
                    float o[4];
#pragma unroll
                    for (int q = 0; q < 4; ++q) o[q] = v[j][q] * r * gg[j][q] * (1.0f + sc[j][q]) + sh[j][q];
                    u32x2 w; w.x = cvt_pk_bf16(o[0], o[1]); w.y = cvt_pk_bf16(o[2], o[3]);
                    if (!shadow) *(unsigned*)((unsigned char*)(ws + OFF_H8) + (size_t)row * 1024 + col) = pk4_fp8(o[0], o[1], o[2], o[3]);
                    *(u32x2*)(lds + RT_HS + rl * 2064 + col * 2) = w; }
            }
        }
        __syncthreads();
        {
            const int mt = wv & 3, nt = wv >> 2, fr = lane & 15, fq = lane >> 4;
            f32x4 acc = (f32x4){0.f, 0.f, 0.f, 0.f};
            const bf16_t* wh = wrt + (size_t)(nt * 16 + fr) * 1024 + fq * 8; const bf16_t* wl = wh + 32 * 1024;
            const unsigned char* ap = lds + RT_HS + (mt * 16 + fr) * 2064 + fq * 16;
#pragma unroll 4
            for (int ks = 0; ks < 32; ++ks) { const bf16x8 a = *(const bf16x8*)(ap + ks * 64); const bf16x8 bh = *(const bf16x8*)(wh + ks * 32), bl = *(const bf16x8*)(wl + ks * 32);
                acc = __builtin_amdgcn_mfma_f32_16x16x32_bf16(a, bh, acc, 0, 0, 0); acc = __builtin_amdgcn_mfma_f32_16x16x32_bf16(a, bl, acc, 0, 0, 0); }
            const float rb = p->router_b[l * 32 + nt * 16 + fr];
#pragma unroll
            for (int r = 0; r < 4; ++r) LG[(mt * 16 + 4 * fq + r) * 33 + nt * 16 + fr] = acc[r] + rb;
        }
        __syncthreads();
        int se[4], sp[4]; float sg[4];
        if (tid < 64) {
            unsigned taken = 0u; float tv[4];
#pragma unroll
            for (int k = 0; k < 4; ++k) { float best = -INFINITY; int bi = 0;
#pragma unroll 4
                for (int e = 0; e < 32; ++e) { const float v = LG[tid * 33 + e]; if (!((taken >> e) & 1u) && v > best) { best = v; bi = e; } }
                taken |= 1u << bi; se[k] = bi; tv[k] = best; }
            float den = 0.f;
#pragma unroll
            for (int k = 0; k < 4; ++k) { sg[k] = __expf(tv[k] - tv[0]); den += sg[k]; }
#pragma unroll
            for (int k = 0; k < 4; ++k) { sg[k] /= den; sp[k] = atomicAdd(&hist[se[k]], 1); }
        }
        __syncthreads();
        if (tid < 32) { const int c = hist[tid]; basep[tid] = (c && !shadow) ? (int)atomicAdd(&ctrl[CW_ECNT(l, tid)], (unsigned)c) : 0; }
        __syncthreads();
        if (tid < 64 && !shadow) { const int tok = chunk * 64 + tid;
#pragma unroll
            for (int k = 0; k < 4; ++k) { const int pos = basep[se[k]] + sp[k];
                ((int*)(ws + OFF_TOKE))[tok * 4 + k] = se[k]; ((int*)(ws + OFF_TOKP))[tok * 4 + k] = pos; ((float*)(ws + OFF_TOKG))[tok * 4 + k] = sg[k];
                ((int*)(ws + OFF_BUCK))[(size_t)se[k] * NTOK + pos] = tok; } }
        __syncthreads();
    }
}
  __syncthreads(); }


__device__ __forceinline__ void phase_combine(KP p, int l, unsigned char* lds) {
    char* ws = p->ws; const int tid = hidden_tid(), lane = tid & 63, wv = tid >> 6;
    int* tbl = (int*)lds; moe_tables(p, l, tbl);
    bf16_t* xr = (bf16_t*)(ws + OFF_XR); const bf16_t* y = (const bf16_t*)(ws + OFF_Y); bf16_t* hb = (bf16_t*)(ws + OFF_HB);
    const bool last = (l + 1 == NLAYER);
    for (int gw = hidden_bid() * 8 + wv; gw < NTOK / 16; gw += gridDim.x * 8) {
        const int row0 = gw * 16, b = row0 >> 11;
        const float* modl = (const float*)(ws + OFF_MOD) + ((size_t)l * 16 + b) * 6144;
        const float* gn = last ? p->final_g : p->norm1_g + (size_t)(l + 1) * 1024;
        const float* modn = (const float*)(ws + OFF_MOD) + ((size_t)(last ? l : l + 1) * 16 + b) * 6144;
        f32x4 g2[4], gg[4], sc[4], sh[4];
#pragma unroll
        for (int j = 0; j < 4; ++j) { const int col = 256 * j + 4 * lane; g2[j] = *(const f32x4*)(modl + 5120 + col); gg[j] = *(const f32x4*)(gn + col);
            sc[j] = last ? (f32x4){0.f, 0.f, 0.f, 0.f} : *(const f32x4*)(modn + 1024 + col); sh[j] = last ? (f32x4){0.f, 0.f, 0.f, 0.f} : *(const f32x4*)(modn + col); }
        typedef int i32x4_ __attribute__((ext_vector_type(4)));
        i32x4_ te = *(const i32x4_*)((const int*)(ws + OFF_TOKE) + (size_t)row0 * 4), tp = *(const i32x4_*)((const int*)(ws + OFF_TOKP) + (size_t)row0 * 4);
        f32x4 tg = *(const f32x4*)((const float*)(ws + OFF_TOKG) + (size_t)row0 * 4);
        u32x2 xin[4]; u32x2 yin[4][4]; float gk[4];
        auto load_row = [&](int row, const i32x4_& e4, const i32x4_& p4, const f32x4& g4) {
#pragma unroll
            for (int k = 0; k < 4; ++k) { const bf16_t* yr = y + ((size_t)tbl[e4[k]] * 256 + p4[k]) * 1024; gk[k] = g4[k];
#pragma unroll
                for (int j = 0; j < 4; ++j) yin[k][j] = *(const u32x2*)(yr + 256 * j + 4 * lane); }
#pragma unroll
            for (int j = 0; j < 4; ++j) xin[j] = *(const u32x2*)(xr + (size_t)row * 1024 + 256 * j + 4 * lane);
        };
        load_row(row0, te, tp, tg);
        if (16 > 1) { te = *(const i32x4_*)((const int*)(ws + OFF_TOKE) + (size_t)(row0 + 1) * 4); tp = *(const i32x4_*)((const int*)(ws + OFF_TOKP) + (size_t)(row0 + 1) * 4); tg = *(const f32x4*)((const float*)(ws + OFF_TOKG) + (size_t)(row0 + 1) * 4); }
        for (int i = 0; i < 16; ++i) {
            const int row = row0 + i;
            f32x4 v[4]; float ss = 0.f;
#pragma unroll
            for (int j = 0; j < 4; ++j) { f32x4 m = (f32x4){0.f, 0.f, 0.f, 0.f};
#pragma unroll
                for (int k = 0; k < 4; ++k) { const u32x2 w = yin[k][j]; m[0] += gk[k] * bflo(w.x); m[1] += gk[k] * bfhi(w.x); m[2] += gk[k] * bflo(w.y); m[3] += gk[k] * bfhi(w.y); }
                v[j] = (f32x4){bflo(xin[j].x), bfhi(xin[j].x), bflo(xin[j].y), bfhi(xin[j].y)} + g2[j] * m;
                ss += v[j][0] * v[j][0] + v[j][1] * v[j][1] + v[j][2] * v[j][2] + v[j][3] * v[j][3]; }
            if (i + 1 < 16) { load_row(row + 1, te, tp, tg);
                if (i + 2 < 16) { te = *(const i32x4_*)((const int*)(ws + OFF_TOKE) + (size_t)(row + 2) * 4); tp = *(const i32x4_*)((const int*)(ws + OFF_TOKP) + (size_t)(row + 2) * 4); tg = *(const f32x4*)((const float*)(ws + OFF_TOKG) + (size_t)(row + 2) * 4); } }
            ss = wave_sum(ss, lane); const float r = 1.0f / sqrtf(ss * (1.0f / 1024.0f) + 1e-5f);
#pragma unroll
            for (int j = 0; j < 4; ++j) { const int col = 256 * j + 4 * lane;
                if (last) { *(f32x4*)(p->out + (size_t)row * 1024 + col) = v[j] * r * gg[j]; }
                else { u32x2 xw; xw.x = cvt_pk_bf16(v[j][0], v[j][1]); xw.y = cvt_pk_bf16(v[j][2], v[j][3]); *(u32x2*)(xr + (size_t)row * 1024 + col) = xw; float o[4];
#pragma unroll
                    for (int q = 0; q < 4; ++q) o[q] = v[j][q] * r * gg[j][q] * (1.0f + sc[j][q]) + sh[j][q];
#if INPROJ_FP8
                    *(unsigned*)((unsigned char*)hb + (size_t)row * 1024 + col) = pk4_fp8(o[0], o[1], o[2], o[3]); }
#else
                    u32x2 w; w.x = cvt_pk_bf16(o[0], o[1]); w.y = cvt_pk_bf16(o[2], o[3]); *(u32x2*)(hb + (size_t)row * 1024 + col) = w; }
#endif
            }
        }
    }
}

#ifndef SWA_IN_AT2
#define SWA_IN_AT2 1
#endif
#define LDS_QSLOT (LDS_BYTES - 64)
#define LDS_BARW  (LDS_BYTES - 16)
__device__ __forceinline__ int q_next(unsigned* ctr, unsigned char* lds) {
    __syncthreads();
    if (hidden_tid() == 0) *(int*)(lds + LDS_QSLOT) = (int)__hip_atomic_fetch_add(ctr, 1u, __ATOMIC_RELAXED, __HIP_MEMORY_SCOPE_AGENT);
    __syncthreads();
    return __builtin_amdgcn_readfirstlane(*(int*)(lds + LDS_QSLOT));
}
__device__ __forceinline__ void phase_at1(KP p, int lq, unsigned char* lds) {
    unsigned* ctrl = (unsigned*)p->ws; const int l = lq & 1;
#ifndef SUB
#define SUB -1
#endif
#ifndef DBLSUB
#define DBLSUB -1
#endif
#ifndef REP0
#define REP0 1
#endif
#ifndef REP1
#define REP1 1
#endif
#ifndef REP2
#define REP2 1
#endif
#ifndef REP3
#define REP3 1
#endif
#ifndef REP4
#define REP4 1
#endif
#define SUBON(k) ((SUB < 0 || SUB == (k)) && (lq < 2 || DBLSUB < 0 || DBLSUB == (k)))
    if (SUBON(0)) for (int rep = 0; rep < REP0; ++rep) for (;;) { const int u = q_next(ctrl + CW_QCTR(lq + 2 * rep, 0), lds); if (u >= 32) break; compress_unit(p, l, u, lds); }
    if (SUBON(1)) for (int rep = 0; rep < REP1; ++rep) for (;;) { const int u = q_next(ctrl + CW_QCTR(lq + 2 * rep, 1), lds); if (u >= 1024) break; attn_diff_unit(p, l, (u & 63) >> 2, u & 3, 15 - (u >> 6), lds, rep); if (COSCHED && rep == 0) xpose8_group(p, l, u, lds); }
    if (SUBON(2)) for (int rep = 0; rep < REP2; ++rep) for (;;) { const int u = q_next(ctrl + CW_QCTR(lq + 2 * rep, 2), lds); if (u >= 1024) break;
        attn_window_unit<false>(p, l, (u & 31) >> 1, u & 1, 31 - (u >> 5), 512, C_QC, C_KWN, C_VWN, (bf16_t*)(p->ws + OFF_OWIN), lds); if (COSCHED && rep == 0) xpose8_group(p, l, 1024 + u, lds); }
#if !SWA_IN_AT2
    if (SUBON(3)) for (int rep = 0; rep < REP3; ++rep) for (;;) { const int u = q_next(ctrl + CW_QCTR(lq + 2 * rep, 3), lds); if (u >= 1024) break;
        attn_window_unit<true>(p, l, (u & 31) >> 1, u & 1, 31 - (u >> 5), 128, C_QA, C_KA, C_VA, (bf16_t*)(p->ws + OFF_OABC), lds); if (COSCHED && rep == 0) xpose8_group(p, l, 2048 + u, lds); }
#endif
}
__device__ __forceinline__ void phase_at2(KP p, int lq, unsigned char* lds) {
    unsigned* ctrl = (unsigned*)p->ws; const int l = lq & 1;
    for (int rep = 0; rep < REP4; ++rep) for (;;) { const int u = q_next(ctrl + CW_QCTR(lq + 2 * rep, 4), lds); if (u >= 1024) break; attn_nsa_unit(p, l, (u & 31) >> 1, u & 1, 31 - (u >> 5), lds); if (COSCHED && INPROJ_FP8 && rep == 0 && lq == 0 && u < MISC_GROUPS) misc_group(p, u, lds); }
#if SWA_IN_AT2
    for (int rep = 0; rep < REP3; ++rep) for (;;) { const int u = q_next(ctrl + CW_QCTR(lq + 2 * rep, 3), lds); if (u >= 1024) break;
        attn_window_unit<true>(p, l, (u & 31) >> 1, u & 1, 31 - (u >> 5), 128, C_QA, C_KA, C_VA, (bf16_t*)(p->ws + OFF_OABC), lds); if (COSCHED && rep == 0) xpose8_group(p, l, 2048 + u, lds); }
#endif
}

#define NPHASE 20
__global__ void __launch_bounds__(NTHREADS, 2) mega(Params pv_unused) {
    KP p0 = (KP)__builtin_amdgcn_kernarg_segment_ptr();
    extern __shared__ __attribute__((aligned(16))) unsigned char lds0[];
    volatile LAS unsigned* st = (volatile LAS unsigned*)(lds0 + LDS_BARW);
    if (hidden_tid() == 0) { st[0] = 0u; st[1] = 0u; st[2] = 0u; st[3] = 0u; }
    __syncthreads();
    XcdBarrier bar = xcd_barrier_post((unsigned*)p0->ws, st);
    int ph = 0;
#ifndef DBL
#define DBL -1
#endif
    int qrep = 0; (void)qrep;
#define PHASE(body) { KP p = p0; asm volatile("" : "+s"(p)); unsigned char* lds = lds0; (void)lds; if (ph >= p->ph_lo && ph <= p->ph_hi) { body; if (ph < p->ph_hi) xcd_barrier(bar); } ++ph; }
#ifndef ONLY
#define ONLY -1
#endif
#ifndef DBLL
#define DBLL -1
#endif
    int lcur = -1; (void)lcur;
#define SEL(n, body) { if (ONLY < 0 || ONLY == (n)) { body; if (DBL == (n) && (DBLL < 0 || DBLL == lcur)) { xcd_barrier(bar); qrep = 2; body; qrep = 0; } } }
    PHASE(SEL(0, phase_prologue(p, lds)));
    PHASE(SEL(1, phase_norm_mod(p->x, p->norm1_g, (const float*)(p->ws + OFF_MOD), 0, 1024, (bf16_t*)(p->ws + OFF_HB))));
#pragma unroll
    for (int l = 0; l < NLAYER; ++l) { lcur = l;
        PHASE(SEL(2, phase_inproj(p, l, lds)));
        PHASE(SEL(3, phase_at1(p, l + qrep, lds)));
        PHASE(SEL(4, phase_at2(p, l + qrep, lds)));
        PHASE(SEL(5, phase_merge(p, l, lds)));
        PHASE(SEL(6, phase_outproj(p, l, lds)));
        PHASE(SEL(7, phase_norm2_router(p, l, lds)));
        PHASE(SEL(8, phase_moe1(p, l, lds)));
        PHASE(SEL(9, phase_moe2(p, l, lds)));
        PHASE(SEL(10, phase_combine(p, l, lds)));
    }
}

#ifndef MK_LAUNCHES
#define MK_LAUNCHES 1
#endif
extern "C" void kernel_launch(void* const* d_in, const int* in_sizes, int n_in, void* d_out, int out_size, void* d_ws, size_t ws_size, hipStream_t stream) {
    if (ws_size < WS_NEED) { fprintf(stderr, "workspace too small: %zu < %zu\n", ws_size, (size_t)WS_NEED); return; }
    static bool attr_done = false;
    if (!attr_done) { hipFuncSetAttribute((const void*)mega, hipFuncAttributeMaxDynamicSharedMemorySize, LDS_BYTES); attr_done = true; }
    Params p{};
    const float** f = (const float**)&p;
    for (int i = 0; i < 25; ++i) f[i] = (const float*)d_in[i];
    p.out = (float*)d_out; p.ws = (char*)d_ws;
    hipMemsetAsync(d_ws, 0, SZ_CTRL, stream);
    int dev = 0, cus = 0; hipGetDevice(&dev); hipDeviceGetAttribute(&cus, hipDeviceAttributeMultiprocessorCount, dev);
    const int grid = cus > 0 ? cus : 256;
#if MK_LAUNCHES == 1
    p.ph_lo = 0; p.ph_hi = NPHASE - 1;
    hipLaunchKernelGGL(mega, dim3(grid), dim3(NTHREADS), LDS_BYTES, stream, p);
#else
    for (int k = 0; k < NPHASE; ++k) { p.ph_lo = k; p.ph_hi = k; hipLaunchKernelGGL(mega, dim3(grid), dim3(NTHREADS), LDS_BYTES, stream, p); }
#endif
}
```

```cpp
#include <hip/hip_runtime.h>
#include <stdint.h>
#include <stdio.h>

#define NB      16
#define NS      2048
#define NTOK    (NB * NS)
#define DM      1024
#define NLAYER  2
#define ZW      6912
#define INW     6680
#define C_QA   0
#define C_KA   512
#define C_VA   640
#define C_QB   768
#define C_KB   1280
#define C_VB   1792
#define C_QC   2304
#define C_KCM  2816
#define C_VCM  2944
#define C_KSL  3072
#define C_VSL  3200
#define C_KWN  3328
#define C_VWN  3456
#define C_GM   3584
#define C_GN   6656
#define NEXP   32
#define PMAX   (NTOK * 4 + NEXP * 256)
#define NCMP   127

typedef unsigned short bf16_t;
typedef short bf16x8 __attribute__((ext_vector_type(8)));
typedef short bf16x4 __attribute__((ext_vector_type(4)));
typedef float f32x4 __attribute__((ext_vector_type(4)));
typedef float f32x2 __attribute__((ext_vector_type(2)));
typedef float f32x16 __attribute__((ext_vector_type(16)));
typedef unsigned u32x4 __attribute__((ext_vector_type(4)));
typedef unsigned u32x2 __attribute__((ext_vector_type(2)));

#define LAS __attribute__((address_space(3)))
#define NTHREADS 512
#define LDS_BYTES (160 * 1024)

__device__ __forceinline__ unsigned cvt_pk_bf16(float lo, float hi) { unsigned r; asm volatile("v_cvt_pk_bf16_f32 %0, %1, %2" : "=v"(r) : "v"(lo), "v"(hi)); return r; }
__device__ __forceinline__ bf16_t f2bf(float f) { return (bf16_t)(cvt_pk_bf16(f, 0.f) & 0xffffu); }
__device__ __forceinline__ float bf2f(bf16_t b) { return __uint_as_float(((unsigned)b) << 16); }
__device__ __forceinline__ float bflo(unsigned w) { return __uint_as_float(w << 16); }
__device__ __forceinline__ float bfhi(unsigned w) { return __uint_as_float(w & 0xffff0000u); }
#define LOG2E 1.4426950408889634f
__device__ __forceinline__ float fast_exp2(float x) { return __builtin_amdgcn_exp2f(x); }
__device__ __forceinline__ float fast_rcp(float x) { return __builtin_amdgcn_rcpf(x); }
__device__ __forceinline__ float sigmoidf_(float x) { return fast_rcp(1.0f + fast_exp2(-1.4426950408889634f * x)); }

__device__ __forceinline__ unsigned hidden_bid() { unsigned b = blockIdx.x; asm volatile("" : "+s"(b)); return b; }
__device__ __forceinline__ int hidden_tid() { int t = threadIdx.x; asm volatile("" : "+v"(t)); return t; }

#define XB_TMO      128
#define XB_XCNT(j)  (256  + 64 * (j))
#define XB_XSUB(j)  (1280 + 64 * (j))
#define XB_XGEN(j)  (2304 + 64 * (j))
#define XB_TOP      3328
#define XB_TOPGEN   3392
#define XCD_BAR_WORDS 3456
#define XB_SPIN_CAP (1u << 24)

__device__ __forceinline__ unsigned xb_ld(unsigned* p)              { return __hip_atomic_load(p, __ATOMIC_RELAXED, __HIP_MEMORY_SCOPE_AGENT); }
__device__ __forceinline__ unsigned xb_add(unsigned* p, unsigned v) { return __hip_atomic_fetch_add(p, v, __ATOMIC_RELAXED, __HIP_MEMORY_SCOPE_AGENT); }
__device__ __forceinline__ unsigned xb_xcc_id() { return (unsigned)__builtin_amdgcn_s_getreg((3 << 11) | 20) & 0xFu; }
#define XB_SPIN(cond, bar) do { unsigned _sp = 0; while (cond) { __builtin_amdgcn_s_sleep(1); \
    if ((++_sp & 255u) == 0u) { if (xb_ld(&(bar)[XB_TMO])) break; if (_sp > XB_SPIN_CAP) { atomicAdd(&(bar)[XB_TMO], 1u); break; } } } } while (0)

struct XcdBarrier { unsigned* bar; unsigned x; volatile LAS unsigned* st; };

__device__ __forceinline__ XcdBarrier xcd_barrier_post(unsigned* bar, volatile LAS unsigned* st) {
    XcdBarrier b; b.bar = bar; b.x = xb_xcc_id(); b.st = st;
    if (hidden_tid() == 0) (void)xb_add(&bar[XB_XCNT(b.x)], 1u);
    return b;
}
__device__ __forceinline__ void xcd_barrier_complete(unsigned* bar, unsigned x, unsigned& nloc, unsigned& nx) {
    const unsigned G = gridDim.x * gridDim.y * gridDim.z;
    unsigned sum, cnt, mine, sp = 0u;
    for (;;) {
        sum = 0u; cnt = 0u; mine = 0u;
#pragma unroll
        for (unsigned j = 0; j < 16; ++j) { const unsigned c = xb_ld(&bar[XB_XCNT(j)]); sum += c; cnt += (c > 0u) ? 1u : 0u; mine = (j == x) ? c : mine; }
        if (sum == G) break;
        __builtin_amdgcn_s_sleep(1);
        if ((++sp & 255u) == 0u) { if (xb_ld(&bar[XB_TMO])) break; if (sp > XB_SPIN_CAP) { atomicAdd(&bar[XB_TMO], 1u); break; } }
    }
    nloc = mine > 0u ? mine : 1u; nx = cnt > 0u ? cnt : 1u;
}
__device__ __forceinline__ void xcd_barrier(const XcdBarrier& b) {
    asm volatile("s_waitcnt vmcnt(0)" ::: "memory");
    __syncthreads();
    if (hidden_tid() == 0) {
        unsigned* bar = b.bar;
        __builtin_amdgcn_s_waitcnt(0);
        unsigned nloc = b.st[0], nx = b.st[1];
        if (nloc == 0u) { xcd_barrier_complete(bar, b.x, nloc, nx); b.st[0] = nloc; b.st[1] = nx; }
        const unsigned old = xb_add(&bar[XB_XSUB(b.x)], 1u);
        const unsigned gen = old / nloc;
        if (old + 1u == (gen + 1u) * nloc) {
            __builtin_amdgcn_fence(__ATOMIC_RELEASE, "agent");
            asm volatile("s_waitcnt vmcnt(0)" ::: "memory");
            const unsigned og = xb_add(&bar[XB_TOP], 1u);
            const unsigned tg = og / nx;
            if (og + 1u == (tg + 1u) * nx) xb_add(&bar[XB_TOPGEN], 1u);
            else XB_SPIN(xb_ld(&bar[XB_TOPGEN]) == tg, bar);
            __builtin_amdgcn_fence(__ATOMIC_ACQUIRE, "agent");
            xb_add(&bar[XB_XGEN(b.x)], 1u);
            asm volatile("s_waitcnt vmcnt(0)" ::: "memory");
        } else {
            XB_SPIN(xb_ld(&bar[XB_XGEN(b.x)]) == gen, bar);
            __builtin_amdgcn_fence(__ATOMIC_ACQUIRE, "agent");
            asm volatile("s_waitcnt vmcnt(0)" ::: "memory");
        }
    }
    __syncthreads();
}

constexpr int BM = 256, BK = 64, HALF = 128, HT = HALF * BK;

__device__ __forceinline__ int lds_byte(int r, int c) { int st = (r >> 4) * 2 + (c >> 5), rr = r & 15, cc = c & 31, ob = rr * 64 + cc * 2; return st * 1024 + (ob ^ (((ob >> 9) & 1) << 5)); }
__device__ __forceinline__ void stage_rc(int b, int& R, int& C) { int st = b / 1024, sb = b % 1024, swz = sb ^ (((sb >> 9) & 1) << 5); R = (st >> 1) * 16 + swz / 64; C = (st & 1) * 32 + (swz % 64) / 2; }

struct GemmOperands {
    const char* Abase; unsigned aoff[4]; unsigned kstride;
    const char* Bbase; unsigned boff; int K;
};

__device__ __forceinline__ void gemm_unit(const GemmOperands& g, bf16_t* shm, f32x4 (&acc)[2][2][4][2]) {
#define SA(b,h) (shm + ((b) * 2 + (h)) * HT)
#define SB(b,h) (shm + (4 + (b) * 2 + (h)) * HT)
#define STAGE_A(T, P, hf, kt) do { const char* _ub = g.Abase + (size_t)(kt) * g.kstride; \
    _Pragma("unroll") for (int _i = 0; _i < 2; ++_i) { const int _b = (T) * 16 + _i * 8192; \
      __builtin_amdgcn_global_load_lds((const unsigned*)(_ub + g.aoff[(hf) * 2 + _i]), (unsigned*)((char*)(P) + _b), 16, 0, 0); } } while (0)
#define STAGE_B(T, P, hf, kt) do { \
    _Pragma("unroll") for (int _i = 0; _i < 2; ++_i) { const int _b = (T) * 16 + _i * 8192; \
      const char* _ub = g.Bbase + (size_t)(kt) * (BK * 2) + (size_t)((hf) * 128 + _i * 64) * (size_t)(g.K * 2); \
      __builtin_amdgcn_global_load_lds((const unsigned*)(_ub + g.boff), (unsigned*)((char*)(P) + _b), 16, 0, 0); } } while (0)
#define LDA(dst, b, h) _Pragma("unroll") for (int m = 0; m < 4; ++m) _Pragma("unroll") for (int k = 0; k < 2; ++k) \
    dst[m][k] = *reinterpret_cast<const bf16x8*>((char*)SA(b, h) + lds_byte(wr * 64 + m * 16 + fr, k * 32 + fq * 8))
#define LDB(dst, b, h) _Pragma("unroll") for (int n = 0; n < 2; ++n) _Pragma("unroll") for (int k = 0; k < 2; ++k) \
    dst[n][k] = *reinterpret_cast<const bf16x8*>((char*)SB(b, h) + lds_byte(wc * 32 + n * 16 + fr, k * 32 + fq * 8))
#define MMA(ai, bj, At_, Bt_) do { __builtin_amdgcn_s_setprio(1); \
    _Pragma("unroll") for (int m = 0; m < 4; ++m) _Pragma("unroll") for (int n = 0; n < 2; ++n) _Pragma("unroll") for (int k = 0; k < 2; ++k) \
      acc[ai][bj][m][n] = __builtin_amdgcn_mfma_f32_16x16x32_bf16(Bt_[n][k], At_[m][k], acc[ai][bj][m][n], 0, 0, 0); \
    __builtin_amdgcn_s_setprio(0); } while (0)
#define WAIT_V(n) asm volatile("s_waitcnt vmcnt(" #n ")" ::: "memory")
#define WAIT_L(n) asm volatile("s_waitcnt lgkmcnt(" #n ")" ::: "memory")
#define BAR __builtin_amdgcn_s_barrier()
#define SCHED __builtin_amdgcn_sched_barrier(0)
    int tid = threadIdx.x; asm volatile("" : "+v"(tid));
    int wid = tid >> 6, lane = tid & 63, wr = wid >> 2, wc = wid & 3, fr = lane & 15, fq = lane >> 4;
#pragma unroll
    for (int a = 0; a < 2; ++a)
#pragma unroll
        for (int b = 0; b < 2; ++b)
#pragma unroll
            for (int m = 0; m < 4; ++m)
#pragma unroll
                for (int n = 0; n < 2; ++n) acc[a][b][m][n] = (f32x4){0.f, 0.f, 0.f, 0.f};
    bf16x8 At[4][2], B0[2][2], B1[2][2];
    const int nt = g.K / BK;
    STAGE_B(tid, SB(0, 0), 0, 0); STAGE_A(tid, SA(0, 0), 0, 0);
    STAGE_B(tid, SB(0, 1), 1, 0); STAGE_A(tid, SA(0, 1), 1, 0);
    if (wr == 1) BAR;
    WAIT_V(4); BAR;
    STAGE_B(tid, SB(1, 0), 0, 1); STAGE_A(tid, SA(1, 0), 0, 1); STAGE_B(tid, SB(1, 1), 1, 1);
    WAIT_V(6); BAR;
    for (int t = 0; t < nt - 2; t += 2) {
        LDB(B0, 0, 0); SCHED; LDA(At, 0, 0); STAGE_A(tid, SA(1, 1), 1, t + 1);
        WAIT_L(8); BAR; WAIT_L(0); MMA(0, 0, At, B0); BAR; SCHED;
        LDB(B1, 0, 1); STAGE_B(tid, SB(0, 0), 0, t + 2);
        BAR; WAIT_L(0); MMA(0, 1, At, B1); BAR;
        LDA(At, 0, 1); STAGE_A(tid, SA(0, 0), 0, t + 2);
        BAR; WAIT_L(0); MMA(1, 0, At, B0); BAR; SCHED;
        STAGE_B(tid, SB(0, 1), 1, t + 2);
        WAIT_V(6); BAR; MMA(1, 1, At, B1); BAR;
        LDB(B0, 1, 0); SCHED; LDA(At, 1, 0); STAGE_A(tid, SA(0, 1), 1, t + 2);
        WAIT_L(8); BAR; WAIT_L(0); MMA(0, 0, At, B0); BAR; SCHED;
        LDB(B1, 1, 1); STAGE_B(tid, SB(1, 0), 0, t + 3);
        BAR; WAIT_L(0); MMA(0, 1, At, B1); BAR;
        LDA(At, 1, 1); STAGE_A(tid, SA(1, 0), 0, t + 3);
        BAR; WAIT_L(0); MMA(1, 0, At, B0); BAR; SCHED;
        STAGE_B(tid, SB(1, 1), 1, t + 3);
        WAIT_V(6); BAR; MMA(1, 1, At, B1); BAR;
    }
    { LDB(B0, 0, 0); WAIT_V(0); LDA(At, 0, 0); STAGE_A(tid, SA(1, 1), 1, nt - 1);
      BAR; WAIT_L(0); MMA(0, 0, At, B0); BAR;
      LDB(B1, 0, 1); BAR; WAIT_L(0); MMA(0, 1, At, B1); BAR;
      LDA(At, 0, 1); WAIT_V(4); BAR; WAIT_L(0); MMA(1, 0, At, B0); MMA(1, 1, At, B1); BAR; }
    { LDB(B0, 1, 0); LDA(At, 1, 0); WAIT_V(2); BAR; WAIT_L(0); MMA(0, 0, At, B0); BAR;
      LDB(B1, 1, 1); WAIT_V(0); BAR; WAIT_L(0); MMA(0, 1, At, B1); BAR;
      LDA(At, 1, 1); BAR; WAIT_L(0); MMA(1, 0, At, B0); MMA(1, 1, At, B1); BAR; }
    if (wr == 0) BAR;
#undef SA
#undef SB
}


struct GDesc { const char* A; const char* B; unsigned aoff[4]; };
typedef int i32x8 __attribute__((ext_vector_type(8)));
typedef int i32x4 __attribute__((ext_vector_type(4)));
template <class S, bool FP8 = false, int SCA = 0x7f7f7f7f, int SCB = 0x7f7f7f7f>
__device__ __forceinline__ void gemm_stream(S& s, const int K, const unsigned kstrideA, unsigned char* lds_) {
    const int rowbytes = FP8 ? K : 2 * K;
    bf16_t* shm = (bf16_t*)lds_;
#define SA(b,h) (shm + ((b) * 2 + (h)) * HT)
#define SB(b,h) (shm + (4 + (b) * 2 + (h)) * HT)
#define UNIPTR(ptr) ({ const unsigned long long _u = (unsigned long long)(ptr); (const char*)(((unsigned long long)(unsigned)__builtin_amdgcn_readfirstlane((int)(_u >> 32)) << 32) | (unsigned)__builtin_amdgcn_readfirstlane((int)_u)); })
#define XSTAGE_A(P, hf, kt) do { const char* _ub = UNIPTR(d.A + (size_t)(kt) * kstrideA); \
    _Pragma("unroll") for (int _i = 0; _i < 2; ++_i) { const int _b = tid * 16 + _i * 8192; \
      unsigned _o = d.aoff[(hf) * 2 + _i]; asm volatile("" : "+v"(_o)); \
      __builtin_amdgcn_global_load_lds((const unsigned*)(_ub + _o), (unsigned*)((char*)(P) + _b), 16, 0, 0); } } while (0)
#define XSTAGE_B(P, hf, kt) do { \
    _Pragma("unroll") for (int _i = 0; _i < 2; ++_i) { const int _b = tid * 16 + _i * 8192; \
      const char* _ub = UNIPTR(d.B + (size_t)(kt) * (BK * 2) + (size_t)((hf) * 128 + _i * 64) * (size_t)rowbytes); \
      unsigned _o = boff; asm volatile("" : "+v"(_o)); \
      __builtin_amdgcn_global_load_lds((const unsigned*)(_ub + _o), (unsigned*)((char*)(P) + _b), 16, 0, 0); } } while (0)
    int tid = threadIdx.x; asm volatile("" : "+v"(tid));
    int wid = tid >> 6, lane = tid & 63, wr = wid >> 2, wc = wid & 3, fr = lane & 15, fq = lane >> 4;
    unsigned boff; { int rS, cS; stage_rc(tid * 16, rS, cS); const int rho = rS & 31, i = rho & 15; const int rP = (rS & ~31) + 8 * (i >> 2) + 4 * (rho >> 4) + (i & 3); boff = (unsigned)(rP * rowbytes + cS * 2); }
    const int nt = rowbytes / (BK * 2);
    GDesc d;
    if (!s.first(d)) return;
    f32x4 acc[2][2][4][2];
    if (S::BIAS_INIT) { s.load_bias_first(); s.init_acc(acc); }
    else
#pragma unroll
    for (int a = 0; a < 2; ++a)
#pragma unroll
        for (int b = 0; b < 2; ++b)
#pragma unroll
            for (int m = 0; m < 4; ++m)
#pragma unroll
                for (int n = 0; n < 2; ++n) acc[a][b][m][n] = (f32x4){0.f, 0.f, 0.f, 0.f};
    int sca_ = SCA, scb_ = SCB; asm volatile("" : "+v"(sca_), "+v"(scb_));
    struct Frag { bf16x8 f2[2]; };
    Frag At[4], B0[2], B1[2];
#undef LDA
#undef LDB
#undef MMA
#define LDA(dst, b, h) _Pragma("unroll") for (int m = 0; m < 4; ++m) _Pragma("unroll") for (int k = 0; k < 2; ++k) \
    dst[m].f2[k] = *reinterpret_cast<const bf16x8*>((char*)SA(b, h) + lds_byte(wr * 64 + m * 16 + fr, k * 32 + fq * 8))
#define LDB(dst, b, h) _Pragma("unroll") for (int n = 0; n < 2; ++n) _Pragma("unroll") for (int k = 0; k < 2; ++k) \
    dst[n].f2[k] = *reinterpret_cast<const bf16x8*>((char*)SB(b, h) + lds_byte(wc * 32 + n * 16 + fr, k * 32 + fq * 8))
#define MMA(ai, bj, At_, Bt_) do { __builtin_amdgcn_s_setprio(1); \
    _Pragma("unroll") for (int m = 0; m < 4; ++m) _Pragma("unroll") for (int n = 0; n < 2; ++n) { \
      if (FP8) asm volatile("v_mfma_scale_f32_16x16x128_f8f6f4 %0, %1, %2, %0, %3, %4 op_sel_hi:[0,0,0]" : "+v"(acc[ai][bj][m][n]) : "v"(__builtin_bit_cast(i32x8, Bt_[n])), "v"(__builtin_bit_cast(i32x8, At_[m])), "v"(scb_), "v"(sca_)); \
      else { _Pragma("unroll") for (int k = 0; k < 2; ++k) acc[ai][bj][m][n] = __builtin_amdgcn_mfma_f32_16x16x32_bf16(Bt_[n].f2[k], At_[m].f2[k], acc[ai][bj][m][n], 0, 0, 0); } } \
    __builtin_amdgcn_s_setprio(0); } while (0)
    XSTAGE_B(SB(0, 0), 0, 0); XSTAGE_B(SB(0, 1), 1, 0); XSTAGE_A(SA(0, 0), 0, 0); XSTAGE_A(SA(0, 1), 1, 0);
    if (wr == 1) BAR;
    WAIT_V(2); BAR;
    XSTAGE_B(SB(1, 0), 0, 1); XSTAGE_A(SA(1, 0), 0, 1); XSTAGE_B(SB(1, 1), 1, 1);
    WAIT_V(6); BAR;
    asm volatile(".p2align 8");
    for (;;) {
        bool has_next = false;
        for (int t = 0; t < nt; t += 2) {
            if (t == nt - 2) s.prefetch();
            LDB(B0, 0, 0); LDB(B1, 0, 1); SCHED; LDA(At, 0, 0); XSTAGE_A(SA(1, 1), 1, t + 1);
            WAIT_V(8); WAIT_L(0); BAR; MMA(0, 0, At, B0); MMA(0, 1, At, B1); BAR; SCHED;
            int ks = t + 2;
            if (t == nt - 2) { has_next = s.next(d); ks = 0; }
            LDA(At, 0, 1); XSTAGE_B(SB(0, 0), 0, ks); XSTAGE_B(SB(0, 1), 1, ks); XSTAGE_A(SA(0, 0), 0, ks);
            WAIT_V(8); WAIT_L(0); BAR; MMA(1, 0, At, B0); MMA(1, 1, At, B1); BAR; SCHED;
            LDB(B0, 1, 0); LDB(B1, 1, 1); SCHED; LDA(At, 1, 0); XSTAGE_A(SA(0, 1), 1, ks);
            WAIT_V(8); WAIT_L(0); BAR; MMA(0, 0, At, B0); MMA(0, 1, At, B1); BAR; SCHED;
            LDA(At, 1, 1); XSTAGE_B(SB(1, 0), 0, ks + 1); XSTAGE_B(SB(1, 1), 1, ks + 1); XSTAGE_A(SA(1, 0), 0, ks + 1);
            WAIT_V(8); WAIT_L(0); BAR; MMA(1, 0, At, B0); MMA(1, 1, At, B1); BAR; SCHED;
        }
        if (wr == 0) BAR;
        if (FP8) asm volatile("s_nop 15\n\ts_nop 15" ::: "memory");
        s.hn = has_next;
        s.epilogue(acc);
        if (!has_next) break;
        const bool zr = s.zero_after();
        s.advance();
        if (S::BIAS_INIT) s.init_acc(acc);
        else if (zr)
#pragma unroll
        for (int a = 0; a < 2; ++a)
#pragma unroll
            for (int b = 0; b < 2; ++b)
#pragma unroll
                for (int m = 0; m < 4; ++m)
#pragma unroll
                    for (int n = 0; n < 2; ++n) acc[a][b][m][n] = (f32x4){0.f, 0.f, 0.f, 0.f};
        if (wr == 1) BAR;
    }
    WAIT_V(0);
    BAR;
#undef SA
#undef SB
#undef XSTAGE_A
#undef XSTAGE_B
}

#define AL4K(x) (((size_t)(x) + 4095) & ~(size_t)4095)
constexpr size_t SZ_CTRL   = 1u << 16;
constexpr size_t OFF_MOD   = SZ_CTRL;
constexpr size_t OFF_CBIAS = OFF_MOD   + AL4K(2 * 16 * 6144 * 4);
constexpr size_t OFF_BIN   = OFF_CBIAS + AL4K(2 * 2 * 4 * 256 * 4);
constexpr size_t OFF_B1P   = OFF_BIN   + AL4K(2 * ZW * 4);
constexpr size_t OFF_WRT   = OFF_B1P   + AL4K(2 * 32 * 2048 * 4);
constexpr size_t OFF_WIN   = OFF_WRT   + AL4K(2 * 2 * 32 * 1024 * 2);
constexpr size_t OFF_WBR   = OFF_WIN   + AL4K((size_t)2 * ZW * 1024 * 2);
constexpr size_t OFF_WOUT  = OFF_WBR   + AL4K((size_t)2 * 3 * 1024 * 512 * 2);
constexpr size_t OFF_W1    = OFF_WOUT  + AL4K((size_t)2 * 1024 * 1024 * 2);
constexpr size_t OFF_W2    = OFF_W1    + AL4K((size_t)2 * 32 * 2048 * 1024 * 2);
constexpr size_t OFF_WC1   = OFF_W2    + AL4K((size_t)2 * 32 * 1024 * 1024 * 2);
constexpr size_t OFF_WC2   = OFF_WC1   + AL4K((size_t)2 * 2 * 256 * 2048 * 2);
constexpr size_t OFF_XR    = OFF_WC2   + AL4K((size_t)2 * 2 * 64 * 256 * 2);
constexpr size_t OFF_HB    = OFF_XR    + AL4K((size_t)NTOK * 1024 * 4);
constexpr size_t OFF_Z     = OFF_HB    + AL4K((size_t)NTOK * 1024 * 2);
constexpr size_t OFF_OABC  = OFF_Z     + AL4K((size_t)NTOK * ZW * 2);
constexpr size_t OFF_OWIN  = OFF_OABC  + AL4K((size_t)3 * NTOK * 512 * 2);
constexpr size_t OFF_KVC   = OFF_OWIN  + AL4K((size_t)NTOK * 512 * 2);
constexpr size_t OFF_MERGED= OFF_KVC   + AL4K((size_t)2 * 16 * 2 * 128 * 64 * 2);
constexpr size_t OFF_MSCR  = OFF_MERGED+ AL4K((size_t)NTOK * 1024 * 2);
constexpr size_t OFF_TOKE  = OFF_MSCR  + AL4K((size_t)256 * 32 * 512 * 16);
constexpr size_t OFF_TOKP  = OFF_TOKE  + AL4K((size_t)NTOK * 4 * 4);
constexpr size_t OFF_TOKG  = OFF_TOKP  + AL4K((size_t)NTOK * 4 * 4);
constexpr size_t OFF_BUCK  = OFF_TOKG  + AL4K((size_t)NTOK * 4 * 4);
constexpr size_t OFF_SELM  = OFF_BUCK  + AL4K((size_t)32 * NTOK * 4);
constexpr size_t OFF_HID   = OFF_SELM  + AL4K((size_t)16 * 2 * 2048 * 4);
constexpr size_t OFF_DELTA = OFF_MSCR;
constexpr size_t OFF_H8    = OFF_HID + AL4K((size_t)PMAX * 1024);
constexpr size_t OFF_Y     = OFF_Z;
constexpr size_t WS_NEED   = OFF_HID   + AL4K((size_t)PMAX * 1024 * 2);
static_assert((size_t)PMAX * 1024 * 2 <= (size_t)NTOK * ZW * 2, "y overlay must fit in z");

#define CW_QCTR(l, q)  (4096 + ((l) * 8 + (q)) * 64)
#define CW_ECNT(l, e)  (8192 + ((l) * 32 + (e)) * 64)
#define CW_LAM         6400

struct Params {
    const float *x, *c, *mod_w, *mod_b, *norm1_g, *norm2_g, *w_in, *b_in, *sinks, *diff_lambda, *diff_subln_g, *cmp_pos, *cmp_w1, *cmp_b1, *cmp_w2, *cmp_b2,
                *w_branch, *w_out, *router_w, *router_b, *exp_w1, *exp_b1, *exp_w2, *exp_b2, *final_g;
    float* out; char* ws; int ph_lo, ph_hi;
};
typedef const Params __attribute__((address_space(4)))* KP;

#ifndef INPROJ_FP8
#define INPROJ_FP8 1
#endif
__device__ __forceinline__ int map_col(int map, int nd) {
    if (map == 1) return nd < 3584 ? nd : (nd < 6656 ? nd + 24 : (nd < 6680 ? nd - 3072 : -1));
    if (map == 2) { const int pn = nd >> 8, r = nd & 255; return r < 128 ? pn * 128 + r : 1024 + pn * 128 + (r - 128); }
    return nd;
}
__device__ __forceinline__ void xpose_load(const float* __restrict__ src, int Nsrc, int k0, int nd0, int map, int ntl, f32x4 (&v)[8], int t) {
    const int n4 = t & 15, kp = t >> 4;
    bool ok[4];
#pragma unroll
    for (int j = 0; j < 4; ++j) { const int ns0 = j < ntl ? map_col(map, nd0 + 64 * j + 4 * n4) : -1; ok[j] = ns0 >= 0; const int nsc = ok[j] ? ns0 : 0;
        v[2 * j] = *(const f32x4*)(src + (size_t)(k0 + 2 * kp) * Nsrc + nsc); v[2 * j + 1] = *(const f32x4*)(src + (size_t)(k0 + 2 * kp + 1) * Nsrc + nsc); }
    __builtin_amdgcn_sched_barrier(0);
    if (map != 0) {
#pragma unroll
        for (int j = 0; j < 4; ++j) if (!ok[j]) { v[2 * j] = (f32x4){0.f, 0.f, 0.f, 0.f}; v[2 * j + 1] = v[2 * j]; } }
}
__device__ __forceinline__ void xpose_store(const f32x4 (&v)[8], bf16_t* __restrict__ dst, int Kdst, int k0, int nd0, int ntl, unsigned char* lds, int t) {
    const int n4 = t & 15, kp = t >> 4;
#pragma unroll
    for (int j = 0; j < 4; ++j)
#pragma unroll
        for (int i = 0; i < 4; ++i) { const int n = 4 * n4 + i; *(unsigned*)(lds + j * 8192 + n * 128 + (((kp >> 2) ^ (n4 & 7)) * 16) + (kp & 3) * 4) = cvt_pk_bf16(v[2 * j][i], v[2 * j + 1][i]); }
    __syncthreads();
    { const int n = t >> 3, ch = t & 7;
#pragma unroll
      for (int j = 0; j < 4; ++j) if (j < ntl) { const u32x4 w = *(const u32x4*)(lds + j * 8192 + n * 128 + ((ch ^ ((n >> 2) & 7)) * 16));
          *(u32x4*)(dst + (size_t)(nd0 + 64 * j + n) * Kdst + k0 + 8 * ch) = w; } }
    __syncthreads();
}
__device__ __forceinline__ void xpose_matrix(const float* src, int K, int Nsrc, bf16_t* dst, int Ndst, int map, unsigned& tbase, unsigned char* lds) {
    const int t = hidden_tid();
    const int nk = K >> 6, nn = Ndst >> 6, ngn = (nn + 3) >> 2, ngrp = nk * ngn; const unsigned G = gridDim.x;
    unsigned gi = (hidden_bid() + G - (tbase % G)) % G;
    f32x4 va[8], vb[8];
    if (gi < (unsigned)ngrp) { const int kt = gi % nk, ng = gi / nk; xpose_load(src, Nsrc, kt * 64, ng * 256, map, min(4, nn - ng * 4), va, t); }
    while (gi < (unsigned)ngrp) {
        const unsigned gn = gi + G; const int kt = gi % nk, ng = gi / nk;
        if (gn < (unsigned)ngrp) { const int kt2 = gn % nk, ng2 = gn / nk; xpose_load(src, Nsrc, kt2 * 64, ng2 * 256, map, min(4, nn - ng2 * 4), vb, t); }
        xpose_store(va, dst, K, kt * 64, ng * 256, min(4, nn - ng * 4), lds, t);
#pragma unroll
        for (int q = 0; q < 8; ++q) va[q] = vb[q];
        gi = gn;
    }
    tbase += ngrp;
}

__device__ __forceinline__ unsigned pk4_fp8(float a, float b, float c, float d) { int w = 0; w = __builtin_amdgcn_cvt_pk_fp8_f32(a, b, w, false); w = __builtin_amdgcn_cvt_pk_fp8_f32(c, d, w, true); return (unsigned)w; }
#define X8T 4
__device__ __forceinline__ unsigned xpose8_load(const float* __restrict__ src, int Nsrc, int k0, int nd0, int map, f32x4 (&v)[4 * X8T], int t) {
    const int n4 = t & 15, kq = t >> 4;
    bool ok[X8T];
#pragma unroll
    for (int j = 0; j < X8T; ++j) { const int ns0 = map_col(map, nd0 + 64 * j + 4 * n4); ok[j] = ns0 >= 0; const int nsc = ok[j] ? ns0 : 0;
#pragma unroll
        for (int q = 0; q < 4; ++q) v[4 * j + q] = __builtin_nontemporal_load((const f32x4*)(src + (size_t)(k0 + 4 * kq + q) * Nsrc + nsc)); }
    __builtin_amdgcn_sched_barrier(0);
    unsigned m = 0;
#pragma unroll
    for (int j = 0; j < X8T; ++j) m |= ok[j] ? (1u << j) : 0u;
    return m;
}
__device__ __forceinline__ void xpose8_store(const f32x4 (&v)[4 * X8T], unsigned char* __restrict__ dst, int Kdst, int k0, int nd0, float scale0, unsigned char* lds, int t, unsigned okm = 0xffffffffu) {
    const int n4 = t & 15, kq = t >> 4;
#pragma unroll
    for (int j = 0; j < X8T; ++j) { const float scale = (okm >> j) & 1u ? scale0 : 0.0f;
#pragma unroll
        for (int i = 0; i < 4; ++i) { const int n = 4 * n4 + i;
            *(unsigned*)(lds + j * 8192 + n * 128 + (((kq >> 2) ^ (n4 & 7)) * 16) + (kq & 3) * 4) = pk4_fp8(v[4 * j][i] * scale, v[4 * j + 1][i] * scale, v[4 * j + 2][i] * scale, v[4 * j + 3][i] * scale); } }
    __syncthreads();
    { const int n = t >> 3, ch = t & 7;
#pragma unroll
      for (int j = 0; j < X8T; ++j) { const u32x4 w = *(const u32x4*)(lds + j * 8192 + n * 128 + ((ch ^ ((n >> 2) & 7)) * 16));
          *(u32x4*)(dst + (size_t)(nd0 + 64 * j + n) * Kdst + k0 + 16 * ch) = w; } }
    __syncthreads();
}
__device__ __forceinline__ void xpose8_matrix(const float* src, int K, int Nsrc, unsigned char* dst, int Ndst, int map, float scale, unsigned& tbase, unsigned char* lds) {
    const int t = hidden_tid();
    const int nk = K >> 7, ngn = Ndst / (64 * X8T), ngrp = nk * ngn; const unsigned G = gridDim.x;
    unsigned gi = (hidden_bid() + G - (tbase % G)) % G;
    f32x4 va[4 * X8T], vb[4 * X8T];
    unsigned ma = 0, mb = 0;
    if (gi < (unsigned)ngrp) ma = xpose8_load(src, Nsrc, (gi % nk) * 128, (gi / nk) * 64 * X8T, map, va, t);
    while (gi < (unsigned)ngrp) {
        const unsigned gn = gi + G;
        if (gn < (unsigned)ngrp) mb = xpose8_load(src, Nsrc, (gn % nk) * 128, (gn / nk) * 64 * X8T, map, vb, t);
        xpose8_store(va, dst, K, (gi % nk) * 128, (gi / nk) * 64 * X8T, scale, lds, t, ma); ma = mb;
#pragma unroll
        for (int q = 0; q < 4 * X8T; ++q) va[q] = vb[q];
        gi = gn;
    }
    tbase += ngrp;
}

#ifndef COSCHED
#define COSCHED 1
#endif
#ifndef XGN
#define XGN 1
#endif
__device__ __forceinline__ void xpose8_gload(KP p, int l, int g, f32x4 (&v)[4 * X8T], int t) {
    const int e = g / 96, r = g - e * 96; const int n4 = t & 15, kq = t >> 4;
    if (r < 64) { const float* b = p->exp_w1 + (size_t)(l * 32 + e) * 1024 * 2048 + (size_t)((r & 7) * 128 + 4 * kq) * 2048 + (r >> 3) * 128 + 4 * n4;
#pragma unroll
        for (int j = 0; j < 4; ++j)
#pragma unroll
            for (int q = 0; q < 4; ++q) v[4 * j + q] = __builtin_nontemporal_load((const f32x4*)(b + q * 2048 + (j >> 1) * 1024 + (j & 1) * 64));
    } else { const float* b = p->exp_w2 + (size_t)(l * 32 + e) * 1024 * 1024 + (size_t)((r & 7) * 128 + 4 * kq) * 1024 + ((r - 64) >> 3) * 256 + 4 * n4;
#pragma unroll
        for (int j = 0; j < 4; ++j)
#pragma unroll
            for (int q = 0; q < 4; ++q) v[4 * j + q] = __builtin_nontemporal_load((const f32x4*)(b + q * 1024 + j * 64));
    }
    __builtin_amdgcn_sched_barrier(0);
}
__device__ __forceinline__ void xpose8_gstore(KP p, int l, int g, const f32x4 (&v)[4 * X8T], unsigned char* lds, int t) {
    const int e = g / 96, r = g - e * 96; char* ws = p->ws;
    if (r < 64) xpose8_store(v, (unsigned char*)(ws + OFF_W1) + (size_t)(l * 32 + e) * 2048 * 1024, 1024, (r & 7) * 128, (r >> 3) * 256, 32.0f, lds, t);
    else xpose8_store(v, (unsigned char*)(ws + OFF_W2) + (size_t)(l * 32 + e) * 1024 * 1024, 1024, (r & 7) * 128, ((r - 64) >> 3) * 256, 32.0f, lds, t);
}
__device__ __forceinline__ void xpose8_group(KP p, int l, int g, unsigned char* lds) {
    if ((g & (XGN - 1)) != XGN - 1) return;
    const int t = hidden_tid(); const int g0 = g - (XGN - 1);
    f32x4 va[4 * X8T], vb[4 * X8T];
    xpose8_gload(p, l, g0, va, t);
    __syncthreads();
#pragma unroll 1
    for (int i = 0; i < XGN; ++i) {
        if (i + 1 < XGN) xpose8_gload(p, l, g0 + i + 1, vb, t);
        xpose8_gstore(p, l, g0 + i, va, lds, t);
#pragma unroll
        for (int q = 0; q < 4 * X8T; ++q) va[q] = vb[q];
    }
}
__device__ __forceinline__ float wave_sum(float v, int lane) { (void)lane;
#define DPP_ADD(ctrl) v += __int_as_float(__builtin_amdgcn_update_dpp(0, __float_as_int(v), (ctrl), 0xf, 0xf, false))
    DPP_ADD(0xB1); DPP_ADD(0x4E); DPP_ADD(0x141); DPP_ADD(0x140);
#undef DPP_ADD
    { auto rr = __builtin_amdgcn_permlane16_swap(__float_as_uint(v), __float_as_uint(v), false, false); v = __uint_as_float(rr[0]) + __uint_as_float(rr[1]); }
    { auto rr = __builtin_amdgcn_permlane32_swap(__float_as_uint(v), __float_as_uint(v), false, false); v = __uint_as_float(rr[0]) + __uint_as_float(rr[1]); }
    return v;
}
__device__ __forceinline__ void phase_prologue(KP p, unsigned char* lds) {
    const int t = hidden_tid(), bi = hidden_bid();
    char* ws = p->ws;
#ifndef PRO_MODREP
#define PRO_MODREP 1
#endif
#ifndef PRO_XREP
#define PRO_XREP 1
#endif
    for (int rep_ = 0; rep_ < PRO_MODREP; ++rep_) {
        float* cs = (float*)lds;
        f32x4* red = (f32x4*)(lds + 65536);
        for (int i = t; i < 16 * 1024; i += NTHREADS) { const float v = p->c[i]; cs[(i & 1023) * 16 + (i >> 10)] = v * sigmoidf_(v); }
        __syncthreads();
        for (int task = bi; task < 192; task += gridDim.x) {
            const int j0 = task * 64, l = j0 / 6144, c0 = j0 % 6144;
            const int c4 = t & 15, kr = t >> 4, lane = t & 63, wv = t >> 6;
            const float* wp = p->mod_w + (size_t)l * 1024 * 6144 + c0 + 4 * c4;
            f32x4 acc[16];
#pragma unroll
            for (int b = 0; b < 16; ++b) acc[b] = (f32x4){0.f, 0.f, 0.f, 0.f};
#pragma unroll 1
            for (int i0 = 0; i0 < 32; i0 += 4) {
                f32x4 w[4];
#pragma unroll
                for (int i = 0; i < 4; ++i) w[i] = __builtin_nontemporal_load((const f32x4*)(wp + (size_t)(kr + 32 * (i0 + i)) * 6144));
                __builtin_amdgcn_sched_barrier(0);
#pragma unroll
                for (int i = 0; i < 4; ++i) { const float* cr = cs + (kr + 32 * (i0 + i)) * 16;
#pragma unroll
                    for (int b4 = 0; b4 < 4; ++b4) { const f32x4 cv = *(const f32x4*)(cr + 4 * b4);
#pragma unroll
                        for (int q = 0; q < 4; ++q) acc[4 * b4 + q] += cv[q] * w[i]; } }
            }
#pragma unroll
            for (int b = 0; b < 16; ++b)
#pragma unroll
                for (int q = 0; q < 4; ++q) { float v = acc[b][q];
                    v += __int_as_float(__builtin_amdgcn_ds_bpermute(((lane ^ 16) & 63) << 2, __float_as_int(v)));
                    v += __int_as_float(__builtin_amdgcn_ds_bpermute(((lane ^ 32) & 63) << 2, __float_as_int(v)));
                    acc[b][q] = v; }
            if (lane < 16) {
#pragma unroll
                for (int b = 0; b < 16; ++b) red[(wv * 16 + b) * 16 + c4] = acc[b]; }
            __syncthreads();
            if (t < 256) { const int b = t >> 4, c2 = t & 15; f32x4 sum = red[b * 16 + c2];
#pragma unroll
                for (int w2 = 1; w2 < 8; ++w2) sum += red[(w2 * 16 + b) * 16 + c2];
                const int col2 = c0 + 4 * c2;
                *(f32x4*)((float*)(ws + OFF_MOD) + ((size_t)l * 16 + b) * 6144 + col2) = sum + *(const f32x4*)(p->mod_b + l * 6144 + col2); }
            __syncthreads();
        }
    }
    if (bi == 0 && t < 64) {
        for (int l2 = 0; l2 < NLAYER; ++l2) { const float* lp = p->diff_lambda + (size_t)l2 * 256; const float a01 = wave_sum(lp[t] * lp[64 + t], t), a23 = wave_sum(lp[128 + t] * lp[192 + t], t);
            if (t == 0) ((float*)ws)[CW_LAM + l2] = expf(a01) - expf(a23) + (0.8f - 0.6f * expf(-0.3f * (float)l2)); } }
    for (int task = (int)gridDim.x - 1 - bi; task < 16; task += gridDim.x) {
        const int lk = task >> 2, kq = task & 3, nq = t & 63, ks = t >> 6;
        const float* w1 = p->cmp_w1 + (size_t)lk * 2048 * 256; const float* pos = p->cmp_pos + (size_t)lk * 2048;
        f32x4 s4 = (f32x4){0.f, 0.f, 0.f, 0.f};
#pragma unroll 1
        for (int k0 = kq * 512 + ks * 64; k0 < kq * 512 + ks * 64 + 64; k0 += 16) {
            f32x4 w[16]; float pz[16];
#pragma unroll
            for (int i = 0; i < 16; ++i) { w[i] = *(const f32x4*)(w1 + (size_t)(k0 + i) * 256 + 4 * nq); pz[i] = pos[k0 + i]; }
            __builtin_amdgcn_sched_barrier(0);
#pragma unroll
            for (int i = 0; i < 16; ++i) s4 += pz[i] * w[i];
        }
        f32x4* red = (f32x4*)lds; red[t] = s4; __syncthreads();
        if (t < 64) { f32x4 r = red[t];
#pragma unroll
            for (int q = 1; q < 8; ++q) r += red[t + 64 * q];
            *(f32x4*)((float*)(ws + OFF_CBIAS) + (size_t)(lk * 4 + kq) * 256 + 4 * t) = r; }
        __syncthreads();
    }
    for (int i = bi * NTHREADS + t; i < 2 * ZW; i += gridDim.x * NTHREADS) { const int l = i / ZW, nd = i % ZW, ns = map_col(1, nd); ((float*)(ws + OFF_BIN))[i] = ns >= 0 ? p->b_in[l * INW + ns] : 0.f; }
    for (int i = bi * NTHREADS + t; i < 2 * 32 * 2048; i += gridDim.x * NTHREADS) { const int le = i >> 11, j = i & 2047; ((float*)(ws + OFF_B1P))[i] = p->exp_b1[(size_t)le * 2048 + map_col(2, j)]; }
    for (int i = bi * NTHREADS + t; i < 2 * 32 * 1024; i += gridDim.x * NTHREADS) {
        const int l = i >> 15, e = (i >> 10) & 31, k = i & 1023; const float w = p->router_w[((size_t)l * 1024 + k) * 32 + e];
        const bf16_t hi = f2bf(w); const bf16_t lo = f2bf(w - bf2f(hi));
        const size_t fo = ((((size_t)(e >> 4) * 32 + (k >> 5)) * 64 + ((k >> 3) & 3) * 16 + (e & 15)) << 3) + (k & 7);
        bf16_t* wr = (bf16_t*)(ws + OFF_WRT); wr[(size_t)(l * 2 + 0) * 32768 + fo] = hi; wr[(size_t)(l * 2 + 1) * 32768 + fo] = lo; }
    __syncthreads();
    for (int rep_ = 0; rep_ < PRO_XREP; ++rep_) {
    unsigned tbase = 0;
    for (int l = 0; l < (COSCHED ? 1 : NLAYER); ++l) {
#if INPROJ_FP8
        xpose8_matrix(p->w_in + (size_t)l * 1024 * INW, 1024, INW, (unsigned char*)(ws + OFF_WIN) + (size_t)l * ZW * 1024, ZW, 1, 32.0f, tbase, lds);
#else
        xpose_matrix(p->w_in + (size_t)l * 1024 * INW, 1024, INW, (bf16_t*)(ws + OFF_WIN) + (size_t)l * ZW * 1024, ZW, 1, tbase, lds);
#endif
        for (int kv = 0; kv < 2; ++kv) {
            xpose_matrix(p->cmp_w1 + (size_t)(l * 2 + kv) * 2048 * 256, 2048, 256, (bf16_t*)(ws + OFF_WC1) + (size_t)(l * 2 + kv) * 256 * 2048, 256, 0, tbase, lds);
            xpose_matrix(p->cmp_w2 + (size_t)(l * 2 + kv) * 256 * 64, 256, 64, (bf16_t*)(ws + OFF_WC2) + (size_t)(l * 2 + kv) * 64 * 256, 64, 0, tbase, lds);
        }
#if !COSCHED
        for (int i = 0; i < 3; ++i) xpose_matrix(p->w_branch + (size_t)(l * 3 + i) * 512 * 1024, 512, 1024, (bf16_t*)(ws + OFF_WBR) + (size_t)(l * 3 + i) * 1024 * 512, 1024, 0, tbase, lds);
        xpose_matrix(p->w_out + (size_t)l * 1024 * 1024, 1024, 1024, (bf16_t*)(ws + OFF_WOUT) + (size_t)l * 1024 * 1024, 1024, 0, tbase, lds);
        for (int e = 0; e < 32; ++e) {
            xpose8_matrix(p->exp_w1 + (size_t)(l * 32 + e) * 1024 * 2048, 1024, 2048, (unsigned char*)(ws + OFF_W1) + (size_t)(l * 32 + e) * 2048 * 1024, 2048, 2, 32.0f, tbase, lds);
            xpose8_matrix(p->exp_w2 + (size_t)(l * 32 + e) * 1024 * 1024, 1024, 1024, (unsigned char*)(ws + OFF_W2) + (size_t)(l * 32 + e) * 1024 * 1024, 1024, 0, 32.0f, tbase, lds);
        }
#endif
    }
}
}

__device__ __forceinline__ void xpose_one(const float* src, int K, int Nsrc, bf16_t* dst, int Ndst, int gi, unsigned char* lds) {
    const int t = hidden_tid(); const int nk = K >> 6, nn = Ndst >> 6, kt = gi % nk, ng = gi / nk, ntl = min(4, nn - ng * 4);
    f32x4 va[8];
    xpose_load(src, Nsrc, kt * 64, ng * 256, 0, ntl, va, t);
    __syncthreads();
    xpose_store(va, dst, K, kt * 64, ng * 256, ntl, lds, t);
}
__device__ __forceinline__ void xpose8_one(const float* src, int K, int Nsrc, unsigned char* dst, int map, float scale, int gi, unsigned char* lds) {
    const int t = hidden_tid(); const int nk = K >> 7;
    f32x4 va[4 * X8T];
    const unsigned m = xpose8_load(src, Nsrc, (gi % nk) * 128, (gi / nk) * 64 * X8T, map, va, t);
    __syncthreads();
    xpose8_store(va, dst, K, (gi % nk) * 128, (gi / nk) * 64 * X8T, scale, lds, t, m);
}
#define MISC_GROUPS 608
__device__ __forceinline__ void misc_group(KP p, int idx, unsigned char* lds) {
    char* ws = p->ws;
    if (idx < 216) {
#if INPROJ_FP8
        xpose8_one(p->w_in + (size_t)1024 * INW, 1024, INW, (unsigned char*)(ws + OFF_WIN) + (size_t)ZW * 1024, 1, 32.0f, idx, lds);
#endif
    } else if (idx < 312 || (idx >= 448 && idx < 544)) { const int l = idx < 312 ? 1 : 0, r = idx - (l ? 216 : 448), i = r >> 5;
        xpose_one(p->w_branch + (size_t)(l * 3 + i) * 512 * 1024, 512, 1024, (bf16_t*)(ws + OFF_WBR) + (size_t)(l * 3 + i) * 1024 * 512, 1024, r & 31, lds);
    } else if (idx < 376 || idx >= 544) { const int l = idx < 376 ? 1 : 0, r = idx - (l ? 312 : 544);
        xpose_one(p->w_out + (size_t)l * 1024 * 1024, 1024, 1024, (bf16_t*)(ws + OFF_WOUT) + (size_t)l * 1024 * 1024, 1024, r, lds);
    } else if (idx < 440) { const int r = idx - 376, kv = r >> 5;
        xpose_one(p->cmp_w1 + (size_t)(2 + kv) * 2048 * 256, 2048, 256, (bf16_t*)(ws + OFF_WC1) + (size_t)(2 + kv) * 256 * 2048, 256, r & 31, lds);
    } else { const int r = idx - 440, kv = r >> 2;
        xpose_one(p->cmp_w2 + (size_t)(2 + kv) * 256 * 64, 256, 64, (bf16_t*)(ws + OFF_WC2) + (size_t)(2 + kv) * 64 * 256, 64, r & 3, lds);
    }
}

__device__ __forceinline__ void phase_norm_mod(const float* __restrict__ xsrc, const float* __restrict__ g, const float* __restrict__ modl  , int sh_off, int sc_off, bf16_t* __restrict__ hb) {
    const int tid = hidden_tid(), lane = tid & 63, wv = tid >> 6;
    for (int gw = hidden_bid() * 8 + wv; gw < NTOK / 16; gw += gridDim.x * 8) {
        const int row0 = gw * 16, b = row0 >> 11;
        f32x4 gg[4], sc[4], sh[4], xn[4];
#pragma unroll
        for (int j = 0; j < 4; ++j) { const int col = 256 * j + 4 * lane; gg[j] = *(const f32x4*)(g + col); sc[j] = *(const f32x4*)(modl + (size_t)b * 6144 + sc_off + col); sh[j] = *(const f32x4*)(modl + (size_t)b * 6144 + sh_off + col);
            xn[j] = *(const f32x4*)(xsrc + (size_t)row0 * 1024 + col); }
        for (int i = 0; i < 16; ++i) {
            const int row = row0 + i; f32x4 v[4]; float ss = 0.f;
#pragma unroll
            for (int j = 0; j < 4; ++j) { v[j] = xn[j]; ss += v[j][0] * v[j][0] + v[j][1] * v[j][1] + v[j][2] * v[j][2] + v[j][3] * v[j][3]; }
            if (i + 1 < 16) {
#pragma unroll
                for (int j = 0; j < 4; ++j) xn[j] = *(const f32x4*)(xsrc + (size_t)(row + 1) * 1024 + 256 * j + 4 * lane); }
            ss = wave_sum(ss, lane); const float r = 1.0f / sqrtf(ss * (1.0f / 1024.0f) + 1e-5f);
#pragma unroll
            for (int j = 0; j < 4; ++j) { const int col = 256 * j + 4 * lane; float o[4];
#pragma unroll
                for (int q = 0; q < 4; ++q) o[q] = v[j][q] * r * gg[j][q] * (1.0f + sc[j][q]) + sh[j][q];
#if INPROJ_FP8
                *(unsigned*)((unsigned char*)hb + (size_t)row * 1024 + col) = pk4_fp8(o[0], o[1], o[2], o[3]); }
#else
                u32x2 w; w.x = cvt_pk_bf16(o[0], o[1]); w.y = cvt_pk_bf16(o[2], o[3]); *(u32x2*)(hb + (size_t)row * 1024 + col) = w; }
#endif
        }
    }
}

__device__ __forceinline__ bool unit_rc(unsigned L, int nRT, int nN, int& rt, int& pn) {
    const int x = L & 7; const unsigned i = L >> 3; const int nrt_x = (nRT - x + 7) >> 3;
    const unsigned per = 8u * (unsigned)nN, grp = i / per, rem = i % per;
    pn = (int)(rem >> 3); const int rtl = (int)(grp * 8u + (rem & 7u));
    if (rtl >= nrt_x) return false;
    rt = x + 8 * rtl; return true;
}
__device__ __forceinline__ unsigned unit_slots(int nRT, int nN) { const int pr = (nRT + 7) >> 3; return 8u * (unsigned)(((pr + 7) >> 3) * 8 * nN); }
struct SlotIter {
    unsigned L, LM; int nRT, nN;
    __device__ __forceinline__ void init(int nRT_, int nN_) { nRT = nRT_; nN = nN_; LM = unit_slots(nRT_, nN_); L = hidden_bid(); }
    __device__ __forceinline__ bool take(int& rt, int& pn) { while (L < LM) { const unsigned l = L; L += gridDim.x; if (unit_rc(l, nRT, nN, rt, pn)) return true; } return false; }
};

#define GEMM_STAGE_IDS() int rS, cS; { int tz_ = threadIdx.x; asm volatile("" : "+v"(tz_)); stage_rc(tz_ * 16, rS, cS); }
#define GEMM_LANE_IDS() int tid = threadIdx.x; asm volatile("" : "+v"(tid)); const int wid = tid >> 6, lane = tid & 63, wr = wid >> 2, wc = wid & 3, fr = lane & 15, fq = lane >> 4; (void)lane; (void)wr; (void)wc; (void)fr; (void)fq
#define TILE_ROW(i) (((i) >> 1) * 128 + ((i) & 1) * 64 + rS)
typedef f32x4 (&AccRef)[2][2][4][2];

struct InprojS {
    KP p; int l; SlotIter it; int rt, pn, nrt, npn; f32x4 pb[2][2]; bool hn;
    static constexpr bool BIAS_INIT = true;
    __device__ __forceinline__ bool zero_after() const { return true; }
    __device__ __forceinline__ void load_bias(int pn_) { GEMM_LANE_IDS(); const float* bias = (const float*)(p->ws + OFF_BIN) + (size_t)l * ZW + pn_ * 256 + wc * 32 + fq * 8;
#pragma unroll
        for (int bj = 0; bj < 2; ++bj) { pb[bj][0] = *(const f32x4*)(bias + bj * 128); pb[bj][1] = *(const f32x4*)(bias + bj * 128 + 4); } }
    __device__ __forceinline__ void load_bias_first() { load_bias(pn); }
    __device__ __forceinline__ void init_acc(AccRef acc) {
#pragma unroll
        for (int ai = 0; ai < 2; ++ai)
#pragma unroll
            for (int bj = 0; bj < 2; ++bj)
#pragma unroll
                for (int m = 0; m < 4; ++m) { acc[ai][bj][m][0] = pb[bj][0]; acc[ai][bj][m][1] = pb[bj][1]; } }
    __device__ __forceinline__ void prefetch() {}
    __device__ __forceinline__ void fill(GDesc& d, int rt_, int pn_) { GEMM_STAGE_IDS(); char* ws = p->ws; d.A = ws + OFF_HB; d.B = ws + OFF_WIN + ((size_t)l * ZW + (size_t)pn_ * 256) * 1024 * (INPROJ_FP8 ? 1 : 2);
#pragma unroll
        for (int i = 0; i < 4; ++i) d.aoff[i] = (unsigned)(((size_t)rt_ * 256 + TILE_ROW(i)) * (INPROJ_FP8 ? 1024 : 2048) + cS * 2); }
    __device__ __forceinline__ bool first(GDesc& d) { it.init(128, 27); if (!it.take(rt, pn)) return false; fill(d, rt, pn); return true; }
    __device__ __forceinline__ bool next(GDesc& d) { int a, b; if (!it.take(a, b)) return false; nrt = a; npn = b; fill(d, a, b); return true; }
    __device__ __forceinline__ void advance() { rt = nrt; pn = npn; }
    __device__ __forceinline__ void epilogue(AccRef acc) {
        if (hn) load_bias(npn);
        GEMM_LANE_IDS(); char* ws = p->ws;
        bf16_t* z = (bf16_t*)(ws + OFF_Z);
        const bool sig = pn >= 14;
        const float qsc = (pn < 2 || pn == 3 || pn == 4 || pn == 9 || pn == 10) ? 0.125f : 1.0f;
        const int row0 = rt * 256 + wr * 64 + fr, col0 = pn * 256 + wc * 32 + fq * 8;
#pragma unroll
        for (int bj = 0; bj < 2; ++bj) { const int col = col0 + bj * 128;
#pragma unroll
            for (int ai = 0; ai < 2; ++ai)
#pragma unroll
                for (int m = 0; m < 4; ++m) { f32x4 v0 = acc[ai][bj][m][0] * qsc, v1 = acc[ai][bj][m][1] * qsc;
                    if (sig) {
#pragma unroll
                        for (int j = 0; j < 4; ++j) { v0[j] = sigmoidf_(v0[j]); v1[j] = sigmoidf_(v1[j]); } }
                    u32x4 w; w.x = cvt_pk_bf16(v0[0], v0[1]); w.y = cvt_pk_bf16(v0[2], v0[3]); w.z = cvt_pk_bf16(v1[0], v1[1]); w.w = cvt_pk_bf16(v1[2], v1[3]);
                    *(u32x4*)(z + (size_t)(row0 + ai * 128 + m * 16) * ZW + col) = w; } }
    }
};
__device__ __forceinline__ void phase_inproj(KP p, int l, unsigned char* lds) { InprojS s; s.p = p; s.l = l;
#if INPROJ_FP8
    gemm_stream<InprojS, true, 0x7f7f7f7f, 0x7a7a7a7a>(s, 1024, 128u, lds);
#else
    gemm_stream(s, 1024, 128u, lds);
#endif
}

struct MergeS {
    KP p; int l; SlotIter it; int rt, pn, br, nrt, npn, nbr; bool hn;
    static constexpr bool BIAS_INIT = false;
    __device__ __forceinline__ void load_bias_first() {}
    __device__ __forceinline__ void init_acc(AccRef) {}
    __device__ __forceinline__ bool zero_after() const { return br == 2; }
    __device__ __forceinline__ void prefetch() {}
    __device__ __forceinline__ void fill(GDesc& d, int rt_, int pn_, int br_) { GEMM_STAGE_IDS(); char* ws = p->ws; d.A = ws + OFF_OABC + (size_t)br_ * NTOK * 512 * 2;
        d.B = ws + OFF_WBR + ((size_t)(l * 3 + br_) * 1024 + (size_t)pn_ * 256) * 512 * 2;
#pragma unroll
        for (int i = 0; i < 4; ++i) d.aoff[i] = (unsigned)(((size_t)rt_ * 256 + TILE_ROW(i)) * 1024 + cS * 2); }
    __device__ __forceinline__ bool first(GDesc& d) { it.init(128, 4); if (!it.take(rt, pn)) return false; br = 0; fill(d, rt, pn, 0); return true; }
    __device__ __forceinline__ bool next(GDesc& d) { if (br < 2) { nrt = rt; npn = pn; nbr = br + 1; } else { int a, b; if (!it.take(a, b)) return false; nrt = a; npn = b; nbr = 0; } fill(d, nrt, npn, nbr); return true; }
    __device__ __forceinline__ void advance() { rt = nrt; pn = npn; br = nbr; }
    __device__ __forceinline__ void epilogue(AccRef acc) {
        GEMM_LANE_IDS(); char* ws = p->ws;
        const bf16_t* z = (const bf16_t*)(ws + OFF_Z); bf16_t* mg = (bf16_t*)(ws + OFF_MERGED);
        const int row0 = rt * 256 + wr * 64 + fr, col0 = pn * 256 + wc * 32 + fq * 8;
#pragma unroll
        for (int ai = 0; ai < 2; ++ai) {
            u32x4 G[2][4], H[2][4];
#pragma unroll
            for (int bj = 0; bj < 2; ++bj)
#pragma unroll
                for (int m = 0; m < 4; ++m) { const bf16_t* gp = z + (size_t)(row0 + ai * 128 + m * 16) * ZW + C_GM + br * 1024 + col0 + bj * 128;
                    G[bj][m] = *(const u32x4*)gp; H[bj][m] = *(const u32x4*)(gp + (br < 2 ? 1024 : 0)); }
            asm volatile("" ::: "memory");
#pragma unroll
            for (int bj = 0; bj < 2; ++bj)
#pragma unroll
                for (int m = 0; m < 4; ++m) {
                    const int row = row0 + ai * 128 + m * 16, col = col0 + bj * 128;
                    const u32x4 gw = G[bj][m], hw = H[bj][m];
                    float g[8] = {bflo(gw.x), bfhi(gw.x), bflo(gw.y), bfhi(gw.y), bflo(gw.z), bfhi(gw.z), bflo(gw.w), bfhi(gw.w)};
                    if (br < 2) { const float hn[8] = {bflo(hw.x), bfhi(hw.x), bflo(hw.y), bfhi(hw.y), bflo(hw.z), bfhi(hw.z), bflo(hw.w), bfhi(hw.w)};
#pragma unroll
                        for (int j = 0; j < 8; ++j) g[j] = fmaxf(g[j], 1e-6f) * fast_rcp(fmaxf(hn[j], 1e-6f));
                    } else {
#pragma unroll
                        for (int j = 0; j < 8; ++j) g[j] = fmaxf(g[j], 1e-6f); }
                    f32x4 v0 = acc[ai][bj][m][0], v1 = acc[ai][bj][m][1];
                    v0[0] *= g[0]; v0[1] *= g[1]; v0[2] *= g[2]; v0[3] *= g[3]; v1[0] *= g[4]; v1[1] *= g[5]; v1[2] *= g[6]; v1[3] *= g[7];
                    if (br < 2) { acc[ai][bj][m][0] = v0; acc[ai][bj][m][1] = v1; }
                    else { u32x4 w; w.x = cvt_pk_bf16(v0[0], v0[1]); w.y = cvt_pk_bf16(v0[2], v0[3]); w.z = cvt_pk_bf16(v1[0], v1[1]); w.w = cvt_pk_bf16(v1[2], v1[3]); *(u32x4*)(mg + (size_t)row * 1024 + col) = w; }
                }
        }
    }
};
__device__ __forceinline__ void phase_merge(KP p, int l, unsigned char* lds) { MergeS s; s.p = p; s.l = l; gemm_stream(s, 512, 128u, lds); }

struct OutprojS {
    KP p; int l; SlotIter it; int rt, pn, nrt, npn; f32x4 pg[2][2]; bool hn;
    static constexpr bool BIAS_INIT = false;
    __device__ __forceinline__ void load_bias_first() {}
    __device__ __forceinline__ void init_acc(AccRef) {}
    __device__ __forceinline__ bool zero_after() const { return true; }
    __device__ __forceinline__ void prefetch() { GEMM_LANE_IDS(); const float* gp = (const float*)(p->ws + OFF_MOD) + ((size_t)l * 16 + (rt >> 3)) * 6144 + 2048 + pn * 256 + wc * 32 + fq * 8;
#pragma unroll
        for (int bj = 0; bj < 2; ++bj) { pg[bj][0] = *(const f32x4*)(gp + bj * 128); pg[bj][1] = *(const f32x4*)(gp + bj * 128 + 4); } }
    __device__ __forceinline__ void fill(GDesc& d, int rt_, int pn_) { GEMM_STAGE_IDS(); char* ws = p->ws; d.A = ws + OFF_MERGED; d.B = ws + OFF_WOUT + ((size_t)l * 1024 + (size_t)pn_ * 256) * 1024 * 2;
#pragma unroll
        for (int i = 0; i < 4; ++i) d.aoff[i] = (unsigned)(((size_t)rt_ * 256 + TILE_ROW(i)) * 2048 + cS * 2); }
    __device__ __forceinline__ bool first(GDesc& d) { it.init(128, 4); if (!it.take(rt, pn)) return false; fill(d, rt, pn); return true; }
    __device__ __forceinline__ bool next(GDesc& d) { int a, b; if (!it.take(a, b)) return false; nrt = a; npn = b; fill(d, a, b); return true; }
    __device__ __forceinline__ void advance() { rt = nrt; pn = npn; }
    __device__ __forceinline__ void epilogue(AccRef acc) {
        GEMM_LANE_IDS(); bf16_t* xrb = (bf16_t*)(p->ws + OFF_XR); const float* xin = p->x;
        const int row0 = rt * 256 + wr * 64 + fr, col0 = pn * 256 + wc * 32 + fq * 8;
#pragma unroll
        for (int ai = 0; ai < 2; ++ai) {
            if (l == 0) {
#pragma unroll
                for (int bj = 0; bj < 2; ++bj) {
                    f32x4 X[4][2];
#pragma unroll
                    for (int m = 0; m < 4; ++m) { const float* xp = xin + (size_t)(row0 + ai * 128 + m * 16) * 1024 + col0 + bj * 128; X[m][0] = *(const f32x4*)xp; X[m][1] = *(const f32x4*)(xp + 4); }
                    asm volatile("" ::: "memory");
#pragma unroll
                    for (int m = 0; m < 4; ++m) { const f32x4 v0 = X[m][0] + pg[bj][0] * acc[ai][bj][m][0], v1 = X[m][1] + pg[bj][1] * acc[ai][bj][m][1];
                        u32x4 w; w.x = cvt_pk_bf16(v0[0], v0[1]); w.y = cvt_pk_bf16(v0[2], v0[3]); w.z = cvt_pk_bf16(v1[0], v1[1]); w.w = cvt_pk_bf16(v1[2], v1[3]);
                        *(u32x4*)(xrb + (size_t)(row0 + ai * 128 + m * 16) * 1024 + col0 + bj * 128) = w; }
                }
            } else {
                u32x4 X[2][4];
#pragma unroll
                for (int bj = 0; bj < 2; ++bj)
#pragma unroll
                    for (int m = 0; m < 4; ++m) X[bj][m] = *(const u32x4*)(xrb + (size_t)(row0 + ai * 128 + m * 16) * 1024 + col0 + bj * 128);
                asm volatile("" ::: "memory");
#pragma unroll
                for (int bj = 0; bj < 2; ++bj)
#pragma unroll
                    for (int m = 0; m < 4; ++m) { const u32x4 xw = X[bj][m];
                        const f32x4 v0 = (f32x4){bflo(xw.x), bfhi(xw.x), bflo(xw.y), bfhi(xw.y)} + pg[bj][0] * acc[ai][bj][m][0], v1 = (f32x4){bflo(xw.z), bfhi(xw.z), bflo(xw.w), bfhi(xw.w)} + pg[bj][1] * acc[ai][bj][m][1];
                        u32x4 w; w.x = cvt_pk_bf16(v0[0], v0[1]); w.y = cvt_pk_bf16(v0[2], v0[3]); w.z = cvt_pk_bf16(v1[0], v1[1]); w.w = cvt_pk_bf16(v1[2], v1[3]);
                        *(u32x4*)(xrb + (size_t)(row0 + ai * 128 + m * 16) * 1024 + col0 + bj * 128) = w; }
            }
        }
    }
};
__device__ __forceinline__ void phase_outproj(KP p, int l, unsigned char* lds) { OutprojS s; s.p = p; s.l = l; gemm_stream(s, 1024, 128u, lds); }

__device__ __forceinline__ void moe_tables(KP p, int l, int* tbl) {
    const int t = hidden_tid();
    if (t < 64) {
        const unsigned* ctrl = (const unsigned*)p->ws; const int e = t & 31;
        const int c = (int)ctrl[CW_ECNT(l, e)]; const int nt = (c + 255) >> 8;
        int incl = nt;
#pragma unroll
        for (int o = 1; o < 32; o <<= 1) { const int v = __builtin_amdgcn_ds_bpermute(((t - o) & 63) << 2, incl); if (e >= o) incl += v; }
        if (t < 32) { tbl[e] = incl - nt; tbl[33 + e] = c; if (e == 31) tbl[32] = incl; }
    }
    __syncthreads();
}
#define RFL(x) __builtin_amdgcn_readfirstlane(x)
__device__ __forceinline__ int moe_find(const int* tbl, int rt, int e = 0) {
    while (RFL(tbl[e + 1]) <= rt) ++e;
    while (RFL(tbl[e]) > rt) --e;
    return e; }
#define MOE_TBL(lds) ((int*)((lds) + 131072 + 4096))

#ifndef MOEX
#define MOEX 0
#endif
struct Moe1S {
    KP p; int l; const int* tbl; SlotIter it; int rt, pn, e, nrt, npn, ne; int shadow; f32x4 bg[2], bu[2]; const int* toktab; int ui; bool hn;
    static constexpr bool BIAS_INIT = true;
    __device__ __forceinline__ bool zero_after() const { return true; }
    __device__ __forceinline__ void prefetch() {}
    __device__ __forceinline__ void load_bias(int pn_, int e_) { GEMM_LANE_IDS(); const float* bb = (const float*)(p->ws + OFF_B1P) + ((size_t)(l * 32 + e_)) * 2048 + pn_ * 256 + wc * 32 + fq * 8;
#pragma unroll
        for (int n = 0; n < 2; ++n) { bg[n] = *(const f32x4*)(bb + n * 4); bu[n] = *(const f32x4*)(bb + 128 + n * 4); } }
    __device__ __forceinline__ void load_bias_first() { load_bias(pn, e); }
    __device__ __forceinline__ void init_acc(AccRef acc) {
#pragma unroll
        for (int ai = 0; ai < 2; ++ai)
#pragma unroll
            for (int m = 0; m < 4; ++m)
#pragma unroll
                for (int n = 0; n < 2; ++n) { acc[ai][0][m][n] = bg[n]; acc[ai][1][m][n] = bu[n]; } }
    __device__ __forceinline__ void fill(GDesc& d, int rt_, int pn_, int e_) { GEMM_STAGE_IDS(); char* ws = p->ws; (void)rt_;
        d.A = ws + OFF_H8; d.B = ws + OFF_W1 + (((size_t)(l * 32 + e_)) * 2048 + (size_t)pn_ * 256) * 1024;
#pragma unroll
        for (int i = 0; i < 4; ++i) d.aoff[i] = (unsigned)((size_t)toktab[ui * 256 + TILE_ROW(i)] * 1024 + cS * 2);
        ++ui; }
    __device__ __forceinline__ bool first(GDesc& d) { it.init(RFL(tbl[32]), 8); if (!it.take(rt, pn)) return false; e = moe_find(tbl, rt); fill(d, rt, pn, e); return true; }
    __device__ __forceinline__ bool next(GDesc& d) { int a, b; if (!it.take(a, b)) return false; nrt = a; npn = b; ne = moe_find(tbl, a, e); fill(d, a, b, ne); return true; }
    __device__ __forceinline__ void advance() { rt = nrt; pn = npn; e = ne; }
    __device__ __forceinline__ void epilogue(AccRef acc) {
        if (shadow && MOEX == 2) { asm volatile("" :: "v"(acc[0][0][0][0]), "v"(acc[1][1][3][1])); return; }
        if (hn) load_bias(npn, ne);
        GEMM_LANE_IDS(); char* ws = p->ws; unsigned char* hid = (unsigned char*)(ws + OFF_HID);
        const size_t prow0 = (size_t)rt * 256 + wr * 64 + fr; const int c0 = wc * 32 + fq * 8;
#pragma unroll
        for (int ai = 0; ai < 2; ++ai)
#pragma unroll
            for (int m = 0; m < 4; ++m) { float o[8];
#pragma unroll
                for (int n = 0; n < 2; ++n) { const f32x4 gq = acc[ai][0][m][n], uq = acc[ai][1][m][n];
#pragma unroll
                    for (int j = 0; j < 4; ++j) { const float gg = fminf(gq[j], 7.0f), uu = __builtin_amdgcn_fmed3f(uq[j], -7.0f, 7.0f); o[n * 4 + j] = __builtin_fmaf(uu, 4.0f, 4.0f) * gg * fast_rcp(1.0f + fast_exp2(-1.702f * LOG2E * gg)); } }
                u32x2 w; w.x = pk4_fp8(o[0], o[1], o[2], o[3]); w.y = pk4_fp8(o[4], o[5], o[6], o[7]);
                *(u32x2*)(hid + (prow0 + ai * 128 + m * 16) * 1024 + pn * 128 + c0) = w; }
    }
};
__device__ __forceinline__ void phase_moe1(KP p, int l, unsigned char* lds) { int* tbl = MOE_TBL(lds); moe_tables(p, l, tbl);
    int* toktab = (int*)(lds + 131072 + 8192);
    { SlotIter it2; it2.init(RFL(tbl[32]), 8); int a, b, u2 = 0, e2 = 0; const int t = hidden_tid();
      while (it2.take(a, b)) { e2 = moe_find(tbl, a, e2); const int cnt = RFL(tbl[33 + e2]), pos0 = (a - RFL(tbl[e2])) * 256;
          if (t < 256) { int pos = pos0 + t; pos = pos < cnt ? pos : 0; toktab[u2 * 256 + t] = ((const int*)(p->ws + OFF_BUCK))[(size_t)e2 * NTOK + pos]; }
          ++u2; }
      __syncthreads(); }
    for (int rep = 0; rep < (MOEX ? 2 : 1); ++rep) { Moe1S s; s.p = p; s.l = l; s.tbl = tbl; s.shadow = rep; s.toktab = toktab; s.ui = 0; gemm_stream<Moe1S, true, 0x7f7f7f7f, 0x7a7a7a7a>(s, 1024, 128u, lds); __syncthreads(); } }

struct Moe2S {
    KP p; int l; const int* tbl; SlotIter it; int rt, pn, e, nrt, npn, ne; f32x4 pb[2][2]; bool hn;
    static constexpr bool BIAS_INIT = true;
    __device__ __forceinline__ bool zero_after() const { return true; }
    __device__ __forceinline__ void prefetch() {}
    __device__ __forceinline__ void load_bias(int pn_, int e_) { GEMM_LANE_IDS(); const float* b2 = p->exp_b2 + ((size_t)(l * 32 + e_)) * 1024 + pn_ * 256 + wc * 32 + fq * 8;
#pragma unroll
        for (int bj = 0; bj < 2; ++bj) { pb[bj][0] = *(const f32x4*)(b2 + bj * 128); pb[bj][1] = *(const f32x4*)(b2 + bj * 128 + 4); } }
    __device__ __forceinline__ void load_bias_first() { load_bias(pn, e); }
    __device__ __forceinline__ void init_acc(AccRef acc) {
#pragma unroll
        for (int ai = 0; ai < 2; ++ai)
#pragma unroll
            for (int bj = 0; bj < 2; ++bj)
#pragma unroll
                for (int m = 0; m < 4; ++m) { acc[ai][bj][m][0] = pb[bj][0]; acc[ai][bj][m][1] = pb[bj][1]; } }
    __device__ __forceinline__ void fill(GDesc& d, int rt_, int pn_, int e_) { GEMM_STAGE_IDS(); char* ws = p->ws; d.A = ws + OFF_HID; d.B = ws + OFF_W2 + (((size_t)(l * 32 + e_)) * 1024 + (size_t)pn_ * 256) * 1024;
#pragma unroll
        for (int i = 0; i < 4; ++i) d.aoff[i] = (unsigned)(((size_t)rt_ * 256 + TILE_ROW(i)) * 1024 + cS * 2); }
    __device__ __forceinline__ bool first(GDesc& d) { it.init(RFL(tbl[32]), 4); if (!it.take(rt, pn)) return false; e = moe_find(tbl, rt); fill(d, rt, pn, e); return true; }
    __device__ __forceinline__ bool next(GDesc& d) { int a, b; if (!it.take(a, b)) return false; nrt = a; npn = b; ne = moe_find(tbl, a, e); fill(d, a, b, ne); return true; }
    __device__ __forceinline__ void advance() { rt = nrt; pn = npn; e = ne; }
    __device__ __forceinline__ void epilogue(AccRef acc) {
        if (hn) load_bias(npn, ne);
        GEMM_LANE_IDS(); char* ws = p->ws; bf16_t* y = (bf16_t*)(ws + OFF_Y);
        const size_t row0 = (size_t)rt * 256 + wr * 64 + fr; const int col0 = pn * 256 + wc * 32 + fq * 8;
#pragma unroll
        for (int bj = 0; bj < 2; ++bj) { const int col = col0 + bj * 128;
#pragma unroll
            for (int ai = 0; ai < 2; ++ai)
#pragma unroll
                for (int m = 0; m < 4; ++m) { const f32x4 v0 = acc[ai][bj][m][0], v1 = acc[ai][bj][m][1];
                    u32x4 w; w.x = cvt_pk_bf16(v0[0], v0[1]); w.y = cvt_pk_bf16(v0[2], v0[3]); w.z = cvt_pk_bf16(v1[0], v1[1]); w.w = cvt_pk_bf16(v1[2], v1[3]);
                    *(u32x4*)(y + (row0 + ai * 128 + m * 16) * 1024 + col) = w; } }
    }
};
__device__ __forceinline__ void phase_moe2(KP p, int l, unsigned char* lds) { int* tbl = MOE_TBL(lds); moe_tables(p, l, tbl); Moe2S s; s.p = p; s.l = l; s.tbl = tbl; gemm_stream<Moe2S, true, 0x7d7d7d7d, 0x7a7a7a7a>(s, 1024, 128u, lds); __syncthreads(); }

#define AT_MISC 65536


typedef short s16x4 __attribute__((ext_vector_type(4)));
__device__ __forceinline__ int crow(int r, int h) { return (r & 3) + 8 * (r >> 2) + 4 * h; }
__device__ __forceinline__ int kaddr(int key, int c) { return (key >> 1) * 256 + (((((key & 1) << 3) | c) ^ ((key >> 1) & 15)) << 4); }
__device__ __forceinline__ int vaddr64(int key, int c) { return (key >> 1) * 256 + (((key & 1) * 2 + ((c >> 2) ^ ((key >> 1) & 1))) << 6) + ((c & 3) << 4); }
__device__ __forceinline__ int vaddr128(int key, int c) { return key * 256 + (((c >> 2) ^ (key & 3)) << 6) + ((c & 3) << 4); }
__device__ __forceinline__ s16x4 vtr(const unsigned char* p) { return __builtin_bit_cast(s16x4, __builtin_amdgcn_ds_read_tr16_b64_v4i16((LAS s16x4*)(p))); }
__device__ __forceinline__ float swap_max(float v) { auto rr = __builtin_amdgcn_permlane32_swap(__float_as_uint(v), __float_as_uint(v), false, false); return fmaxf(__uint_as_float(rr[0]), __uint_as_float(rr[1])); }
__device__ __forceinline__ float swap_sum(float v) { auto rr = __builtin_amdgcn_permlane32_swap(__float_as_uint(v), __float_as_uint(v), false, false); return __uint_as_float(rr[0]) + __uint_as_float(rr[1]); }
__device__ __forceinline__ float swap_other(float v, int h) { auto rr = __builtin_amdgcn_permlane32_swap(__float_as_uint(v), __float_as_uint(v), false, false); return __uint_as_float(h ? rr[0] : rr[1]); }
#define MFMA32(a, b, c) __builtin_amdgcn_mfma_f32_32x32x16_bf16((a), (b), (c), 0, 0, 0)

struct KVSrc { const char* k; unsigned kstride; const char* v; unsigned vstride; };
__device__ __forceinline__ void kinv(int o, int& key, int& c) { const int sup = o >> 8, x = ((o >> 4) & 15) ^ (sup & 15); key = 2 * sup + (x >> 3); c = x & 7; }
__device__ __forceinline__ void vinv64(int o, int& key, int& c) { const int sup = o >> 8, seg = (o >> 6) & 3; key = 2 * sup + (seg >> 1); c = (((seg & 1) ^ (sup & 1)) << 2) | ((o >> 4) & 3); }
__device__ __forceinline__ void vinv128(int o, int& key, int& c) { key = o >> 8; c = ((((o >> 6) & 3) ^ (key & 3)) << 2) | ((o >> 4) & 3); }
#define RING_NB 4
#define RING_AHEAD 3
template <int KW, int DV> struct KVRing {
    static constexpr int LPT = KW + DV / 64, BUFB = KW * 8192 + DV * 128;
    unsigned kof[KW], vof[DV / 64];
    unsigned kdst[KW], vdst[DV / 64];
    const char* kb; const char* vb; unsigned kstride, vstride;
    __device__ __forceinline__ void init(const KVSrc& s, int tid) {
        kb = s.k; vb = s.v; kstride = s.kstride; vstride = s.vstride;
        const int wv = tid >> 6, lane = tid & 63;
#pragma unroll
        for (int i = 0; i < KW; ++i) { const int o = (i * 8 + wv) * 1024 + lane * 16, img = o >> 13; int key, c; kinv(o & 8191, key, c); kof[i] = (unsigned)key * kstride + (unsigned)(img * 128 + c * 16); kdst[i] = (unsigned)o; }
#pragma unroll
        for (int i = 0; i < DV / 64; ++i) { const int o = (i * 8 + wv) * 1024 + lane * 16; int key, c; if (DV == 64) vinv64(o, key, c); else vinv128(o, key, c);
            vof[i] = (unsigned)key * vstride + (unsigned)(c * 16); vdst[i] = (unsigned)(KW * 8192 + o); }
    }
    __device__ __forceinline__ void issue(int key0, int buf, unsigned char* lds) const {
        const char* kt = UNIPTR(kb + (size_t)key0 * kstride); const char* vt = UNIPTR(vb + (size_t)key0 * vstride);
#pragma unroll
        for (int i = 0; i < KW; ++i) { unsigned o = kof[i]; asm volatile("" : "+v"(o)); __builtin_amdgcn_global_load_lds((const unsigned*)(kt + o), (unsigned*)(lds + buf * BUFB + kdst[i]), 16, 0, 0); }
#pragma unroll
        for (int i = 0; i < DV / 64; ++i) { unsigned o = vof[i]; asm volatile("" : "+v"(o)); __builtin_amdgcn_global_load_lds((const unsigned*)(vt + o), (unsigned*)(lds + buf * BUFB + vdst[i]), 16, 0, 0); }
    }
    __device__ __forceinline__ void wait_bar(int later) const {
        if (later >= 2 && RING_AHEAD >= 3) asm volatile("s_waitcnt vmcnt(%0)" :: "n"(2 * LPT) : "memory");
        else if (later >= 1) asm volatile("s_waitcnt vmcnt(%0)" :: "n"(LPT) : "memory");
        else asm volatile("s_waitcnt vmcnt(0)" ::: "memory");
        __builtin_amdgcn_s_barrier(); asm volatile("" ::: "memory");
    }
    __device__ __forceinline__ const unsigned char* kimg(const unsigned char* lds, int buf, int img) const { return lds + buf * BUFB + img * 8192; }
    __device__ __forceinline__ const unsigned char* vimg(const unsigned char* lds, int buf) const { return lds + buf * BUFB + KW * 8192; }
};

template <int DV> struct WaveAcc { float m, l; f32x16 o[DV / 32]; };
template <int DV> __device__ __forceinline__ void acc_init(WaveAcc<DV>& a) { a.m = -1e30f; a.l = 0.f;
#pragma unroll
    for (int d = 0; d < DV / 32; ++d)
#pragma unroll
        for (int r = 0; r < 16; ++r) a.o[d][r] = 0.f; }

__device__ __forceinline__ f32x16 qk_sub(const bf16x8 (&qf)[4], const unsigned char* kimg, int sub, int lane) {
    const int r32 = lane & 31, h = lane >> 5;
    f32x16 s;
#pragma unroll
    for (int r = 0; r < 16; ++r) s[r] = 0.f;
#pragma unroll
    for (int ks = 0; ks < 4; ++ks) { const bf16x8 kf = *(const bf16x8*)(kimg + kaddr(32 * sub + r32, 2 * ks + h)); s = MFMA32(kf, qf[ks], s); }
    return s;
}
template <int DV> struct VFrag { s16x4 r[2][DV / 32][2]; };
__device__ __forceinline__ void v_read_all(VFrag<64>& f, const unsigned char* vimg, int sub, int lane) {
    const int h = lane >> 5, i16 = lane & 15, qq = i16 >> 2, pp = i16 & 3, g1 = (lane >> 4) & 1, k0 = 32 * sub + 4 * h + qq;
    const unsigned b0 = (unsigned)(uintptr_t)(vimg + vaddr64(k0, 2 * g1 + (pp >> 1)) + (pp & 1) * 8), b1 = (unsigned)(uintptr_t)(vimg + vaddr64(k0, 4 + 2 * g1 + (pp >> 1)) + (pp & 1) * 8);
    asm volatile("ds_read_b64_tr_b16 %0, %8\n\tds_read_b64_tr_b16 %1, %8 offset:1024\n\tds_read_b64_tr_b16 %2, %9\n\tds_read_b64_tr_b16 %3, %9 offset:1024\n\t"
                 "ds_read_b64_tr_b16 %4, %8 offset:2048\n\tds_read_b64_tr_b16 %5, %8 offset:3072\n\tds_read_b64_tr_b16 %6, %9 offset:2048\n\tds_read_b64_tr_b16 %7, %9 offset:3072\n\t"
                 "s_waitcnt lgkmcnt(0)"
                 : "=&v"(f.r[0][0][0]), "=&v"(f.r[0][0][1]), "=&v"(f.r[0][1][0]), "=&v"(f.r[0][1][1]), "=&v"(f.r[1][0][0]), "=&v"(f.r[1][0][1]), "=&v"(f.r[1][1][0]), "=&v"(f.r[1][1][1])
                 : "v"(b0), "v"(b1) : "memory");
}
__device__ __forceinline__ void v_read_all(VFrag<128>& f, const unsigned char* vimg, int sub, int lane) {
    const int h = lane >> 5, i16 = lane & 15, qq = i16 >> 2, pp = i16 & 3, g1 = (lane >> 4) & 1, k0 = 32 * sub + 4 * h + qq;
    unsigned b[4];
#pragma unroll
    for (int db = 0; db < 4; ++db) b[db] = (unsigned)(uintptr_t)(vimg + vaddr128(k0, db * 4 + 2 * g1 + (pp >> 1)) + (pp & 1) * 8);
    asm volatile("ds_read_b64_tr_b16 %0, %16\n\tds_read_b64_tr_b16 %1, %16 offset:2048\n\tds_read_b64_tr_b16 %2, %17\n\tds_read_b64_tr_b16 %3, %17 offset:2048\n\t"
                 "ds_read_b64_tr_b16 %4, %18\n\tds_read_b64_tr_b16 %5, %18 offset:2048\n\tds_read_b64_tr_b16 %6, %19\n\tds_read_b64_tr_b16 %7, %19 offset:2048\n\t"
                 "ds_read_b64_tr_b16 %8, %16 offset:4096\n\tds_read_b64_tr_b16 %9, %16 offset:6144\n\tds_read_b64_tr_b16 %10, %17 offset:4096\n\tds_read_b64_tr_b16 %11, %17 offset:6144\n\t"
                 "ds_read_b64_tr_b16 %12, %18 offset:4096\n\tds_read_b64_tr_b16 %13, %18 offset:6144\n\tds_read_b64_tr_b16 %14, %19 offset:4096\n\tds_read_b64_tr_b16 %15, %19 offset:6144\n\t"
                 "s_waitcnt lgkmcnt(0)"
                 : "=&v"(f.r[0][0][0]), "=&v"(f.r[0][0][1]), "=&v"(f.r[0][1][0]), "=&v"(f.r[0][1][1]), "=&v"(f.r[0][2][0]), "=&v"(f.r[0][2][1]), "=&v"(f.r[0][3][0]), "=&v"(f.r[0][3][1]),
                   "=&v"(f.r[1][0][0]), "=&v"(f.r[1][0][1]), "=&v"(f.r[1][1][0]), "=&v"(f.r[1][1][1]), "=&v"(f.r[1][2][0]), "=&v"(f.r[1][2][1]), "=&v"(f.r[1][3][0]), "=&v"(f.r[1][3][1])
                 : "v"(b[0]), "v"(b[1]), "v"(b[2]), "v"(b[3]) : "memory");
}
template <int DV> __device__ __forceinline__ void pv_sub(const f32x16& pr, const VFrag<DV>& f, f32x16 (&o)[DV / 32]) {
#pragma unroll
    for (int s2 = 0; s2 < 2; ++s2) {
        u32x4 pw; pw.x = cvt_pk_bf16(pr[8 * s2 + 0], pr[8 * s2 + 1]); pw.y = cvt_pk_bf16(pr[8 * s2 + 2], pr[8 * s2 + 3]);
        pw.z = cvt_pk_bf16(pr[8 * s2 + 4], pr[8 * s2 + 5]); pw.w = cvt_pk_bf16(pr[8 * s2 + 6], pr[8 * s2 + 7]);
        const bf16x8 pf = __builtin_bit_cast(bf16x8, pw);
#pragma unroll
        for (int db = 0; db < DV / 32; ++db) { const s16x4 lo = f.r[s2][db][0], hi = f.r[s2][db][1];
            bf16x8 vf; vf[0] = lo[0]; vf[1] = lo[1]; vf[2] = lo[2]; vf[3] = lo[3]; vf[4] = hi[0]; vf[5] = hi[1]; vf[6] = hi[2]; vf[7] = hi[3];
            o[db] = MFMA32(vf, pf, o[db]); }
    }
}
template <int DV> __device__ __forceinline__ void attn_sub_auto(const bf16x8 (&qf)[5], const unsigned char* kimg, const unsigned char* vimg, int sub, int key0, int tqw, int tq, int h,
                                                               int whi, bool lbit, WaveAcc<DV>& a, int lane) {
    f32x16 s = qk_sub(*(const bf16x8 (*)[4])&qf, kimg, sub, lane);
    { const int r32 = lane & 31, tk = key0 + r32; const unsigned hi = __float_as_uint((float)(tk >> 8)) >> 16, lo = __float_as_uint((float)(tk & 255)) & 0xffff0000u;
      u32x4 kw; kw.x = (lane < 32) ? (hi | lo) : 0u; kw.y = 0u; kw.z = 0u; kw.w = 0u;
      s = MFMA32(__builtin_bit_cast(bf16x8, kw), qf[4], s); }
    VFrag<DV> vf; v_read_all(vf, vimg, sub, lane);
    const bool interior = (tqw - (key0 + 31) >= 0) && (tqw + 31 - key0 < whi) && __all(lbit);
    if (!interior) { const int d0 = tq - key0 - 4 * h;
#pragma unroll
        for (int r = 0; r < 16; ++r) { const int dist = d0 - ((r & 3) + 8 * (r >> 2)); s[r] = (lbit && dist >= 0 && dist < whi) ? s[r] : -INFINITY; } }
    float tmax = fmaxf(fmaxf(s[0], s[1]), fmaxf(s[2], s[3]));
#pragma unroll
    for (int r = 4; r < 16; r += 4) tmax = fmaxf(tmax, fmaxf(fmaxf(s[r], s[r + 1]), fmaxf(s[r + 2], s[r + 3])));
    tmax = swap_max(tmax);
    if (!__all(tmax - a.m <= 8.0f)) {
        const float mnew = fmaxf(a.m, tmax), alpha = fast_exp2((a.m - mnew) * LOG2E);
        a.l *= alpha; a.m = mnew;
#pragma unroll
        for (int d = 0; d < DV / 32; ++d)
#pragma unroll
            for (int r = 0; r < 16; ++r) a.o[d][r] *= alpha;
    }
    const float nm = -a.m * LOG2E;
    float rs0 = 0.f, rs1 = 0.f;
#pragma unroll
    for (int r = 0; r < 16; r += 2) { s[r] = fast_exp2(__builtin_fmaf(s[r], LOG2E, nm)); s[r + 1] = fast_exp2(__builtin_fmaf(s[r + 1], LOG2E, nm)); rs0 += s[r]; rs1 += s[r + 1]; }
    a.l += rs0 + rs1;
    pv_sub<DV>(s, vf, a.o);
}
__device__ __forceinline__ void load_q(bf16x8 (&qf)[5], const bf16_t* qp  , float slope, int lane) {
#pragma unroll
    for (int ks = 0; ks < 4; ++ks) qf[ks] = *(const bf16x8*)(qp + 16 * ks);
    u32x4 qw; qw.x = (lane < 32) ? ((__float_as_uint(256.0f * slope) >> 16) | (__float_as_uint(slope) & 0xffff0000u)) : 0u; qw.y = 0u; qw.z = 0u; qw.w = 0u;
    qf[4] = __builtin_bit_cast(bf16x8, qw);
}
template <int DV> __device__ __forceinline__ void store_o(const f32x16 (&o)[DV / 32], float sc, bf16_t* orow, int h) {
#pragma unroll
    for (int db = 0; db < DV / 32; ++db)
#pragma unroll
        for (int rg = 0; rg < 4; ++rg) { u32x2 w; w.x = cvt_pk_bf16(o[db][4 * rg] * sc, o[db][4 * rg + 1] * sc); w.y = cvt_pk_bf16(o[db][4 * rg + 2] * sc, o[db][4 * rg + 3] * sc);
            *(u32x2*)(orow + db * 32 + 8 * rg + 4 * h) = w; }
}


template <bool SINK> __device__ __forceinline__ void attn_window_unit(KP p, int l, int b, int hkv, int qt, int W, int cq, int ck, int cv, bf16_t* outbuf, unsigned char* lds) {
    const int tid = hidden_tid(), lane = tid & 63, wv = __builtin_amdgcn_readfirstlane(tid >> 6), r32 = lane & 31, h = lane >> 5, g = wv & 3, qsub = wv >> 2;
    const int head = hkv * 4 + g, t0 = qt * 64, tqw = t0 + 32 * qsub, tq = tqw + r32;
    const bf16_t* z = (const bf16_t*)(p->ws + OFF_Z);
    const float slope = exp2f(-(float)(head + 1));
    KVSrc src; src.k = (const char*)(z + (size_t)b * NS * ZW + ck + hkv * 64); src.v = (const char*)(z + (size_t)b * NS * ZW + cv + hkv * 64); src.kstride = ZW * 2; src.vstride = ZW * 2;
    int klo = t0 - W + 1; klo = klo < 0 ? 0 : klo; const int kt0 = klo >> 6, kt1 = qt;
    WaveAcc<64> a; acc_init(a);
    KVRing<1, 64> ring; ring.init(src, tid);
    const int nt = kt1 - kt0 + 1;
    for (int j = 0; j < RING_AHEAD && j < nt; ++j) ring.issue((kt1 - j) * 64, j, lds);
    bf16x8 qf[5]; load_q(qf, z + ((size_t)b * NS + tq) * ZW + cq + head * 64 + 8 * h, slope, lane);
    asm volatile("" :: "v"(qf[0]), "v"(qf[1]), "v"(qf[2]), "v"(qf[3]));
    asm volatile(".p2align 8");
    for (int t = 0; t < nt; ++t) {
        const int kt = kt1 - t, buf = t & (RING_NB - 1);
        ring.wait_bar(nt - 1 - t);
        if (t + RING_AHEAD < nt) ring.issue((kt - RING_AHEAD) * 64, (t + RING_AHEAD) & (RING_NB - 1), lds);
        const unsigned char* kimg = ring.kimg(lds, buf, 0); const unsigned char* vimg = ring.vimg(lds, buf);
#pragma unroll
        for (int sr = 0; sr < 2; ++sr) { const int sub = 1 - sr, key0 = kt * 64 + 32 * sub;
            if (key0 <= tqw + 31 && key0 + 31 >= tqw - W + 1) attn_sub_auto<64>(qf, kimg, vimg, sub, key0, tqw, tq, h, W, true, a, lane); }
    }
    __syncthreads();
    float den = swap_sum(a.l);
    if (SINK) den += fast_exp2((p->sinks[l * 8 + head] + slope * (float)tq - a.m) * LOG2E);
    store_o<64>(a.o, 1.0f / den, outbuf + ((size_t)b * NS + tq) * 512 + head * 64, h);
}

#ifndef EXPER
#define EXPER 0
#endif
__device__ __forceinline__ void attn_diff_unit(KP p, int l, int b, int hd, int qt, unsigned char* lds, const int shadow = 0) {
    const int tid = hidden_tid(), lane = tid & 63, wv = __builtin_amdgcn_readfirstlane(tid >> 6), r32 = lane & 31, h = lane >> 5, c = wv & 1, qsub = wv >> 1;
    const int t0 = qt * 128, tqw = t0 + 32 * qsub, tq = tqw + r32;
    const bf16_t* z = (const bf16_t*)(p->ws + OFF_Z);
    KVSrc src; src.k = (const char*)(z + (size_t)b * NS * ZW + C_KB + hd * 128); src.v = (const char*)(z + (size_t)b * NS * ZW + C_VB + hd * 128); src.kstride = ZW * 2; src.vstride = ZW * 2;
    const int kt1 = 2 * qt + 1;
    WaveAcc<128> a; acc_init(a);
    KVRing<2, 128> ring; ring.init(src, tid);
    const int nt = kt1 + 1;
    for (int j = 0; j < RING_AHEAD && j < nt; ++j) ring.issue((kt1 - j) * 64, j, lds);
    bf16x8 qf[5]; load_q(qf, z + ((size_t)b * NS + tq) * ZW + C_QB + hd * 128 + c * 64 + 8 * h, exp2f(-2.0f * (float)(hd + 1)), lane);
    asm volatile("" :: "v"(qf[0]), "v"(qf[1]), "v"(qf[2]), "v"(qf[3]));
    asm volatile(".p2align 8");
    for (int t = 0; t < nt; ++t) {
        const int kt = kt1 - t, buf = t & (RING_NB - 1);
        ring.wait_bar(nt - 1 - t);
        if (t + RING_AHEAD < nt) ring.issue((kt - RING_AHEAD) * 64, (t + RING_AHEAD) & (RING_NB - 1), lds);
        const unsigned char* kimg = ring.kimg(lds, buf, c); const unsigned char* vimg = ring.vimg(lds, buf);
#pragma unroll
        for (int sr = 0; sr < 2; ++sr) { const int sub = 1 - sr, key0 = kt * 64 + 32 * sub;
            if (key0 <= tqw + 31) {
                if (shadow && EXPER == 1) { }
                else attn_sub_auto<128>(qf, kimg, vimg, sub, key0, tqw, tq, h, 1 << 30, true, a, lane); } }
    }
    __syncthreads();
    const float lam_init = 0.8f - 0.6f * expf(-0.3f * (float)l);
    const float lam = ((const float*)p->ws)[CW_LAM + l];
    const float inv = 1.0f / swap_sum(a.l);
    float* ex = (float*)lds;
    if (c == 1) {
#pragma unroll
        for (int db = 0; db < 4; ++db)
#pragma unroll
            for (int r = 0; r < 16; ++r) ex[(qsub * 128 + db * 32 + crow(r, h)) * 32 + r32] = a.o[db][r] * inv;
    }
    __syncthreads();
    if (c == 0) {
        float ss = 0.f;
#pragma unroll
        for (int db = 0; db < 4; ++db)
#pragma unroll
            for (int r = 0; r < 16; ++r) { const float v = a.o[db][r] * inv - lam * ex[(qsub * 128 + db * 32 + crow(r, h)) * 32 + r32]; a.o[db][r] = v; ss += v * v; }
        ss = swap_sum(ss);
        const float rn = (1.0f - lam_init) / sqrtf(ss * (1.0f / 128.0f) + 1e-5f);
        const float* sg = p->diff_subln_g + (size_t)l * 128;
        bf16_t* orow = (shadow ? (bf16_t*)(p->ws + OFF_MSCR) : (bf16_t*)(p->ws + OFF_OABC) + (size_t)1 * NTOK * 512) + ((size_t)b * NS + tq) * 512 + hd * 128;
#pragma unroll
        for (int db = 0; db < 4; ++db)
#pragma unroll
            for (int rg = 0; rg < 4; ++rg) { const int d = db * 32 + 8 * rg + 4 * h; const f32x4 gv = *(const f32x4*)(sg + d);
                u32x2 w; w.x = cvt_pk_bf16(a.o[db][4 * rg] * rn * gv[0], a.o[db][4 * rg + 1] * rn * gv[1]); w.y = cvt_pk_bf16(a.o[db][4 * rg + 2] * rn * gv[2], a.o[db][4 * rg + 3] * rn * gv[3]);
                *(u32x2*)(orow + d) = w; }
    }
    __syncthreads();
}

#define AT_IMP   (AT_MISC)
#define AT_SELM  (AT_MISC + 34816)
__device__ __forceinline__ void attn_nsa_unit(KP p, int l, int b, int hkv, int qt, unsigned char* lds) {
    const int tid = hidden_tid(), lane = tid & 63, wv = __builtin_amdgcn_readfirstlane(tid >> 6), r32 = lane & 31, h = lane >> 5, g = wv & 3, qsub = wv >> 2;
    const int head = hkv * 4 + g, t0 = qt * 64, tqw = t0 + 32 * qsub, tq = tqw + r32;
    const bf16_t* z = (const bf16_t*)(p->ws + OFF_Z);
    bf16x8 qf[5]; load_q(qf, z + ((size_t)b * NS + tq) * ZW + C_QC + head * 64 + 8 * h, exp2f(-(float)(head + 1)), lane);
    float* imp = (float*)(lds + AT_IMP); unsigned* selm = (unsigned*)(lds + AT_SELM);
    KVRing<1, 64> ring;
    f32x16 ocmp[2];
    {
        const bf16_t* kvc = (const bf16_t*)(p->ws + OFF_KVC);
        KVSrc cs; cs.k = (const char*)(kvc + ((size_t)(0 * 16 + b) * 2 + hkv) * 128 * 64); cs.v = (const char*)(kvc + ((size_t)(1 * 16 + b) * 2 + hkv) * 128 * 64); cs.kstride = 128; cs.vstride = 128;
        ring.init(cs, tid); ring.issue(0, 0, lds); ring.issue(64, 1, lds);
        if (tid == 0) selm[64] = 0u;
        ring.wait_bar(0);
        f32x16 sc[4];
#pragma unroll
        for (int st = 0; st < 4; ++st) sc[st] = qk_sub(*(const bf16x8 (*)[4])&qf, ring.kimg(lds, st >> 1, 0), st & 1, lane);
        const int nvalid = tq >= 31 ? min(127, ((tq - 31) >> 4) + 1) : 0;
        float mx = -1e30f;
#pragma unroll
        for (int st = 0; st < 4; ++st)
#pragma unroll
            for (int r = 0; r < 16; ++r) { const int cidx = 32 * st + crow(r, h); const float v = cidx < nvalid ? sc[st][r] * LOG2E : -INFINITY; sc[st][r] = v; mx = fmaxf(mx, v); }
        mx = swap_max(mx);
        float ls = 0.f;
#pragma unroll
        for (int st = 0; st < 4; ++st)
#pragma unroll
            for (int r = 0; r < 16; ++r) { sc[st][r] = fast_exp2(sc[st][r] - mx); ls += sc[st][r]; }
        ls = swap_sum(ls); const float inv = ls > 0.f ? 1.0f / ls : 0.f;
        float Bv[4][4];
#pragma unroll
        for (int st = 0; st < 4; ++st)
#pragma unroll
            for (int r = 0; r < 16; ++r) sc[st][r] *= inv;
#pragma unroll
        for (int st = 0; st < 4; ++st)
#pragma unroll
            for (int g4 = 0; g4 < 4; ++g4) Bv[st][g4] = swap_other(sc[st][4 * g4 + 3], h);
#pragma unroll
        for (int st = 0; st < 4; ++st)
#pragma unroll
            for (int g4 = 0; g4 < 4; ++g4) {
                const float A = sc[st][4 * g4] + sc[st][4 * g4 + 1] + sc[st][4 * g4 + 2] + 0.5f * sc[st][4 * g4 + 3];
                const float prevlo = g4 > 0 ? Bv[st][g4 - 1] : (st > 0 ? Bv[st - 1][3] : 0.f);
                const float prev = h ? Bv[st][g4] : prevlo;
                imp[(g * 64 + qsub * 32 + r32) * 33 + 8 * st + 2 * g4 + h] = A + 0.5f * prev;
            }
#pragma unroll
        for (int d = 0; d < 2; ++d)
#pragma unroll
            for (int r = 0; r < 16; ++r) ocmp[d][r] = 0.f;
#pragma unroll
        for (int st = 0; st < 4; ++st) { VFrag<64> vf; v_read_all(vf, ring.vimg(lds, st >> 1), st & 1, lane); pv_sub<64>(sc[st], vf, ocmp); }
    }
    __syncthreads();
    const int cur = qt;
    for (int i = tid; i < 64 * 32; i += NTHREADS) { const int q = i >> 5, n = i & 31; imp[q * 33 + n] = (imp[q * 33 + n] + imp[(64 + q) * 33 + n]) + (imp[(128 + q) * 33 + n] + imp[(192 + q) * 33 + n]); }
    __syncthreads();
#pragma unroll 1
    for (int ps = 0; ps < 4; ++ps) {
        const int i = ps * NTHREADS + tid, q = i >> 5, n = i & 31;
        const bool forced = (n == 0) | (n == cur) | (n == cur - 1);
        const float kn = forced ? INFINITY : imp[q * 33 + n];
        int rank = 0;
#pragma unroll
        for (int m2 = 0; m2 < 32; ++m2) { const float km = __int_as_float(__builtin_amdgcn_ds_bpermute(((lane & 32) + m2) << 2, __float_as_int(kn)));
            rank += (m2 <= cur) && (m2 != n) && ((km > kn) || (km == kn && m2 < n)); }
        const bool sel = (n <= cur) && (rank < 16);
        const unsigned long long bal = __ballot(sel);
        if ((lane & 31) == 0) { const unsigned mk = (unsigned)(lane ? (bal >> 32) : bal); selm[q] = mk; atomicOr(&selm[64], mk); }
    }
    __syncthreads();
    const unsigned mymask = selm[qsub * 32 + r32]; unsigned um = __builtin_amdgcn_readfirstlane(selm[64]);
    WaveAcc<64> a; acc_init(a);
    {
        KVSrc src; src.k = (const char*)(z + (size_t)b * NS * ZW + C_KSL + hkv * 64); src.v = (const char*)(z + (size_t)b * NS * ZW + C_VSL + hkv * 64); src.kstride = ZW * 2; src.vstride = ZW * 2;
        ring.init(src, tid);
        unsigned m_issue = um; int nis = 0, ncp = 0; const int ntl = __popc(um);
        for (int j = 0; j < RING_AHEAD && m_issue; ++j) { const int kt = 31 - __clz((int)m_issue); m_issue &= ~(1u << kt); ring.issue(kt * 64, nis & (RING_NB - 1), lds); ++nis; }
    asm volatile(".p2align 8");
        while (um) {
            const int kt = 31 - __clz((int)um); um &= ~(1u << kt); const int buf = ncp & (RING_NB - 1);
            ring.wait_bar(nis - 1 - ncp);
            if (m_issue) { const int ktn = 31 - __clz((int)m_issue); m_issue &= ~(1u << ktn); ring.issue(ktn * 64, nis & (RING_NB - 1), lds); ++nis; }
            const bool lbit = (mymask >> kt) & 1u;
            if (__any(lbit)) {
                const unsigned char* kimg = ring.kimg(lds, buf, 0); const unsigned char* vimg = ring.vimg(lds, buf);
#pragma unroll
                for (int sr = 0; sr < 2; ++sr) { const int sub = 1 - sr, key0 = kt * 64 + 32 * sub;
                    if (key0 <= tqw + 31) attn_sub_auto<64>(qf, kimg, vimg, sub, key0, tqw, tq, h, 1 << 30, lbit, a, lane); }
            }
            ++ncp;
        }
        (void)ntl;
    }
    {
        const size_t tok = (size_t)b * NS + tq;
        const bf16_t* gp = z + tok * ZW + C_GN + head * 3;
        const float gc = bf2f(gp[0]), gs = bf2f(gp[1]) / swap_sum(a.l), gw = bf2f(gp[2]);
        const bf16_t* ow = (const bf16_t*)(p->ws + OFF_OWIN) + tok * 512 + head * 64;
        bf16_t* oc = (bf16_t*)(p->ws + OFF_OABC) + (size_t)2 * NTOK * 512 + tok * 512 + head * 64;
#pragma unroll
        for (int db = 0; db < 2; ++db)
#pragma unroll
            for (int rg = 0; rg < 4; ++rg) { const int d = db * 32 + 8 * rg + 4 * h; const u32x2 wv2 = *(const u32x2*)(ow + d);
                const float o0 = gc * ocmp[db][4 * rg] + gs * a.o[db][4 * rg] + gw * bflo(wv2.x), o1 = gc * ocmp[db][4 * rg + 1] + gs * a.o[db][4 * rg + 1] + gw * bfhi(wv2.x);
                const float o2 = gc * ocmp[db][4 * rg + 2] + gs * a.o[db][4 * rg + 2] + gw * bflo(wv2.y), o3 = gc * ocmp[db][4 * rg + 3] + gs * a.o[db][4 * rg + 3] + gw * bfhi(wv2.y);
                u32x2 w; w.x = cvt_pk_bf16(o0, o1); w.y = cvt_pk_bf16(o2, o3); *(u32x2*)(oc + d) = w; }
    }
    __syncthreads();
}

__device__ __forceinline__ void compress_unit(KP p, int l, int u, unsigned char* lds) {
    char* ws = p->ws;
    const int kv = u >> 4, rt = u & 15;
    GemmOperands g; g.Abase = ws + OFF_Z; g.kstride = ZW * 2; g.K = 2048; g.Bbase = ws + OFF_WC1 + ((size_t)(l * 2 + kv) * 256) * 2048 * 2;
GEMM_STAGE_IDS();
#pragma unroll
    for (int i = 0; i < 4; ++i) { const int row = rt * 256 + TILE_ROW(i), bh = row >> 7, b = bh >> 1, hk = bh & 1; int c = row & 127; c = c > 126 ? 126 : c;
        g.aoff[i] = (unsigned)((((size_t)b * NS + 16 * c) * ZW + (kv ? C_VCM : C_KCM) + hk * 64 + cS) * 2); } g.boff = (unsigned)((rS * 2048 + cS) * 2);
    f32x4 acc[2][2][4][2];
    gemm_unit(g, (bf16_t*)lds, acc);
    GEMM_LANE_IDS();
    const float* cb = (const float*)(ws + OFF_CBIAS) + (size_t)(l * 2 + kv) * 4 * 256; const float* cb1 = p->cmp_b1 + (l * 2 + kv) * 256;
#pragma unroll
    for (int bj = 0; bj < 2; ++bj)
#pragma unroll
        for (int n = 0; n < 2; ++n) { const int col = bj * 128 + wc * 32 + n * 16 + fq * 4; const f32x4 bv = (*(const f32x4*)(cb + col) + *(const f32x4*)(cb + 256 + col)) + (*(const f32x4*)(cb + 512 + col) + *(const f32x4*)(cb + 768 + col)) + *(const f32x4*)(cb1 + col);
#pragma unroll
            for (int ai = 0; ai < 2; ++ai)
#pragma unroll
                for (int m = 0; m < 4; ++m) { const int row = ai * 128 + wr * 64 + m * 16 + fr; f32x4 v = acc[ai][bj][m][n] + bv;
#pragma unroll
                    for (int j = 0; j < 4; ++j) { const float x = v[j]; v[j] = x * sigmoidf_(1.5957691216057308f * (x + 0.044715f * x * x * x)); }
                    u32x2 w; w.x = cvt_pk_bf16(v[0], v[1]); w.y = cvt_pk_bf16(v[2], v[3]); *(u32x2*)(lds + row * 528 + col * 2) = w; } }
    __syncthreads();
    {
        const bf16_t* w2 = (const bf16_t*)(ws + OFF_WC2) + (size_t)(l * 2 + kv) * 64 * 256;
        f32x4 c2[2][4];
#pragma unroll
        for (int mt = 0; mt < 2; ++mt)
#pragma unroll
            for (int nt = 0; nt < 4; ++nt) c2[mt][nt] = (f32x4){0.f, 0.f, 0.f, 0.f};
#pragma unroll
        for (int ks = 0; ks < 8; ++ks) {
            bf16x8 af[2], bfr[4];
#pragma unroll
            for (int mt = 0; mt < 2; ++mt) af[mt] = *(const bf16x8*)(lds + (wid * 32 + mt * 16 + fr) * 528 + (ks * 32 + fq * 8) * 2);
#pragma unroll
            for (int nt = 0; nt < 4; ++nt) bfr[nt] = *(const bf16x8*)(w2 + (size_t)(nt * 16 + fr) * 256 + ks * 32 + fq * 8);
#pragma unroll
            for (int mt = 0; mt < 2; ++mt)
#pragma unroll
                for (int nt = 0; nt < 4; ++nt) c2[mt][nt] = __builtin_amdgcn_mfma_f32_16x16x32_bf16(af[mt], bfr[nt], c2[mt][nt], 0, 0, 0);
        }
        bf16_t* kvc = (bf16_t*)(ws + OFF_KVC) + (size_t)kv * 16 * 2 * 128 * 64;
        const float* b2 = p->cmp_b2 + (l * 2 + kv) * 64;
#pragma unroll
        for (int mt = 0; mt < 2; ++mt)
#pragma unroll
            for (int nt = 0; nt < 4; ++nt)
#pragma unroll
                for (int r = 0; r < 4; ++r) { const int row = rt * 256 + wid * 32 + mt * 16 + 4 * fq + r, col = nt * 16 + fr;
                    kvc[(size_t)row * 64 + col] = f2bf(c2[mt][nt][r] + b2[col]); }
    }
    __syncthreads();
}

#define RT_HS    0
#define RT_LG    132096
#define RT_HIST  (RT_LG + 8448)
#ifndef REPN2
#define REPN2 1
#endif
__device__ __forceinline__ void phase_norm2_router(KP p, int l, unsigned char* lds) {
  for (int shadow = 0; shadow < REPN2; ++shadow) {
    char* ws = p->ws; const int tid = hidden_tid(), lane = tid & 63, wv = __builtin_amdgcn_readfirstlane(tid >> 6);
    const float* modl = (const float*)(ws + OFF_MOD) + (size_t)l * 16 * 6144; const float* g = p->norm2_g + (size_t)l * 1024;
    const bf16_t* xrb = (const bf16_t*)(ws + OFF_XR);
    float* LG = (float*)(lds + RT_LG); int* hist = (int*)(lds + RT_HIST); int* basep = hist + 32;
    unsigned* ctrl = (unsigned*)ws;
    const bf16_t* wrt = (const bf16_t*)(ws + OFF_WRT) + (size_t)l * 2 * 32 * 1024;
    for (int chunk = hidden_bid(); chunk < NTOK / 64; chunk += gridDim.x) {
        if (tid < 32) hist[tid] = 0;
        {
            const int rowa = chunk * 64 + wv * 8, b = rowa >> 11;
            f32x4 gg[4], sc[4], sh[4]; u32x2 xn[4];
#pragma unroll
            for (int j = 0; j < 4; ++j) { const int col = 256 * j + 4 * lane; gg[j] = *(const f32x4*)(g + col); sc[j] = *(const f32x4*)(modl + (size_t)b * 6144 + 4096 + col); sh[j] = *(const f32x4*)(modl + (size_t)b * 6144 + 3072 + col);
                xn[j] = *(const u32x2*)(xrb + (size_t)rowa * 1024 + col); }
            for (int i = 0; i < 8; ++i) {
                const int rl = wv * 8 + i, row = rowa + i;
                f32x4 v[4]; float ss = 0.f;
#pragma unroll
                for (int j = 0; j < 4; ++j) { v[j] = (f32x4){bflo(xn[j].x), bfhi(xn[j].x), bflo(xn[j].y), bfhi(xn[j].y)};
                    ss += v[j][0] * v[j][0] + v[j][1] * v[j][1] + v[j][2] * v[j][2] + v[j][3] * v[j][3]; }
                if (i + 1 < 8) {
#pragma unroll
                    for (int j = 0; j < 4; ++j) { const int col = 256 * j + 4 * lane; xn[j] = *(const u32x2*)(xrb + (size_t)(row + 1) * 1024 + col); } }
                ss = wave_sum(ss, lane); const float r = 1.0f / sqrtf(ss * (1.0f / 1024.0f) + 1e-5f);
#pragma unroll
                for (int j = 0; j < 4; ++j) { const int col = 256 * j + 4 * lane;
                    float o[4];
#pragma unroll
                    for (int q = 0; q < 4; ++q) o[q] = v[j][q] * r * gg[j][q] * (1.0f + sc[j][q]) + sh[j][q];
                    u32x2 w; w.x = cvt_pk_bf16(o[0], o[1]); w.y = cvt_pk_bf16(o[2], o[3]);
                    if (!shadow) *(unsigned*)((unsigned char*)(ws + OFF_H8) + (size_t)row * 1024 + col) = pk4_fp8(o[0], o[1], o[2], o[3]);
                    *(u32x2*)(lds + RT_HS + rl * 2064 + col * 2) = w; }
            }
        }
        __syncthreads();
        {
            const int mt = wv & 3, nt = wv >> 2, fr = lane & 15, fq = lane >> 4;
            f32x4 acc = (f32x4){0.f, 0.f, 0.f, 0.f};
            const bf16_t* wh = wrt + ((size_t)nt * 32 * 64 + lane) * 8; const bf16_t* wl = wh + 32768;
            const unsigned char* ap = lds + RT_HS + (mt * 16 + fr) * 2064 + fq * 16;
#pragma unroll 8
            for (int ks = 0; ks < 32; ++ks) { const bf16x8 a = *(const bf16x8*)(ap + ks * 64); const bf16x8 bh = *(const bf16x8*)(wh + ks * 512), bl = *(const bf16x8*)(wl + ks * 512);
                acc = __builtin_amdgcn_mfma_f32_16x16x32_bf16(a, bh, acc, 0, 0, 0); acc = __builtin_amdgcn_mfma_f32_16x16x32_bf16(a, bl, acc, 0, 0, 0); }
            const float rb = p->router_b[l * 32 + nt * 16 + fr];
#pragma unroll
            for (int r = 0; r < 4; ++r) LG[(mt * 16 + 4 * fq + r) * 33 + nt * 16 + fr] = acc[r] + rb;
        }
        __syncthreads();
        int se[4], sp[4]; float sg[4];
        if (tid < 64) {
            unsigned taken = 0u; float tv[4];
#pragma unroll
            for (int k = 0; k < 4; ++k) { float best = -INFINITY; int bi = 0;
#pragma unroll 4
                for (int e = 0; e < 32; ++e) { const float v = LG[tid * 33 + e]; if (!((taken >> e) & 1u) && v > best) { best = v; bi = e; } }
                taken |= 1u << bi; se[k] = bi; tv[k] = best; }
            float den = 0.f;
#pragma unroll
            for (int k = 0; k < 4; ++k) { sg[k] = __expf(tv[k] - tv[0]); den += sg[k]; }
#pragma unroll
            for (int k = 0; k < 4; ++k) { sg[k] /= den; sp[k] = atomicAdd(&hist[se[k]], 1); }
        }
        __syncthreads();
        if (tid < 32) { const int c = hist[tid]; basep[tid] = (c && !shadow) ? (int)atomicAdd(&ctrl[CW_ECNT(l, tid)], (unsigned)c) : 0; }
        __syncthreads();
        if (tid < 64 && !shadow) { const int tok = chunk * 64 + tid;
#pragma unroll
            for (int k = 0; k < 4; ++k) { const int pos = basep[se[k]] + sp[k];
                ((int*)(ws + OFF_TOKE))[tok * 4 + k] = se[k]; ((int*)(ws + OFF_TOKP))[tok * 4 + k] = pos; ((float*)(ws + OFF_TOKG))[tok * 4 + k] = sg[k];
                ((int*)(ws + OFF_BUCK))[(size_t)se[k] * NTOK + pos] = tok; } }
        __syncthreads();
    }
}
  __syncthreads(); }


__device__ __forceinline__ void phase_combine(KP p, int l, unsigned char* lds) {
    char* ws = p->ws; const int tid = hidden_tid(), lane = tid & 63, wv = tid >> 6;
    int* tbl = (int*)lds; moe_tables(p, l, tbl);
    bf16_t* xr = (bf16_t*)(ws + OFF_XR); const bf16_t* y = (const bf16_t*)(ws + OFF_Y); bf16_t* hb = (bf16_t*)(ws + OFF_HB);
    const bool last = (l + 1 == NLAYER);
    for (int gw = hidden_bid() * 8 + wv; gw < NTOK / 16; gw += gridDim.x * 8) {
        const int row0 = gw * 16, b = row0 >> 11;
        const float* modl = (const float*)(ws + OFF_MOD) + ((size_t)l * 16 + b) * 6144;
        const float* gn = last ? p->final_g : p->norm1_g + (size_t)(l + 1) * 1024;
        const float* modn = (const float*)(ws + OFF_MOD) + ((size_t)(last ? l : l + 1) * 16 + b) * 6144;
        f32x4 g2[4], gg[4], sc[4], sh[4];
#pragma unroll
        for (int j = 0; j < 4; ++j) { const int col = 256 * j + 4 * lane; g2[j] = *(const f32x4*)(modl + 5120 + col); gg[j] = *(const f32x4*)(gn + col);
            sc[j] = last ? (f32x4){0.f, 0.f, 0.f, 0.f} : *(const f32x4*)(modn + 1024 + col); sh[j] = last ? (f32x4){0.f, 0.f, 0.f, 0.f} : *(const f32x4*)(modn + col); }
        typedef int i32x4_ __attribute__((ext_vector_type(4)));
        i32x4_ te = *(const i32x4_*)((const int*)(ws + OFF_TOKE) + (size_t)row0 * 4), tp = *(const i32x4_*)((const int*)(ws + OFF_TOKP) + (size_t)row0 * 4);
        f32x4 tg = *(const f32x4*)((const float*)(ws + OFF_TOKG) + (size_t)row0 * 4);
        u32x2 xin[4]; u32x2 yin[4][4]; float gk[4];
        auto load_row = [&](int row, const i32x4_& e4, const i32x4_& p4, const f32x4& g4) {
#pragma unroll
            for (int k = 0; k < 4; ++k) { const bf16_t* yr = y + ((size_t)tbl[e4[k]] * 256 + p4[k]) * 1024; gk[k] = g4[k];
#pragma unroll
                for (int j = 0; j < 4; ++j) yin[k][j] = *(const u32x2*)(yr + 256 * j + 4 * lane); }
#pragma unroll
            for (int j = 0; j < 4; ++j) xin[j] = *(const u32x2*)(xr + (size_t)row * 1024 + 256 * j + 4 * lane);
        };
        load_row(row0, te, tp, tg);
        if (16 > 1) { te = *(const i32x4_*)((const int*)(ws + OFF_TOKE) + (size_t)(row0 + 1) * 4); tp = *(const i32x4_*)((const int*)(ws + OFF_TOKP) + (size_t)(row0 + 1) * 4); tg = *(const f32x4*)((const float*)(ws + OFF_TOKG) + (size_t)(row0 + 1) * 4); }
        for (int i = 0; i < 16; ++i) {
            const int row = row0 + i;
            f32x4 v[4]; float ss = 0.f;
#pragma unroll
            for (int j = 0; j < 4; ++j) { f32x4 m = (f32x4){0.f, 0.f, 0.f, 0.f};
#pragma unroll
                for (int k = 0; k < 4; ++k) { const u32x2 w = yin[k][j]; m[0] += gk[k] * bflo(w.x); m[1] += gk[k] * bfhi(w.x); m[2] += gk[k] * bflo(w.y); m[3] += gk[k] * bfhi(w.y); }
                v[j] = (f32x4){bflo(xin[j].x), bfhi(xin[j].x), bflo(xin[j].y), bfhi(xin[j].y)} + g2[j] * m;
                ss += v[j][0] * v[j][0] + v[j][1] * v[j][1] + v[j][2] * v[j][2] + v[j][3] * v[j][3]; }
            if (i + 1 < 16) { load_row(row + 1, te, tp, tg);
                if (i + 2 < 16) { te = *(const i32x4_*)((const int*)(ws + OFF_TOKE) + (size_t)(row + 2) * 4); tp = *(const i32x4_*)((const int*)(ws + OFF_TOKP) + (size_t)(row + 2) * 4); tg = *(const f32x4*)((const float*)(ws + OFF_TOKG) + (size_t)(row + 2) * 4); } }
            ss = wave_sum(ss, lane); const float r = 1.0f / sqrtf(ss * (1.0f / 1024.0f) + 1e-5f);
#pragma unroll
            for (int j = 0; j < 4; ++j) { const int col = 256 * j + 4 * lane;
                if (last) { *(f32x4*)(p->out + (size_t)row * 1024 + col) = v[j] * r * gg[j]; }
                else { u32x2 xw; xw.x = cvt_pk_bf16(v[j][0], v[j][1]); xw.y = cvt_pk_bf16(v[j][2], v[j][3]); *(u32x2*)(xr + (size_t)row * 1024 + col) = xw; float o[4];
#pragma unroll
                    for (int q = 0; q < 4; ++q) o[q] = v[j][q] * r * gg[j][q] * (1.0f + sc[j][q]) + sh[j][q];
#if INPROJ_FP8
                    *(unsigned*)((unsigned char*)hb + (size_t)row * 1024 + col) = pk4_fp8(o[0], o[1], o[2], o[3]); }
#else
                    u32x2 w; w.x = cvt_pk_bf16(o[0], o[1]); w.y = cvt_pk_bf16(o[2], o[3]); *(u32x2*)(hb + (size_t)row * 1024 + col) = w; }
#endif
            }
        }
    }
}

#ifndef SWA_IN_AT2
#define SWA_IN_AT2 1
#endif
#define LDS_QSLOT (LDS_BYTES - 64)
#define LDS_BARW  (LDS_BYTES - 16)
__device__ __forceinline__ int q_next(unsigned* ctr, unsigned char* lds) {
    __syncthreads();
    if (hidden_tid() == 0) *(int*)(lds + LDS_QSLOT) = (int)__hip_atomic_fetch_add(ctr, 1u, __ATOMIC_RELAXED, __HIP_MEMORY_SCOPE_AGENT);
    __syncthreads();
    return __builtin_amdgcn_readfirstlane(*(int*)(lds + LDS_QSLOT));
}
__device__ __forceinline__ void phase_at1(KP p, int lq, unsigned char* lds) {
    unsigned* ctrl = (unsigned*)p->ws; const int l = lq & 1;
#ifndef SUB
#define SUB -1
#endif
#ifndef DBLSUB
#define DBLSUB -1
#endif
#ifndef REP0
#define REP0 1
#endif
#ifndef REP1
#define REP1 1
#endif
#ifndef REP2
#define REP2 1
#endif
#ifndef REP3
#define REP3 1
#endif
#ifndef REP4
#define REP4 1
#endif
#define SUBON(k) ((SUB < 0 || SUB == (k)) && (lq < 2 || DBLSUB < 0 || DBLSUB == (k)))
    if (SUBON(0)) for (int rep = 0; rep < REP0; ++rep) for (;;) { const int u = q_next(ctrl + CW_QCTR(lq + 2 * rep, 0), lds); if (u >= 32) break; compress_unit(p, l, u, lds); }
    if (SUBON(1)) for (int rep = 0; rep < REP1; ++rep) for (;;) { const int u = q_next(ctrl + CW_QCTR(lq + 2 * rep, 1), lds); if (u >= 1024) break; attn_diff_unit(p, l, (u & 63) >> 2, u & 3, 15 - (u >> 6), lds, rep); if (COSCHED && rep == 0) xpose8_group(p, l, u, lds); }
    if (SUBON(2)) for (int rep = 0; rep < REP2; ++rep) for (;;) { const int u = q_next(ctrl + CW_QCTR(lq + 2 * rep, 2), lds); if (u >= 1024) break;
        attn_window_unit<false>(p, l, (u & 31) >> 1, u & 1, 31 - (u >> 5), 512, C_QC, C_KWN, C_VWN, (bf16_t*)(p->ws + OFF_OWIN), lds); if (COSCHED && rep == 0) xpose8_group(p, l, 1024 + u, lds); }
#if !SWA_IN_AT2
    if (SUBON(3)) for (int rep = 0; rep < REP3; ++rep) for (;;) { const int u = q_next(ctrl + CW_QCTR(lq + 2 * rep, 3), lds); if (u >= 1024) break;
        attn_window_unit<true>(p, l, (u & 31) >> 1, u & 1, 31 - (u >> 5), 128, C_QA, C_KA, C_VA, (bf16_t*)(p->ws + OFF_OABC), lds); if (COSCHED && rep == 0) xpose8_group(p, l, 2048 + u, lds); }
#endif
}
__device__ __forceinline__ void phase_at2(KP p, int lq, unsigned char* lds) {
    unsigned* ctrl = (unsigned*)p->ws; const int l = lq & 1;
    for (int rep = 0; rep < REP4; ++rep) for (;;) { const int u = q_next(ctrl + CW_QCTR(lq + 2 * rep, 4), lds); if (u >= 1024) break; attn_nsa_unit(p, l, (u & 31) >> 1, u & 1, 31 - (u >> 5), lds); if (COSCHED && INPROJ_FP8 && rep == 0 && lq == 0 && u < MISC_GROUPS) misc_group(p, u, lds); }
#if SWA_IN_AT2
    for (int rep = 0; rep < REP3; ++rep) for (;;) { const int u = q_next(ctrl + CW_QCTR(lq + 2 * rep, 3), lds); if (u >= 1024) break;
        attn_window_unit<true>(p, l, (u & 31) >> 1, u & 1, 31 - (u >> 5), 128, C_QA, C_KA, C_VA, (bf16_t*)(p->ws + OFF_OABC), lds); if (COSCHED && rep == 0) xpose8_group(p, l, 2048 + u, lds); }
#endif
}

#define NPHASE 20
__global__ void __launch_bounds__(NTHREADS, 2) mega(Params pv_unused) {
    KP p0 = (KP)__builtin_amdgcn_kernarg_segment_ptr();
    extern __shared__ __attribute__((aligned(16))) unsigned char lds0[];
    volatile LAS unsigned* st = (volatile LAS unsigned*)(lds0 + LDS_BARW);
    if (hidden_tid() == 0) { st[0] = 0u; st[1] = 0u; st[2] = 0u; st[3] = 0u; }
    __syncthreads();
    XcdBarrier bar = xcd_barrier_post((unsigned*)p0->ws, st);
    int ph = 0;
#ifndef DBL
#define DBL -1
#endif
    int qrep = 0; (void)qrep;
#define PHASE(body) { KP p = p0; asm volatile("" : "+s"(p)); unsigned char* lds = lds0; (void)lds; if (ph >= p->ph_lo && ph <= p->ph_hi) { body; if (ph < p->ph_hi) xcd_barrier(bar); } ++ph; }
#ifndef ONLY
#define ONLY -1
#endif
#ifndef DBLL
#define DBLL -1
#endif
    int lcur = -1; (void)lcur;
#define SEL(n, body) { if (ONLY < 0 || ONLY == (n)) { body; if (DBL == (n) && (DBLL < 0 || DBLL == lcur)) { xcd_barrier(bar); qrep = 2; body; qrep = 0; } } }
    PHASE(SEL(0, phase_prologue(p, lds)));
    PHASE(SEL(1, phase_norm_mod(p->x, p->norm1_g, (const float*)(p->ws + OFF_MOD), 0, 1024, (bf16_t*)(p->ws + OFF_HB))));
#pragma unroll
    for (int l = 0; l < NLAYER; ++l) { lcur = l;
        PHASE(SEL(2, phase_inproj(p, l, lds)));
        PHASE(SEL(3, phase_at1(p, l + qrep, lds)));
        PHASE(SEL(4, phase_at2(p, l + qrep, lds)));
        PHASE(SEL(5, phase_merge(p, l, lds)));
        PHASE(SEL(6, phase_outproj(p, l, lds)));
        PHASE(SEL(7, phase_norm2_router(p, l, lds)));
        PHASE(SEL(8, phase_moe1(p, l, lds)));
        PHASE(SEL(9, phase_moe2(p, l, lds)));
        PHASE(SEL(10, phase_combine(p, l, lds)));
    }
}

#ifndef MK_LAUNCHES
#define MK_LAUNCHES 1
#endif
extern "C" void kernel_launch(void* const* d_in, const int* in_sizes, int n_in, void* d_out, int out_size, void* d_ws, size_t ws_size, hipStream_t stream) {
    if (ws_size < WS_NEED) { fprintf(stderr, "workspace too small: %zu < %zu\n", ws_size, (size_t)WS_NEED); return; }
    static bool attr_done = false;
    if (!attr_done) { hipFuncSetAttribute((const void*)mega, hipFuncAttributeMaxDynamicSharedMemorySize, LDS_BYTES); attr_done = true; }
    Params p{};
    const float** f = (const float**)&p;
    for (int i = 0; i < 25; ++i) f[i] = (const float*)d_in[i];
    p.out = (float*)d_out; p.ws = (char*)d_ws;
    hipMemsetAsync(d_ws, 0, SZ_CTRL, stream);
    int dev = 0, cus = 0; hipGetDevice(&dev); hipDeviceGetAttribute(&cus, hipDeviceAttributeMultiprocessorCount, dev);
    const int grid = cus > 0 ? cus : 256;
#if MK_LAUNCHES == 1
    p.ph_lo = 0; p.ph_hi = NPHASE - 1;
    hipLaunchKernelGGL(mega, dim3(grid), dim3(NTHREADS), LDS_BYTES, stream, p);
#else
    for (int k = 0; k < NPHASE; ++k) { p.ph_lo = k; p.ph_hi = k; hipLaunchKernelGGL(mega, dim3(grid), dim3(NTHREADS), LDS_BYTES, stream, p); }
#endif
}
```

```cpp
#include <hip/hip_runtime.h>
#include <stdint.h>
#include <stdio.h>

#define NB      16
#define NS      2048
#define NTOK    (NB * NS)
#define DM      1024
#define NLAYER  2
#define ZW      6912
#define INW     6680
#define C_QA   0
#define C_KA   512
#define C_VA   640
#define C_QB   768
#define C_KB   1280
#define C_VB   1792
#define C_QC   2304
#define C_KCM  2816
#define C_VCM  2944
#define C_KSL  3072
#define C_VSL  3200
#define C_KWN  3328
#define C_VWN  3456
#define C_GM   3584
#define C_GN   6656
#define NEXP   32
#define PMAX   (NTOK * 4 + NEXP * 256)
#define NCMP   127

typedef unsigned short bf16_t;
typedef short bf16x8 __attribute__((ext_vector_type(8)));
typedef short bf16x4 __attribute__((ext_vector_type(4)));
typedef float f32x4 __attribute__((ext_vector_type(4)));
typedef float f32x2 __attribute__((ext_vector_type(2)));
typedef float f32x16 __attribute__((ext_vector_type(16)));
typedef unsigned u32x4 __attribute__((ext_vector_type(4)));
typedef unsigned u32x2 __attribute__((ext_vector_type(2)));

#define LAS __attribute__((address_space(3)))
#define NTHREADS 512
#define LDS_BYTES (160 * 1024)

__device__ __forceinline__ unsigned cvt_pk_bf16(float lo, float hi) { unsigned r; asm volatile("v_cvt_pk_bf16_f32 %0, %1, %2" : "=v"(r) : "v"(lo), "v"(hi)); return r; }
__device__ __forceinline__ bf16_t f2bf(float f) { return (bf16_t)(cvt_pk_bf16(f, 0.f) & 0xffffu); }
__device__ __forceinline__ float bf2f(bf16_t b) { return __uint_as_float(((unsigned)b) << 16); }
__device__ __forceinline__ float bflo(unsigned w) { return __uint_as_float(w << 16); }
__device__ __forceinline__ float bfhi(unsigned w) { return __uint_as_float(w & 0xffff0000u); }
#define LOG2E 1.4426950408889634f
__device__ __forceinline__ float fast_exp2(float x) { return __builtin_amdgcn_exp2f(x); }
__device__ __forceinline__ float fast_rcp(float x) { return __builtin_amdgcn_rcpf(x); }
__device__ __forceinline__ float sigmoidf_(float x) { return fast_rcp(1.0f + fast_exp2(-1.4426950408889634f * x)); }

__device__ __forceinline__ unsigned hidden_bid() { unsigned b = blockIdx.x; asm volatile("" : "+s"(b)); return b; }
__device__ __forceinline__ int hidden_tid() { int t = threadIdx.x; asm volatile("" : "+v"(t)); return t; }

#define XB_TMO      128
#define XB_XCNT(j)  (256  + 64 * (j))
#define XB_XSUB(j)  (1280 + 64 * (j))
#define XB_XGEN(j)  (2304 + 64 * (j))
#define XB_TOP      3328
#define XB_TOPGEN   3392
#define XCD_BAR_WORDS 3456
#define XB_SPIN_CAP (1u << 24)

__device__ __forceinline__ unsigned xb_ld(unsigned* p)              { return __hip_atomic_load(p, __ATOMIC_RELAXED, __HIP_MEMORY_SCOPE_AGENT); }
__device__ __forceinline__ unsigned xb_add(unsigned* p, unsigned v) { return __hip_atomic_fetch_add(p, v, __ATOMIC_RELAXED, __HIP_MEMORY_SCOPE_AGENT); }
__device__ __forceinline__ unsigned xb_xcc_id() { return (unsigned)__builtin_amdgcn_s_getreg((3 << 11) | 20) & 0xFu; }
#define XB_SPIN(cond, bar) do { unsigned _sp = 0; while (cond) { __builtin_amdgcn_s_sleep(1); \
    if ((++_sp & 255u) == 0u) { if (xb_ld(&(bar)[XB_TMO])) break; if (_sp > XB_SPIN_CAP) { atomicAdd(&(bar)[XB_TMO], 1u); break; } } } } while (0)

struct XcdBarrier { unsigned* bar; unsigned x; volatile LAS unsigned* st; };

__device__ __forceinline__ XcdBarrier xcd_barrier_post(unsigned* bar, volatile LAS unsigned* st) {
    XcdBarrier b; b.bar = bar; b.x = xb_xcc_id(); b.st = st;
    if (hidden_tid() == 0) (void)xb_add(&bar[XB_XCNT(b.x)], 1u);
    return b;
}
__device__ __forceinline__ void xcd_barrier_complete(unsigned* bar, unsigned x, unsigned& nloc, unsigned& nx) {
    const unsigned G = gridDim.x * gridDim.y * gridDim.z;
    unsigned sum, cnt, mine, sp = 0u;
    for (;;) {
        sum = 0u; cnt = 0u; mine = 0u;
#pragma unroll
        for (unsigned j = 0; j < 16; ++j) { const unsigned c = xb_ld(&bar[XB_XCNT(j)]); sum += c; cnt += (c > 0u) ? 1u : 0u; mine = (j == x) ? c : mine; }
        if (sum == G) break;
        __builtin_amdgcn_s_sleep(1);
        if ((++sp & 255u) == 0u) { if (xb_ld(&bar[XB_TMO])) break; if (sp > XB_SPIN_CAP) { atomicAdd(&bar[XB_TMO], 1u); break; } }
    }
    nloc = mine > 0u ? mine : 1u; nx = cnt > 0u ? cnt : 1u;
}
__device__ __forceinline__ void xcd_barrier(const XcdBarrier& b) {
    asm volatile("s_waitcnt vmcnt(0)" ::: "memory");
    __syncthreads();
    if (hidden_tid() == 0) {
        unsigned* bar = b.bar;
        __builtin_amdgcn_s_waitcnt(0);
        unsigned nloc = b.st[0], nx = b.st[1];
        if (nloc == 0u) { xcd_barrier_complete(bar, b.x, nloc, nx); b.st[0] = nloc; b.st[1] = nx; }
        const unsigned old = xb_add(&bar[XB_XSUB(b.x)], 1u);
        const unsigned gen = old / nloc;
        if (old + 1u == (gen + 1u) * nloc) {
            __builtin_amdgcn_fence(__ATOMIC_RELEASE, "agent");
            asm volatile("s_waitcnt vmcnt(0)" ::: "memory");
            const unsigned og = xb_add(&bar[XB_TOP], 1u);
            const unsigned tg = og / nx;
            if (og + 1u == (tg + 1u) * nx) xb_add(&bar[XB_TOPGEN], 1u);
            else XB_SPIN(xb_ld(&bar[XB_TOPGEN]) == tg, bar);
            __builtin_amdgcn_fence(__ATOMIC_ACQUIRE, "agent");
            xb_add(&bar[XB_XGEN(b.x)], 1u);
            asm volatile("s_waitcnt vmcnt(0)" ::: "memory");
        } else {
            XB_SPIN(xb_ld(&bar[XB_XGEN(b.x)]) == gen, bar);
            __builtin_amdgcn_fence(__ATOMIC_ACQUIRE, "agent");
            asm volatile("s_waitcnt vmcnt(0)" ::: "memory");
        }
    }
    __syncthreads();
}

constexpr int BM = 256, BK = 64, HALF = 128, HT = HALF * BK;

__device__ __forceinline__ int lds_byte(int r, int c) { int st = (r >> 4) * 2 + (c >> 5), rr = r & 15, cc = c & 31, ob = rr * 64 + cc * 2; return st * 1024 + (ob ^ (((ob >> 9) & 1) << 5)); }
__device__ __forceinline__ void stage_rc(int b, int& R, int& C) { int st = b / 1024, sb = b % 1024, swz = sb ^ (((sb >> 9) & 1) << 5); R = (st >> 1) * 16 + swz / 64; C = (st & 1) * 32 + (swz % 64) / 2; }

struct GemmOperands {
    const char* Abase; unsigned aoff[4]; unsigned kstride;
    const char* Bbase; unsigned boff; int K;
};

__device__ __forceinline__ void gemm_unit(const GemmOperands& g, bf16_t* shm, f32x4 (&acc)[2][2][4][2]) {
#define SA(b,h) (shm + ((b) * 2 + (h)) * HT)
#define SB(b,h) (shm + (4 + (b) * 2 + (h)) * HT)
#define STAGE_A(T, P, hf, kt) do { const char* _ub = g.Abase + (size_t)(kt) * g.kstride; \
    _Pragma("unroll") for (int _i = 0; _i < 2; ++_i) { const int _b = (T) * 16 + _i * 8192; \
      __builtin_amdgcn_global_load_lds((const unsigned*)(_ub + g.aoff[(hf) * 2 + _i]), (unsigned*)((char*)(P) + _b), 16, 0, 0); } } while (0)
#define STAGE_B(T, P, hf, kt) do { \
    _Pragma("unroll") for (int _i = 0; _i < 2; ++_i) { const int _b = (T) * 16 + _i * 8192; \
      const char* _ub = g.Bbase + (size_t)(kt) * (BK * 2) + (size_t)((hf) * 128 + _i * 64) * (size_t)(g.K * 2); \
      __builtin_amdgcn_global_load_lds((const unsigned*)(_ub + g.boff), (unsigned*)((char*)(P) + _b), 16, 0, 0); } } while (0)
#define LDA(dst, b, h) _Pragma("unroll") for (int m = 0; m < 4; ++m) _Pragma("unroll") for (int k = 0; k < 2; ++k) \
    dst[m][k] = *reinterpret_cast<const bf16x8*>((char*)SA(b, h) + lds_byte(wr * 64 + m * 16 + fr, k * 32 + fq * 8))
#define LDB(dst, b, h) _Pragma("unroll") for (int n = 0; n < 2; ++n) _Pragma("unroll") for (int k = 0; k < 2; ++k) \
    dst[n][k] = *reinterpret_cast<const bf16x8*>((char*)SB(b, h) + lds_byte(wc * 32 + n * 16 + fr, k * 32 + fq * 8))
#define MMA(ai, bj, At_, Bt_) do { __builtin_amdgcn_s_setprio(1); \
    _Pragma("unroll") for (int m = 0; m < 4; ++m) _Pragma("unroll") for (int n = 0; n < 2; ++n) _Pragma("unroll") for (int k = 0; k < 2; ++k) \
      acc[ai][bj][m][n] = __builtin_amdgcn_mfma_f32_16x16x32_bf16(Bt_[n][k], At_[m][k], acc[ai][bj][m][n], 0, 0, 0); \
    __builtin_amdgcn_s_setprio(0); } while (0)
#define WAIT_V(n) asm volatile("s_waitcnt vmcnt(" #n ")" ::: "memory")
#define WAIT_L(n) asm volatile("s_waitcnt lgkmcnt(" #n ")" ::: "memory")
#define BAR __builtin_amdgcn_s_barrier()
#define SCHED __builtin_amdgcn_sched_barrier(0)
    int tid = threadIdx.x; asm volatile("" : "+v"(tid));
    int wid = tid >> 6, lane = tid & 63, wr = wid >> 2, wc = wid & 3, fr = lane & 15, fq = lane >> 4;
#pragma unroll
    for (int a = 0; a < 2; ++a)
#pragma unroll
        for (int b = 0; b < 2; ++b)
#pragma unroll
            for (int m = 0; m < 4; ++m)
#pragma unroll
                for (int n = 0; n < 2; ++n) acc[a][b][m][n] = (f32x4){0.f, 0.f, 0.f, 0.f};
    bf16x8 At[4][2], B0[2][2], B1[2][2];
    const int nt = g.K / BK;
    STAGE_B(tid, SB(0, 0), 0, 0); STAGE_A(tid, SA(0, 0), 0, 0);
    STAGE_B(tid, SB(0, 1), 1, 0); STAGE_A(tid, SA(0, 1), 1, 0);
    if (wr == 1) BAR;
    WAIT_V(4); BAR;
    STAGE_B(tid, SB(1, 0), 0, 1); STAGE_A(tid, SA(1, 0), 0, 1); STAGE_B(tid, SB(1, 1), 1, 1);
    WAIT_V(6); BAR;
    for (int t = 0; t < nt - 2; t += 2) {
        LDB(B0, 0, 0); SCHED; LDA(At, 0, 0); STAGE_A(tid, SA(1, 1), 1, t + 1);
        WAIT_L(8); BAR; WAIT_L(0); MMA(0, 0, At, B0); BAR; SCHED;
        LDB(B1, 0, 1); STAGE_B(tid, SB(0, 0), 0, t + 2);
        BAR; WAIT_L(0); MMA(0, 1, At, B1); BAR;
        LDA(At, 0, 1); STAGE_A(tid, SA(0, 0), 0, t + 2);
        BAR; WAIT_L(0); MMA(1, 0, At, B0); BAR; SCHED;
        STAGE_B(tid, SB(0, 1), 1, t + 2);
        WAIT_V(6); BAR; MMA(1, 1, At, B1); BAR;
        LDB(B0, 1, 0); SCHED; LDA(At, 1, 0); STAGE_A(tid, SA(0, 1), 1, t + 2);
        WAIT_L(8); BAR; WAIT_L(0); MMA(0, 0, At, B0); BAR; SCHED;
        LDB(B1, 1, 1); STAGE_B(tid, SB(1, 0), 0, t + 3);
        BAR; WAIT_L(0); MMA(0, 1, At, B1); BAR;
        LDA(At, 1, 1); STAGE_A(tid, SA(1, 0), 0, t + 3);
        BAR; WAIT_L(0); MMA(1, 0, At, B0); BAR; SCHED;
        STAGE_B(tid, SB(1, 1), 1, t + 3);
        WAIT_V(6); BAR; MMA(1, 1, At, B1); BAR;
    }
    { LDB(B0, 0, 0); WAIT_V(0); LDA(At, 0, 0); STAGE_A(tid, SA(1, 1), 1, nt - 1);
      BAR; WAIT_L(0); MMA(0, 0, At, B0); BAR;
      LDB(B1, 0, 1); BAR; WAIT_L(0); MMA(0, 1, At, B1); BAR;
      LDA(At, 0, 1); WAIT_V(4); BAR; WAIT_L(0); MMA(1, 0, At, B0); MMA(1, 1, At, B1); BAR; }
    { LDB(B0, 1, 0); LDA(At, 1, 0); WAIT_V(2); BAR; WAIT_L(0); MMA(0, 0, At, B0); BAR;
      LDB(B1, 1, 1); WAIT_V(0); BAR; WAIT_L(0); MMA(0, 1, At, B1); BAR;
      LDA(At, 1, 1); BAR; WAIT_L(0); MMA(1, 0, At, B0); MMA(1, 1, At, B1); BAR; }
    if (wr == 0) BAR;
#undef SA
#undef SB
}


struct GDesc { const char* A; const char* B; unsigned aoff[4]; };
typedef int i32x8 __attribute__((ext_vector_type(8)));
typedef int i32x4 __attribute__((ext_vector_type(4)));
template <class S, bool FP8 = false, int SCA = 0x7f7f7f7f, int SCB = 0x7f7f7f7f>
__device__ __forceinline__ void gemm_stream(S& s, const int K, const unsigned kstrideA, unsigned char* lds_) {
    const int rowbytes = FP8 ? K : 2 * K;
    bf16_t* shm = (bf16_t*)lds_;
#define SA(b,h) (shm + ((b) * 2 + (h)) * HT)
#define SB(b,h) (shm + (4 + (b) * 2 + (h)) * HT)
#define UNIPTR(ptr) ({ const unsigned long long _u = (unsigned long long)(ptr); (const char*)(((unsigned long long)(unsigned)__builtin_amdgcn_readfirstlane((int)(_u >> 32)) << 32) | (unsigned)__builtin_amdgcn_readfirstlane((int)_u)); })
#define XSTAGE_A(P, hf, kt) do { const char* _ub = UNIPTR(d.A + (size_t)(kt) * kstrideA); \
    _Pragma("unroll") for (int _i = 0; _i < 2; ++_i) { const int _b = tid * 16 + _i * 8192; \
      unsigned _o = d.aoff[(hf) * 2 + _i]; asm volatile("" : "+v"(_o)); \
      __builtin_amdgcn_global_load_lds((const unsigned*)(_ub + _o), (unsigned*)((char*)(P) + _b), 16, 0, 0); } } while (0)
#define XSTAGE_B(P, hf, kt) do { \
    _Pragma("unroll") for (int _i = 0; _i < 2; ++_i) { const int _b = tid * 16 + _i * 8192; \
      const char* _ub = UNIPTR(d.B + (size_t)(kt) * (BK * 2) + (size_t)((hf) * 128 + _i * 64) * (size_t)rowbytes); \
      unsigned _o = boff; asm volatile("" : "+v"(_o)); \
      __builtin_amdgcn_global_load_lds((const unsigned*)(_ub + _o), (unsigned*)((char*)(P) + _b), 16, 0, 0); } } while (0)
    int tid = threadIdx.x; asm volatile("" : "+v"(tid));
    int wid = tid >> 6, lane = tid & 63, wr = wid >> 2, wc = wid & 3, fr = lane & 15, fq = lane >> 4;
    unsigned boff; { int rS, cS; stage_rc(tid * 16, rS, cS); const int rho = rS & 31, i = rho & 15; const int rP = (rS & ~31) + 8 * (i >> 2) + 4 * (rho >> 4) + (i & 3); boff = (unsigned)(rP * rowbytes + cS * 2); }
    const int nt = rowbytes / (BK * 2);
    GDesc d;
    if (!s.first(d)) return;
    f32x4 acc[2][2][4][2];
    if (S::BIAS_INIT) { s.load_bias_first(); s.init_acc(acc); }
    else
#pragma unroll
    for (int a = 0; a < 2; ++a)
#pragma unroll
        for (int b = 0; b < 2; ++b)
#pragma unroll
            for (int m = 0; m < 4; ++m)
#pragma unroll
                for (int n = 0; n < 2; ++n) acc[a][b][m][n] = (f32x4){0.f, 0.f, 0.f, 0.f};
    int sca_ = SCA, scb_ = SCB; asm volatile("" : "+v"(sca_), "+v"(scb_));
    struct Frag { bf16x8 f2[2]; };
    Frag At[4], B0[2], B1[2];
#undef LDA
#undef LDB
#undef MMA
#define LDA(dst, b, h) _Pragma("unroll") for (int m = 0; m < 4; ++m) _Pragma("unroll") for (int k = 0; k < 2; ++k) \
    dst[m].f2[k] = *reinterpret_cast<const bf16x8*>((char*)SA(b, h) + lds_byte(wr * 64 + m * 16 + fr, k * 32 + fq * 8))
#define LDB(dst, b, h) _Pragma("unroll") for (int n = 0; n < 2; ++n) _Pragma("unroll") for (int k = 0; k < 2; ++k) \
    dst[n].f2[k] = *reinterpret_cast<const bf16x8*>((char*)SB(b, h) + lds_byte(wc * 32 + n * 16 + fr, k * 32 + fq * 8))
#define MMA(ai, bj, At_, Bt_) do { __builtin_amdgcn_s_setprio(1); \
    _Pragma("unroll") for (int m = 0; m < 4; ++m) _Pragma("unroll") for (int n = 0; n < 2; ++n) { \
      if (FP8) asm volatile("v_mfma_scale_f32_16x16x128_f8f6f4 %0, %1, %2, %0, %3, %4 op_sel_hi:[0,0,0]" : "+v"(acc[ai][bj][m][n]) : "v"(__builtin_bit_cast(i32x8, Bt_[n])), "v"(__builtin_bit_cast(i32x8, At_[m])), "v"(scb_), "v"(sca_)); \
      else { _Pragma("unroll") for (int k = 0; k < 2; ++k) acc[ai][bj][m][n] = __builtin_amdgcn_mfma_f32_16x16x32_bf16(Bt_[n].f2[k], At_[m].f2[k], acc[ai][bj][m][n], 0, 0, 0); } } \
    __builtin_amdgcn_s_setprio(0); } while (0)
    XSTAGE_B(SB(0, 0), 0, 0); XSTAGE_B(SB(0, 1), 1, 0); XSTAGE_A(SA(0, 0), 0, 0); XSTAGE_A(SA(0, 1), 1, 0);
    if (wr == 1) BAR;
    WAIT_V(2); BAR;
    XSTAGE_B(SB(1, 0), 0, 1); XSTAGE_A(SA(1, 0), 0, 1); XSTAGE_B(SB(1, 1), 1, 1);
    WAIT_V(6); BAR;
    asm volatile(".p2align 8");
    for (;;) {
        bool has_next = false;
        for (int t = 0; t < nt; t += 2) {
            if (t == nt - 2) s.prefetch();
            LDB(B0, 0, 0); LDB(B1, 0, 1); SCHED; LDA(At, 0, 0); XSTAGE_A(SA(1, 1), 1, t + 1);
            WAIT_V(8); WAIT_L(0); BAR; MMA(0, 0, At, B0); MMA(0, 1, At, B1); BAR; SCHED;
            int ks = t + 2;
            if (t == nt - 2) { has_next = s.next(d); ks = 0; }
            LDA(At, 0, 1); XSTAGE_B(SB(0, 0), 0, ks); XSTAGE_B(SB(0, 1), 1, ks); XSTAGE_A(SA(0, 0), 0, ks);
            WAIT_V(8); WAIT_L(0); BAR; MMA(1, 0, At, B0); MMA(1, 1, At, B1); BAR; SCHED;
            LDB(B0, 1, 0); LDB(B1, 1, 1); SCHED; LDA(At, 1, 0); XSTAGE_A(SA(0, 1), 1, ks);
            WAIT_V(8); WAIT_L(0); BAR; MMA(0, 0, At, B0); MMA(0, 1, At, B1); BAR; SCHED;
            LDA(At, 1, 1); XSTAGE_B(SB(1, 0), 0, ks + 1); XSTAGE_B(SB(1, 1), 1, ks + 1); XSTAGE_A(SA(1, 0), 0, ks + 1);
            WAIT_V(8); WAIT_L(0); BAR; MMA(1, 0, At, B0); MMA(1, 1, At, B1); BAR; SCHED;
        }
        if (wr == 0) BAR;
        if (FP8) asm volatile("s_nop 15\n\ts_nop 15" ::: "memory");
        s.hn = has_next;
        s.epilogue(acc);
        if (!has_next) break;
        const bool zr = s.zero_after();
        s.advance();
        if (S::BIAS_INIT) s.init_acc(acc);
        else if (zr)
#pragma unroll
        for (int a = 0; a < 2; ++a)
#pragma unroll
            for (int b = 0; b < 2; ++b)
#pragma unroll
                for (int m = 0; m < 4; ++m)
#pragma unroll
                    for (int n = 0; n < 2; ++n) acc[a][b][m][n] = (f32x4){0.f, 0.f, 0.f, 0.f};
        if (wr == 1) BAR;
    }
    WAIT_V(0);
    BAR;
#undef SA
#undef SB
#undef XSTAGE_A
#undef XSTAGE_B
}

#define AL4K(x) (((size_t)(x) + 4095) & ~(size_t)4095)
constexpr size_t SZ_CTRL   = 1u << 16;
constexpr size_t OFF_MOD   = SZ_CTRL;
constexpr size_t OFF_CBIAS = OFF_MOD   + AL4K(2 * 16 * 6144 * 4);
constexpr size_t OFF_BIN   = OFF_CBIAS + AL4K(2 * 2 * 4 * 256 * 4);
constexpr size_t OFF_B1P   = OFF_BIN   + AL4K(2 * ZW * 4);
constexpr size_t OFF_WRT   = OFF_B1P   + AL4K(2 * 32 * 2048 * 4);
constexpr size_t OFF_WIN   = OFF_WRT   + AL4K(2 * 2 * 32 * 1024 * 2);
constexpr size_t OFF_WBR   = OFF_WIN   + AL4K((size_t)2 * ZW * 1024 * 2);
constexpr size_t OFF_WOUT  = OFF_WBR   + AL4K((size_t)2 * 3 * 1024 * 512 * 2);
constexpr size_t OFF_W1    = OFF_WOUT  + AL4K((size_t)2 * 1024 * 1024 * 2);
constexpr size_t OFF_W2    = OFF_W1    + AL4K((size_t)2 * 32 * 2048 * 1024 * 2);
constexpr size_t OFF_WC1   = OFF_W2    + AL4K((size_t)2 * 32 * 1024 * 1024 * 2);
constexpr size_t OFF_WC2   = OFF_WC1   + AL4K((size_t)2 * 2 * 256 * 2048 * 2);
constexpr size_t OFF_XR    = OFF_WC2   + AL4K((size_t)2 * 2 * 64 * 256 * 2);
constexpr size_t OFF_HB    = OFF_XR    + AL4K((size_t)NTOK * 1024 * 4);
constexpr size_t OFF_Z     = OFF_HB    + AL4K((size_t)NTOK * 1024 * 2);
constexpr size_t OFF_OABC  = OFF_Z     + AL4K((size_t)NTOK * ZW * 2);
constexpr size_t OFF_OWIN  = OFF_OABC  + AL4K((size_t)3 * NTOK * 512 * 2);
constexpr size_t OFF_KVC   = OFF_OWIN  + AL4K((size_t)NTOK * 512 * 2);
constexpr size_t OFF_MERGED= OFF_KVC   + AL4K((size_t)2 * 16 * 2 * 128 * 64 * 2);
constexpr size_t OFF_MSCR  = OFF_MERGED+ AL4K((size_t)NTOK * 1024 * 2);
constexpr size_t OFF_TOKE  = OFF_MSCR  + AL4K((size_t)256 * 32 * 512 * 16);
constexpr size_t OFF_TOKP  = OFF_TOKE  + AL4K((size_t)NTOK * 4 * 4);
constexpr size_t OFF_TOKG  = OFF_TOKP  + AL4K((size_t)NTOK * 4 * 4);
constexpr size_t OFF_BUCK  = OFF_TOKG  + AL4K((size_t)NTOK * 4 * 4);
constexpr size_t OFF_SELM  = OFF_BUCK  + AL4K((size_t)32 * NTOK * 4);
constexpr size_t OFF_HID   = OFF_SELM  + AL4K((size_t)16 * 2 * 2048 * 4);
constexpr size_t OFF_DELTA = OFF_MSCR;
constexpr size_t OFF_H8    = OFF_HID + AL4K((size_t)PMAX * 1024);
constexpr size_t OFF_Y     = OFF_Z;
constexpr size_t WS_NEED   = OFF_HID   + AL4K((size_t)PMAX * 1024 * 2);
static_assert((size_t)PMAX * 1024 * 2 <= (size_t)NTOK * ZW * 2, "y overlay must fit in z");

#define CW_QCTR(l, q)  (4096 + ((l) * 8 + (q)) * 64)
#define CW_ECNT(l, e)  (8192 + ((l) * 32 + (e)) * 64)
#define CW_XG(l)       (12800 + 64 * (l))
#define CW_LAM         6400

struct Params {
    const float *x, *c, *mod_w, *mod_b, *norm1_g, *norm2_g, *w_in, *b_in, *sinks, *diff_lambda, *diff_subln_g, *cmp_pos, *cmp_w1, *cmp_b1, *cmp_w2, *cmp_b2,
                *w_branch, *w_out, *router_w, *router_b, *exp_w1, *exp_b1, *exp_w2, *exp_b2, *final_g;
    float* out; char* ws; int ph_lo, ph_hi;
};
typedef const Params __attribute__((address_space(4)))* KP;

#ifndef INPROJ_FP8
#define INPROJ_FP8 1
#endif
__device__ __forceinline__ int map_col(int map, int nd) {
    if (map == 1) return nd < 3584 ? nd : (nd < 6656 ? nd + 24 : (nd < 6680 ? nd - 3072 : -1));
    if (map == 2) { const int pn = nd >> 8, r = nd & 255; return r < 128 ? pn * 128 + r : 1024 + pn * 128 + (r - 128); }
    return nd;
}
__device__ __forceinline__ void xpose_load(const float* __restrict__ src, int Nsrc, int k0, int nd0, int map, int ntl, f32x4 (&v)[8], int t) {
    const int n4 = t & 15, kp = t >> 4;
    bool ok[4];
#pragma unroll
    for (int j = 0; j < 4; ++j) { const int ns0 = j < ntl ? map_col(map, nd0 + 64 * j + 4 * n4) : -1; ok[j] = ns0 >= 0; const int nsc = ok[j] ? ns0 : 0;
        v[2 * j] = *(const f32x4*)(src + (size_t)(k0 + 2 * kp) * Nsrc + nsc); v[2 * j + 1] = *(const f32x4*)(src + (size_t)(k0 + 2 * kp + 1) * Nsrc + nsc); }
    __builtin_amdgcn_sched_barrier(0);
    if (map != 0) {
#pragma unroll
        for (int j = 0; j < 4; ++j) if (!ok[j]) { v[2 * j] = (f32x4){0.f, 0.f, 0.f, 0.f}; v[2 * j + 1] = v[2 * j]; } }
}
__device__ __forceinline__ void xpose_store(const f32x4 (&v)[8], bf16_t* __restrict__ dst, int Kdst, int k0, int nd0, int ntl, unsigned char* lds, int t) {
    const int n4 = t & 15, kp = t >> 4;
#pragma unroll
    for (int j = 0; j < 4; ++j)
#pragma unroll
        for (int i = 0; i < 4; ++i) { const int n = 4 * n4 + i; *(unsigned*)(lds + j * 8192 + n * 128 + (((kp >> 2) ^ (n4 & 7)) * 16) + (kp & 3) * 4) = cvt_pk_bf16(v[2 * j][i], v[2 * j + 1][i]); }
    __syncthreads();
    { const int n = t >> 3, ch = t & 7;
#pragma unroll
      for (int j = 0; j < 4; ++j) if (j < ntl) { const u32x4 w = *(const u32x4*)(lds + j * 8192 + n * 128 + ((ch ^ ((n >> 2) & 7)) * 16));
          *(u32x4*)(dst + (size_t)(nd0 + 64 * j + n) * Kdst + k0 + 8 * ch) = w; } }
    __syncthreads();
}
__device__ __forceinline__ void xpose_matrix(const float* src, int K, int Nsrc, bf16_t* dst, int Ndst, int map, unsigned& tbase, unsigned char* lds) {
    const int t = hidden_tid();
    const int nk = K >> 6, nn = Ndst >> 6, ngn = (nn + 3) >> 2, ngrp = nk * ngn; const unsigned G = gridDim.x;
    unsigned gi = (hidden_bid() + G - (tbase % G)) % G;
    f32x4 va[8], vb[8];
    if (gi < (unsigned)ngrp) { const int kt = gi % nk, ng = gi / nk; xpose_load(src, Nsrc, kt * 64, ng * 256, map, min(4, nn - ng * 4), va, t); }
    while (gi < (unsigned)ngrp) {
        const unsigned gn = gi + G; const int kt = gi % nk, ng = gi / nk;
        if (gn < (unsigned)ngrp) { const int kt2 = gn % nk, ng2 = gn / nk; xpose_load(src, Nsrc, kt2 * 64, ng2 * 256, map, min(4, nn - ng2 * 4), vb, t); }
        xpose_store(va, dst, K, kt * 64, ng * 256, min(4, nn - ng * 4), lds, t);
#pragma unroll
        for (int q = 0; q < 8; ++q) va[q] = vb[q];
        gi = gn;
    }
    tbase += ngrp;
}

__device__ __forceinline__ unsigned pk4_fp8(float a, float b, float c, float d) { int w = 0; w = __builtin_amdgcn_cvt_pk_fp8_f32(a, b, w, false); w = __builtin_amdgcn_cvt_pk_fp8_f32(c, d, w, true); return (unsigned)w; }
#define X8T 4
__device__ __forceinline__ unsigned xpose8_load(const float* __restrict__ src, int Nsrc, int k0, int nd0, int map, f32x4 (&v)[4 * X8T], int t) {
    const int n4 = t & 15, kq = t >> 4;
    bool ok[X8T];
#pragma unroll
    for (int j = 0; j < X8T; ++j) { const int ns0 = map_col(map, nd0 + 64 * j + 4 * n4); ok[j] = ns0 >= 0; const int nsc = ok[j] ? ns0 : 0;
#pragma unroll
        for (int q = 0; q < 4; ++q) v[4 * j + q] = __builtin_nontemporal_load((const f32x4*)(src + (size_t)(k0 + 4 * kq + q) * Nsrc + nsc)); }
    __builtin_amdgcn_sched_barrier(0);
    unsigned m = 0;
#pragma unroll
    for (int j = 0; j < X8T; ++j) m |= ok[j] ? (1u << j) : 0u;
    return m;
}
__device__ __forceinline__ void xpose8_store(const f32x4 (&v)[4 * X8T], unsigned char* __restrict__ dst, int Kdst, int k0, int nd0, float scale0, unsigned char* lds, int t, unsigned okm = 0xffffffffu) {
    const int n4 = t & 15, kq = t >> 4;
#pragma unroll
    for (int j = 0; j < X8T; ++j) { const float scale = (okm >> j) & 1u ? scale0 : 0.0f;
#pragma unroll
        for (int i = 0; i < 4; ++i) { const int n = 4 * n4 + i;
            *(unsigned*)(lds + j * 8192 + n * 128 + (((kq >> 2) ^ (n4 & 7)) * 16) + (kq & 3) * 4) = pk4_fp8(v[4 * j][i] * scale, v[4 * j + 1][i] * scale, v[4 * j + 2][i] * scale, v[4 * j + 3][i] * scale); } }
    __syncthreads();
    { const int n = t >> 3, ch = t & 7;
#pragma unroll
      for (int j = 0; j < X8T; ++j) { const u32x4 w = *(const u32x4*)(lds + j * 8192 + n * 128 + ((ch ^ ((n >> 2) & 7)) * 16));
          *(u32x4*)(dst + (size_t)(nd0 + 64 * j + n) * Kdst + k0 + 16 * ch) = w; } }
    __syncthreads();
}
__device__ __forceinline__ void xpose8_matrix(const float* src, int K, int Nsrc, unsigned char* dst, int Ndst, int map, float scale, unsigned& tbase, unsigned char* lds) {
    const int t = hidden_tid();
    const int nk = K >> 7, ngn = Ndst / (64 * X8T), ngrp = nk * ngn; const unsigned G = gridDim.x;
    unsigned gi = (hidden_bid() + G - (tbase % G)) % G;
    f32x4 va[4 * X8T], vb[4 * X8T];
    unsigned ma = 0, mb = 0;
    if (gi < (unsigned)ngrp) ma = xpose8_load(src, Nsrc, (gi % nk) * 128, (gi / nk) * 64 * X8T, map, va, t);
    while (gi < (unsigned)ngrp) {
        const unsigned gn = gi + G;
        if (gn < (unsigned)ngrp) mb = xpose8_load(src, Nsrc, (gn % nk) * 128, (gn / nk) * 64 * X8T, map, vb, t);
        xpose8_store(va, dst, K, (gi % nk) * 128, (gi / nk) * 64 * X8T, scale, lds, t, ma); ma = mb;
#pragma unroll
        for (int q = 0; q < 4 * X8T; ++q) va[q] = vb[q];
        gi = gn;
    }
    tbase += ngrp;
}

#ifndef COSCHED
#define COSCHED 1
#endif
#ifndef XGN
#define XGN 1
#endif
__device__ __forceinline__ void xpose8_gload(KP p, int l, int g, f32x4 (&v)[4 * X8T], int t) {
    const int e = g / 96, r = g - e * 96; const int n4 = t & 15, kq = t >> 4;
    if (r < 64) { const float* b = p->exp_w1 + (size_t)(l * 32 + e) * 1024 * 2048 + (size_t)((r & 7) * 128 + 4 * kq) * 2048 + (r >> 3) * 128 + 4 * n4;
#pragma unroll
        for (int j = 0; j < 4; ++j)
#pragma unroll
            for (int q = 0; q < 4; ++q) v[4 * j + q] = __builtin_nontemporal_load((const f32x4*)(b + q * 2048 + (j >> 1) * 1024 + (j & 1) * 64));
    } else { const float* b = p->exp_w2 + (size_t)(l * 32 + e) * 1024 * 1024 + (size_t)((r & 7) * 128 + 4 * kq) * 1024 + ((r - 64) >> 3) * 256 + 4 * n4;
#pragma unroll
        for (int j = 0; j < 4; ++j)
#pragma unroll
            for (int q = 0; q < 4; ++q) v[4 * j + q] = __builtin_nontemporal_load((const f32x4*)(b + q * 1024 + j * 64));
    }
    __builtin_amdgcn_sched_barrier(0);
}
__device__ __forceinline__ void xpose8_gstore(KP p, int l, int g, const f32x4 (&v)[4 * X8T], unsigned char* lds, int t) {
    const int e = g / 96, r = g - e * 96; char* ws = p->ws;
    if (r < 64) xpose8_store(v, (unsigned char*)(ws + OFF_W1) + (size_t)(l * 32 + e) * 2048 * 1024, 1024, (r & 7) * 128, (r >> 3) * 256, 32.0f, lds, t);
    else xpose8_store(v, (unsigned char*)(ws + OFF_W2) + (size_t)(l * 32 + e) * 1024 * 1024, 1024, (r & 7) * 128, ((r - 64) >> 3) * 256, 32.0f, lds, t);
}
__device__ __forceinline__ void xpose8_group(KP p, int l, int g, unsigned char* lds) {
    if ((g & (XGN - 1)) != XGN - 1) return;
    const int t = hidden_tid(); const int g0 = g - (XGN - 1);
    f32x4 va[4 * X8T], vb[4 * X8T];
    xpose8_gload(p, l, g0, va, t);
    __syncthreads();
#pragma unroll 1
    for (int i = 0; i < XGN; ++i) {
        if (i + 1 < XGN) xpose8_gload(p, l, g0 + i + 1, vb, t);
        xpose8_gstore(p, l, g0 + i, va, lds, t);
#pragma unroll
        for (int q = 0; q < 4 * X8T; ++q) va[q] = vb[q];
    }
}
__device__ __forceinline__ float wave_sum(float v, int lane) { (void)lane;
#define DPP_ADD(ctrl) v += __int_as_float(__builtin_amdgcn_update_dpp(0, __float_as_int(v), (ctrl), 0xf, 0xf, false))
    DPP_ADD(0xB1); DPP_ADD(0x4E); DPP_ADD(0x141); DPP_ADD(0x140);
#undef DPP_ADD
    { auto rr = __builtin_amdgcn_permlane16_swap(__float_as_uint(v), __float_as_uint(v), false, false); v = __uint_as_float(rr[0]) + __uint_as_float(rr[1]); }
    { auto rr = __builtin_amdgcn_permlane32_swap(__float_as_uint(v), __float_as_uint(v), false, false); v = __uint_as_float(rr[0]) + __uint_as_float(rr[1]); }
    return v;
}
__device__ __forceinline__ void phase_prologue(KP p, unsigned char* lds) {
    const int t = hidden_tid(), bi = hidden_bid();
    char* ws = p->ws;
#ifndef PRO_MODREP
#define PRO_MODREP 1
#endif
#ifndef PRO_XREP
#define PRO_XREP 1
#endif
    for (int rep_ = 0; rep_ < PRO_MODREP; ++rep_) {
        float* cs = (float*)lds;
        f32x4* red = (f32x4*)(lds + 65536);
        for (int i = t; i < 16 * 1024; i += NTHREADS) { const float v = p->c[i]; cs[(i & 1023) * 16 + (i >> 10)] = v * sigmoidf_(v); }
        __syncthreads();
        for (int task = bi; task < 192; task += gridDim.x) {
            const int j0 = task * 64, l = j0 / 6144, c0 = j0 % 6144;
            const int c4 = t & 15, kr = t >> 4, lane = t & 63, wv = t >> 6;
            const float* wp = p->mod_w + (size_t)l * 1024 * 6144 + c0 + 4 * c4;
            f32x4 acc[16];
#pragma unroll
            for (int b = 0; b < 16; ++b) acc[b] = (f32x4){0.f, 0.f, 0.f, 0.f};
#pragma unroll 1
            for (int i0 = 0; i0 < 32; i0 += 4) {
                f32x4 w[4];
#pragma unroll
                for (int i = 0; i < 4; ++i) w[i] = __builtin_nontemporal_load((const f32x4*)(wp + (size_t)(kr + 32 * (i0 + i)) * 6144));
                __builtin_amdgcn_sched_barrier(0);
#pragma unroll
                for (int i = 0; i < 4; ++i) { const float* cr = cs + (kr + 32 * (i0 + i)) * 16;
#pragma unroll
                    for (int b4 = 0; b4 < 4; ++b4) { const f32x4 cv = *(const f32x4*)(cr + 4 * b4);
#pragma unroll
                        for (int q = 0; q < 4; ++q) acc[4 * b4 + q] += cv[q] * w[i]; } }
            }
#pragma unroll
            for (int b = 0; b < 16; ++b)
#pragma unroll
                for (int q = 0; q < 4; ++q) { float v = acc[b][q];
                    v += __int_as_float(__builtin_amdgcn_ds_bpermute(((lane ^ 16) & 63) << 2, __float_as_int(v)));
                    v += __int_as_float(__builtin_amdgcn_ds_bpermute(((lane ^ 32) & 63) << 2, __float_as_int(v)));
                    acc[b][q] = v; }
            if (lane < 16) {
#pragma unroll
                for (int b = 0; b < 16; ++b) red[(wv * 16 + b) * 16 + c4] = acc[b]; }
            __syncthreads();
            if (t < 256) { const int b = t >> 4, c2 = t & 15; f32x4 sum = red[b * 16 + c2];
#pragma unroll
                for (int w2 = 1; w2 < 8; ++w2) sum += red[(w2 * 16 + b) * 16 + c2];
                const int col2 = c0 + 4 * c2;
                *(f32x4*)((float*)(ws + OFF_MOD) + ((size_t)l * 16 + b) * 6144 + col2) = sum + *(const f32x4*)(p->mod_b + l * 6144 + col2); }
            __syncthreads();
        }
    }
    if (bi == 0 && t < 64) {
        for (int l2 = 0; l2 < NLAYER; ++l2) { const float* lp = p->diff_lambda + (size_t)l2 * 256; const float a01 = wave_sum(lp[t] * lp[64 + t], t), a23 = wave_sum(lp[128 + t] * lp[192 + t], t);
            if (t == 0) ((float*)ws)[CW_LAM + l2] = expf(a01) - expf(a23) + (0.8f - 0.6f * expf(-0.3f * (float)l2)); } }
    for (int task = (int)gridDim.x - 1 - bi; task < 16; task += gridDim.x) {
        const int lk = task >> 2, kq = task & 3, nq = t & 63, ks = t >> 6;
        const float* w1 = p->cmp_w1 + (size_t)lk * 2048 * 256; const float* pos = p->cmp_pos + (size_t)lk * 2048;
        f32x4 s4 = (f32x4){0.f, 0.f, 0.f, 0.f};
#pragma unroll 1
        for (int k0 = kq * 512 + ks * 64; k0 < kq * 512 + ks * 64 + 64; k0 += 16) {
            f32x4 w[16]; float pz[16];
#pragma unroll
            for (int i = 0; i < 16; ++i) { w[i] = *(const f32x4*)(w1 + (size_t)(k0 + i) * 256 + 4 * nq); pz[i] = pos[k0 + i]; }
            __builtin_amdgcn_sched_barrier(0);
#pragma unroll
            for (int i = 0; i < 16; ++i) s4 += pz[i] * w[i];
        }
        f32x4* red = (f32x4*)lds; red[t] = s4; __syncthreads();
        if (t < 64) { f32x4 r = red[t];
#pragma unroll
            for (int q = 1; q < 8; ++q) r += red[t + 64 * q];
            *(f32x4*)((float*)(ws + OFF_CBIAS) + (size_t)(lk * 4 + kq) * 256 + 4 * t) = r; }
        __syncthreads();
    }
    for (int i = bi * NTHREADS + t; i < 2 * ZW; i += gridDim.x * NTHREADS) { const int l = i / ZW, nd = i % ZW, ns = map_col(1, nd); ((float*)(ws + OFF_BIN))[i] = ns >= 0 ? p->b_in[l * INW + ns] : 0.f; }
    for (int i = bi * NTHREADS + t; i < 2 * 32 * 2048; i += gridDim.x * NTHREADS) { const int le = i >> 11, j = i & 2047; ((float*)(ws + OFF_B1P))[i] = p->exp_b1[(size_t)le * 2048 + map_col(2, j)]; }
    for (int i = bi * NTHREADS + t; i < 2 * 32 * 1024; i += gridDim.x * NTHREADS) {
        const int l = i >> 15, e = (i >> 10) & 31, k = i & 1023; const float w = p->router_w[((size_t)l * 1024 + k) * 32 + e];
        const bf16_t hi = f2bf(w); const bf16_t lo = f2bf(w - bf2f(hi));
        const size_t fo = ((((size_t)(e >> 4) * 32 + (k >> 5)) * 64 + ((k >> 3) & 3) * 16 + (e & 15)) << 3) + (k & 7);
        bf16_t* wr = (bf16_t*)(ws + OFF_WRT); wr[(size_t)(l * 2 + 0) * 32768 + fo] = hi; wr[(size_t)(l * 2 + 1) * 32768 + fo] = lo; }
    __syncthreads();
    for (int rep_ = 0; rep_ < PRO_XREP; ++rep_) {
    unsigned tbase = 0;
    for (int l = 0; l < (COSCHED ? 1 : NLAYER); ++l) {
#if INPROJ_FP8
        xpose8_matrix(p->w_in + (size_t)l * 1024 * INW, 1024, INW, (unsigned char*)(ws + OFF_WIN) + (size_t)l * ZW * 1024, ZW, 1, 32.0f, tbase, lds);
#else
        xpose_matrix(p->w_in + (size_t)l * 1024 * INW, 1024, INW, (bf16_t*)(ws + OFF_WIN) + (size_t)l * ZW * 1024, ZW, 1, tbase, lds);
#endif
        for (int kv = 0; kv < 2; ++kv) {
            xpose_matrix(p->cmp_w1 + (size_t)(l * 2 + kv) * 2048 * 256, 2048, 256, (bf16_t*)(ws + OFF_WC1) + (size_t)(l * 2 + kv) * 256 * 2048, 256, 0, tbase, lds);
            xpose_matrix(p->cmp_w2 + (size_t)(l * 2 + kv) * 256 * 64, 256, 64, (bf16_t*)(ws + OFF_WC2) + (size_t)(l * 2 + kv) * 64 * 256, 64, 0, tbase, lds);
        }
#if !COSCHED
        for (int i = 0; i < 3; ++i) xpose_matrix(p->w_branch + (size_t)(l * 3 + i) * 512 * 1024, 512, 1024, (bf16_t*)(ws + OFF_WBR) + (size_t)(l * 3 + i) * 1024 * 512, 1024, 0, tbase, lds);
        xpose_matrix(p->w_out + (size_t)l * 1024 * 1024, 1024, 1024, (bf16_t*)(ws + OFF_WOUT) + (size_t)l * 1024 * 1024, 1024, 0, tbase, lds);
        for (int e = 0; e < 32; ++e) {
            xpose8_matrix(p->exp_w1 + (size_t)(l * 32 + e) * 1024 * 2048, 1024, 2048, (unsigned char*)(ws + OFF_W1) + (size_t)(l * 32 + e) * 2048 * 1024, 2048, 2, 32.0f, tbase, lds);
            xpose8_matrix(p->exp_w2 + (size_t)(l * 32 + e) * 1024 * 1024, 1024, 1024, (unsigned char*)(ws + OFF_W2) + (size_t)(l * 32 + e) * 1024 * 1024, 1024, 0, 32.0f, tbase, lds);
        }
#endif
    }
}
}

__device__ __forceinline__ void xpose_one(const float* src, int K, int Nsrc, bf16_t* dst, int Ndst, int gi, unsigned char* lds) {
    const int t = hidden_tid(); const int nk = K >> 6, nn = Ndst >> 6, kt = gi % nk, ng = gi / nk, ntl = min(4, nn - ng * 4);
    f32x4 va[8];
    xpose_load(src, Nsrc, kt * 64, ng * 256, 0, ntl, va, t);
    __syncthreads();
    xpose_store(va, dst, K, kt * 64, ng * 256, ntl, lds, t);
}
__device__ __forceinline__ void xpose8_one(const float* src, int K, int Nsrc, unsigned char* dst, int map, float scale, int gi, unsigned char* lds) {
    const int t = hidden_tid(); const int nk = K >> 7;
    f32x4 va[4 * X8T];
    const unsigned m = xpose8_load(src, Nsrc, (gi % nk) * 128, (gi / nk) * 64 * X8T, map, va, t);
    __syncthreads();
    xpose8_store(va, dst, K, (gi % nk) * 128, (gi / nk) * 64 * X8T, scale, lds, t, m);
}
#define MISC_GROUPS 608
__device__ __forceinline__ void misc_group(KP p, int idx, unsigned char* lds) {
    char* ws = p->ws;
    if (idx < 216) {
#if INPROJ_FP8
        xpose8_one(p->w_in + (size_t)1024 * INW, 1024, INW, (unsigned char*)(ws + OFF_WIN) + (size_t)ZW * 1024, 1, 32.0f, idx, lds);
#endif
    } else if (idx < 312 || (idx >= 448 && idx < 544)) { const int l = idx < 312 ? 1 : 0, r = idx - (l ? 216 : 448), i = r >> 5;
        xpose_one(p->w_branch + (size_t)(l * 3 + i) * 512 * 1024, 512, 1024, (bf16_t*)(ws + OFF_WBR) + (size_t)(l * 3 + i) * 1024 * 512, 1024, r & 31, lds);
    } else if (idx < 376 || idx >= 544) { const int l = idx < 376 ? 1 : 0, r = idx - (l ? 312 : 544);
        xpose_one(p->w_out + (size_t)l * 1024 * 1024, 1024, 1024, (bf16_t*)(ws + OFF_WOUT) + (size_t)l * 1024 * 1024, 1024, r, lds);
    } else if (idx < 440) { const int r = idx - 376, kv = r >> 5;
        xpose_one(p->cmp_w1 + (size_t)(2 + kv) * 2048 * 256, 2048, 256, (bf16_t*)(ws + OFF_WC1) + (size_t)(2 + kv) * 256 * 2048, 256, r & 31, lds);
    } else { const int r = idx - 440, kv = r >> 2;
        xpose_one(p->cmp_w2 + (size_t)(2 + kv) * 256 * 64, 256, 64, (bf16_t*)(ws + OFF_WC2) + (size_t)(2 + kv) * 64 * 256, 64, r & 3, lds);
    }
}

__device__ __forceinline__ void phase_norm_mod(const float* __restrict__ xsrc, const float* __restrict__ g, const float* __restrict__ modl  , int sh_off, int sc_off, bf16_t* __restrict__ hb) {
    const int tid = hidden_tid(), lane = tid & 63, wv = tid >> 6;
    for (int gw = hidden_bid() * 8 + wv; gw < NTOK / 16; gw += gridDim.x * 8) {
        const int row0 = gw * 16, b = row0 >> 11;
        f32x4 gg[4], sc[4], sh[4], xn[4];
#pragma unroll
        for (int j = 0; j < 4; ++j) { const int col = 256 * j + 4 * lane; gg[j] = *(const f32x4*)(g + col); sc[j] = *(const f32x4*)(modl + (size_t)b * 6144 + sc_off + col); sh[j] = *(const f32x4*)(modl + (size_t)b * 6144 + sh_off + col);
            xn[j] = *(const f32x4*)(xsrc + (size_t)row0 * 1024 + col); }
        for (int i = 0; i < 16; ++i) {
            const int row = row0 + i; f32x4 v[4]; float ss = 0.f;
#pragma unroll
            for (int j = 0; j < 4; ++j) { v[j] = xn[j]; ss += v[j][0] * v[j][0] + v[j][1] * v[j][1] + v[j][2] * v[j][2] + v[j][3] * v[j][3]; }
            if (i + 1 < 16) {
#pragma unroll
                for (int j = 0; j < 4; ++j) xn[j] = *(const f32x4*)(xsrc + (size_t)(row + 1) * 1024 + 256 * j + 4 * lane); }
            ss = wave_sum(ss, lane); const float r = 1.0f / sqrtf(ss * (1.0f / 1024.0f) + 1e-5f);
#pragma unroll
            for (int j = 0; j < 4; ++j) { const int col = 256 * j + 4 * lane; float o[4];
#pragma unroll
                for (int q = 0; q < 4; ++q) o[q] = v[j][q] * r * gg[j][q] * (1.0f + sc[j][q]) + sh[j][q];
#if INPROJ_FP8
                *(unsigned*)((unsigned char*)hb + (size_t)row * 1024 + col) = pk4_fp8(o[0], o[1], o[2], o[3]); }
#else
                u32x2 w; w.x = cvt_pk_bf16(o[0], o[1]); w.y = cvt_pk_bf16(o[2], o[3]); *(u32x2*)(hb + (size_t)row * 1024 + col) = w; }
#endif
        }
    }
}

__device__ __forceinline__ bool unit_rc(unsigned L, int nRT, int nN, int& rt, int& pn) {
    const int x = L & 7; const unsigned i = L >> 3; const int nrt_x = (nRT - x + 7) >> 3;
    const unsigned per = 8u * (unsigned)nN, grp = i / per, rem = i % per;
    pn = (int)(rem >> 3); const int rtl = (int)(grp * 8u + (rem & 7u));
    if (rtl >= nrt_x) return false;
    rt = x + 8 * rtl; return true;
}
__device__ __forceinline__ unsigned unit_slots(int nRT, int nN) { const int pr = (nRT + 7) >> 3; return 8u * (unsigned)(((pr + 7) >> 3) * 8 * nN); }
struct SlotIter {
    unsigned L, LM; int nRT, nN;
    __device__ __forceinline__ void init(int nRT_, int nN_) { nRT = nRT_; nN = nN_; LM = unit_slots(nRT_, nN_); L = hidden_bid(); }
    __device__ __forceinline__ bool take(int& rt, int& pn) { while (L < LM) { const unsigned l = L; L += gridDim.x; if (unit_rc(l, nRT, nN, rt, pn)) return true; } return false; }
};

#define GEMM_STAGE_IDS() int rS, cS; { int tz_ = threadIdx.x; asm volatile("" : "+v"(tz_)); stage_rc(tz_ * 16, rS, cS); }
#define GEMM_LANE_IDS() int tid = threadIdx.x; asm volatile("" : "+v"(tid)); const int wid = tid >> 6, lane = tid & 63, wr = wid >> 2, wc = wid & 3, fr = lane & 15, fq = lane >> 4; (void)lane; (void)wr; (void)wc; (void)fr; (void)fq
#define TILE_ROW(i) (((i) >> 1) * 128 + ((i) & 1) * 64 + rS)
typedef f32x4 (&AccRef)[2][2][4][2];

struct InprojS {
    KP p; int l; SlotIter it; int rt, pn, nrt, npn; f32x4 pb[2][2]; bool hn;
    static constexpr bool BIAS_INIT = true;
    __device__ __forceinline__ bool zero_after() const { return true; }
    __device__ __forceinline__ void load_bias(int pn_) { GEMM_LANE_IDS(); const float* bias = (const float*)(p->ws + OFF_BIN) + (size_t)l * ZW + pn_ * 256 + wc * 32 + fq * 8;
#pragma unroll
        for (int bj = 0; bj < 2; ++bj) { pb[bj][0] = *(const f32x4*)(bias + bj * 128); pb[bj][1] = *(const f32x4*)(bias + bj * 128 + 4); } }
    __device__ __forceinline__ void load_bias_first() { load_bias(pn); }
    __device__ __forceinline__ void init_acc(AccRef acc) {
#pragma unroll
        for (int ai = 0; ai < 2; ++ai)
#pragma unroll
            for (int bj = 0; bj < 2; ++bj)
#pragma unroll
                for (int m = 0; m < 4; ++m) { acc[ai][bj][m][0] = pb[bj][0]; acc[ai][bj][m][1] = pb[bj][1]; } }
    __device__ __forceinline__ void prefetch() {}
    __device__ __forceinline__ void fill(GDesc& d, int rt_, int pn_) { GEMM_STAGE_IDS(); char* ws = p->ws; d.A = ws + OFF_HB; d.B = ws + OFF_WIN + ((size_t)l * ZW + (size_t)pn_ * 256) * 1024 * (INPROJ_FP8 ? 1 : 2);
#pragma unroll
        for (int i = 0; i < 4; ++i) d.aoff[i] = (unsigned)(((size_t)rt_ * 256 + TILE_ROW(i)) * (INPROJ_FP8 ? 1024 : 2048) + cS * 2); }
    __device__ __forceinline__ bool first(GDesc& d) { it.init(128, 27); if (!it.take(rt, pn)) return false; fill(d, rt, pn); return true; }
    __device__ __forceinline__ bool next(GDesc& d) { int a, b; if (!it.take(a, b)) return false; nrt = a; npn = b; fill(d, a, b); return true; }
    __device__ __forceinline__ void advance() { rt = nrt; pn = npn; }
    __device__ __forceinline__ void epilogue(AccRef acc) {
        if (hn) load_bias(npn);
        GEMM_LANE_IDS(); char* ws = p->ws;
        bf16_t* z = (bf16_t*)(ws + OFF_Z);
        const bool sig = pn >= 14;
        const float qsc = (pn < 2 || pn == 3 || pn == 4 || pn == 9 || pn == 10) ? 0.125f : 1.0f;
        const int row0 = rt * 256 + wr * 64 + fr, col0 = pn * 256 + wc * 32 + fq * 8;
#pragma unroll
        for (int bj = 0; bj < 2; ++bj) { const int col = col0 + bj * 128;
#pragma unroll
            for (int ai = 0; ai < 2; ++ai)
#pragma unroll
                for (int m = 0; m < 4; ++m) { f32x4 v0 = acc[ai][bj][m][0] * qsc, v1 = acc[ai][bj][m][1] * qsc;
                    if (sig) {
#pragma unroll
                        for (int j = 0; j < 4; ++j) { v0[j] = sigmoidf_(v0[j]); v1[j] = sigmoidf_(v1[j]); } }
                    u32x4 w; w.x = cvt_pk_bf16(v0[0], v0[1]); w.y = cvt_pk_bf16(v0[2], v0[3]); w.z = cvt_pk_bf16(v1[0], v1[1]); w.w = cvt_pk_bf16(v1[2], v1[3]);
                    *(u32x4*)(z + (size_t)(row0 + ai * 128 + m * 16) * ZW + col) = w; } }
    }
};
__device__ __forceinline__ void phase_inproj(KP p, int l, unsigned char* lds) { InprojS s; s.p = p; s.l = l;
#if INPROJ_FP8
    gemm_stream<InprojS, true, 0x7f7f7f7f, 0x7a7a7a7a>(s, 1024, 128u, lds);
#else
    gemm_stream(s, 1024, 128u, lds);
#endif
}

struct MergeS {
    KP p; int l; SlotIter it; int rt, pn, br, nrt, npn, nbr; bool hn;
    static constexpr bool BIAS_INIT = false;
    __device__ __forceinline__ void load_bias_first() {}
    __device__ __forceinline__ void init_acc(AccRef) {}
    __device__ __forceinline__ bool zero_after() const { return br == 2; }
    __device__ __forceinline__ void prefetch() {}
    __device__ __forceinline__ void fill(GDesc& d, int rt_, int pn_, int br_) { GEMM_STAGE_IDS(); char* ws = p->ws; d.A = ws + OFF_OABC + (size_t)br_ * NTOK * 512 * 2;
        d.B = ws + OFF_WBR + ((size_t)(l * 3 + br_) * 1024 + (size_t)pn_ * 256) * 512 * 2;
#pragma unroll
        for (int i = 0; i < 4; ++i) d.aoff[i] = (unsigned)(((size_t)rt_ * 256 + TILE_ROW(i)) * 1024 + cS * 2); }
    __device__ __forceinline__ bool first(GDesc& d) { it.init(128, 4); if (!it.take(rt, pn)) return false; br = 0; fill(d, rt, pn, 0); return true; }
    __device__ __forceinline__ bool next(GDesc& d) { if (br < 2) { nrt = rt; npn = pn; nbr = br + 1; } else { int a, b; if (!it.take(a, b)) return false; nrt = a; npn = b; nbr = 0; } fill(d, nrt, npn, nbr); return true; }
    __device__ __forceinline__ void advance() { rt = nrt; pn = npn; br = nbr; }
    __device__ __forceinline__ void epilogue(AccRef acc) {
        GEMM_LANE_IDS(); char* ws = p->ws;
        const bf16_t* z = (const bf16_t*)(ws + OFF_Z); bf16_t* mg = (bf16_t*)(ws + OFF_MERGED);
        const int row0 = rt * 256 + wr * 64 + fr, col0 = pn * 256 + wc * 32 + fq * 8;
        u32x4 Ga[2], Ha[2], Gb[2], Hb[2], Gc[2], Hc[2];
#define MG_LOAD(e, G, H) _Pragma("unroll") for (int mm = 0; mm < 2; ++mm) { const int m = 2 * ((e) & 1) + mm; const bf16_t* gp = z + (size_t)(row0 + ((e) >> 2) * 128 + m * 16) * ZW + C_GM + br * 1024 + col0 + (((e) >> 1) & 1) * 128; \
            G[mm] = *(const u32x4*)gp; H[mm] = *(const u32x4*)(gp + (br < 2 ? 1024 : 0)); } asm volatile("" ::: "memory")
#define MG_PROC(e, G, H) _Pragma("unroll") for (int mm = 0; mm < 2; ++mm) { constexpr int ai = (e) >> 2, bj = ((e) >> 1) & 1; const int m = 2 * ((e) & 1) + mm; \
            const int row = row0 + ai * 128 + m * 16, col = col0 + bj * 128; const u32x4 gw = G[mm], hw = H[mm]; \
            float g[8] = {bflo(gw.x), bfhi(gw.x), bflo(gw.y), bfhi(gw.y), bflo(gw.z), bfhi(gw.z), bflo(gw.w), bfhi(gw.w)}; \
            if (br < 2) { const float hn[8] = {bflo(hw.x), bfhi(hw.x), bflo(hw.y), bfhi(hw.y), bflo(hw.z), bfhi(hw.z), bflo(hw.w), bfhi(hw.w)}; \
                _Pragma("unroll") for (int j = 0; j < 8; ++j) g[j] = fmaxf(g[j], 1e-6f) * fast_rcp(fmaxf(hn[j], 1e-6f)); \
            } else { _Pragma("unroll") for (int j = 0; j < 8; ++j) g[j] = fmaxf(g[j], 1e-6f); } \
            f32x4 v0 = acc[ai][bj][m][0], v1 = acc[ai][bj][m][1]; \
            v0[0] *= g[0]; v0[1] *= g[1]; v0[2] *= g[2]; v0[3] *= g[3]; v1[0] *= g[4]; v1[1] *= g[5]; v1[2] *= g[6]; v1[3] *= g[7]; \
            if (br < 2) { acc[ai][bj][m][0] = v0; acc[ai][bj][m][1] = v1; } \
            else { u32x4 w; w.x = cvt_pk_bf16(v0[0], v0[1]); w.y = cvt_pk_bf16(v0[2], v0[3]); w.z = cvt_pk_bf16(v1[0], v1[1]); w.w = cvt_pk_bf16(v1[2], v1[3]); *(u32x4*)(mg + (size_t)row * 1024 + col) = w; } } \
            asm volatile("" ::: "memory")
        MG_LOAD(0, Ga, Ha); MG_LOAD(1, Gb, Hb); MG_LOAD(2, Gc, Hc);
        MG_PROC(0, Ga, Ha); MG_LOAD(3, Ga, Ha);
        MG_PROC(1, Gb, Hb); MG_LOAD(4, Gb, Hb);
        MG_PROC(2, Gc, Hc); MG_LOAD(5, Gc, Hc);
        MG_PROC(3, Ga, Ha); MG_LOAD(6, Ga, Ha);
        MG_PROC(4, Gb, Hb); MG_LOAD(7, Gb, Hb);
        MG_PROC(5, Gc, Hc); MG_PROC(6, Ga, Ha); MG_PROC(7, Gb, Hb);
#undef MG_LOAD
#undef MG_PROC
    }
};
__device__ __forceinline__ void phase_merge(KP p, int l, unsigned char* lds) { MergeS s; s.p = p; s.l = l; gemm_stream(s, 512, 128u, lds); }

struct OutprojS {
    KP p; int l; SlotIter it; int rt, pn, nrt, npn; f32x4 pg[2][2]; bool hn;
    static constexpr bool BIAS_INIT = false;
    __device__ __forceinline__ void load_bias_first() {}
    __device__ __forceinline__ void init_acc(AccRef) {}
    __device__ __forceinline__ bool zero_after() const { return true; }
    __device__ __forceinline__ void prefetch() { GEMM_LANE_IDS(); const float* gp = (const float*)(p->ws + OFF_MOD) + ((size_t)l * 16 + (rt >> 3)) * 6144 + 2048 + pn * 256 + wc * 32 + fq * 8;
#pragma unroll
        for (int bj = 0; bj < 2; ++bj) { pg[bj][0] = *(const f32x4*)(gp + bj * 128); pg[bj][1] = *(const f32x4*)(gp + bj * 128 + 4); } }
    __device__ __forceinline__ void fill(GDesc& d, int rt_, int pn_) { GEMM_STAGE_IDS(); char* ws = p->ws; d.A = ws + OFF_MERGED; d.B = ws + OFF_WOUT + ((size_t)l * 1024 + (size_t)pn_ * 256) * 1024 * 2;
#pragma unroll
        for (int i = 0; i < 4; ++i) d.aoff[i] = (unsigned)(((size_t)rt_ * 256 + TILE_ROW(i)) * 2048 + cS * 2); }
    __device__ __forceinline__ bool first(GDesc& d) { it.init(128, 4); if (!it.take(rt, pn)) return false; fill(d, rt, pn); return true; }
    __device__ __forceinline__ bool next(GDesc& d) { int a, b; if (!it.take(a, b)) return false; nrt = a; npn = b; fill(d, a, b); return true; }
    __device__ __forceinline__ void advance() { rt = nrt; pn = npn; }
    __device__ __forceinline__ void epilogue(AccRef acc) {
        GEMM_LANE_IDS(); bf16_t* xrb = (bf16_t*)(p->ws + OFF_XR); const float* xin = p->x;
        const int row0 = rt * 256 + wr * 64 + fr, col0 = pn * 256 + wc * 32 + fq * 8;
#define OP_ROW(ai, m) ((size_t)(row0 + (ai) * 128 + (m) * 16) * 1024 + col0)
        if (l == 0) {
            f32x4 Xa[2][2], Xb[2][2];
#define OP_LOAD(e, X) _Pragma("unroll") for (int mm = 0; mm < 2; ++mm) { const float* xp = xin + OP_ROW((e) >> 2, 2 * ((e) & 1) + mm) + (((e) >> 1) & 1) * 128; X[mm][0] = *(const f32x4*)xp; X[mm][1] = *(const f32x4*)(xp + 4); } asm volatile("" ::: "memory")
#define OP_PROC(e, X) _Pragma("unroll") for (int mm = 0; mm < 2; ++mm) { constexpr int ai = (e) >> 2, bj = ((e) >> 1) & 1; const int m = 2 * ((e) & 1) + mm; \
                const f32x4 v0 = X[mm][0] + pg[bj][0] * acc[ai][bj][m][0], v1 = X[mm][1] + pg[bj][1] * acc[ai][bj][m][1]; \
                u32x4 w; w.x = cvt_pk_bf16(v0[0], v0[1]); w.y = cvt_pk_bf16(v0[2], v0[3]); w.z = cvt_pk_bf16(v1[0], v1[1]); w.w = cvt_pk_bf16(v1[2], v1[3]); \
                *(u32x4*)(xrb + OP_ROW(ai, m) + bj * 128) = w; } asm volatile("" ::: "memory")
            OP_LOAD(0, Xa); OP_LOAD(1, Xb);
            OP_PROC(0, Xa); OP_LOAD(2, Xa);
            OP_PROC(1, Xb); OP_LOAD(3, Xb);
            OP_PROC(2, Xa); OP_LOAD(4, Xa);
            OP_PROC(3, Xb); OP_LOAD(5, Xb);
            OP_PROC(4, Xa); OP_LOAD(6, Xa);
            OP_PROC(5, Xb); OP_LOAD(7, Xb);
            OP_PROC(6, Xa); OP_PROC(7, Xb);
#undef OP_LOAD
#undef OP_PROC
        } else {
            u32x4 Xa[4], Xb[4];
#define OP_LOAD(q, X) _Pragma("unroll") for (int m = 0; m < 4; ++m) X[m] = *(const u32x4*)(xrb + OP_ROW((q) >> 1, m) + ((q) & 1) * 128); asm volatile("" ::: "memory")
#define OP_PROC(q, X) _Pragma("unroll") for (int m = 0; m < 4; ++m) { constexpr int ai = (q) >> 1, bj = (q) & 1; const u32x4 xw = X[m]; \
                const f32x4 v0 = (f32x4){bflo(xw.x), bfhi(xw.x), bflo(xw.y), bfhi(xw.y)} + pg[bj][0] * acc[ai][bj][m][0], v1 = (f32x4){bflo(xw.z), bfhi(xw.z), bflo(xw.w), bfhi(xw.w)} + pg[bj][1] * acc[ai][bj][m][1]; \
                u32x4 w; w.x = cvt_pk_bf16(v0[0], v0[1]); w.y = cvt_pk_bf16(v0[2], v0[3]); w.z = cvt_pk_bf16(v1[0], v1[1]); w.w = cvt_pk_bf16(v1[2], v1[3]); \
                *(u32x4*)(xrb + OP_ROW(ai, m) + bj * 128) = w; } asm volatile("" ::: "memory")
            OP_LOAD(0, Xa); OP_LOAD(1, Xb);
            OP_PROC(0, Xa); OP_LOAD(2, Xa);
            OP_PROC(1, Xb); OP_LOAD(3, Xb);
            OP_PROC(2, Xa); OP_PROC(3, Xb);
#undef OP_LOAD
#undef OP_PROC
        }
#undef OP_ROW
    }
};
__device__ __forceinline__ void phase_outproj(KP p, int l, unsigned char* lds) { OutprojS s; s.p = p; s.l = l; gemm_stream(s, 1024, 128u, lds); }

__device__ __forceinline__ void moe_tables(KP p, int l, int* tbl) {
    const int t = hidden_tid();
    if (t < 64) {
        const unsigned* ctrl = (const unsigned*)p->ws; const int e = t & 31;
        const int c = (int)ctrl[CW_ECNT(l, e)]; const int nt = (c + 255) >> 8;
        int incl = nt;
#pragma unroll
        for (int o = 1; o < 32; o <<= 1) { const int v = __builtin_amdgcn_ds_bpermute(((t - o) & 63) << 2, incl); if (e >= o) incl += v; }
        if (t < 32) { tbl[e] = incl - nt; tbl[33 + e] = c; if (e == 31) tbl[32] = incl; }
    }
    __syncthreads();
}
#define RFL(x) __builtin_amdgcn_readfirstlane(x)
__device__ __forceinline__ int moe_find(const int* tbl, int rt, int e = 0) {
    while (RFL(tbl[e + 1]) <= rt) ++e;
    while (RFL(tbl[e]) > rt) --e;
    return e; }
#define MOE_TBL(lds) ((int*)((lds) + 131072 + 4096))

#ifndef MOEX
#define MOEX 0
#endif
struct Moe1S {
    KP p; int l; const int* tbl; SlotIter it; int rt, pn, e, nrt, npn, ne; int shadow; f32x4 bg[2], bu[2]; const int* toktab; int ui; bool hn;
    static constexpr bool BIAS_INIT = true;
    __device__ __forceinline__ bool zero_after() const { return true; }
    __device__ __forceinline__ void prefetch() {}
    __device__ __forceinline__ void load_bias(int pn_, int e_) { GEMM_LANE_IDS(); const float* bb = (const float*)(p->ws + OFF_B1P) + ((size_t)(l * 32 + e_)) * 2048 + pn_ * 256 + wc * 32 + fq * 8;
#pragma unroll
        for (int n = 0; n < 2; ++n) { bg[n] = *(const f32x4*)(bb + n * 4); bu[n] = *(const f32x4*)(bb + 128 + n * 4); } }
    __device__ __forceinline__ void load_bias_first() { load_bias(pn, e); }
    __device__ __forceinline__ void init_acc(AccRef acc) {
#pragma unroll
        for (int ai = 0; ai < 2; ++ai)
#pragma unroll
            for (int m = 0; m < 4; ++m)
#pragma unroll
                for (int n = 0; n < 2; ++n) { acc[ai][0][m][n] = bg[n]; acc[ai][1][m][n] = bu[n]; } }
    __device__ __forceinline__ void fill(GDesc& d, int rt_, int pn_, int e_) { GEMM_STAGE_IDS(); char* ws = p->ws; (void)rt_;
        d.A = ws + OFF_H8; d.B = ws + OFF_W1 + (((size_t)(l * 32 + e_)) * 2048 + (size_t)pn_ * 256) * 1024;
#pragma unroll
        for (int i = 0; i < 4; ++i) d.aoff[i] = (unsigned)((size_t)toktab[ui * 256 + TILE_ROW(i)] * 1024 + cS * 2);
        ++ui; }
    __device__ __forceinline__ bool first(GDesc& d) { it.init(RFL(tbl[32]), 8); if (!it.take(rt, pn)) return false; e = moe_find(tbl, rt); fill(d, rt, pn, e); return true; }
    __device__ __forceinline__ bool next(GDesc& d) { int a, b; if (!it.take(a, b)) return false; nrt = a; npn = b; ne = moe_find(tbl, a, e); fill(d, a, b, ne); return true; }
    __device__ __forceinline__ void advance() { rt = nrt; pn = npn; e = ne; }
    __device__ __forceinline__ void epilogue(AccRef acc) {
        if (shadow && MOEX == 2) { asm volatile("" :: "v"(acc[0][0][0][0]), "v"(acc[1][1][3][1])); return; }
        if (hn) load_bias(npn, ne);
        GEMM_LANE_IDS(); char* ws = p->ws; unsigned char* hid = (unsigned char*)(ws + OFF_HID);
        const size_t prow0 = (size_t)rt * 256 + wr * 64 + fr; const int c0 = wc * 32 + fq * 8;
#pragma unroll
        for (int ai = 0; ai < 2; ++ai)
#pragma unroll
            for (int m = 0; m < 4; ++m) { float o[8];
#pragma unroll
                for (int n = 0; n < 2; ++n) { const f32x4 gq = acc[ai][0][m][n], uq = acc[ai][1][m][n];
#pragma unroll
                    for (int j = 0; j < 4; ++j) { const float gg = fminf(gq[j], 7.0f), uu = __builtin_amdgcn_fmed3f(uq[j], -7.0f, 7.0f); o[n * 4 + j] = __builtin_fmaf(uu, 4.0f, 4.0f) * gg * fast_rcp(1.0f + fast_exp2(-1.702f * LOG2E * gg)); } }
                u32x2 w; w.x = pk4_fp8(o[0], o[1], o[2], o[3]); w.y = pk4_fp8(o[4], o[5], o[6], o[7]);
                *(u32x2*)(hid + (prow0 + ai * 128 + m * 16) * 1024 + pn * 128 + c0) = w; }
    }
};
__device__ __forceinline__ void phase_moe1(KP p, int l, unsigned char* lds) { int* tbl = MOE_TBL(lds); moe_tables(p, l, tbl);
    int* toktab = (int*)(lds + 131072 + 8192);
    { SlotIter it2; it2.init(RFL(tbl[32]), 8); int a, b, u2 = 0, e2 = 0; const int t = hidden_tid();
      while (it2.take(a, b)) { e2 = moe_find(tbl, a, e2); const int cnt = RFL(tbl[33 + e2]), pos0 = (a - RFL(tbl[e2])) * 256;
          if (t < 256) { int pos = pos0 + t; pos = pos < cnt ? pos : 0; toktab[u2 * 256 + t] = ((const int*)(p->ws + OFF_BUCK))[(size_t)e2 * NTOK + pos]; }
          ++u2; }
      __syncthreads(); }
    for (int rep = 0; rep < (MOEX ? 2 : 1); ++rep) { Moe1S s; s.p = p; s.l = l; s.tbl = tbl; s.shadow = rep; s.toktab = toktab; s.ui = 0; gemm_stream<Moe1S, true, 0x7f7f7f7f, 0x7a7a7a7a>(s, 1024, 128u, lds); __syncthreads(); } }

struct Moe2S {
    KP p; int l; const int* tbl; SlotIter it; int rt, pn, e, nrt, npn, ne; f32x4 pb[2][2]; bool hn;
    static constexpr bool BIAS_INIT = true;
    __device__ __forceinline__ bool zero_after() const { return true; }
    __device__ __forceinline__ void prefetch() {}
    __device__ __forceinline__ void load_bias(int pn_, int e_) { GEMM_LANE_IDS(); const float* b2 = p->exp_b2 + ((size_t)(l * 32 + e_)) * 1024 + pn_ * 256 + wc * 32 + fq * 8;
#pragma unroll
        for (int bj = 0; bj < 2; ++bj) { pb[bj][0] = *(const f32x4*)(b2 + bj * 128); pb[bj][1] = *(const f32x4*)(b2 + bj * 128 + 4); } }
    __device__ __forceinline__ void load_bias_first() { load_bias(pn, e); }
    __device__ __forceinline__ void init_acc(AccRef acc) {
#pragma unroll
        for (int ai = 0; ai < 2; ++ai)
#pragma unroll
            for (int bj = 0; bj < 2; ++bj)
#pragma unroll
                for (int m = 0; m < 4; ++m) { acc[ai][bj][m][0] = pb[bj][0]; acc[ai][bj][m][1] = pb[bj][1]; } }
    __device__ __forceinline__ void fill(GDesc& d, int rt_, int pn_, int e_) { GEMM_STAGE_IDS(); char* ws = p->ws; d.A = ws + OFF_HID; d.B = ws + OFF_W2 + (((size_t)(l * 32 + e_)) * 1024 + (size_t)pn_ * 256) * 1024;
#pragma unroll
        for (int i = 0; i < 4; ++i) d.aoff[i] = (unsigned)(((size_t)rt_ * 256 + TILE_ROW(i)) * 1024 + cS * 2); }
    __device__ __forceinline__ bool first(GDesc& d) { it.init(RFL(tbl[32]), 4); if (!it.take(rt, pn)) return false; e = moe_find(tbl, rt); fill(d, rt, pn, e); return true; }
    __device__ __forceinline__ bool next(GDesc& d) { int a, b; if (!it.take(a, b)) return false; nrt = a; npn = b; ne = moe_find(tbl, a, e); fill(d, a, b, ne); return true; }
    __device__ __forceinline__ void advance() { rt = nrt; pn = npn; e = ne; }
    __device__ __forceinline__ void epilogue(AccRef acc) {
        if (hn) load_bias(npn, ne);
        GEMM_LANE_IDS(); char* ws = p->ws; bf16_t* y = (bf16_t*)(ws + OFF_Y);
        const size_t row0 = (size_t)rt * 256 + wr * 64 + fr; const int col0 = pn * 256 + wc * 32 + fq * 8;
#pragma unroll
        for (int bj = 0; bj < 2; ++bj) { const int col = col0 + bj * 128;
#pragma unroll
            for (int ai = 0; ai < 2; ++ai)
#pragma unroll
                for (int m = 0; m < 4; ++m) { const f32x4 v0 = acc[ai][bj][m][0], v1 = acc[ai][bj][m][1];
                    u32x4 w; w.x = cvt_pk_bf16(v0[0], v0[1]); w.y = cvt_pk_bf16(v0[2], v0[3]); w.z = cvt_pk_bf16(v1[0], v1[1]); w.w = cvt_pk_bf16(v1[2], v1[3]);
                    *(u32x4*)(y + (row0 + ai * 128 + m * 16) * 1024 + col) = w; } }
    }
};
__device__ __forceinline__ void phase_moe2(KP p, int l, unsigned char* lds) { int* tbl = MOE_TBL(lds); moe_tables(p, l, tbl); Moe2S s; s.p = p; s.l = l; s.tbl = tbl; gemm_stream<Moe2S, true, 0x7d7d7d7d, 0x7a7a7a7a>(s, 1024, 128u, lds); __syncthreads(); }

#define AT_MISC 65536


typedef short s16x4 __attribute__((ext_vector_type(4)));
__device__ __forceinline__ int crow(int r, int h) { return (r & 3) + 8 * (r >> 2) + 4 * h; }
__device__ __forceinline__ int kaddr(int key, int c) { return (key >> 1) * 256 + (((((key & 1) << 3) | c) ^ ((key >> 1) & 15)) << 4); }
__device__ __forceinline__ int vaddr64(int key, int c) { return (key >> 1) * 256 + (((key & 1) * 2 + ((c >> 2) ^ ((key >> 1) & 1))) << 6) + ((c & 3) << 4); }
__device__ __forceinline__ int vaddr128(int key, int c) { return key * 256 + (((c >> 2) ^ (key & 3)) << 6) + ((c & 3) << 4); }
__device__ __forceinline__ s16x4 vtr(const unsigned char* p) { return __builtin_bit_cast(s16x4, __builtin_amdgcn_ds_read_tr16_b64_v4i16((LAS s16x4*)(p))); }
__device__ __forceinline__ float swap_max(float v) { auto rr = __builtin_amdgcn_permlane32_swap(__float_as_uint(v), __float_as_uint(v), false, false); return fmaxf(__uint_as_float(rr[0]), __uint_as_float(rr[1])); }
__device__ __forceinline__ float swap_sum(float v) { auto rr = __builtin_amdgcn_permlane32_swap(__float_as_uint(v), __float_as_uint(v), false, false); return __uint_as_float(rr[0]) + __uint_as_float(rr[1]); }
__device__ __forceinline__ float swap_other(float v, int h) { auto rr = __builtin_amdgcn_permlane32_swap(__float_as_uint(v), __float_as_uint(v), false, false); return __uint_as_float(h ? rr[0] : rr[1]); }
#define MFMA32(a, b, c) __builtin_amdgcn_mfma_f32_32x32x16_bf16((a), (b), (c), 0, 0, 0)

struct KVSrc { const char* k; unsigned kstride; const char* v; unsigned vstride; };
__device__ __forceinline__ void kinv(int o, int& key, int& c) { const int sup = o >> 8, x = ((o >> 4) & 15) ^ (sup & 15); key = 2 * sup + (x >> 3); c = x & 7; }
__device__ __forceinline__ void vinv64(int o, int& key, int& c) { const int sup = o >> 8, seg = (o >> 6) & 3; key = 2 * sup + (seg >> 1); c = (((seg & 1) ^ (sup & 1)) << 2) | ((o >> 4) & 3); }
__device__ __forceinline__ void vinv128(int o, int& key, int& c) { key = o >> 8; c = ((((o >> 6) & 3) ^ (key & 3)) << 2) | ((o >> 4) & 3); }
#define RING_NB 4
#define RING_AHEAD 3
template <int KW, int DV> struct KVRing {
    static constexpr int LPT = KW + DV / 64, BUFB = KW * 8192 + DV * 128;
    unsigned kof[KW], vof[DV / 64];
    unsigned kdst[KW], vdst[DV / 64];
    const char* kb; const char* vb; unsigned kstride, vstride;
    __device__ __forceinline__ void init(const KVSrc& s, int tid) {
        kb = s.k; vb = s.v; kstride = s.kstride; vstride = s.vstride;
        const int wv = tid >> 6, lane = tid & 63;
#pragma unroll
        for (int i = 0; i < KW; ++i) { const int o = (i * 8 + wv) * 1024 + lane * 16, img = o >> 13; int key, c; kinv(o & 8191, key, c); kof[i] = (unsigned)key * kstride + (unsigned)(img * 128 + c * 16); kdst[i] = (unsigned)o; }
#pragma unroll
        for (int i = 0; i < DV / 64; ++i) { const int o = (i * 8 + wv) * 1024 + lane * 16; int key, c; if (DV == 64) vinv64(o, key, c); else vinv128(o, key, c);
            vof[i] = (unsigned)key * vstride + (unsigned)(c * 16); vdst[i] = (unsigned)(KW * 8192 + o); }
    }
    __device__ __forceinline__ void issue(int key0, int buf, unsigned char* lds) const {
        const char* kt = UNIPTR(kb + (size_t)key0 * kstride); const char* vt = UNIPTR(vb + (size_t)key0 * vstride);
#pragma unroll
        for (int i = 0; i < KW; ++i) { unsigned o = kof[i]; asm volatile("" : "+v"(o)); __builtin_amdgcn_global_load_lds((const unsigned*)(kt + o), (unsigned*)(lds + buf * BUFB + kdst[i]), 16, 0, 0); }
#pragma unroll
        for (int i = 0; i < DV / 64; ++i) { unsigned o = vof[i]; asm volatile("" : "+v"(o)); __builtin_amdgcn_global_load_lds((const unsigned*)(vt + o), (unsigned*)(lds + buf * BUFB + vdst[i]), 16, 0, 0); }
    }
    __device__ __forceinline__ void wait_bar(int later) const {
        if (later >= 2 && RING_AHEAD >= 3) asm volatile("s_waitcnt vmcnt(%0)" :: "n"(2 * LPT) : "memory");
        else if (later >= 1) asm volatile("s_waitcnt vmcnt(%0)" :: "n"(LPT) : "memory");
        else asm volatile("s_waitcnt vmcnt(0)" ::: "memory");
        __builtin_amdgcn_s_barrier(); asm volatile("" ::: "memory");
    }
    __device__ __forceinline__ const unsigned char* kimg(const unsigned char* lds, int buf, int img) const { return lds + buf * BUFB + img * 8192; }
    __device__ __forceinline__ const unsigned char* vimg(const unsigned char* lds, int buf) const { return lds + buf * BUFB + KW * 8192; }
};

template <int DV> struct WaveAcc { float m, l; f32x16 o[DV / 32]; };
template <int DV> __device__ __forceinline__ void acc_init(WaveAcc<DV>& a) { a.m = -1e30f; a.l = 0.f;
#pragma unroll
    for (int d = 0; d < DV / 32; ++d)
#pragma unroll
        for (int r = 0; r < 16; ++r) a.o[d][r] = 0.f; }

__device__ __forceinline__ f32x16 qk_sub(const bf16x8 (&qf)[4], const unsigned char* kimg, int sub, int lane) {
    const int r32 = lane & 31, h = lane >> 5;
    f32x16 s;
#pragma unroll
    for (int r = 0; r < 16; ++r) s[r] = 0.f;
#pragma unroll
    for (int ks = 0; ks < 4; ++ks) { const bf16x8 kf = *(const bf16x8*)(kimg + kaddr(32 * sub + r32, 2 * ks + h)); s = MFMA32(kf, qf[ks], s); }
    return s;
}
template <int DV> struct VFrag { s16x4 r[2][DV / 32][2]; };
__device__ __forceinline__ void v_read_all(VFrag<64>& f, const unsigned char* vimg, int sub, int lane) {
    const int h = lane >> 5, i16 = lane & 15, qq = i16 >> 2, pp = i16 & 3, g1 = (lane >> 4) & 1, k0 = 32 * sub + 4 * h + qq;
    const unsigned b0 = (unsigned)(uintptr_t)(vimg + vaddr64(k0, 2 * g1 + (pp >> 1)) + (pp & 1) * 8), b1 = (unsigned)(uintptr_t)(vimg + vaddr64(k0, 4 + 2 * g1 + (pp >> 1)) + (pp & 1) * 8);
    asm volatile("ds_read_b64_tr_b16 %0, %8\n\tds_read_b64_tr_b16 %1, %8 offset:1024\n\tds_read_b64_tr_b16 %2, %9\n\tds_read_b64_tr_b16 %3, %9 offset:1024\n\t"
                 "ds_read_b64_tr_b16 %4, %8 offset:2048\n\tds_read_b64_tr_b16 %5, %8 offset:3072\n\tds_read_b64_tr_b16 %6, %9 offset:2048\n\tds_read_b64_tr_b16 %7, %9 offset:3072\n\t"
                 "s_waitcnt lgkmcnt(0)"
                 : "=&v"(f.r[0][0][0]), "=&v"(f.r[0][0][1]), "=&v"(f.r[0][1][0]), "=&v"(f.r[0][1][1]), "=&v"(f.r[1][0][0]), "=&v"(f.r[1][0][1]), "=&v"(f.r[1][1][0]), "=&v"(f.r[1][1][1])
                 : "v"(b0), "v"(b1) : "memory");
}
__device__ __forceinline__ void v_read_all(VFrag<128>& f, const unsigned char* vimg, int sub, int lane) {
    const int h = lane >> 5, i16 = lane & 15, qq = i16 >> 2, pp = i16 & 3, g1 = (lane >> 4) & 1, k0 = 32 * sub + 4 * h + qq;
    unsigned b[4];
#pragma unroll
    for (int db = 0; db < 4; ++db) b[db] = (unsigned)(uintptr_t)(vimg + vaddr128(k0, db * 4 + 2 * g1 + (pp >> 1)) + (pp & 1) * 8);
    asm volatile("ds_read_b64_tr_b16 %0, %16\n\tds_read_b64_tr_b16 %1, %16 offset:2048\n\tds_read_b64_tr_b16 %2, %17\n\tds_read_b64_tr_b16 %3, %17 offset:2048\n\t"
                 "ds_read_b64_tr_b16 %4, %18\n\tds_read_b64_tr_b16 %5, %18 offset:2048\n\tds_read_b64_tr_b16 %6, %19\n\tds_read_b64_tr_b16 %7, %19 offset:2048\n\t"
                 "ds_read_b64_tr_b16 %8, %16 offset:4096\n\tds_read_b64_tr_b16 %9, %16 offset:6144\n\tds_read_b64_tr_b16 %10, %17 offset:4096\n\tds_read_b64_tr_b16 %11, %17 offset:6144\n\t"
                 "ds_read_b64_tr_b16 %12, %18 offset:4096\n\tds_read_b64_tr_b16 %13, %18 offset:6144\n\tds_read_b64_tr_b16 %14, %19 offset:4096\n\tds_read_b64_tr_b16 %15, %19 offset:6144\n\t"
                 "s_waitcnt lgkmcnt(0)"
                 : "=&v"(f.r[0][0][0]), "=&v"(f.r[0][0][1]), "=&v"(f.r[0][1][0]), "=&v"(f.r[0][1][1]), "=&v"(f.r[0][2][0]), "=&v"(f.r[0][2][1]), "=&v"(f.r[0][3][0]), "=&v"(f.r[0][3][1]),
                   "=&v"(f.r[1][0][0]), "=&v"(f.r[1][0][1]), "=&v"(f.r[1][1][0]), "=&v"(f.r[1][1][1]), "=&v"(f.r[1][2][0]), "=&v"(f.r[1][2][1]), "=&v"(f.r[1][3][0]), "=&v"(f.r[1][3][1])
                 : "v"(b[0]), "v"(b[1]), "v"(b[2]), "v"(b[3]) : "memory");
}
template <int DV> __device__ __forceinline__ void pv_sub(const f32x16& pr, const VFrag<DV>& f, f32x16 (&o)[DV / 32]) {
#pragma unroll
    for (int s2 = 0; s2 < 2; ++s2) {
        u32x4 pw; pw.x = cvt_pk_bf16(pr[8 * s2 + 0], pr[8 * s2 + 1]); pw.y = cvt_pk_bf16(pr[8 * s2 + 2], pr[8 * s2 + 3]);
        pw.z = cvt_pk_bf16(pr[8 * s2 + 4], pr[8 * s2 + 5]); pw.w = cvt_pk_bf16(pr[8 * s2 + 6], pr[8 * s2 + 7]);
        const bf16x8 pf = __builtin_bit_cast(bf16x8, pw);
#pragma unroll
        for (int db = 0; db < DV / 32; ++db) { const s16x4 lo = f.r[s2][db][0], hi = f.r[s2][db][1];
            bf16x8 vf; vf[0] = lo[0]; vf[1] = lo[1]; vf[2] = lo[2]; vf[3] = lo[3]; vf[4] = hi[0]; vf[5] = hi[1]; vf[6] = hi[2]; vf[7] = hi[3];
            o[db] = MFMA32(vf, pf, o[db]); }
    }
}
template <int DV> __device__ __forceinline__ void attn_sub_auto(const bf16x8 (&qf)[5], const unsigned char* kimg, const unsigned char* vimg, int sub, int key0, int tqw, int tq, int h,
                                                               int whi, bool lbit, WaveAcc<DV>& a, int lane) {
    f32x16 s = qk_sub(*(const bf16x8 (*)[4])&qf, kimg, sub, lane);
    { const int r32 = lane & 31, tk = key0 + r32; const unsigned hi = __float_as_uint((float)(tk >> 8)) >> 16, lo = __float_as_uint((float)(tk & 255)) & 0xffff0000u;
      u32x4 kw; kw.x = (lane < 32) ? (hi | lo) : 0u; kw.y = 0u; kw.z = 0u; kw.w = 0u;
      s = MFMA32(__builtin_bit_cast(bf16x8, kw), qf[4], s); }
    VFrag<DV> vf; v_read_all(vf, vimg, sub, lane);
    const bool interior = (tqw - (key0 + 31) >= 0) && (tqw + 31 - key0 < whi) && __all(lbit);
    if (!interior) { const int d0 = tq - key0 - 4 * h;
#pragma unroll
        for (int r = 0; r < 16; ++r) { const int dist = d0 - ((r & 3) + 8 * (r >> 2)); s[r] = (lbit && dist >= 0 && dist < whi) ? s[r] : -INFINITY; } }
    float tmax = fmaxf(fmaxf(s[0], s[1]), fmaxf(s[2], s[3]));
#pragma unroll
    for (int r = 4; r < 16; r += 4) tmax = fmaxf(tmax, fmaxf(fmaxf(s[r], s[r + 1]), fmaxf(s[r + 2], s[r + 3])));
    tmax = swap_max(tmax);
    if (!__all(tmax - a.m <= 8.0f)) {
        const float mnew = fmaxf(a.m, tmax), alpha = fast_exp2((a.m - mnew) * LOG2E);
        a.l *= alpha; a.m = mnew;
#pragma unroll
        for (int d = 0; d < DV / 32; ++d)
#pragma unroll
            for (int r = 0; r < 16; ++r) a.o[d][r] *= alpha;
    }
    const float nm = -a.m * LOG2E;
    float rs0 = 0.f, rs1 = 0.f;
#pragma unroll
    for (int r = 0; r < 16; r += 2) { s[r] = fast_exp2(__builtin_fmaf(s[r], LOG2E, nm)); s[r + 1] = fast_exp2(__builtin_fmaf(s[r + 1], LOG2E, nm)); rs0 += s[r]; rs1 += s[r + 1]; }
    a.l += rs0 + rs1;
    pv_sub<DV>(s, vf, a.o);
}
__device__ __forceinline__ void load_q(bf16x8 (&qf)[5], const bf16_t* qp  , float slope, int lane) {
#pragma unroll
    for (int ks = 0; ks < 4; ++ks) qf[ks] = *(const bf16x8*)(qp + 16 * ks);
    u32x4 qw; qw.x = (lane < 32) ? ((__float_as_uint(256.0f * slope) >> 16) | (__float_as_uint(slope) & 0xffff0000u)) : 0u; qw.y = 0u; qw.z = 0u; qw.w = 0u;
    qf[4] = __builtin_bit_cast(bf16x8, qw);
}
template <int DV> __device__ __forceinline__ void store_o(const f32x16 (&o)[DV / 32], float sc, bf16_t* orow, int h) {
#pragma unroll
    for (int db = 0; db < DV / 32; ++db)
#pragma unroll
        for (int rg = 0; rg < 4; ++rg) { u32x2 w; w.x = cvt_pk_bf16(o[db][4 * rg] * sc, o[db][4 * rg + 1] * sc); w.y = cvt_pk_bf16(o[db][4 * rg + 2] * sc, o[db][4 * rg + 3] * sc);
            *(u32x2*)(orow + db * 32 + 8 * rg + 4 * h) = w; }
}


template <bool SINK> __device__ __forceinline__ void attn_window_unit(KP p, int l, int b, int hkv, int qt, int W, int cq, int ck, int cv, bf16_t* outbuf, unsigned char* lds) {
    const int tid = hidden_tid(), lane = tid & 63, wv = __builtin_amdgcn_readfirstlane(tid >> 6), r32 = lane & 31, h = lane >> 5, g = wv & 3, qsub = wv >> 2;
    const int head = hkv * 4 + g, t0 = qt * 64, tqw = t0 + 32 * qsub, tq = tqw + r32;
    const bf16_t* z = (const bf16_t*)(p->ws + OFF_Z);
    const float slope = exp2f(-(float)(head + 1));
    KVSrc src; src.k = (const char*)(z + (size_t)b * NS * ZW + ck + hkv * 64); src.v = (const char*)(z + (size_t)b * NS * ZW + cv + hkv * 64); src.kstride = ZW * 2; src.vstride = ZW * 2;
    int klo = t0 - W + 1; klo = klo < 0 ? 0 : klo; const int kt0 = klo >> 6, kt1 = qt;
    WaveAcc<64> a; acc_init(a);
    KVRing<1, 64> ring; ring.init(src, tid);
    const int nt = kt1 - kt0 + 1;
    for (int j = 0; j < RING_AHEAD && j < nt; ++j) ring.issue((kt1 - j) * 64, j, lds);
    bf16x8 qf[5]; load_q(qf, z + ((size_t)b * NS + tq) * ZW + cq + head * 64 + 8 * h, slope, lane);
    asm volatile("" :: "v"(qf[0]), "v"(qf[1]), "v"(qf[2]), "v"(qf[3]));
    asm volatile(".p2align 8");
    for (int t = 0; t < nt; ++t) {
        const int kt = kt1 - t, buf = t & (RING_NB - 1);
        ring.wait_bar(nt - 1 - t);
        if (t + RING_AHEAD < nt) ring.issue((kt - RING_AHEAD) * 64, (t + RING_AHEAD) & (RING_NB - 1), lds);
        const unsigned char* kimg = ring.kimg(lds, buf, 0); const unsigned char* vimg = ring.vimg(lds, buf);
#pragma unroll
        for (int sr = 0; sr < 2; ++sr) { const int sub = 1 - sr, key0 = kt * 64 + 32 * sub;
            if (key0 <= tqw + 31 && key0 + 31 >= tqw - W + 1) attn_sub_auto<64>(qf, kimg, vimg, sub, key0, tqw, tq, h, W, true, a, lane); }
    }
    __syncthreads();
    float den = swap_sum(a.l);
    if (SINK) den += fast_exp2((p->sinks[l * 8 + head] + slope * (float)tq - a.m) * LOG2E);
    store_o<64>(a.o, 1.0f / den, outbuf + ((size_t)b * NS + tq) * 512 + head * 64, h);
}

#ifndef EXPER
#define EXPER 0
#endif
__device__ __forceinline__ void attn_diff_unit(KP p, int l, int b, int hd, int qt, unsigned char* lds, const int shadow = 0) {
    const int tid = hidden_tid(), lane = tid & 63, wv = __builtin_amdgcn_readfirstlane(tid >> 6), r32 = lane & 31, h = lane >> 5, c = wv & 1, qsub = wv >> 1;
    const int t0 = qt * 128, tqw = t0 + 32 * qsub, tq = tqw + r32;
    const bf16_t* z = (const bf16_t*)(p->ws + OFF_Z);
    KVSrc src; src.k = (const char*)(z + (size_t)b * NS * ZW + C_KB + hd * 128); src.v = (const char*)(z + (size_t)b * NS * ZW + C_VB + hd * 128); src.kstride = ZW * 2; src.vstride = ZW * 2;
    const int kt1 = 2 * qt + 1;
    WaveAcc<128> a; acc_init(a);
    KVRing<2, 128> ring; ring.init(src, tid);
    const int nt = kt1 + 1;
    for (int j = 0; j < RING_AHEAD && j < nt; ++j) ring.issue((kt1 - j) * 64, j, lds);
    bf16x8 qf[5]; load_q(qf, z + ((size_t)b * NS + tq) * ZW + C_QB + hd * 128 + c * 64 + 8 * h, exp2f(-2.0f * (float)(hd + 1)), lane);
    asm volatile("" :: "v"(qf[0]), "v"(qf[1]), "v"(qf[2]), "v"(qf[3]));
    asm volatile(".p2align 8");
    for (int t = 0; t < nt; ++t) {
        const int kt = kt1 - t, buf = t & (RING_NB - 1);
        ring.wait_bar(nt - 1 - t);
        if (t + RING_AHEAD < nt) ring.issue((kt - RING_AHEAD) * 64, (t + RING_AHEAD) & (RING_NB - 1), lds);
        const unsigned char* kimg = ring.kimg(lds, buf, c); const unsigned char* vimg = ring.vimg(lds, buf);
#pragma unroll
        for (int sr = 0; sr < 2; ++sr) { const int sub = 1 - sr, key0 = kt * 64 + 32 * sub;
            if (key0 <= tqw + 31) {
                if (shadow && EXPER == 1) { }
                else attn_sub_auto<128>(qf, kimg, vimg, sub, key0, tqw, tq, h, 1 << 30, true, a, lane); } }
    }
    __syncthreads();
    const float lam_init = 0.8f - 0.6f * expf(-0.3f * (float)l);
    const float lam = ((const float*)p->ws)[CW_LAM + l];
    const float inv = 1.0f / swap_sum(a.l);
    float* ex = (float*)lds;
    if (c == 1) {
#pragma unroll
        for (int db = 0; db < 4; ++db)
#pragma unroll
            for (int r = 0; r < 16; ++r) ex[(qsub * 128 + db * 32 + crow(r, h)) * 32 + r32] = a.o[db][r] * inv;
    }
    __syncthreads();
    if (c == 0) {
        float ss = 0.f;
#pragma unroll
        for (int db = 0; db < 4; ++db)
#pragma unroll
            for (int r = 0; r < 16; ++r) { const float v = a.o[db][r] * inv - lam * ex[(qsub * 128 + db * 32 + crow(r, h)) * 32 + r32]; a.o[db][r] = v; ss += v * v; }
        ss = swap_sum(ss);
        const float rn = (1.0f - lam_init) / sqrtf(ss * (1.0f / 128.0f) + 1e-5f);
        const float* sg = p->diff_subln_g + (size_t)l * 128;
        bf16_t* orow = (shadow ? (bf16_t*)(p->ws + OFF_MSCR) : (bf16_t*)(p->ws + OFF_OABC) + (size_t)1 * NTOK * 512) + ((size_t)b * NS + tq) * 512 + hd * 128;
#pragma unroll
        for (int db = 0; db < 4; ++db)
#pragma unroll
            for (int rg = 0; rg < 4; ++rg) { const int d = db * 32 + 8 * rg + 4 * h; const f32x4 gv = *(const f32x4*)(sg + d);
                u32x2 w; w.x = cvt_pk_bf16(a.o[db][4 * rg] * rn * gv[0], a.o[db][4 * rg + 1] * rn * gv[1]); w.y = cvt_pk_bf16(a.o[db][4 * rg + 2] * rn * gv[2], a.o[db][4 * rg + 3] * rn * gv[3]);
                *(u32x2*)(orow + d) = w; }
    }
    __syncthreads();
}

#define AT_IMP   (AT_MISC)
#define AT_SELM  (AT_MISC + 34816)
__device__ __forceinline__ void attn_nsa_unit(KP p, int l, int b, int hkv, int qt, unsigned char* lds) {
    const int tid = hidden_tid(), lane = tid & 63, wv = __builtin_amdgcn_readfirstlane(tid >> 6), r32 = lane & 31, h = lane >> 5, g = wv & 3, qsub = wv >> 2;
    const int head = hkv * 4 + g, t0 = qt * 64, tqw = t0 + 32 * qsub, tq = tqw + r32;
    const bf16_t* z = (const bf16_t*)(p->ws + OFF_Z);
    bf16x8 qf[5]; load_q(qf, z + ((size_t)b * NS + tq) * ZW + C_QC + head * 64 + 8 * h, exp2f(-(float)(head + 1)), lane);
    float* imp = (float*)(lds + AT_IMP); unsigned* selm = (unsigned*)(lds + AT_SELM);
    KVRing<1, 64> ring;
    f32x16 ocmp[2];
    {
        const bf16_t* kvc = (const bf16_t*)(p->ws + OFF_KVC);
        KVSrc cs; cs.k = (const char*)(kvc + ((size_t)(0 * 16 + b) * 2 + hkv) * 128 * 64); cs.v = (const char*)(kvc + ((size_t)(1 * 16 + b) * 2 + hkv) * 128 * 64); cs.kstride = 128; cs.vstride = 128;
        ring.init(cs, tid); ring.issue(0, 0, lds); ring.issue(64, 1, lds);
        if (tid == 0) selm[64] = 0u;
        ring.wait_bar(0);
        f32x16 sc[4];
#pragma unroll
        for (int st = 0; st < 4; ++st) sc[st] = qk_sub(*(const bf16x8 (*)[4])&qf, ring.kimg(lds, st >> 1, 0), st & 1, lane);
        const int nvalid = tq >= 31 ? min(127, ((tq - 31) >> 4) + 1) : 0;
        float mx = -1e30f;
#pragma unroll
        for (int st = 0; st < 4; ++st)
#pragma unroll
            for (int r = 0; r < 16; ++r) { const int cidx = 32 * st + crow(r, h); const float v = cidx < nvalid ? sc[st][r] * LOG2E : -INFINITY; sc[st][r] = v; mx = fmaxf(mx, v); }
        mx = swap_max(mx);
        float ls = 0.f;
#pragma unroll
        for (int st = 0; st < 4; ++st)
#pragma unroll
            for (int r = 0; r < 16; ++r) { sc[st][r] = fast_exp2(sc[st][r] - mx); ls += sc[st][r]; }
        ls = swap_sum(ls); const float inv = ls > 0.f ? 1.0f / ls : 0.f;
        float Bv[4][4];
#pragma unroll
        for (int st = 0; st < 4; ++st)
#pragma unroll
            for (int r = 0; r < 16; ++r) sc[st][r] *= inv;
#pragma unroll
        for (int st = 0; st < 4; ++st)
#pragma unroll
            for (int g4 = 0; g4 < 4; ++g4) Bv[st][g4] = swap_other(sc[st][4 * g4 + 3], h);
#pragma unroll
        for (int st = 0; st < 4; ++st)
#pragma unroll
            for (int g4 = 0; g4 < 4; ++g4) {
                const float A = sc[st][4 * g4] + sc[st][4 * g4 + 1] + sc[st][4 * g4 + 2] + 0.5f * sc[st][4 * g4 + 3];
                const float prevlo = g4 > 0 ? Bv[st][g4 - 1] : (st > 0 ? Bv[st - 1][3] : 0.f);
                const float prev = h ? Bv[st][g4] : prevlo;
                imp[(g * 64 + qsub * 32 + r32) * 33 + 8 * st + 2 * g4 + h] = A + 0.5f * prev;
            }
#pragma unroll
        for (int d = 0; d < 2; ++d)
#pragma unroll
            for (int r = 0; r < 16; ++r) ocmp[d][r] = 0.f;
#pragma unroll
        for (int st = 0; st < 4; ++st) { VFrag<64> vf; v_read_all(vf, ring.vimg(lds, st >> 1), st & 1, lane); pv_sub<64>(sc[st], vf, ocmp); }
    }
    __syncthreads();
    const int cur = qt;
    for (int i = tid; i < 64 * 32; i += NTHREADS) { const int q = i >> 5, n = i & 31; imp[q * 33 + n] = (imp[q * 33 + n] + imp[(64 + q) * 33 + n]) + (imp[(128 + q) * 33 + n] + imp[(192 + q) * 33 + n]); }
    __syncthreads();
#pragma unroll 1
    for (int ps = 0; ps < 4; ++ps) {
        const int i = ps * NTHREADS + tid, q = i >> 5, n = i & 31;
        const bool forced = (n == 0) | (n == cur) | (n == cur - 1);
        const float kn = forced ? INFINITY : imp[q * 33 + n];
        int rank = 0;
#pragma unroll
        for (int m2 = 0; m2 < 32; ++m2) { const float km = __int_as_float(__builtin_amdgcn_ds_bpermute(((lane & 32) + m2) << 2, __float_as_int(kn)));
            rank += (m2 <= cur) && (m2 != n) && ((km > kn) || (km == kn && m2 < n)); }
        const bool sel = (n <= cur) && (rank < 16);
        const unsigned long long bal = __ballot(sel);
        if ((lane & 31) == 0) { const unsigned mk = (unsigned)(lane ? (bal >> 32) : bal); selm[q] = mk; atomicOr(&selm[64], mk); }
    }
    __syncthreads();
    const unsigned mymask = selm[qsub * 32 + r32]; unsigned um = __builtin_amdgcn_readfirstlane(selm[64]);
    WaveAcc<64> a; acc_init(a);
    {
        KVSrc src; src.k = (const char*)(z + (size_t)b * NS * ZW + C_KSL + hkv * 64); src.v = (const char*)(z + (size_t)b * NS * ZW + C_VSL + hkv * 64); src.kstride = ZW * 2; src.vstride = ZW * 2;
        ring.init(src, tid);
        unsigned m_issue = um; int nis = 0, ncp = 0; const int ntl = __popc(um);
        for (int j = 0; j < RING_AHEAD && m_issue; ++j) { const int kt = 31 - __clz((int)m_issue); m_issue &= ~(1u << kt); ring.issue(kt * 64, nis & (RING_NB - 1), lds); ++nis; }
    asm volatile(".p2align 8");
        while (um) {
            const int kt = 31 - __clz((int)um); um &= ~(1u << kt); const int buf = ncp & (RING_NB - 1);
            ring.wait_bar(nis - 1 - ncp);
            if (m_issue) { const int ktn = 31 - __clz((int)m_issue); m_issue &= ~(1u << ktn); ring.issue(ktn * 64, nis & (RING_NB - 1), lds); ++nis; }
            const bool lbit = (mymask >> kt) & 1u;
            if (__any(lbit)) {
                const unsigned char* kimg = ring.kimg(lds, buf, 0); const unsigned char* vimg = ring.vimg(lds, buf);
#pragma unroll
                for (int sr = 0; sr < 2; ++sr) { const int sub = 1 - sr, key0 = kt * 64 + 32 * sub;
                    if (key0 <= tqw + 31) attn_sub_auto<64>(qf, kimg, vimg, sub, key0, tqw, tq, h, 1 << 30, lbit, a, lane); }
            }
            ++ncp;
        }
        (void)ntl;
    }
    {
        const size_t tok = (size_t)b * NS + tq;
        const bf16_t* gp = z + tok * ZW + C_GN + head * 3;
        const float gc = bf2f(gp[0]), gs = bf2f(gp[1]) / swap_sum(a.l), gw = bf2f(gp[2]);
        const bf16_t* ow = (const bf16_t*)(p->ws + OFF_OWIN) + tok * 512 + head * 64;
        bf16_t* oc = (bf16_t*)(p->ws + OFF_OABC) + (size_t)2 * NTOK * 512 + tok * 512 + head * 64;
#pragma unroll
        for (int db = 0; db < 2; ++db)
#pragma unroll
            for (int rg = 0; rg < 4; ++rg) { const int d = db * 32 + 8 * rg + 4 * h; const u32x2 wv2 = *(const u32x2*)(ow + d);
                const float o0 = gc * ocmp[db][4 * rg] + gs * a.o[db][4 * rg] + gw * bflo(wv2.x), o1 = gc * ocmp[db][4 * rg + 1] + gs * a.o[db][4 * rg + 1] + gw * bfhi(wv2.x);
                const float o2 = gc * ocmp[db][4 * rg + 2] + gs * a.o[db][4 * rg + 2] + gw * bflo(wv2.y), o3 = gc * ocmp[db][4 * rg + 3] + gs * a.o[db][4 * rg + 3] + gw * bfhi(wv2.y);
                u32x2 w; w.x = cvt_pk_bf16(o0, o1); w.y = cvt_pk_bf16(o2, o3); *(u32x2*)(oc + d) = w; }
    }
    __syncthreads();
}

__device__ __forceinline__ void compress_unit(KP p, int l, int u, unsigned char* lds) {
    char* ws = p->ws;
    const int kv = u >> 4, rt = u & 15;
    GemmOperands g; g.Abase = ws + OFF_Z; g.kstride = ZW * 2; g.K = 2048; g.Bbase = ws + OFF_WC1 + ((size_t)(l * 2 + kv) * 256) * 2048 * 2;
GEMM_STAGE_IDS();
#pragma unroll
    for (int i = 0; i < 4; ++i) { const int row = rt * 256 + TILE_ROW(i), bh = row >> 7, b = bh >> 1, hk = bh & 1; int c = row & 127; c = c > 126 ? 126 : c;
        g.aoff[i] = (unsigned)((((size_t)b * NS + 16 * c) * ZW + (kv ? C_VCM : C_KCM) + hk * 64 + cS) * 2); } g.boff = (unsigned)((rS * 2048 + cS) * 2);
    f32x4 acc[2][2][4][2];
    gemm_unit(g, (bf16_t*)lds, acc);
    GEMM_LANE_IDS();
    const float* cb = (const float*)(ws + OFF_CBIAS) + (size_t)(l * 2 + kv) * 4 * 256; const float* cb1 = p->cmp_b1 + (l * 2 + kv) * 256;
#pragma unroll
    for (int bj = 0; bj < 2; ++bj)
#pragma unroll
        for (int n = 0; n < 2; ++n) { const int col = bj * 128 + wc * 32 + n * 16 + fq * 4; const f32x4 bv = (*(const f32x4*)(cb + col) + *(const f32x4*)(cb + 256 + col)) + (*(const f32x4*)(cb + 512 + col) + *(const f32x4*)(cb + 768 + col)) + *(const f32x4*)(cb1 + col);
#pragma unroll
            for (int ai = 0; ai < 2; ++ai)
#pragma unroll
                for (int m = 0; m < 4; ++m) { const int row = ai * 128 + wr * 64 + m * 16 + fr; f32x4 v = acc[ai][bj][m][n] + bv;
#pragma unroll
                    for (int j = 0; j < 4; ++j) { const float x = v[j]; v[j] = x * sigmoidf_(1.5957691216057308f * (x + 0.044715f * x * x * x)); }
                    u32x2 w; w.x = cvt_pk_bf16(v[0], v[1]); w.y = cvt_pk_bf16(v[2], v[3]); *(u32x2*)(lds + row * 528 + col * 2) = w; } }
    __syncthreads();
    {
        const bf16_t* w2 = (const bf16_t*)(ws + OFF_WC2) + (size_t)(l * 2 + kv) * 64 * 256;
        f32x4 c2[2][4];
#pragma unroll
        for (int mt = 0; mt < 2; ++mt)
#pragma unroll
            for (int nt = 0; nt < 4; ++nt) c2[mt][nt] = (f32x4){0.f, 0.f, 0.f, 0.f};
#pragma unroll
        for (int ks = 0; ks < 8; ++ks) {
            bf16x8 af[2], bfr[4];
#pragma unroll
            for (int mt = 0; mt < 2; ++mt) af[mt] = *(const bf16x8*)(lds + (wid * 32 + mt * 16 + fr) * 528 + (ks * 32 + fq * 8) * 2);
#pragma unroll
            for (int nt = 0; nt < 4; ++nt) bfr[nt] = *(const bf16x8*)(w2 + (size_t)(nt * 16 + fr) * 256 + ks * 32 + fq * 8);
#pragma unroll
            for (int mt = 0; mt < 2; ++mt)
#pragma unroll
                for (int nt = 0; nt < 4; ++nt) c2[mt][nt] = __builtin_amdgcn_mfma_f32_16x16x32_bf16(af[mt], bfr[nt], c2[mt][nt], 0, 0, 0);
        }
        bf16_t* kvc = (bf16_t*)(ws + OFF_KVC) + (size_t)kv * 16 * 2 * 128 * 64;
        const float* b2 = p->cmp_b2 + (l * 2 + kv) * 64;
#pragma unroll
        for (int mt = 0; mt < 2; ++mt)
#pragma unroll
            for (int nt = 0; nt < 4; ++nt)
#pragma unroll
                for (int r = 0; r < 4; ++r) { const int row = rt * 256 + wid * 32 + mt * 16 + 4 * fq + r, col = nt * 16 + fr;
                    kvc[(size_t)row * 64 + col] = f2bf(c2[mt][nt][r] + b2[col]); }
    }
    __syncthreads();
}

#define RT_HS    0
#define RT_LG    132096
#define RT_HIST  (RT_LG + 8448)
#ifndef REPN2
#define REPN2 1
#endif
__device__ __forceinline__ void phase_norm2_router(KP p, int l, unsigned char* lds) {
  for (int shadow = 0; shadow < REPN2; ++shadow) {
    char* ws = p->ws; const int tid = hidden_tid(), lane = tid & 63, wv = __builtin_amdgcn_readfirstlane(tid >> 6);
    const float* modl = (const float*)(ws + OFF_MOD) + (size_t)l * 16 * 6144; const float* g = p->norm2_g + (size_t)l * 1024;
    const bf16_t* xrb = (const bf16_t*)(ws + OFF_XR);
    float* LG = (float*)(lds + RT_LG); int* hist = (int*)(lds + RT_HIST); int* basep = hist + 32;
    unsigned* ctrl = (unsigned*)ws;
    const bf16_t* wrt = (const bf16_t*)(ws + OFF_WRT) + (size_t)l * 2 * 32 * 1024;
    for (int chunk = hidden_bid(); chunk < NTOK / 64; chunk += gridDim.x) {
        if (tid < 32) hist[tid] = 0;
        {
            const int rowa = chunk * 64 + wv * 8, b = rowa >> 11;
            f32x4 gg[4], sc[4], sh[4]; u32x2 xn[4];
#pragma unroll
            for (int j = 0; j < 4; ++j) { const int col = 256 * j + 4 * lane; gg[j] = *(const f32x4*)(g + col); sc[j] = *(const f32x4*)(modl + (size_t)b * 6144 + 4096 + col); sh[j] = *(const f32x4*)(modl + (size_t)b * 6144 + 3072 + col);
                xn[j] = *(const u32x2*)(xrb + (size_t)rowa * 1024 + col); }
            for (int i = 0; i < 8; ++i) {
                const int rl = wv * 8 + i, row = rowa + i;
                f32x4 v[4]; float ss = 0.f;
#pragma unroll
                for (int j = 0; j < 4; ++j) { v[j] = (f32x4){bflo(xn[j].x), bfhi(xn[j].x), bflo(xn[j].y), bfhi(xn[j].y)};
                    ss += v[j][0] * v[j][0] + v[j][1] * v[j][1] + v[j][2] * v[j][2] + v[j][3] * v[j][3]; }
                if (i + 1 < 8) {
#pragma unroll
                    for (int j = 0; j < 4; ++j) { const int col = 256 * j + 4 * lane; xn[j] = *(const u32x2*)(xrb + (size_t)(row + 1) * 1024 + col); } }
                ss = wave_sum(ss, lane); const float r = 1.0f / sqrtf(ss * (1.0f / 1024.0f) + 1e-5f);
#pragma unroll
                for (int j = 0; j < 4; ++j) { const int col = 256 * j + 4 * lane;
                    float o[4];
#pragma unroll
                    for (int q = 0; q < 4; ++q) o[q] = v[j][q] * r * gg[j][q] * (1.0f + sc[j][q]) + sh[j][q];
                    u32x2 w; w.x = cvt_pk_bf16(o[0], o[1]); w.y = cvt_pk_bf16(o[2], o[3]);
                    if (!shadow) *(unsigned*)((unsigned char*)(ws + OFF_H8) + (size_t)row * 1024 + col) = pk4_fp8(o[0], o[1], o[2], o[3]);
                    *(u32x2*)(lds + RT_HS + rl * 2064 + col * 2) = w; }
            }
        }
        __syncthreads();
        {
            const int mt = wv & 3, nt = wv >> 2, fr = lane & 15, fq = lane >> 4;
            f32x4 acc = (f32x4){0.f, 0.f, 0.f, 0.f};
            const bf16_t* wh = wrt + ((size_t)nt * 32 * 64 + lane) * 8; const bf16_t* wl = wh + 32768;
            const unsigned char* ap = lds + RT_HS + (mt * 16 + fr) * 2064 + fq * 16;
#pragma unroll 8
            for (int ks = 0; ks < 32; ++ks) { const bf16x8 a = *(const bf16x8*)(ap + ks * 64); const bf16x8 bh = *(const bf16x8*)(wh + ks * 512), bl = *(const bf16x8*)(wl + ks * 512);
                acc = __builtin_amdgcn_mfma_f32_16x16x32_bf16(a, bh, acc, 0, 0, 0); acc = __builtin_amdgcn_mfma_f32_16x16x32_bf16(a, bl, acc, 0, 0, 0); }
            const float rb = p->router_b[l * 32 + nt * 16 + fr];
#pragma unroll
            for (int r = 0; r < 4; ++r) LG[(mt * 16 + 4 * fq + r) * 33 + nt * 16 + fr] = acc[r] + rb;
        }
        __syncthreads();
        int se[4], sp[4]; float sg[4];
        if (tid < 64) {
            unsigned taken = 0u; float tv[4];
#pragma unroll
            for (int k = 0; k < 4; ++k) { float best = -INFINITY; int bi = 0;
#pragma unroll 4
                for (int e = 0; e < 32; ++e) { const float v = LG[tid * 33 + e]; if (!((taken >> e) & 1u) && v > best) { best = v; bi = e; } }
                taken |= 1u << bi; se[k] = bi; tv[k] = best; }
            float den = 0.f;
#pragma unroll
            for (int k = 0; k < 4; ++k) { sg[k] = __expf(tv[k] - tv[0]); den += sg[k]; }
#pragma unroll
            for (int k = 0; k < 4; ++k) { sg[k] /= den; sp[k] = atomicAdd(&hist[se[k]], 1); }
        }
        __syncthreads();
        if (tid < 32) { const int c = hist[tid]; basep[tid] = (c && !shadow) ? (int)atomicAdd(&ctrl[CW_ECNT(l, tid)], (unsigned)c) : 0; }
        __syncthreads();
        if (tid < 64 && !shadow) { const int tok = chunk * 64 + tid;
#pragma unroll
            for (int k = 0; k < 4; ++k) { const int pos = basep[se[k]] + sp[k];
                ((int*)(ws + OFF_TOKE))[tok * 4 + k] = se[k]; ((int*)(ws + OFF_TOKP))[tok * 4 + k] = pos; ((float*)(ws + OFF_TOKG))[tok * 4 + k] = sg[k];
                ((int*)(ws + OFF_BUCK))[(size_t)se[k] * NTOK + pos] = tok; } }
        __syncthreads();
    }
}
  __syncthreads(); }


__device__ __forceinline__ void phase_combine(KP p, int l, unsigned char* lds) {
    char* ws = p->ws; const int tid = hidden_tid(), lane = tid & 63, wv = tid >> 6;
    int* tbl = (int*)lds; moe_tables(p, l, tbl);
    bf16_t* xr = (bf16_t*)(ws + OFF_XR); const bf16_t* y = (const bf16_t*)(ws + OFF_Y); bf16_t* hb = (bf16_t*)(ws + OFF_HB);
    const bool last = (l + 1 == NLAYER);
    for (int gw = hidden_bid() * 8 + wv; gw < NTOK / 16; gw += gridDim.x * 8) {
        const int row0 = gw * 16, b = row0 >> 11;
        const float* modl = (const float*)(ws + OFF_MOD) + ((size_t)l * 16 + b) * 6144;
        const float* gn = last ? p->final_g : p->norm1_g + (size_t)(l + 1) * 1024;
        const float* modn = (const float*)(ws + OFF_MOD) + ((size_t)(last ? l : l + 1) * 16 + b) * 6144;
        f32x4 g2[4], gg[4], sc[4], sh[4];
#pragma unroll
        for (int j = 0; j < 4; ++j) { const int col = 256 * j + 4 * lane; g2[j] = *(const f32x4*)(modl + 5120 + col); gg[j] = *(const f32x4*)(gn + col);
            sc[j] = last ? (f32x4){0.f, 0.f, 0.f, 0.f} : *(const f32x4*)(modn + 1024 + col); sh[j] = last ? (f32x4){0.f, 0.f, 0.f, 0.f} : *(const f32x4*)(modn + col); }
        typedef int i32x4_ __attribute__((ext_vector_type(4)));
        i32x4_ te = *(const i32x4_*)((const int*)(ws + OFF_TOKE) + (size_t)row0 * 4), tp = *(const i32x4_*)((const int*)(ws + OFF_TOKP) + (size_t)row0 * 4);
        f32x4 tg = *(const f32x4*)((const float*)(ws + OFF_TOKG) + (size_t)row0 * 4);
        u32x2 xin[4]; u32x2 yin[4][4]; float gk[4];
        auto load_row = [&](int row, const i32x4_& e4, const i32x4_& p4, const f32x4& g4) {
#pragma unroll
            for (int k = 0; k < 4; ++k) { const bf16_t* yr = y + ((size_t)tbl[e4[k]] * 256 + p4[k]) * 1024; gk[k] = g4[k];
#pragma unroll
                for (int j = 0; j < 4; ++j) yin[k][j] = *(const u32x2*)(yr + 256 * j + 4 * lane); }
#pragma unroll
            for (int j = 0; j < 4; ++j) xin[j] = *(const u32x2*)(xr + (size_t)row * 1024 + 256 * j + 4 * lane);
        };
        load_row(row0, te, tp, tg);
        if (16 > 1) { te = *(const i32x4_*)((const int*)(ws + OFF_TOKE) + (size_t)(row0 + 1) * 4); tp = *(const i32x4_*)((const int*)(ws + OFF_TOKP) + (size_t)(row0 + 1) * 4); tg = *(const f32x4*)((const float*)(ws + OFF_TOKG) + (size_t)(row0 + 1) * 4); }
        for (int i = 0; i < 16; ++i) {
            const int row = row0 + i;
            f32x4 v[4]; float ss = 0.f;
#pragma unroll
            for (int j = 0; j < 4; ++j) { f32x4 m = (f32x4){0.f, 0.f, 0.f, 0.f};
#pragma unroll
                for (int k = 0; k < 4; ++k) { const u32x2 w = yin[k][j]; m[0] += gk[k] * bflo(w.x); m[1] += gk[k] * bfhi(w.x); m[2] += gk[k] * bflo(w.y); m[3] += gk[k] * bfhi(w.y); }
                v[j] = (f32x4){bflo(xin[j].x), bfhi(xin[j].x), bflo(xin[j].y), bfhi(xin[j].y)} + g2[j] * m;
                ss += v[j][0] * v[j][0] + v[j][1] * v[j][1] + v[j][2] * v[j][2] + v[j][3] * v[j][3]; }
            if (i + 1 < 16) { load_row(row + 1, te, tp, tg);
                if (i + 2 < 16) { te = *(const i32x4_*)((const int*)(ws + OFF_TOKE) + (size_t)(row + 2) * 4); tp = *(const i32x4_*)((const int*)(ws + OFF_TOKP) + (size_t)(row + 2) * 4); tg = *(const f32x4*)((const float*)(ws + OFF_TOKG) + (size_t)(row + 2) * 4); } }
            ss = wave_sum(ss, lane); const float r = 1.0f / sqrtf(ss * (1.0f / 1024.0f) + 1e-5f);
#pragma unroll
            for (int j = 0; j < 4; ++j) { const int col = 256 * j + 4 * lane;
                if (last) { *(f32x4*)(p->out + (size_t)row * 1024 + col) = v[j] * r * gg[j]; }
                else { u32x2 xw; xw.x = cvt_pk_bf16(v[j][0], v[j][1]); xw.y = cvt_pk_bf16(v[j][2], v[j][3]); *(u32x2*)(xr + (size_t)row * 1024 + col) = xw; float o[4];
#pragma unroll
                    for (int q = 0; q < 4; ++q) o[q] = v[j][q] * r * gg[j][q] * (1.0f + sc[j][q]) + sh[j][q];
#if INPROJ_FP8
                    *(unsigned*)((unsigned char*)hb + (size_t)row * 1024 + col) = pk4_fp8(o[0], o[1], o[2], o[3]); }
#else
                    u32x2 w; w.x = cvt_pk_bf16(o[0], o[1]); w.y = cvt_pk_bf16(o[2], o[3]); *(u32x2*)(hb + (size_t)row * 1024 + col) = w; }
#endif
            }
        }
    }
}

#ifndef SWA_IN_AT2
#define SWA_IN_AT2 1
#endif
#define LDS_QSLOT (LDS_BYTES - 64)
#define LDS_BARW  (LDS_BYTES - 16)
__device__ __forceinline__ int q_next(unsigned* ctr, unsigned char* lds) {
    __syncthreads();
    if (hidden_tid() == 0) *(int*)(lds + LDS_QSLOT) = (int)__hip_atomic_fetch_add(ctr, 1u, __ATOMIC_RELAXED, __HIP_MEMORY_SCOPE_AGENT);
    __syncthreads();
    return __builtin_amdgcn_readfirstlane(*(int*)(lds + LDS_QSLOT));
}
__device__ __forceinline__ int q_next2(unsigned* ctr, unsigned* xg, unsigned char* lds, int& g) {
    __syncthreads();
    if (hidden_tid() == 0) { const unsigned a = __hip_atomic_fetch_add(ctr, 1u, __ATOMIC_RELAXED, __HIP_MEMORY_SCOPE_AGENT), b = __hip_atomic_fetch_add(xg, 1u, __ATOMIC_RELAXED, __HIP_MEMORY_SCOPE_AGENT);
        *(int*)(lds + LDS_QSLOT) = (int)a; *(int*)(lds + LDS_QSLOT + 4) = (int)(b < 3072u ? b : 3072u); }
    __syncthreads();
    g = __builtin_amdgcn_readfirstlane(*(int*)(lds + LDS_QSLOT + 4));
    return __builtin_amdgcn_readfirstlane(*(int*)(lds + LDS_QSLOT));
}
__device__ __forceinline__ void phase_at1(KP p, int lq, unsigned char* lds) {
    unsigned* ctrl = (unsigned*)p->ws; const int l = lq & 1;
#ifndef SUB
#define SUB -1
#endif
#ifndef DBLSUB
#define DBLSUB -1
#endif
#ifndef REP0
#define REP0 1
#endif
#ifndef REP1
#define REP1 1
#endif
#ifndef REP2
#define REP2 1
#endif
#ifndef REP3
#define REP3 1
#endif
#ifndef REP4
#define REP4 1
#endif
#define SUBON(k) ((SUB < 0 || SUB == (k)) && (lq < 2 || DBLSUB < 0 || DBLSUB == (k)))
    if (SUBON(0)) for (int rep = 0; rep < REP0; ++rep) for (;;) { const int u = q_next(ctrl + CW_QCTR(lq + 2 * rep, 0), lds); if (u >= 32) break; compress_unit(p, l, u, lds); }
    if (SUBON(1)) for (int rep = 0; rep < REP1; ++rep) for (;;) { int g; const int u = q_next2(ctrl + CW_QCTR(lq + 2 * rep, 1), ctrl + CW_XG(l), lds, g); if (u >= 1024) { if (COSCHED && rep == 0 && g < 3072) xpose8_group(p, l, g, lds); break; }     attn_diff_unit(p, l, (u & 63) >> 2, u & 3, 15 - (u >> 6), lds, rep); if (COSCHED && rep == 0 && g < 3072) xpose8_group(p, l, g, lds); }
    if (SUBON(2)) for (int rep = 0; rep < REP2; ++rep) for (;;) { int g; const int u = q_next2(ctrl + CW_QCTR(lq + 2 * rep, 2), ctrl + CW_XG(l), lds, g); if (u >= 1024) { if (COSCHED && rep == 0 && g < 3072) xpose8_group(p, l, g, lds); break; }
        attn_window_unit<false>(p, l, (u & 31) >> 1, u & 1, 31 - (u >> 5), 512, C_QC, C_KWN, C_VWN, (bf16_t*)(p->ws + OFF_OWIN), lds); if (COSCHED && rep == 0 && g < 3072) xpose8_group(p, l, g, lds); }
#if !SWA_IN_AT2
    if (SUBON(3)) for (int rep = 0; rep < REP3; ++rep) for (;;) { int g; const int u = q_next2(ctrl + CW_QCTR(lq + 2 * rep, 3), ctrl + CW_XG(l), lds, g); if (u >= 1024) { if (COSCHED && rep == 0 && g < 3072) xpose8_group(p, l, g, lds); break; }
        attn_window_unit<true>(p, l, (u & 31) >> 1, u & 1, 31 - (u >> 5), 128, C_QA, C_KA, C_VA, (bf16_t*)(p->ws + OFF_OABC), lds); if (COSCHED && rep == 0 && g < 3072) xpose8_group(p, l, g, lds); }
#endif
}
__device__ __forceinline__ void phase_at2(KP p, int lq, unsigned char* lds) {
    unsigned* ctrl = (unsigned*)p->ws; const int l = lq & 1;
    for (int rep = 0; rep < REP4; ++rep) for (;;) { const int u = q_next(ctrl + CW_QCTR(lq + 2 * rep, 4), lds); if (u >= 1024) break; attn_nsa_unit(p, l, (u & 31) >> 1, u & 1, 31 - (u >> 5), lds); if (COSCHED && INPROJ_FP8 && rep == 0 && lq == 0 && u < MISC_GROUPS) misc_group(p, u, lds); }
#if SWA_IN_AT2
    for (int rep = 0; rep < REP3; ++rep) for (;;) { int g; const int u = q_next2(ctrl + CW_QCTR(lq + 2 * rep, 3), ctrl + CW_XG(l), lds, g); if (u >= 1024) { if (COSCHED && rep == 0 && g < 3072) xpose8_group(p, l, g, lds); break; }
        attn_window_unit<true>(p, l, (u & 31) >> 1, u & 1, 31 - (u >> 5), 128, C_QA, C_KA, C_VA, (bf16_t*)(p->ws + OFF_OABC), lds); if (COSCHED && rep == 0 && g < 3072) xpose8_group(p, l, g, lds); }
#endif
}

#ifndef BAR_RIDERS
#define BAR_RIDERS 1
#endif
__device__ __forceinline__ void xcd_barrier_work(const XcdBarrier& b, int ph, KP p, unsigned char* lds) {
    asm volatile("s_waitcnt vmcnt(0)" ::: "memory");
    __syncthreads();
    volatile LAS unsigned* st = b.st;
    const int wl = (!COSCHED || !BAR_RIDERS) ? -1 : (ph <= 6 ? 0 : (ph <= 15 ? 1 : -1));
    bool lastx = true; unsigned gen = 0u;
    if (hidden_tid() == 0) {
        unsigned* bar = b.bar;
        __builtin_amdgcn_s_waitcnt(0);
        unsigned nloc = st[0], nx = st[1];
        if (nloc == 0u) { xcd_barrier_complete(bar, b.x, nloc, nx); st[0] = nloc; st[1] = nx; }
        const unsigned old = xb_add(&bar[XB_XSUB(b.x)], 1u);
        gen = old / nloc;
        lastx = old + 1u == (gen + 1u) * nloc;
        int gl = -1; unsigned g = 0u;
        if (!lastx && wl >= 0 && (old - gen * nloc) < (nloc >> 1)) {
            gl = wl; g = xb_add(&bar[CW_XG(gl)], 1u);
            if (g >= 3072u && gl == 0) { gl = 1; g = xb_add(&bar[CW_XG(1)], 1u); }
            if (g >= 3072u) gl = -1; }
        st[2] = (unsigned)(gl + 1); st[3] = g;
        if (lastx) {
            __builtin_amdgcn_fence(__ATOMIC_RELEASE, "agent");
            asm volatile("s_waitcnt vmcnt(0)" ::: "memory");
            const unsigned og = xb_add(&bar[XB_TOP], 1u);
            const unsigned tg = og / nx;
            if (og + 1u == (tg + 1u) * nx) xb_add(&bar[XB_TOPGEN], 1u);
            else XB_SPIN(xb_ld(&bar[XB_TOPGEN]) == tg, bar);
            __builtin_amdgcn_fence(__ATOMIC_ACQUIRE, "agent");
            xb_add(&bar[XB_XGEN(b.x)], 1u);
            asm volatile("s_waitcnt vmcnt(0)" ::: "memory");
        }
    }
    __syncthreads();
    const int gl = __builtin_amdgcn_readfirstlane((int)st[2]) - 1;
    if (gl >= 0) { const int g = __builtin_amdgcn_readfirstlane((int)st[3]); xpose8_group(p, gl, g, lds); asm volatile("s_waitcnt vmcnt(0)" ::: "memory"); }
    if (hidden_tid() == 0 && !lastx) {
        unsigned* bar = b.bar;
        XB_SPIN(xb_ld(&bar[XB_XGEN(b.x)]) == gen, bar);
        __builtin_amdgcn_fence(__ATOMIC_ACQUIRE, "agent");
        asm volatile("s_waitcnt vmcnt(0)" ::: "memory");
    }
    __syncthreads();
}

#define NPHASE 20
__global__ void __launch_bounds__(NTHREADS, 2) mega(Params pv_unused) {
    KP p0 = (KP)__builtin_amdgcn_kernarg_segment_ptr();
    extern __shared__ __attribute__((aligned(16))) unsigned char lds0[];
    volatile LAS unsigned* st = (volatile LAS unsigned*)(lds0 + LDS_BARW);
    if (hidden_tid() == 0) { st[0] = 0u; st[1] = 0u; st[2] = 0u; st[3] = 0u; }
    __syncthreads();
    XcdBarrier bar = xcd_barrier_post((unsigned*)p0->ws, st);
    int ph = 0;
#ifndef DBL
#define DBL -1
#endif
    int qrep = 0; (void)qrep;
#define PHASE(body) { KP p = p0; asm volatile("" : "+s"(p)); unsigned char* lds = lds0; (void)lds; if (ph >= p->ph_lo && ph <= p->ph_hi) { body; if (ph < p->ph_hi) xcd_barrier_work(bar, ph, p, lds); } ++ph; }
#ifndef ONLY
#define ONLY -1
#endif
#ifndef DBLL
#define DBLL -1
#endif
    int lcur = -1; (void)lcur;
#define SEL(n, body) { if (ONLY < 0 || ONLY == (n)) { body; if (DBL == (n) && (DBLL < 0 || DBLL == lcur)) { xcd_barrier(bar); qrep = 2; body; qrep = 0; } } }
    PHASE(SEL(0, phase_prologue(p, lds)));
    PHASE(SEL(1, phase_norm_mod(p->x, p->norm1_g, (const float*)(p->ws + OFF_MOD), 0, 1024, (bf16_t*)(p->ws + OFF_HB))));
#pragma unroll
    for (int l = 0; l < NLAYER; ++l) { lcur = l;
        PHASE(SEL(2, phase_inproj(p, l, lds)));
        PHASE(SEL(3, phase_at1(p, l + qrep, lds)));
        PHASE(SEL(4, phase_at2(p, l + qrep, lds)));
        PHASE(SEL(5, phase_merge(p, l, lds)));
        PHASE(SEL(6, phase_outproj(p, l, lds)));
        PHASE(SEL(7, phase_norm2_router(p, l, lds)));
        PHASE(SEL(8, phase_moe1(p, l, lds)));
        PHASE(SEL(9, phase_moe2(p, l, lds)));
        PHASE(SEL(10, phase_combine(p, l, lds)));
    }
}

#ifndef MK_LAUNCHES
#define MK_LAUNCHES 1
#endif
extern "C" void kernel_launch(void* const* d_in, const int* in_sizes, int n_in, void* d_out, int out_size, void* d_ws, size_t ws_size, hipStream_t stream) {
    if (ws_size < WS_NEED) { fprintf(stderr, "workspace too small: %zu < %zu\n", ws_size, (size_t)WS_NEED); return; }
    static bool attr_done = false;
    if (!attr_done) { hipFuncSetAttribute((const void*)mega, hipFuncAttributeMaxDynamicSharedMemorySize, LDS_BYTES); attr_done = true; }
    Params p{};
    const float** f = (const float**)&p;
    for (int i = 0; i < 25; ++i) f[i] = (const float*)d_in[i];
    p.out = (float*)d_out; p.ws = (char*)d_ws;
    hipMemsetAsync(d_ws, 0, SZ_CTRL, stream);
    int dev = 0, cus = 0; hipGetDevice(&dev); hipDeviceGetAttribute(&cus, hipDeviceAttributeMultiprocessorCount, dev);
    const int grid = cus > 0 ? cus : 256;
#if MK_LAUNCHES == 1
    p.ph_lo = 0; p.ph_hi = NPHASE - 1;
    hipLaunchKernelGGL(mega, dim3(grid), dim3(NTHREADS), LDS_BYTES, stream, p);
#else
    for (int k = 0; k < NPHASE; ++k) { p.ph_lo = k; p.ph_hi = k; hipLaunchKernelGGL(mega, dim3(grid), dim3(NTHREADS), LDS_BYTES, stream, p); }
#endif
}
```

```cpp
#include <hip/hip_runtime.h>
#include <stdint.h>
#include <stdio.h>

#define NB      16
#define NS      2048
#define NTOK    (NB * NS)
#define DM      1024
#define NLAYER  2
#define ZW      6912
#define INW     6680
#define C_QA   0
#define C_KA   512
#define C_VA   640
#define C_QB   768
#define C_KB   1280
#define C_VB   1792
#define C_QC   2304
#define C_KCM  2816
#define C_VCM  2944
#define C_KSL  3072
#define C_VSL  3200
#define C_KWN  3328
#define C_VWN  3456
#define C_GM   3584
#define C_GN   6656
#define NEXP   32
#define PMAX   (NTOK * 4 + NEXP * 256)
#define NCMP   127

typedef unsigned short bf16_t;
typedef short bf16x8 __attribute__((ext_vector_type(8)));
typedef short bf16x4 __attribute__((ext_vector_type(4)));
typedef float f32x4 __attribute__((ext_vector_type(4)));
typedef float f32x2 __attribute__((ext_vector_type(2)));
typedef float f32x16 __attribute__((ext_vector_type(16)));
typedef unsigned u32x4 __attribute__((ext_vector_type(4)));
typedef unsigned u32x2 __attribute__((ext_vector_type(2)));

#define LAS __attribute__((address_space(3)))
#define NTHREADS 512
#define LDS_BYTES (160 * 1024)

__device__ __forceinline__ unsigned cvt_pk_bf16(float lo, float hi) { unsigned r; asm volatile("v_cvt_pk_bf16_f32 %0, %1, %2" : "=v"(r) : "v"(lo), "v"(hi)); return r; }
__device__ __forceinline__ bf16_t f2bf(float f) { return (bf16_t)(cvt_pk_bf16(f, 0.f) & 0xffffu); }
__device__ __forceinline__ float bf2f(bf16_t b) { return __uint_as_float(((unsigned)b) << 16); }
__device__ __forceinline__ float bflo(unsigned w) { return __uint_as_float(w << 16); }
__device__ __forceinline__ float bfhi(unsigned w) { return __uint_as_float(w & 0xffff0000u); }
#define LOG2E 1.4426950408889634f
__device__ __forceinline__ float fast_exp2(float x) { return __builtin_amdgcn_exp2f(x); }
__device__ __forceinline__ float fast_rcp(float x) { return __builtin_amdgcn_rcpf(x); }
__device__ __forceinline__ float sigmoidf_(float x) { return fast_rcp(1.0f + fast_exp2(-1.4426950408889634f * x)); }

__device__ __forceinline__ unsigned hidden_bid() { unsigned b = blockIdx.x; asm volatile("" : "+s"(b)); return b; }
__device__ __forceinline__ int hidden_tid() { int t = threadIdx.x; asm volatile("" : "+v"(t)); return t; }

#define XB_TMO      128
#define XB_XCNT(j)  (256  + 64 * (j))
#define XB_XSUB(j)  (1280 + 64 * (j))
#define XB_XGEN(j)  (2304 + 64 * (j))
#define XB_TOP      3328
#define XB_TOPGEN   3392
#define XCD_BAR_WORDS 3456
#define XB_SPIN_CAP (1u << 24)

__device__ __forceinline__ unsigned xb_ld(unsigned* p)              { return __hip_atomic_load(p, __ATOMIC_RELAXED, __HIP_MEMORY_SCOPE_AGENT); }
__device__ __forceinline__ unsigned xb_add(unsigned* p, unsigned v) { return __hip_atomic_fetch_add(p, v, __ATOMIC_RELAXED, __HIP_MEMORY_SCOPE_AGENT); }
__device__ __forceinline__ unsigned xb_xcc_id() { return (unsigned)__builtin_amdgcn_s_getreg((3 << 11) | 20) & 0xFu; }
#define XB_SPIN(cond, bar) do { unsigned _sp = 0; while (cond) { __builtin_amdgcn_s_sleep(1); \
    if ((++_sp & 255u) == 0u) { if (xb_ld(&(bar)[XB_TMO])) break; if (_sp > XB_SPIN_CAP) { atomicAdd(&(bar)[XB_TMO], 1u); break; } } } } while (0)

struct XcdBarrier { unsigned* bar; unsigned x; volatile LAS unsigned* st; };

__device__ __forceinline__ XcdBarrier xcd_barrier_post(unsigned* bar, volatile LAS unsigned* st) {
    XcdBarrier b; b.bar = bar; b.x = xb_xcc_id(); b.st = st;
    if (hidden_tid() == 0) (void)xb_add(&bar[XB_XCNT(b.x)], 1u);
    return b;
}
__device__ __forceinline__ void xcd_barrier_complete(unsigned* bar, unsigned x, unsigned& nloc, unsigned& nx) {
    const unsigned G = gridDim.x * gridDim.y * gridDim.z;
    unsigned sum, cnt, mine, sp = 0u;
    for (;;) {
        sum = 0u; cnt = 0u; mine = 0u;
#pragma unroll
        for (unsigned j = 0; j < 16; ++j) { const unsigned c = xb_ld(&bar[XB_XCNT(j)]); sum += c; cnt += (c > 0u) ? 1u : 0u; mine = (j == x) ? c : mine; }
        if (sum == G) break;
        __builtin_amdgcn_s_sleep(1);
        if ((++sp & 255u) == 0u) { if (xb_ld(&bar[XB_TMO])) break; if (sp > XB_SPIN_CAP) { atomicAdd(&bar[XB_TMO], 1u); break; } }
    }
    nloc = mine > 0u ? mine : 1u; nx = cnt > 0u ? cnt : 1u;
}
__device__ __forceinline__ void xcd_barrier(const XcdBarrier& b) {
    asm volatile("s_waitcnt vmcnt(0)" ::: "memory");
    __syncthreads();
    if (hidden_tid() == 0) {
        unsigned* bar = b.bar;
        __builtin_amdgcn_s_waitcnt(0);
        unsigned nloc = b.st[0], nx = b.st[1];
        if (nloc == 0u) { xcd_barrier_complete(bar, b.x, nloc, nx); b.st[0] = nloc; b.st[1] = nx; }
        const unsigned old = xb_add(&bar[XB_XSUB(b.x)], 1u);
        const unsigned gen = old / nloc;
        if (old + 1u == (gen + 1u) * nloc) {
            __builtin_amdgcn_fence(__ATOMIC_RELEASE, "agent");
            asm volatile("s_waitcnt vmcnt(0)" ::: "memory");
            const unsigned og = xb_add(&bar[XB_TOP], 1u);
            const unsigned tg = og / nx;
            if (og + 1u == (tg + 1u) * nx) xb_add(&bar[XB_TOPGEN], 1u);
            else XB_SPIN(xb_ld(&bar[XB_TOPGEN]) == tg, bar);
            __builtin_amdgcn_fence(__ATOMIC_ACQUIRE, "agent");
            xb_add(&bar[XB_XGEN(b.x)], 1u);
            asm volatile("s_waitcnt vmcnt(0)" ::: "memory");
        } else {
            XB_SPIN(xb_ld(&bar[XB_XGEN(b.x)]) == gen, bar);
            __builtin_amdgcn_fence(__ATOMIC_ACQUIRE, "agent");
            asm volatile("s_waitcnt vmcnt(0)" ::: "memory");
        }
    }
    __syncthreads();
}

constexpr int BM = 256, BK = 64, HALF = 128, HT = HALF * BK;

__device__ __forceinline__ int lds_byte(int r, int c) { int st = (r >> 4) * 2 + (c >> 5), rr = r & 15, cc = c & 31, ob = rr * 64 + cc * 2; return st * 1024 + (ob ^ (((ob >> 9) & 1) << 5)); }
__device__ __forceinline__ void stage_rc(int b, int& R, int& C) { int st = b / 1024, sb = b % 1024, swz = sb ^ (((sb >> 9) & 1) << 5); R = (st >> 1) * 16 + swz / 64; C = (st & 1) * 32 + (swz % 64) / 2; }

struct GemmOperands {
    const char* Abase; unsigned aoff[4]; unsigned kstride;
    const char* Bbase; unsigned boff; int K;
};

__device__ __forceinline__ void gemm_unit(const GemmOperands& g, bf16_t* shm, f32x4 (&acc)[2][2][4][2]) {
#define SA(b,h) (shm + ((b) * 2 + (h)) * HT)
#define SB(b,h) (shm + (4 + (b) * 2 + (h)) * HT)
#define STAGE_A(T, P, hf, kt) do { const char* _ub = g.Abase + (size_t)(kt) * g.kstride; \
    _Pragma("unroll") for (int _i = 0; _i < 2; ++_i) { const int _b = (T) * 16 + _i * 8192; \
      __builtin_amdgcn_global_load_lds((const unsigned*)(_ub + g.aoff[(hf) * 2 + _i]), (unsigned*)((char*)(P) + _b), 16, 0, 0); } } while (0)
#define STAGE_B(T, P, hf, kt) do { \
    _Pragma("unroll") for (int _i = 0; _i < 2; ++_i) { const int _b = (T) * 16 + _i * 8192; \
      const char* _ub = g.Bbase + (size_t)(kt) * (BK * 2) + (size_t)((hf) * 128 + _i * 64) * (size_t)(g.K * 2); \
      __builtin_amdgcn_global_load_lds((const unsigned*)(_ub + g.boff), (unsigned*)((char*)(P) + _b), 16, 0, 0); } } while (0)
#define LDA(dst, b, h) _Pragma("unroll") for (int m = 0; m < 4; ++m) _Pragma("unroll") for (int k = 0; k < 2; ++k) \
    dst[m][k] = *reinterpret_cast<const bf16x8*>((char*)SA(b, h) + lds_byte(wr * 64 + m * 16 + fr, k * 32 + fq * 8))
#define LDB(dst, b, h) _Pragma("unroll") for (int n = 0; n < 2; ++n) _Pragma("unroll") for (int k = 0; k < 2; ++k) \
    dst[n][k] = *reinterpret_cast<const bf16x8*>((char*)SB(b, h) + lds_byte(wc * 32 + n * 16 + fr, k * 32 + fq * 8))
#define MMA(ai, bj, At_, Bt_) do { __builtin_amdgcn_s_setprio(1); \
    _Pragma("unroll") for (int m = 0; m < 4; ++m) _Pragma("unroll") for (int n = 0; n < 2; ++n) _Pragma("unroll") for (int k = 0; k < 2; ++k) \
      acc[ai][bj][m][n] = __builtin_amdgcn_mfma_f32_16x16x32_bf16(Bt_[n][k], At_[m][k], acc[ai][bj][m][n], 0, 0, 0); \
    __builtin_amdgcn_s_setprio(0); } while (0)
#define WAIT_V(n) asm volatile("s_waitcnt vmcnt(" #n ")" ::: "memory")
#define WAIT_L(n) asm volatile("s_waitcnt lgkmcnt(" #n ")" ::: "memory")
#define BAR __builtin_amdgcn_s_barrier()
#define SCHED __builtin_amdgcn_sched_barrier(0)
    int tid = threadIdx.x; asm volatile("" : "+v"(tid));
    int wid = tid >> 6, lane = tid & 63, wr = wid >> 2, wc = wid & 3, fr = lane & 15, fq = lane >> 4;
#pragma unroll
    for (int a = 0; a < 2; ++a)
#pragma unroll
        for (int b = 0; b < 2; ++b)
#pragma unroll
            for (int m = 0; m < 4; ++m)
#pragma unroll
                for (int n = 0; n < 2; ++n) acc[a][b][m][n] = (f32x4){0.f, 0.f, 0.f, 0.f};
    bf16x8 At[4][2], B0[2][2], B1[2][2];
    const int nt = g.K / BK;
    STAGE_B(tid, SB(0, 0), 0, 0); STAGE_A(tid, SA(0, 0), 0, 0);
    STAGE_B(tid, SB(0, 1), 1, 0); STAGE_A(tid, SA(0, 1), 1, 0);
    if (wr == 1) BAR;
    WAIT_V(4); BAR;
    STAGE_B(tid, SB(1, 0), 0, 1); STAGE_A(tid, SA(1, 0), 0, 1); STAGE_B(tid, SB(1, 1), 1, 1);
    WAIT_V(6); BAR;
    for (int t = 0; t < nt - 2; t += 2) {
        LDB(B0, 0, 0); SCHED; LDA(At, 0, 0); STAGE_A(tid, SA(1, 1), 1, t + 1);
        WAIT_L(8); BAR; WAIT_L(0); MMA(0, 0, At, B0); BAR; SCHED;
        LDB(B1, 0, 1); STAGE_B(tid, SB(0, 0), 0, t + 2);
        BAR; WAIT_L(0); MMA(0, 1, At, B1); BAR;
        LDA(At, 0, 1); STAGE_A(tid, SA(0, 0), 0, t + 2);
        BAR; WAIT_L(0); MMA(1, 0, At, B0); BAR; SCHED;
        STAGE_B(tid, SB(0, 1), 1, t + 2);
        WAIT_V(6); BAR; MMA(1, 1, At, B1); BAR;
        LDB(B0, 1, 0); SCHED; LDA(At, 1, 0); STAGE_A(tid, SA(0, 1), 1, t + 2);
        WAIT_L(8); BAR; WAIT_L(0); MMA(0, 0, At, B0); BAR; SCHED;
        LDB(B1, 1, 1); STAGE_B(tid, SB(1, 0), 0, t + 3);
        BAR; WAIT_L(0); MMA(0, 1, At, B1); BAR;
        LDA(At, 1, 1); STAGE_A(tid, SA(1, 0), 0, t + 3);
        BAR; WAIT_L(0); MMA(1, 0, At, B0); BAR; SCHED;
        STAGE_B(tid, SB(1, 1), 1, t + 3);
        WAIT_V(6); BAR; MMA(1, 1, At, B1); BAR;
    }
    { LDB(B0, 0, 0); WAIT_V(0); LDA(At, 0, 0); STAGE_A(tid, SA(1, 1), 1, nt - 1);
      BAR; WAIT_L(0); MMA(0, 0, At, B0); BAR;
      LDB(B1, 0, 1); BAR; WAIT_L(0); MMA(0, 1, At, B1); BAR;
      LDA(At, 0, 1); WAIT_V(4); BAR; WAIT_L(0); MMA(1, 0, At, B0); MMA(1, 1, At, B1); BAR; }
    { LDB(B0, 1, 0); LDA(At, 1, 0); WAIT_V(2); BAR; WAIT_L(0); MMA(0, 0, At, B0); BAR;
      LDB(B1, 1, 1); WAIT_V(0); BAR; WAIT_L(0); MMA(0, 1, At, B1); BAR;
      LDA(At, 1, 1); BAR; WAIT_L(0); MMA(1, 0, At, B0); MMA(1, 1, At, B1); BAR; }
    if (wr == 0) BAR;
#undef SA
#undef SB
}


struct GDesc { const char* A; const char* B; unsigned aoff[4]; };
typedef int i32x8 __attribute__((ext_vector_type(8)));
typedef int i32x4 __attribute__((ext_vector_type(4)));
template <class S, bool FP8 = false, int SCA = 0x7f7f7f7f, int SCB = 0x7f7f7f7f>
__device__ __forceinline__ void gemm_stream(S& s, const int K, const unsigned kstrideA, unsigned char* lds_) {
    const int rowbytes = FP8 ? K : 2 * K;
    bf16_t* shm = (bf16_t*)lds_;
#define SA(b,h) (shm + ((b) * 2 + (h)) * HT)
#define SB(b,h) (shm + (4 + (b) * 2 + (h)) * HT)
#define UNIPTR(ptr) ({ const unsigned long long _u = (unsigned long long)(ptr); (const char*)(((unsigned long long)(unsigned)__builtin_amdgcn_readfirstlane((int)(_u >> 32)) << 32) | (unsigned)__builtin_amdgcn_readfirstlane((int)_u)); })
#define XSTAGE_A(P, hf, kt) do { const char* _ub = UNIPTR(d.A + (size_t)(kt) * kstrideA); \
    _Pragma("unroll") for (int _i = 0; _i < 2; ++_i) { const int _b = tid * 16 + _i * 8192; \
      unsigned _o = d.aoff[(hf) * 2 + _i]; asm volatile("" : "+v"(_o)); \
      __builtin_amdgcn_global_load_lds((const unsigned*)(_ub + _o), (unsigned*)((char*)(P) + _b), 16, 0, 0); } } while (0)
#define XSTAGE_B(P, hf, kt) do { \
    _Pragma("unroll") for (int _i = 0; _i < 2; ++_i) { const int _b = tid * 16 + _i * 8192; \
      const char* _ub = UNIPTR(d.B + (size_t)(kt) * (BK * 2) + (size_t)((hf) * 128 + _i * 64) * (size_t)rowbytes); \
      unsigned _o = boff; asm volatile("" : "+v"(_o)); \
      __builtin_amdgcn_global_load_lds((const unsigned*)(_ub + _o), (unsigned*)((char*)(P) + _b), 16, 0, 0); } } while (0)
    int tid = threadIdx.x; asm volatile("" : "+v"(tid));
    int wid = tid >> 6, lane = tid & 63, wr = wid >> 2, wc = wid & 3, fr = lane & 15, fq = lane >> 4;
    unsigned boff; { int rS, cS; stage_rc(tid * 16, rS, cS); const int rho = rS & 31, i = rho & 15; const int rP = (rS & ~31) + 8 * (i >> 2) + 4 * (rho >> 4) + (i & 3); boff = (unsigned)(rP * rowbytes + cS * 2); }
    const int nt = rowbytes / (BK * 2);
    GDesc d;
    if (!s.first(d)) return;
    f32x4 acc[2][2][4][2];
    if (S::BIAS_INIT) { s.load_bias_first(); s.init_acc(acc); }
    else
#pragma unroll
    for (int a = 0; a < 2; ++a)
#pragma unroll
        for (int b = 0; b < 2; ++b)
#pragma unroll
            for (int m = 0; m < 4; ++m)
#pragma unroll
                for (int n = 0; n < 2; ++n) acc[a][b][m][n] = (f32x4){0.f, 0.f, 0.f, 0.f};
    int sca_ = SCA, scb_ = SCB; asm volatile("" : "+v"(sca_), "+v"(scb_));
    struct Frag { bf16x8 f2[2]; };
    Frag At[4], B0[2], B1[2];
#undef LDA
#undef LDB
#undef MMA
#define LDA(dst, b, h) _Pragma("unroll") for (int m = 0; m < 4; ++m) _Pragma("unroll") for (int k = 0; k < 2; ++k) \
    dst[m].f2[k] = *reinterpret_cast<const bf16x8*>((char*)SA(b, h) + lds_byte(wr * 64 + m * 16 + fr, k * 32 + fq * 8))
#define LDB(dst, b, h) _Pragma("unroll") for (int n = 0; n < 2; ++n) _Pragma("unroll") for (int k = 0; k < 2; ++k) \
    dst[n].f2[k] = *reinterpret_cast<const bf16x8*>((char*)SB(b, h) + lds_byte(wc * 32 + n * 16 + fr, k * 32 + fq * 8))
#define MMA(ai, bj, At_, Bt_) do { __builtin_amdgcn_s_setprio(1); \
    _Pragma("unroll") for (int m = 0; m < 4; ++m) _Pragma("unroll") for (int n = 0; n < 2; ++n) { \
      if (FP8) asm volatile("v_mfma_scale_f32_16x16x128_f8f6f4 %0, %1, %2, %0, %3, %4 op_sel_hi:[0,0,0]" : "+v"(acc[ai][bj][m][n]) : "v"(__builtin_bit_cast(i32x8, Bt_[n])), "v"(__builtin_bit_cast(i32x8, At_[m])), "v"(scb_), "v"(sca_)); \
      else { _Pragma("unroll") for (int k = 0; k < 2; ++k) acc[ai][bj][m][n] = __builtin_amdgcn_mfma_f32_16x16x32_bf16(Bt_[n].f2[k], At_[m].f2[k], acc[ai][bj][m][n], 0, 0, 0); } } \
    __builtin_amdgcn_s_setprio(0); } while (0)
    XSTAGE_B(SB(0, 0), 0, 0); XSTAGE_B(SB(0, 1), 1, 0); XSTAGE_A(SA(0, 0), 0, 0); XSTAGE_A(SA(0, 1), 1, 0);
    if (wr == 1) BAR;
    WAIT_V(2); BAR;
    XSTAGE_B(SB(1, 0), 0, 1); XSTAGE_A(SA(1, 0), 0, 1); XSTAGE_B(SB(1, 1), 1, 1);
    WAIT_V(6); BAR;
    asm volatile(".p2align 8");
    for (;;) {
        bool has_next = false;
        for (int t = 0; t < nt; t += 2) {
            if (t == nt - 2) s.prefetch();
            LDB(B0, 0, 0); LDB(B1, 0, 1); SCHED; LDA(At, 0, 0); XSTAGE_A(SA(1, 1), 1, t + 1);
            WAIT_V(8); WAIT_L(0); BAR; MMA(0, 0, At, B0); MMA(0, 1, At, B1); BAR; SCHED;
            int ks = t + 2;
            if (t == nt - 2) { has_next = s.next(d); ks = 0; }
            LDA(At, 0, 1); XSTAGE_B(SB(0, 0), 0, ks); XSTAGE_B(SB(0, 1), 1, ks); XSTAGE_A(SA(0, 0), 0, ks);
            WAIT_V(8); WAIT_L(0); BAR; MMA(1, 0, At, B0); MMA(1, 1, At, B1); BAR; SCHED;
            LDB(B0, 1, 0); LDB(B1, 1, 1); SCHED; LDA(At, 1, 0); XSTAGE_A(SA(0, 1), 1, ks);
            WAIT_V(8); WAIT_L(0); BAR; MMA(0, 0, At, B0); MMA(0, 1, At, B1); BAR; SCHED;
            LDA(At, 1, 1); XSTAGE_B(SB(1, 0), 0, ks + 1); XSTAGE_B(SB(1, 1), 1, ks + 1); XSTAGE_A(SA(1, 0), 0, ks + 1);
            WAIT_V(8); WAIT_L(0); BAR; MMA(1, 0, At, B0); MMA(1, 1, At, B1); BAR; SCHED;
        }
        if (wr == 0) BAR;
        if (FP8) asm volatile("s_nop 15\n\ts_nop 15" ::: "memory");
        s.hn = has_next;
        s.epilogue(acc);
        if (!has_next) break;
        const bool zr = s.zero_after();
        s.advance();
        if (S::BIAS_INIT) s.init_acc(acc);
        else if (zr)
#pragma unroll
        for (int a = 0; a < 2; ++a)
#pragma unroll
            for (int b = 0; b < 2; ++b)
#pragma unroll
                for (int m = 0; m < 4; ++m)
#pragma unroll
                    for (int n = 0; n < 2; ++n) acc[a][b][m][n] = (f32x4){0.f, 0.f, 0.f, 0.f};
        if (wr == 1) BAR;
    }
    WAIT_V(0);
    BAR;
#undef SA
#undef SB
#undef XSTAGE_A
#undef XSTAGE_B
}

#define AL4K(x) (((size_t)(x) + 4095) & ~(size_t)4095)
constexpr size_t SZ_CTRL   = 1u << 16;
constexpr size_t OFF_MOD   = SZ_CTRL;
constexpr size_t OFF_CBIAS = OFF_MOD   + AL4K(2 * 16 * 6144 * 4);
constexpr size_t OFF_BIN   = OFF_CBIAS + AL4K(2 * 2 * 4 * 256 * 4);
constexpr size_t OFF_B1P   = OFF_BIN   + AL4K(2 * ZW * 4);
constexpr size_t OFF_WRT   = OFF_B1P   + AL4K(2 * 32 * 2048 * 4);
constexpr size_t OFF_WIN   = OFF_WRT   + AL4K(2 * 2 * 32 * 1024 * 2);
constexpr size_t OFF_WBR   = OFF_WIN   + AL4K((size_t)2 * ZW * 1024 * 2);
constexpr size_t OFF_WOUT  = OFF_WBR   + AL4K((size_t)2 * 3 * 1024 * 512 * 2);
constexpr size_t OFF_W1    = OFF_WOUT  + AL4K((size_t)2 * 1024 * 1024 * 2);
constexpr size_t OFF_W2    = OFF_W1    + AL4K((size_t)2 * 32 * 2048 * 1024 * 2);
constexpr size_t OFF_WC1   = OFF_W2    + AL4K((size_t)2 * 32 * 1024 * 1024 * 2);
constexpr size_t OFF_WC2   = OFF_WC1   + AL4K((size_t)2 * 2 * 256 * 2048 * 2);
constexpr size_t OFF_XR    = OFF_WC2   + AL4K((size_t)2 * 2 * 64 * 256 * 2);
constexpr size_t OFF_HB    = OFF_XR    + AL4K((size_t)NTOK * 1024 * 4);
constexpr size_t OFF_Z     = OFF_HB    + AL4K((size_t)NTOK * 1024 * 2);
constexpr size_t OFF_OABC  = OFF_Z     + AL4K((size_t)NTOK * ZW * 2);
constexpr size_t OFF_OWIN  = OFF_OABC  + AL4K((size_t)3 * NTOK * 512 * 2);
constexpr size_t OFF_KVC   = OFF_OWIN  + AL4K((size_t)NTOK * 512 * 2);
constexpr size_t OFF_MERGED= OFF_KVC   + AL4K((size_t)2 * 16 * 2 * 128 * 64 * 2);
constexpr size_t OFF_MSCR  = OFF_MERGED+ AL4K((size_t)NTOK * 1024 * 2);
constexpr size_t OFF_TOKE  = OFF_MSCR  + AL4K((size_t)256 * 32 * 512 * 16);
constexpr size_t OFF_TOKP  = OFF_TOKE  + AL4K((size_t)NTOK * 4 * 4);
constexpr size_t OFF_TOKG  = OFF_TOKP  + AL4K((size_t)NTOK * 4 * 4);
constexpr size_t OFF_BUCK  = OFF_TOKG  + AL4K((size_t)NTOK * 4 * 4);
constexpr size_t OFF_SELM  = OFF_BUCK  + AL4K((size_t)32 * NTOK * 4);
constexpr size_t OFF_HID   = OFF_SELM  + AL4K((size_t)16 * 2 * 2048 * 4);
constexpr size_t OFF_DELTA = OFF_MSCR;
constexpr size_t OFF_H8    = OFF_HID + AL4K((size_t)PMAX * 1024);
constexpr size_t OFF_Y     = OFF_Z;
constexpr size_t WS_NEED   = OFF_HID   + AL4K((size_t)PMAX * 1024 * 2);
static_assert((size_t)PMAX * 1024 * 2 <= (size_t)NTOK * ZW * 2, "y overlay must fit in z");

#define CW_QCTR(l, q)  (4096 + ((l) * 8 + (q)) * 64)
#define CW_ECNT(l, e)  (8192 + ((l) * 32 + (e)) * 64)
#define CW_XG(l)       (12800 + 64 * (l))
#define CW_LAM         6400

struct Params {
    const float *x, *c, *mod_w, *mod_b, *norm1_g, *norm2_g, *w_in, *b_in, *sinks, *diff_lambda, *diff_subln_g, *cmp_pos, *cmp_w1, *cmp_b1, *cmp_w2, *cmp_b2,
                *w_branch, *w_out, *router_w, *router_b, *exp_w1, *exp_b1, *exp_w2, *exp_b2, *final_g;
    float* out; char* ws; int ph_lo, ph_hi;
};
typedef const Params __attribute__((address_space(4)))* KP;

#ifndef INPROJ_FP8
#define INPROJ_FP8 1
#endif
__device__ __forceinline__ int map_col(int map, int nd) {
    if (map == 1) return nd < 3584 ? nd : (nd < 6656 ? nd + 24 : (nd < 6680 ? nd - 3072 : -1));
    if (map == 2) { const int pn = nd >> 8, r = nd & 255; return r < 128 ? pn * 128 + r : 1024 + pn * 128 + (r - 128); }
    return nd;
}
__device__ __forceinline__ void xpose_load(const float* __restrict__ src, int Nsrc, int k0, int nd0, int map, int ntl, f32x4 (&v)[8], int t) {
    const int n4 = t & 15, kp = t >> 4;
    bool ok[4];
#pragma unroll
    for (int j = 0; j < 4; ++j) { const int ns0 = j < ntl ? map_col(map, nd0 + 64 * j + 4 * n4) : -1; ok[j] = ns0 >= 0; const int nsc = ok[j] ? ns0 : 0;
        v[2 * j] = *(const f32x4*)(src + (size_t)(k0 + 2 * kp) * Nsrc + nsc); v[2 * j + 1] = *(const f32x4*)(src + (size_t)(k0 + 2 * kp + 1) * Nsrc + nsc); }
    __builtin_amdgcn_sched_barrier(0);
    if (map != 0) {
#pragma unroll
        for (int j = 0; j < 4; ++j) if (!ok[j]) { v[2 * j] = (f32x4){0.f, 0.f, 0.f, 0.f}; v[2 * j + 1] = v[2 * j]; } }
}
__device__ __forceinline__ void xpose_store(const f32x4 (&v)[8], bf16_t* __restrict__ dst, int Kdst, int k0, int nd0, int ntl, unsigned char* lds, int t) {
    const int n4 = t & 15, kp = t >> 4;
#pragma unroll
    for (int j = 0; j < 4; ++j)
#pragma unroll
        for (int i = 0; i < 4; ++i) { const int n = 4 * n4 + i; *(unsigned*)(lds + j * 8192 + n * 128 + (((kp >> 2) ^ (n4 & 7)) * 16) + (kp & 3) * 4) = cvt_pk_bf16(v[2 * j][i], v[2 * j + 1][i]); }
    __syncthreads();
    { const int n = t >> 3, ch = t & 7;
#pragma unroll
      for (int j = 0; j < 4; ++j) if (j < ntl) { const u32x4 w = *(const u32x4*)(lds + j * 8192 + n * 128 + ((ch ^ ((n >> 2) & 7)) * 16));
          *(u32x4*)(dst + (size_t)(nd0 + 64 * j + n) * Kdst + k0 + 8 * ch) = w; } }
    __syncthreads();
}
__device__ __forceinline__ void xpose_matrix(const float* src, int K, int Nsrc, bf16_t* dst, int Ndst, int map, unsigned& tbase, unsigned char* lds) {
    const int t = hidden_tid();
    const int nk = K >> 6, nn = Ndst >> 6, ngn = (nn + 3) >> 2, ngrp = nk * ngn; const unsigned G = gridDim.x;
    unsigned gi = (hidden_bid() + G - (tbase % G)) % G;
    f32x4 va[8], vb[8];
    if (gi < (unsigned)ngrp) { const int kt = gi % nk, ng = gi / nk; xpose_load(src, Nsrc, kt * 64, ng * 256, map, min(4, nn - ng * 4), va, t); }
    while (gi < (unsigned)ngrp) {
        const unsigned gn = gi + G; const int kt = gi % nk, ng = gi / nk;
        if (gn < (unsigned)ngrp) { const int kt2 = gn % nk, ng2 = gn / nk; xpose_load(src, Nsrc, kt2 * 64, ng2 * 256, map, min(4, nn - ng2 * 4), vb, t); }
        xpose_store(va, dst, K, kt * 64, ng * 256, min(4, nn - ng * 4), lds, t);
#pragma unroll
        for (int q = 0; q < 8; ++q) va[q] = vb[q];
        gi = gn;
    }
    tbase += ngrp;
}

__device__ __forceinline__ unsigned pk4_fp8(float a, float b, float c, float d) { int w = 0; w = __builtin_amdgcn_cvt_pk_fp8_f32(a, b, w, false); w = __builtin_amdgcn_cvt_pk_fp8_f32(c, d, w, true); return (unsigned)w; }
__device__ __forceinline__ unsigned pk4_u8(float a, float b, float c, float d) {
    const unsigned fa = __float_as_uint(__builtin_fmaf(a, 254.0f, 8388609.0f)), fb = __float_as_uint(__builtin_fmaf(b, 254.0f, 8388609.0f));
    const unsigned fc = __float_as_uint(__builtin_fmaf(c, 254.0f, 8388609.0f)), fd = __float_as_uint(__builtin_fmaf(d, 254.0f, 8388609.0f));
    const unsigned t01 = __builtin_amdgcn_perm(fb, fa, 0x0c0c0400u), t23 = __builtin_amdgcn_perm(fd, fc, 0x0c0c0400u);
    return __builtin_amdgcn_perm(t23, t01, 0x05040100u); }
#ifndef ATT_PRIO
#define ATT_PRIO 1
#endif
#ifndef GATE_FOLD
#define GATE_FOLD 1
#endif
#ifndef MOE1_UFOLD
#define MOE1_UFOLD 1
#endif
#ifndef DIFF_GAIN_IN_W
#define DIFF_GAIN_IN_W 1
#endif
#ifndef OUTPROJ_FP8
#define OUTPROJ_FP8 1
#endif
#ifndef MERGE_FP8
#define MERGE_FP8 1
#endif
#define O8S 16.0f
__device__ __forceinline__ unsigned pk4_fp8c(float a, float b, float c, float d) {
    return pk4_fp8(__builtin_amdgcn_fmed3f(a * O8S, -448.f, 448.f), __builtin_amdgcn_fmed3f(b * O8S, -448.f, 448.f), __builtin_amdgcn_fmed3f(c * O8S, -448.f, 448.f), __builtin_amdgcn_fmed3f(d * O8S, -448.f, 448.f)); }
__device__ __forceinline__ u32x4 pair16(u32x2 a, u32x2 b) {
    auto rx = __builtin_amdgcn_permlane16_swap(a.x, b.x, false, false); auto ry = __builtin_amdgcn_permlane16_swap(a.y, b.y, false, false);
    u32x4 w; w.x = rx[0]; w.y = ry[0]; w.z = rx[1]; w.w = ry[1]; return w; }
#define X8T 4
__device__ __forceinline__ unsigned xpose8_load(const float* __restrict__ src, int Nsrc, int k0, int nd0, int map, f32x4 (&v)[4 * X8T], int t) {
    const int n4 = t & 15, kq = t >> 4;
    bool ok[X8T];
#pragma unroll
    for (int j = 0; j < X8T; ++j) { const int ns0 = map_col(map, nd0 + 64 * j + 4 * n4); ok[j] = ns0 >= 0; const int nsc = ok[j] ? ns0 : 0;
#pragma unroll
        for (int q = 0; q < 4; ++q) v[4 * j + q] = __builtin_nontemporal_load((const f32x4*)(src + (size_t)(k0 + 4 * kq + q) * Nsrc + nsc)); }
    __builtin_amdgcn_sched_barrier(0);
    unsigned m = 0;
#pragma unroll
    for (int j = 0; j < X8T; ++j) m |= ok[j] ? (1u << j) : 0u;
    return m;
}
__device__ __forceinline__ void xpose8_store(const f32x4 (&v)[4 * X8T], unsigned char* __restrict__ dst, int Kdst, int k0, int nd0, float scale0, unsigned char* lds, int t, unsigned okm = 0xffffffffu,
                                              const float* rowgain = nullptr  , const float scale_hi = 0.0f  ) {
    const int n4 = t & 15, kq = t >> 4;
    f32x4 rg4 = (f32x4){1.f, 1.f, 1.f, 1.f}; if (rowgain) rg4 = *(const f32x4*)(rowgain + ((k0 + 4 * kq) & 127));
#pragma unroll
    for (int j = 0; j < X8T; ++j) { const float scale = (okm >> j) & 1u ? ((scale_hi != 0.0f && j >= 2) ? scale_hi : scale0) : 0.0f;
#pragma unroll
        for (int i = 0; i < 4; ++i) { const int n = 4 * n4 + i;
            *(unsigned*)(lds + j * 8192 + n * 128 + (((kq >> 2) ^ (n4 & 7)) * 16) + (kq & 3) * 4) = pk4_fp8(v[4 * j][i] * (scale * rg4[0]), v[4 * j + 1][i] * (scale * rg4[1]), v[4 * j + 2][i] * (scale * rg4[2]), v[4 * j + 3][i] * (scale * rg4[3])); } }
    __syncthreads();
    { const int n = t >> 3, ch = t & 7;
#pragma unroll
      for (int j = 0; j < X8T; ++j) { const u32x4 w = *(const u32x4*)(lds + j * 8192 + n * 128 + ((ch ^ ((n >> 2) & 7)) * 16));
          *(u32x4*)(dst + (size_t)(nd0 + 64 * j + n) * Kdst + k0 + 16 * ch) = w; } }
    __syncthreads();
}
__device__ __forceinline__ void xpose8_matrix(const float* src, int K, int Nsrc, unsigned char* dst, int Ndst, int map, float scale, unsigned& tbase, unsigned char* lds) {
    const int t = hidden_tid();
    const int nk = K >> 7, ngn = Ndst / (64 * X8T), ngrp = nk * ngn; const unsigned G = gridDim.x;
    unsigned gi = (hidden_bid() + G - (tbase % G)) % G;
    f32x4 va[4 * X8T], vb[4 * X8T];
    unsigned ma = 0, mb = 0;
    if (gi < (unsigned)ngrp) ma = xpose8_load(src, Nsrc, (gi % nk) * 128, (gi / nk) * 64 * X8T, map, va, t);
    while (gi < (unsigned)ngrp) {
        const unsigned gn = gi + G;
        if (gn < (unsigned)ngrp) mb = xpose8_load(src, Nsrc, (gn % nk) * 128, (gn / nk) * 64 * X8T, map, vb, t);
        xpose8_store(va, dst, K, (gi % nk) * 128, (gi / nk) * 64 * X8T, (GATE_FOLD && map == 1 && (int)(gi / nk) * 64 * X8T >= C_GM) ? scale * -LOG2E : scale, lds, t, ma); ma = mb;
#pragma unroll
        for (int q = 0; q < 4 * X8T; ++q) va[q] = vb[q];
        gi = gn;
    }
    tbase += ngrp;
}

#ifndef COSCHED
#define COSCHED 1
#endif
#ifndef XGN
#define XGN 1
#endif
__device__ __forceinline__ void xpose8_gload(KP p, int l, int g, f32x4 (&v)[4 * X8T], int t) {
    const int e = g / 96, r = g - e * 96; const int n4 = t & 15, kq = t >> 4;
    if (r < 64) { const float* b = p->exp_w1 + (size_t)(l * 32 + e) * 1024 * 2048 + (size_t)((r & 7) * 128 + 4 * kq) * 2048 + (r >> 3) * 128 + 4 * n4;
#pragma unroll
        for (int j = 0; j < 4; ++j)
#pragma unroll
            for (int q = 0; q < 4; ++q) v[4 * j + q] = __builtin_nontemporal_load((const f32x4*)(b + q * 2048 + (j >> 1) * 1024 + (j & 1) * 64));
    } else { const float* b = p->exp_w2 + (size_t)(l * 32 + e) * 1024 * 1024 + (size_t)((r & 7) * 128 + 4 * kq) * 1024 + ((r - 64) >> 3) * 256 + 4 * n4;
#pragma unroll
        for (int j = 0; j < 4; ++j)
#pragma unroll
            for (int q = 0; q < 4; ++q) v[4 * j + q] = __builtin_nontemporal_load((const f32x4*)(b + q * 1024 + j * 64));
    }
    __builtin_amdgcn_sched_barrier(0);
}
__device__ __forceinline__ void xpose8_gstore(KP p, int l, int g, const f32x4 (&v)[4 * X8T], unsigned char* lds, int t) {
    const int e = g / 96, r = g - e * 96; char* ws = p->ws;
    if (r < 64) xpose8_store(v, (unsigned char*)(ws + OFF_W1) + (size_t)(l * 32 + e) * 2048 * 1024, 1024, (r & 7) * 128, (r >> 3) * 256, 32.0f, lds, t, 0xffffffffu, nullptr, MOE1_UFOLD ? 128.0f : 0.0f);
    else xpose8_store(v, (unsigned char*)(ws + OFF_W2) + (size_t)(l * 32 + e) * 1024 * 1024, 1024, (r & 7) * 128, ((r - 64) >> 3) * 256, 32.0f, lds, t);
}
__device__ __forceinline__ void xpose8_group(KP p, int l, int g, unsigned char* lds) {
    if ((g & (XGN - 1)) != XGN - 1) return;
    const int t = hidden_tid(); const int g0 = g - (XGN - 1);
    f32x4 va[4 * X8T], vb[4 * X8T];
    xpose8_gload(p, l, g0, va, t);
    __syncthreads();
#pragma unroll 1
    for (int i = 0; i < XGN; ++i) {
        if (i + 1 < XGN) xpose8_gload(p, l, g0 + i + 1, vb, t);
        xpose8_gstore(p, l, g0 + i, va, lds, t);
#pragma unroll
        for (int q = 0; q < 4 * X8T; ++q) va[q] = vb[q];
    }
}
__device__ __forceinline__ float wave_sum(float v, int lane) { (void)lane;
#define DPP_ADD(ctrl) v += __int_as_float(__builtin_amdgcn_update_dpp(0, __float_as_int(v), (ctrl), 0xf, 0xf, false))
    DPP_ADD(0xB1); DPP_ADD(0x4E); DPP_ADD(0x141); DPP_ADD(0x140);
#undef DPP_ADD
    { auto rr = __builtin_amdgcn_permlane16_swap(__float_as_uint(v), __float_as_uint(v), false, false); v = __uint_as_float(rr[0]) + __uint_as_float(rr[1]); }
    { auto rr = __builtin_amdgcn_permlane32_swap(__float_as_uint(v), __float_as_uint(v), false, false); v = __uint_as_float(rr[0]) + __uint_as_float(rr[1]); }
    return v;
}
__device__ __forceinline__ void phase_prologue(KP p, unsigned char* lds) {
    const int t = hidden_tid(), bi = hidden_bid();
    char* ws = p->ws;
#ifndef PRO_MODREP
#define PRO_MODREP 1
#endif
#ifndef PRO_XREP
#define PRO_XREP 1
#endif
    for (int rep_ = 0; rep_ < PRO_MODREP; ++rep_) {
        float* cs = (float*)lds;
        f32x4* red = (f32x4*)(lds + 65536);
        for (int i = t; i < 16 * 1024; i += NTHREADS) { const float v = p->c[i]; cs[(i & 1023) * 16 + (i >> 10)] = v * sigmoidf_(v); }
        __syncthreads();
        for (int task = bi; task < 192; task += gridDim.x) {
            const int j0 = task * 64, l = j0 / 6144, c0 = j0 % 6144;
            const int c4 = t & 15, kr = t >> 4, lane = t & 63, wv = t >> 6;
            const float* wp = p->mod_w + (size_t)l * 1024 * 6144 + c0 + 4 * c4;
            f32x4 acc[16];
#pragma unroll
            for (int b = 0; b < 16; ++b) acc[b] = (f32x4){0.f, 0.f, 0.f, 0.f};
#pragma unroll 1
            for (int i0 = 0; i0 < 32; i0 += 4) {
                f32x4 w[4];
#pragma unroll
                for (int i = 0; i < 4; ++i) w[i] = __builtin_nontemporal_load((const f32x4*)(wp + (size_t)(kr + 32 * (i0 + i)) * 6144));
                __builtin_amdgcn_sched_barrier(0);
#pragma unroll
                for (int i = 0; i < 4; ++i) { const float* cr = cs + (kr + 32 * (i0 + i)) * 16;
#pragma unroll
                    for (int b4 = 0; b4 < 4; ++b4) { const f32x4 cv = *(const f32x4*)(cr + 4 * b4);
#pragma unroll
                        for (int q = 0; q < 4; ++q) acc[4 * b4 + q] += cv[q] * w[i]; } }
            }
#pragma unroll
            for (int b = 0; b < 16; ++b)
#pragma unroll
                for (int q = 0; q < 4; ++q) { float v = acc[b][q];
                    v += __int_as_float(__builtin_amdgcn_ds_bpermute(((lane ^ 16) & 63) << 2, __float_as_int(v)));
                    v += __int_as_float(__builtin_amdgcn_ds_bpermute(((lane ^ 32) & 63) << 2, __float_as_int(v)));
                    acc[b][q] = v; }
            if (lane < 16) {
#pragma unroll
                for (int b = 0; b < 16; ++b) red[(wv * 16 + b) * 16 + c4] = acc[b]; }
            __syncthreads();
            if (t < 256) { const int b = t >> 4, c2 = t & 15; f32x4 sum = red[b * 16 + c2];
#pragma unroll
                for (int w2 = 1; w2 < 8; ++w2) sum += red[(w2 * 16 + b) * 16 + c2];
                const int col2 = c0 + 4 * c2;
                *(f32x4*)((float*)(ws + OFF_MOD) + ((size_t)l * 16 + b) * 6144 + col2) = sum + *(const f32x4*)(p->mod_b + l * 6144 + col2); }
            __syncthreads();
        }
    }
    if (bi == 0 && t < 64) {
        for (int l2 = 0; l2 < NLAYER; ++l2) { const float* lp = p->diff_lambda + (size_t)l2 * 256; const float a01 = wave_sum(lp[t] * lp[64 + t], t), a23 = wave_sum(lp[128 + t] * lp[192 + t], t);
            if (t == 0) ((float*)ws)[CW_LAM + l2] = expf(a01) - expf(a23) + (0.8f - 0.6f * expf(-0.3f * (float)l2)); } }
    for (int task = (int)gridDim.x - 1 - bi; task < 16; task += gridDim.x) {
        const int lk = task >> 2, kq = task & 3, nq = t & 63, ks = t >> 6;
        const float* w1 = p->cmp_w1 + (size_t)lk * 2048 * 256; const float* pos = p->cmp_pos + (size_t)lk * 2048;
        f32x4 s4 = (f32x4){0.f, 0.f, 0.f, 0.f};
#pragma unroll 1
        for (int k0 = kq * 512 + ks * 64; k0 < kq * 512 + ks * 64 + 64; k0 += 16) {
            f32x4 w[16]; float pz[16];
#pragma unroll
            for (int i = 0; i < 16; ++i) { w[i] = *(const f32x4*)(w1 + (size_t)(k0 + i) * 256 + 4 * nq); pz[i] = pos[k0 + i]; }
            __builtin_amdgcn_sched_barrier(0);
#pragma unroll
            for (int i = 0; i < 16; ++i) s4 += pz[i] * w[i];
        }
        f32x4* red = (f32x4*)lds; red[t] = s4; __syncthreads();
        if (t < 64) { f32x4 r = red[t];
#pragma unroll
            for (int q = 1; q < 8; ++q) r += red[t + 64 * q];
            *(f32x4*)((float*)(ws + OFF_CBIAS) + (size_t)(lk * 4 + kq) * 256 + 4 * t) = r; }
        __syncthreads();
    }
    for (int i = bi * NTHREADS + t; i < 2 * ZW; i += gridDim.x * NTHREADS) { const int l = i / ZW, nd = i % ZW, ns = map_col(1, nd); ((float*)(ws + OFF_BIN))[i] = ns >= 0 ? p->b_in[l * INW + ns] * ((GATE_FOLD && nd >= C_GM) ? -LOG2E : 1.0f) : 0.f; }
    for (int i = bi * NTHREADS + t; i < 2 * 32 * 2048; i += gridDim.x * NTHREADS) { const int le = i >> 11, j = i & 2047; const float bv = p->exp_b1[(size_t)le * 2048 + map_col(2, j)]; ((float*)(ws + OFF_B1P))[i] = (MOE1_UFOLD && (j & 255) >= 128) ? __builtin_fmaf(bv, 4.0f, 4.0f) : bv; }
    for (int i = bi * NTHREADS + t; i < 2 * 32 * 1024; i += gridDim.x * NTHREADS) {
        const int l = i >> 15, e = (i >> 10) & 31, k = i & 1023; const float w = p->router_w[((size_t)l * 1024 + k) * 32 + e];
        const bf16_t hi = f2bf(w); const bf16_t lo = f2bf(w - bf2f(hi));
        const size_t fo = ((((size_t)(e >> 4) * 32 + (k >> 5)) * 64 + ((k >> 3) & 3) * 16 + (e & 15)) << 3) + (k & 7);
        bf16_t* wr = (bf16_t*)(ws + OFF_WRT); wr[(size_t)(l * 2 + 0) * 32768 + fo] = hi; wr[(size_t)(l * 2 + 1) * 32768 + fo] = lo; }
    __syncthreads();
    for (int rep_ = 0; rep_ < PRO_XREP; ++rep_) {
    unsigned tbase = 0;
    for (int l = 0; l < (COSCHED ? 1 : NLAYER); ++l) {
#if INPROJ_FP8
        xpose8_matrix(p->w_in + (size_t)l * 1024 * INW, 1024, INW, (unsigned char*)(ws + OFF_WIN) + (size_t)l * ZW * 1024, ZW, 1, 32.0f, tbase, lds);
#else
        xpose_matrix(p->w_in + (size_t)l * 1024 * INW, 1024, INW, (bf16_t*)(ws + OFF_WIN) + (size_t)l * ZW * 1024, ZW, 1, tbase, lds);
#endif
        for (int kv = 0; kv < 2; ++kv) {
            xpose_matrix(p->cmp_w1 + (size_t)(l * 2 + kv) * 2048 * 256, 2048, 256, (bf16_t*)(ws + OFF_WC1) + (size_t)(l * 2 + kv) * 256 * 2048, 256, 0, tbase, lds);
            xpose_matrix(p->cmp_w2 + (size_t)(l * 2 + kv) * 256 * 64, 256, 64, (bf16_t*)(ws + OFF_WC2) + (size_t)(l * 2 + kv) * 64 * 256, 64, 0, tbase, lds);
        }
#if !COSCHED
        for (int i = 0; i < 3; ++i) xpose_matrix(p->w_branch + (size_t)(l * 3 + i) * 512 * 1024, 512, 1024, (bf16_t*)(ws + OFF_WBR) + (size_t)(l * 3 + i) * 1024 * 512, 1024, 0, tbase, lds);
        xpose_matrix(p->w_out + (size_t)l * 1024 * 1024, 1024, 1024, (bf16_t*)(ws + OFF_WOUT) + (size_t)l * 1024 * 1024, 1024, 0, tbase, lds);
        for (int e = 0; e < 32; ++e) {
            xpose8_matrix(p->exp_w1 + (size_t)(l * 32 + e) * 1024 * 2048, 1024, 2048, (unsigned char*)(ws + OFF_W1) + (size_t)(l * 32 + e) * 2048 * 1024, 2048, 2, 32.0f, tbase, lds);
            xpose8_matrix(p->exp_w2 + (size_t)(l * 32 + e) * 1024 * 1024, 1024, 1024, (unsigned char*)(ws + OFF_W2) + (size_t)(l * 32 + e) * 1024 * 1024, 1024, 0, 32.0f, tbase, lds);
        }
#endif
    }
}
}

__device__ __forceinline__ void xpose_one(const float* src, int K, int Nsrc, bf16_t* dst, int Ndst, int gi, unsigned char* lds) {
    const int t = hidden_tid(); const int nk = K >> 6, nn = Ndst >> 6, kt = gi % nk, ng = gi / nk, ntl = min(4, nn - ng * 4);
    f32x4 va[8];
    xpose_load(src, Nsrc, kt * 64, ng * 256, 0, ntl, va, t);
    __syncthreads();
    xpose_store(va, dst, K, kt * 64, ng * 256, ntl, lds, t);
}
__device__ __forceinline__ void xpose8_one(const float* src, int K, int Nsrc, unsigned char* dst, int map, float scale, int gi, unsigned char* lds, const float* rowgain = nullptr) {
    const int t = hidden_tid(); const int nk = K >> 7;
    f32x4 va[4 * X8T];
    const unsigned m = xpose8_load(src, Nsrc, (gi % nk) * 128, (gi / nk) * 64 * X8T, map, va, t);
    __syncthreads();
    xpose8_store(va, dst, K, (gi % nk) * 128, (gi / nk) * 64 * X8T, (GATE_FOLD && map == 1 && (gi / nk) * 64 * X8T >= C_GM) ? scale * -LOG2E : scale, lds, t, m, rowgain);
}
#define MISC_GROUPS 608
__device__ __forceinline__ void misc_group(KP p, int idx, unsigned char* lds) {
    char* ws = p->ws;
    if (idx < 216) {
#if INPROJ_FP8
        xpose8_one(p->w_in + (size_t)1024 * INW, 1024, INW, (unsigned char*)(ws + OFF_WIN) + (size_t)ZW * 1024, 1, 32.0f, idx, lds);
#endif
    } else if (idx < 312 || (idx >= 448 && idx < 544)) { const int l = idx < 312 ? 1 : 0, r = idx - (l ? 216 : 448), i = r >> 5;
#if MERGE_FP8
        if ((r & 31) < 16) xpose8_one(p->w_branch + (size_t)(l * 3 + i) * 512 * 1024, 512, 1024, (unsigned char*)(ws + OFF_WBR) + (size_t)(l * 3 + i) * 1024 * 512, 0, 32.0f, r & 31, lds,
                                      (DIFF_GAIN_IN_W && i == 1) ? p->diff_subln_g + (size_t)l * 128 : nullptr);
#else
        xpose_one(p->w_branch + (size_t)(l * 3 + i) * 512 * 1024, 512, 1024, (bf16_t*)(ws + OFF_WBR) + (size_t)(l * 3 + i) * 1024 * 512, 1024, r & 31, lds);
#endif
    } else if (idx < 376 || idx >= 544) { const int l = idx < 376 ? 1 : 0, r = idx - (l ? 312 : 544);
#if OUTPROJ_FP8
        if (r < 32) xpose8_one(p->w_out + (size_t)l * 1024 * 1024, 1024, 1024, (unsigned char*)(ws + OFF_WOUT) + (size_t)l * 1024 * 1024, 0, 32.0f, r, lds);
#else
        xpose_one(p->w_out + (size_t)l * 1024 * 1024, 1024, 1024, (bf16_t*)(ws + OFF_WOUT) + (size_t)l * 1024 * 1024, 1024, r, lds);
#endif
    } else if (idx < 440) { const int r = idx - 376, kv = r >> 5;
        xpose_one(p->cmp_w1 + (size_t)(2 + kv) * 2048 * 256, 2048, 256, (bf16_t*)(ws + OFF_WC1) + (size_t)(2 + kv) * 256 * 2048, 256, r & 31, lds);
    } else { const int r = idx - 440, kv = r >> 2;
        xpose_one(p->cmp_w2 + (size_t)(2 + kv) * 256 * 64, 256, 64, (bf16_t*)(ws + OFF_WC2) + (size_t)(2 + kv) * 64 * 256, 64, r & 3, lds);
    }
}

__device__ __forceinline__ void phase_norm_mod(const float* __restrict__ xsrc, const float* __restrict__ g, const float* __restrict__ modl  , int sh_off, int sc_off, bf16_t* __restrict__ hb) {
    const int tid = hidden_tid(), lane = tid & 63, wv = tid >> 6;
    for (int gw = hidden_bid() * 8 + wv; gw < NTOK / 16; gw += gridDim.x * 8) {
        const int row0 = gw * 16, b = row0 >> 11;
        f32x4 gg[4], sc[4], sh[4], xn[4];
#pragma unroll
        for (int j = 0; j < 4; ++j) { const int col = 256 * j + 4 * lane; gg[j] = *(const f32x4*)(g + col); sc[j] = *(const f32x4*)(modl + (size_t)b * 6144 + sc_off + col); sh[j] = *(const f32x4*)(modl + (size_t)b * 6144 + sh_off + col);
            xn[j] = *(const f32x4*)(xsrc + (size_t)row0 * 1024 + col); }
        for (int i = 0; i < 16; ++i) {
            const int row = row0 + i; f32x4 v[4]; float ss = 0.f;
#pragma unroll
            for (int j = 0; j < 4; ++j) { v[j] = xn[j]; ss += v[j][0] * v[j][0] + v[j][1] * v[j][1] + v[j][2] * v[j][2] + v[j][3] * v[j][3]; }
            if (i + 1 < 16) {
#pragma unroll
                for (int j = 0; j < 4; ++j) xn[j] = *(const f32x4*)(xsrc + (size_t)(row + 1) * 1024 + 256 * j + 4 * lane); }
            ss = wave_sum(ss, lane); const float r = 1.0f / sqrtf(ss * (1.0f / 1024.0f) + 1e-5f);
#pragma unroll
            for (int j = 0; j < 4; ++j) { const int col = 256 * j + 4 * lane; float o[4];
#pragma unroll
                for (int q = 0; q < 4; ++q) o[q] = v[j][q] * r * gg[j][q] * (1.0f + sc[j][q]) + sh[j][q];
#if INPROJ_FP8
                *(unsigned*)((unsigned char*)hb + (size_t)row * 1024 + col) = pk4_fp8(o[0], o[1], o[2], o[3]); }
#else
                u32x2 w; w.x = cvt_pk_bf16(o[0], o[1]); w.y = cvt_pk_bf16(o[2], o[3]); *(u32x2*)(hb + (size_t)row * 1024 + col) = w; }
#endif
        }
    }
}

__device__ __forceinline__ bool unit_rc(unsigned L, int nRT, int nN, int& rt, int& pn) {
    const int x = L & 7; const unsigned i = L >> 3; const int nrt_x = (nRT - x + 7) >> 3;
    const unsigned per = 8u * (unsigned)nN, grp = i / per, rem = i % per;
    pn = (int)(rem >> 3); const int rtl = (int)(grp * 8u + (rem & 7u));
    if (rtl >= nrt_x) return false;
    rt = x + 8 * rtl; return true;
}
__device__ __forceinline__ unsigned unit_slots(int nRT, int nN) { const int pr = (nRT + 7) >> 3; return 8u * (unsigned)(((pr + 7) >> 3) * 8 * nN); }
struct SlotIter {
    unsigned L, LM; int nRT, nN;
    __device__ __forceinline__ void init(int nRT_, int nN_) { nRT = nRT_; nN = nN_; LM = unit_slots(nRT_, nN_); L = hidden_bid(); }
    __device__ __forceinline__ bool take(int& rt, int& pn) { while (L < LM) { const unsigned l = L; L += gridDim.x; if (unit_rc(l, nRT, nN, rt, pn)) return true; } return false; }
};

#define GEMM_STAGE_IDS() int rS, cS; { int tz_ = threadIdx.x; asm volatile("" : "+v"(tz_)); stage_rc(tz_ * 16, rS, cS); }
#define GEMM_LANE_IDS() int tid = threadIdx.x; asm volatile("" : "+v"(tid)); const int wid = tid >> 6, lane = tid & 63, wr = wid >> 2, wc = wid & 3, fr = lane & 15, fq = lane >> 4; (void)lane; (void)wr; (void)wc; (void)fr; (void)fq
#define TILE_ROW(i) (((i) >> 1) * 128 + ((i) & 1) * 64 + rS)
typedef f32x4 (&AccRef)[2][2][4][2];

__device__ __forceinline__ void pull_groups(KP p, int l, int n, unsigned char* lds) {
    unsigned* xg = (unsigned*)p->ws + CW_XG(l);
#pragma unroll 1
    for (int i = 0; i < n; ++i) {
        __syncthreads();
        if (hidden_tid() == 0) *(unsigned*)(lds + LDS_BYTES - 56) = __hip_atomic_fetch_add(xg, 1u, __ATOMIC_RELAXED, __HIP_MEMORY_SCOPE_AGENT);
        __syncthreads();
        const unsigned g = (unsigned)__builtin_amdgcn_readfirstlane(*(int*)(lds + LDS_BYTES - 56));
        if (g >= 3072u) break;
        xpose8_group(p, l, (int)g, lds);
    }
}
struct InprojS {
    KP p; int l; SlotIter it; int rt, pn, nrt, npn; f32x4 pb[2][2]; bool hn;
    static constexpr bool BIAS_INIT = true;
    __device__ __forceinline__ bool zero_after() const { return true; }
    __device__ __forceinline__ void load_bias(int pn_) { GEMM_LANE_IDS(); const float* bias = (const float*)(p->ws + OFF_BIN) + (size_t)l * ZW + pn_ * 256 + wc * 32 + fq * 8;
#pragma unroll
        for (int bj = 0; bj < 2; ++bj) { pb[bj][0] = *(const f32x4*)(bias + bj * 128); pb[bj][1] = *(const f32x4*)(bias + bj * 128 + 4); } }
    __device__ __forceinline__ void load_bias_first() { load_bias(pn); }
    __device__ __forceinline__ void init_acc(AccRef acc) {
#pragma unroll
        for (int ai = 0; ai < 2; ++ai)
#pragma unroll
            for (int bj = 0; bj < 2; ++bj)
#pragma unroll
                for (int m = 0; m < 4; ++m) { acc[ai][bj][m][0] = pb[bj][0]; acc[ai][bj][m][1] = pb[bj][1]; } }
    __device__ __forceinline__ void prefetch() {}
    __device__ __forceinline__ void fill(GDesc& d, int rt_, int pn_) { GEMM_STAGE_IDS(); char* ws = p->ws; d.A = ws + OFF_HB; d.B = ws + OFF_WIN + ((size_t)l * ZW + (size_t)pn_ * 256) * 1024 * (INPROJ_FP8 ? 1 : 2);
#pragma unroll
        for (int i = 0; i < 4; ++i) d.aoff[i] = (unsigned)(((size_t)rt_ * 256 + TILE_ROW(i)) * (INPROJ_FP8 ? 1024 : 2048) + cS * 2); }
    __device__ __forceinline__ bool first(GDesc& d) { it.init(128, 27); if (!it.take(rt, pn)) return false; fill(d, rt, pn); return true; }
    __device__ __forceinline__ bool next(GDesc& d) { int a, b; if (!it.take(a, b)) return false; nrt = a; npn = b; fill(d, a, b); return true; }
    __device__ __forceinline__ void advance() { rt = nrt; pn = npn; }
    __device__ __forceinline__ void epilogue(AccRef acc) {
        if (hn) load_bias(npn);
        GEMM_LANE_IDS(); char* ws = p->ws;
        bf16_t* z = (bf16_t*)(ws + OFF_Z);
        const bool sig = pn >= 14;
        const float qsc = (pn < 2 || pn == 3 || pn == 4 || pn == 9 || pn == 10) ? 0.125f : 1.0f;
        const int row0 = rt * 256 + wr * 64 + fr, col0 = pn * 256 + wc * 32 + fq * 8;
        if (pn >= 14 && pn < 26) {
#pragma unroll
            for (int bj = 0; bj < 2; ++bj) { const int col = col0 + bj * 128;
#pragma unroll
                for (int ai = 0; ai < 2; ++ai)
#pragma unroll
                    for (int m2 = 0; m2 < 4; m2 += 2) { u32x2 wp[2];
#pragma unroll
                        for (int mq = 0; mq < 2; ++mq) { f32x4 v0 = acc[ai][bj][m2 + mq][0], v1 = acc[ai][bj][m2 + mq][1];
#pragma unroll
                            for (int j = 0; j < 4; ++j) { v0[j] = GATE_FOLD ? fast_rcp(1.0f + fast_exp2(v0[j])) : sigmoidf_(v0[j]); v1[j] = GATE_FOLD ? fast_rcp(1.0f + fast_exp2(v1[j])) : sigmoidf_(v1[j]); }
                            wp[mq].x = pk4_u8(v0[0], v0[1], v0[2], v0[3]); wp[mq].y = pk4_u8(v1[0], v1[1], v1[2], v1[3]); }
                        *(u32x4*)((unsigned char*)z + (size_t)(row0 + ai * 128 + (m2 + (fq & 1)) * 16) * (ZW * 2) + C_GM * 2 + (col - C_GM) - (fq & 1) * 8) = pair16(wp[0], wp[1]); } }
        } else {
#pragma unroll
        for (int bj = 0; bj < 2; ++bj) { const int col = col0 + bj * 128;
#pragma unroll
            for (int ai = 0; ai < 2; ++ai)
#pragma unroll
                for (int m = 0; m < 4; ++m) { f32x4 v0 = acc[ai][bj][m][0] * qsc, v1 = acc[ai][bj][m][1] * qsc;
                    if (sig) {
#pragma unroll
                        for (int j = 0; j < 4; ++j) { v0[j] = GATE_FOLD ? fast_rcp(1.0f + fast_exp2(v0[j])) : sigmoidf_(v0[j]); v1[j] = GATE_FOLD ? fast_rcp(1.0f + fast_exp2(v1[j])) : sigmoidf_(v1[j]); } }
                    u32x4 w; w.x = cvt_pk_bf16(v0[0], v0[1]); w.y = cvt_pk_bf16(v0[2], v0[3]); w.z = cvt_pk_bf16(v1[0], v1[1]); w.w = cvt_pk_bf16(v1[2], v1[3]);
                    *(u32x4*)(z + (size_t)(row0 + ai * 128 + m * 16) * ZW + col) = w; } }
        }
    }
};
__device__ __forceinline__ void phase_inproj(KP p, int l, unsigned char* lds) { InprojS s; s.p = p; s.l = l;
#if INPROJ_FP8
    gemm_stream<InprojS, true, 0x7f7f7f7f, 0x7a7a7a7a>(s, 1024, 128u, lds);
#else
    gemm_stream(s, 1024, 128u, lds);
#endif
    if (COSCHED && gridDim.x == 256 && hidden_bid() >= 128) pull_groups(p, l, 3, lds);
}

struct MergeS {
    KP p; int l; SlotIter it; int rt, pn, br, nrt, npn, nbr; bool hn;
    static constexpr bool BIAS_INIT = false;
    __device__ __forceinline__ void load_bias_first() {}
    __device__ __forceinline__ void init_acc(AccRef) {}
    __device__ __forceinline__ bool zero_after() const { return br == 2; }
    __device__ __forceinline__ void prefetch() {}
    __device__ __forceinline__ void fill(GDesc& d, int rt_, int pn_, int br_) { GEMM_STAGE_IDS(); char* ws = p->ws; d.A = ws + OFF_OABC + (size_t)br_ * NTOK * 512 * (MERGE_FP8 ? 1 : 2);
        d.B = ws + OFF_WBR + ((size_t)(l * 3 + br_) * 1024 + (size_t)pn_ * 256) * 512 * (MERGE_FP8 ? 1 : 2);
#pragma unroll
        for (int i = 0; i < 4; ++i) d.aoff[i] = (unsigned)(((size_t)rt_ * 256 + TILE_ROW(i)) * (MERGE_FP8 ? 512 : 1024) + cS * 2); }
    __device__ __forceinline__ bool first(GDesc& d) { it.init(128, 4); if (!it.take(rt, pn)) return false; br = 0; fill(d, rt, pn, 0); return true; }
    __device__ __forceinline__ bool next(GDesc& d) { if (br < 2) { nrt = rt; npn = pn; nbr = br + 1; } else { int a, b; if (!it.take(a, b)) return false; nrt = a; npn = b; nbr = 0; } fill(d, nrt, npn, nbr); return true; }
    __device__ __forceinline__ void advance() { rt = nrt; pn = npn; br = nbr; }
    __device__ __forceinline__ void epilogue(AccRef acc) {
        GEMM_LANE_IDS(); char* ws = p->ws;
        const bf16_t* z = (const bf16_t*)(ws + OFF_Z); bf16_t* mg = (bf16_t*)(ws + OFF_MERGED);
        const int row0 = rt * 256 + wr * 64 + fr, col0 = pn * 256 + wc * 32 + fq * 8;
        u32x2 Ga[2], Ha[2], Gb[2], Hb[2], Gc[2], Hc[2];
#define U8F(w, i) ((float)(((w) >> (8 * (i))) & 0xffu))
#define MG_LOAD(e, G, H) { const unsigned char* gp = (const unsigned char*)z + (size_t)(row0 + ((e) >> 2) * 128 + (2 * ((e) & 1) + (fq & 1)) * 16) * (ZW * 2) + C_GM * 2 + br * 1024 + col0 - (fq & 1) * 8 + (((e) >> 1) & 1) * 128; \
            const u32x4 g4_ = *(const u32x4*)gp; u32x4 h4_ = g4_; if (LT2) h4_ = *(const u32x4*)(gp + 1024); G[0].x = g4_.x; G[0].y = g4_.y; G[1].x = g4_.z; G[1].y = g4_.w; H[0].x = h4_.x; H[0].y = h4_.y; H[1].x = h4_.z; H[1].y = h4_.w; } asm volatile("" ::: "memory")
#define MG_UNPACK(G) { auto rx_ = __builtin_amdgcn_permlane16_swap(G[0].x, G[1].x, false, false); auto ry_ = __builtin_amdgcn_permlane16_swap(G[0].y, G[1].y, false, false); G[0].x = rx_[0]; G[0].y = ry_[0]; G[1].x = rx_[1]; G[1].y = ry_[1]; }
#define MG_PROC(e, G, H) { MG_UNPACK(G); MG_UNPACK(H); u32x2 wq_[2]; _Pragma("unroll") for (int mm = 0; mm < 2; ++mm) { constexpr int ai = (e) >> 2, bj = ((e) >> 1) & 1; const int m = 2 * ((e) & 1) + mm; \
            const int row = row0 + ai * 128 + m * 16, col = col0 + bj * 128; const u32x2 gw = G[mm], hw = H[mm]; \
            asm volatile("" :: "v"(hw.x), "v"(hw.y));     \
            float g[8] = {U8F(gw.x, 0), U8F(gw.x, 1), U8F(gw.x, 2), U8F(gw.x, 3), U8F(gw.y, 0), U8F(gw.y, 1), U8F(gw.y, 2), U8F(gw.y, 3)}; \
            if (LT2) { const float hn[8] = {U8F(hw.x, 0), U8F(hw.x, 1), U8F(hw.x, 2), U8F(hw.x, 3), U8F(hw.y, 0), U8F(hw.y, 1), U8F(hw.y, 2), U8F(hw.y, 3)}; \
                _Pragma("unroll") for (int j = 0; j < 8; ++j) g[j] = g[j] * fast_rcp(hn[j]); \
            } else { _Pragma("unroll") for (int j = 0; j < 8; ++j) g[j] = g[j] * (1.0f / 255.0f); } \
            f32x4 v0 = acc[ai][bj][m][0], v1 = acc[ai][bj][m][1]; \
            v0[0] *= g[0]; v0[1] *= g[1]; v0[2] *= g[2]; v0[3] *= g[3]; v1[0] *= g[4]; v1[1] *= g[5]; v1[2] *= g[6]; v1[3] *= g[7]; \
            if (LT2) { acc[ai][bj][m][0] = v0; acc[ai][bj][m][1] = v1; } \
            else if (OUTPROJ_FP8) { wq_[mm].x = pk4_fp8c(v0[0], v0[1], v0[2], v0[3]); wq_[mm].y = pk4_fp8c(v1[0], v1[1], v1[2], v1[3]); (void)row; (void)col; } \
            else { u32x4 w; w.x = cvt_pk_bf16(v0[0], v0[1]); w.y = cvt_pk_bf16(v0[2], v0[3]); w.z = cvt_pk_bf16(v1[0], v1[1]); w.w = cvt_pk_bf16(v1[2], v1[3]); *(u32x4*)(mg + (size_t)row * 1024 + col) = w; } } \
            if (!LT2 && OUTPROJ_FP8) *(u32x4*)((unsigned char*)mg + (size_t)(row0 + ((e) >> 2) * 128 + (2 * ((e) & 1) + (fq & 1)) * 16) * 1024 + col0 + (((e) >> 1) & 1) * 128 - (fq & 1) * 8) = pair16(wq_[0], wq_[1]); } \
            asm volatile("" ::: "memory")
#define MG_SEQ MG_LOAD(0, Ga, Ha); MG_LOAD(1, Gb, Hb); MG_LOAD(2, Gc, Hc); \
        MG_PROC(0, Ga, Ha); MG_LOAD(3, Ga, Ha); MG_PROC(1, Gb, Hb); MG_LOAD(4, Gb, Hb); MG_PROC(2, Gc, Hc); MG_LOAD(5, Gc, Hc); \
        MG_PROC(3, Ga, Ha); MG_LOAD(6, Ga, Ha); MG_PROC(4, Gb, Hb); MG_LOAD(7, Gb, Hb); MG_PROC(5, Gc, Hc); MG_PROC(6, Ga, Ha); MG_PROC(7, Gb, Hb);
        if (br < 2) { constexpr bool LT2 = true; MG_SEQ } else { constexpr bool LT2 = false; MG_SEQ }
#undef MG_SEQ
#undef MG_LOAD
#undef MG_PROC
#undef MG_UNPACK
#undef U8F
    }
};
__device__ __forceinline__ void phase_merge(KP p, int l, unsigned char* lds) { MergeS s; s.p = p; s.l = l;
#if MERGE_FP8
    gemm_stream<MergeS, true, 0x7b7b7b7b, 0x7a7a7a7a>(s, 512, 128u, lds);
#else
    gemm_stream(s, 512, 128u, lds);
#endif
}

struct OutprojS {
    KP p; int l; SlotIter it; int rt, pn, nrt, npn; f32x4 pg[2][2]; bool hn;
    static constexpr bool BIAS_INIT = false;
    __device__ __forceinline__ void load_bias_first() {}
    __device__ __forceinline__ void init_acc(AccRef) {}
    __device__ __forceinline__ bool zero_after() const { return true; }
    __device__ __forceinline__ void prefetch() { GEMM_LANE_IDS(); const float* gp = (const float*)(p->ws + OFF_MOD) + ((size_t)l * 16 + (rt >> 3)) * 6144 + 2048 + pn * 256 + wc * 32 + fq * 8;
#pragma unroll
        for (int bj = 0; bj < 2; ++bj) { pg[bj][0] = *(const f32x4*)(gp + bj * 128); pg[bj][1] = *(const f32x4*)(gp + bj * 128 + 4); } }
    __device__ __forceinline__ void fill(GDesc& d, int rt_, int pn_) { GEMM_STAGE_IDS(); char* ws = p->ws; d.A = ws + OFF_MERGED; d.B = ws + OFF_WOUT + ((size_t)l * 1024 + (size_t)pn_ * 256) * 1024 * (OUTPROJ_FP8 ? 1 : 2);
#pragma unroll
        for (int i = 0; i < 4; ++i) d.aoff[i] = (unsigned)(((size_t)rt_ * 256 + TILE_ROW(i)) * (OUTPROJ_FP8 ? 1024 : 2048) + cS * 2); }
    __device__ __forceinline__ bool first(GDesc& d) { it.init(128, 4); if (!it.take(rt, pn)) return false; fill(d, rt, pn); return true; }
    __device__ __forceinline__ bool next(GDesc& d) { int a, b; if (!it.take(a, b)) return false; nrt = a; npn = b; fill(d, a, b); return true; }
    __device__ __forceinline__ void advance() { rt = nrt; pn = npn; }
    __device__ __forceinline__ void epilogue(AccRef acc) {
        GEMM_LANE_IDS(); bf16_t* xrb = (bf16_t*)(p->ws + OFF_XR); const float* xin = p->x;
        const int row0 = rt * 256 + wr * 64 + fr, col0 = pn * 256 + wc * 32 + fq * 8;
#define OP_ROW(ai, m) ((size_t)(row0 + (ai) * 128 + (m) * 16) * 1024 + col0)
        if (l == 0) {
            f32x4 Xa[2][2], Xb[2][2];
#define OP_LOAD(e, X) _Pragma("unroll") for (int mm = 0; mm < 2; ++mm) { const float* xp = xin + OP_ROW((e) >> 2, 2 * ((e) & 1) + mm) + (((e) >> 1) & 1) * 128; X[mm][0] = *(const f32x4*)xp; X[mm][1] = *(const f32x4*)(xp + 4); } asm volatile("" ::: "memory")
#define OP_PROC(e, X) _Pragma("unroll") for (int mm = 0; mm < 2; ++mm) { constexpr int ai = (e) >> 2, bj = ((e) >> 1) & 1; const int m = 2 * ((e) & 1) + mm; \
                const f32x4 v0 = X[mm][0] + pg[bj][0] * acc[ai][bj][m][0], v1 = X[mm][1] + pg[bj][1] * acc[ai][bj][m][1]; \
                u32x4 w; w.x = cvt_pk_bf16(v0[0], v0[1]); w.y = cvt_pk_bf16(v0[2], v0[3]); w.z = cvt_pk_bf16(v1[0], v1[1]); w.w = cvt_pk_bf16(v1[2], v1[3]); \
                *(u32x4*)(xrb + OP_ROW(ai, m) + bj * 128) = w; } asm volatile("" ::: "memory")
            OP_LOAD(0, Xa); OP_LOAD(1, Xb);
            OP_PROC(0, Xa); OP_LOAD(2, Xa);
            OP_PROC(1, Xb); OP_LOAD(3, Xb);
            OP_PROC(2, Xa); OP_LOAD(4, Xa);
            OP_PROC(3, Xb); OP_LOAD(5, Xb);
            OP_PROC(4, Xa); OP_LOAD(6, Xa);
            OP_PROC(5, Xb); OP_LOAD(7, Xb);
            OP_PROC(6, Xa); OP_PROC(7, Xb);
#undef OP_LOAD
#undef OP_PROC
        } else {
            u32x4 Xa[4], Xb[4];
#define OP_LOAD(q, X) _Pragma("unroll") for (int m = 0; m < 4; ++m) X[m] = *(const u32x4*)(xrb + OP_ROW((q) >> 1, m) + ((q) & 1) * 128); asm volatile("" ::: "memory")
#define OP_PROC(q, X) _Pragma("unroll") for (int m = 0; m < 4; ++m) { constexpr int ai = (q) >> 1, bj = (q) & 1; const u32x4 xw = X[m]; \
                const f32x4 v0 = (f32x4){bflo(xw.x), bfhi(xw.x), bflo(xw.y), bfhi(xw.y)} + pg[bj][0] * acc[ai][bj][m][0], v1 = (f32x4){bflo(xw.z), bfhi(xw.z), bflo(xw.w), bfhi(xw.w)} + pg[bj][1] * acc[ai][bj][m][1]; \
                u32x4 w; w.x = cvt_pk_bf16(v0[0], v0[1]); w.y = cvt_pk_bf16(v0[2], v0[3]); w.z = cvt_pk_bf16(v1[0], v1[1]); w.w = cvt_pk_bf16(v1[2], v1[3]); \
                *(u32x4*)(xrb + OP_ROW(ai, m) + bj * 128) = w; } asm volatile("" ::: "memory")
            OP_LOAD(0, Xa); OP_LOAD(1, Xb);
            OP_PROC(0, Xa); OP_LOAD(2, Xa);
            OP_PROC(1, Xb); OP_LOAD(3, Xb);
            OP_PROC(2, Xa); OP_PROC(3, Xb);
#undef OP_LOAD
#undef OP_PROC
        }
#undef OP_ROW
    }
};
__device__ __forceinline__ void phase_outproj(KP p, int l, unsigned char* lds) { OutprojS s; s.p = p; s.l = l;
#if OUTPROJ_FP8
    gemm_stream<OutprojS, true, 0x7b7b7b7b, 0x7a7a7a7a>(s, 1024, 128u, lds);
#else
    gemm_stream(s, 1024, 128u, lds);
#endif
}

__device__ __forceinline__ void moe_tables(KP p, int l, int* tbl) {
    const int t = hidden_tid();
    if (t < 64) {
        const unsigned* ctrl = (const unsigned*)p->ws; const int e = t & 31;
        const int c = (int)ctrl[CW_ECNT(l, e)]; const int nt = (c + 255) >> 8;
        int incl = nt;
#pragma unroll
        for (int o = 1; o < 32; o <<= 1) { const int v = __builtin_amdgcn_ds_bpermute(((t - o) & 63) << 2, incl); if (e >= o) incl += v; }
        if (t < 32) { tbl[e] = incl - nt; tbl[33 + e] = c; if (e == 31) tbl[32] = incl; }
    }
    __syncthreads();
}
#define RFL(x) __builtin_amdgcn_readfirstlane(x)
__device__ __forceinline__ int moe_find(const int* tbl, int rt, int e = 0) {
    while (RFL(tbl[e + 1]) <= rt) ++e;
    while (RFL(tbl[e]) > rt) --e;
    return e; }
#define MOE_TBL(lds) ((int*)((lds) + 131072 + 4096))

#ifndef MOEX
#define MOEX 0
#endif
struct Moe1S {
    KP p; int l; const int* tbl; SlotIter it; int rt, pn, e, nrt, npn, ne; int shadow; f32x4 bg[2], bu[2]; const int* toktab; int ui; bool hn;
    static constexpr bool BIAS_INIT = true;
    __device__ __forceinline__ bool zero_after() const { return true; }
    __device__ __forceinline__ void prefetch() {}
    __device__ __forceinline__ void load_bias(int pn_, int e_) { GEMM_LANE_IDS(); const float* bb = (const float*)(p->ws + OFF_B1P) + ((size_t)(l * 32 + e_)) * 2048 + pn_ * 256 + wc * 32 + fq * 8;
#pragma unroll
        for (int n = 0; n < 2; ++n) { bg[n] = *(const f32x4*)(bb + n * 4); bu[n] = *(const f32x4*)(bb + 128 + n * 4); } }
    __device__ __forceinline__ void load_bias_first() { load_bias(pn, e); }
    __device__ __forceinline__ void init_acc(AccRef acc) {
#pragma unroll
        for (int ai = 0; ai < 2; ++ai)
#pragma unroll
            for (int m = 0; m < 4; ++m)
#pragma unroll
                for (int n = 0; n < 2; ++n) { acc[ai][0][m][n] = bg[n]; acc[ai][1][m][n] = bu[n]; } }
    __device__ __forceinline__ void fill(GDesc& d, int rt_, int pn_, int e_) { GEMM_STAGE_IDS(); char* ws = p->ws; (void)rt_;
        d.A = ws + OFF_H8; d.B = ws + OFF_W1 + (((size_t)(l * 32 + e_)) * 2048 + (size_t)pn_ * 256) * 1024;
#pragma unroll
        for (int i = 0; i < 4; ++i) d.aoff[i] = (unsigned)((size_t)toktab[ui * 256 + TILE_ROW(i)] * 1024 + cS * 2);
        ++ui; }
    __device__ __forceinline__ bool first(GDesc& d) { it.init(RFL(tbl[32]), 8); if (!it.take(rt, pn)) return false; e = moe_find(tbl, rt); fill(d, rt, pn, e); return true; }
    __device__ __forceinline__ bool next(GDesc& d) { int a, b; if (!it.take(a, b)) return false; nrt = a; npn = b; ne = moe_find(tbl, a, e); fill(d, a, b, ne); return true; }
    __device__ __forceinline__ void advance() { rt = nrt; pn = npn; e = ne; }
    __device__ __forceinline__ void epilogue(AccRef acc) {
        if (shadow && MOEX == 2) { asm volatile("" :: "v"(acc[0][0][0][0]), "v"(acc[1][1][3][1])); return; }
        if (hn) load_bias(npn, ne);
        GEMM_LANE_IDS(); char* ws = p->ws; unsigned char* hid = (unsigned char*)(ws + OFF_HID);
        const size_t prow0 = (size_t)rt * 256 + wr * 64 + fr; const int c0 = wc * 32 + fq * 8;
#pragma unroll
        for (int ai = 0; ai < 2; ++ai)
#pragma unroll
            for (int m2 = 0; m2 < 4; m2 += 2) { u32x2 wp[2];
#pragma unroll
              for (int mq = 0; mq < 2; ++mq) { const int m = m2 + mq; float o[8];
#pragma unroll
                for (int n = 0; n < 2; ++n) { const f32x4 gq = acc[ai][0][m][n], uq = acc[ai][1][m][n];
#pragma unroll
                    for (int j = 0; j < 4; ++j) { const float gg = fminf(gq[j], 7.0f); const float u4 = MOE1_UFOLD ? __builtin_amdgcn_fmed3f(uq[j], -24.0f, 32.0f) : __builtin_fmaf(__builtin_amdgcn_fmed3f(uq[j], -7.0f, 7.0f), 4.0f, 4.0f); o[n * 4 + j] = u4 * gg * fast_rcp(1.0f + fast_exp2(-1.702f * LOG2E * gg)); } }
                wp[mq].x = pk4_fp8(o[0], o[1], o[2], o[3]); wp[mq].y = pk4_fp8(o[4], o[5], o[6], o[7]); }
              *(u32x4*)(hid + (prow0 + ai * 128 + (m2 + (fq & 1)) * 16) * 1024 + pn * 128 + c0 - (fq & 1) * 8) = pair16(wp[0], wp[1]); }
    }
};
__device__ __forceinline__ void phase_moe1(KP p, int l, unsigned char* lds) { int* tbl = MOE_TBL(lds); moe_tables(p, l, tbl);
    int* toktab = (int*)(lds + 131072 + 8192);
    {
        SlotIter it2; it2.init(RFL(tbl[32]), 8); int a, b, n = 0, e2 = 0; const int t = hidden_tid();
        int* udesc = (int*)(lds + 131072 + 4096 + 1024);
        while (it2.take(a, b)) { e2 = moe_find(tbl, a, e2); if (t == 0 && n < 20) { udesc[3 * n] = e2; udesc[3 * n + 1] = (a - RFL(tbl[e2])) * 256; udesc[3 * n + 2] = RFL(tbl[33 + e2]); } ++n; }
        __syncthreads();
        n = n < 20 ? n : 20;
        if (n > 0) {
            const int half = t >> 8, row = t & 255; int v[10];
#pragma unroll
            for (int j = 0; j < 10; ++j) { int i = 2 * j + half; i = i < n ? i : n - 1; const int e = udesc[3 * i], cnt = udesc[3 * i + 2]; int pos = udesc[3 * i + 1] + row; pos = pos < cnt ? pos : 0;
                v[j] = ((const int*)(p->ws + OFF_BUCK))[(size_t)e * NTOK + pos]; }
            __builtin_amdgcn_sched_barrier(0);
#pragma unroll
            for (int j = 0; j < 10; ++j) { const int i = 2 * j + half; if (i < n) toktab[i * 256 + row] = v[j]; }
        }
        __syncthreads(); }
    for (int rep = 0; rep < (MOEX ? 2 : 1); ++rep) { Moe1S s; s.p = p; s.l = l; s.tbl = tbl; s.shadow = rep; s.toktab = toktab; s.ui = 0; gemm_stream<Moe1S, true, 0x7f7f7f7f, 0x7a7a7a7a>(s, 1024, 128u, lds); __syncthreads();
        if (COSCHED && rep == 0 && l == 0 && s.ui < (int)((RFL(tbl[32]) * 8 + gridDim.x - 1) / gridDim.x)) pull_groups(p, 1, 3, lds); } }

#ifndef Y8S
#define Y8S 16.0f
#endif
struct Moe2S {
    KP p; int l; const int* tbl; SlotIter it; int rt, pn, e, nrt, npn, ne; f32x4 pb[2][2]; bool hn; int nu;
    static constexpr bool BIAS_INIT = true;
    __device__ __forceinline__ bool zero_after() const { return true; }
    __device__ __forceinline__ void prefetch() {}
    __device__ __forceinline__ void load_bias(int pn_, int e_) { GEMM_LANE_IDS(); const float* b2 = p->exp_b2 + ((size_t)(l * 32 + e_)) * 1024 + pn_ * 256 + wc * 32 + fq * 8;
#pragma unroll
        for (int bj = 0; bj < 2; ++bj) { pb[bj][0] = *(const f32x4*)(b2 + bj * 128); pb[bj][1] = *(const f32x4*)(b2 + bj * 128 + 4); } }
    __device__ __forceinline__ void load_bias_first() { load_bias(pn, e); }
    __device__ __forceinline__ void init_acc(AccRef acc) {
#pragma unroll
        for (int bj = 0; bj < 2; ++bj) { const f32x4 b0 = pb[bj][0] * Y8S, b1 = pb[bj][1] * Y8S;
#pragma unroll
            for (int ai = 0; ai < 2; ++ai)
#pragma unroll
                for (int m = 0; m < 4; ++m) { acc[ai][bj][m][0] = b0; acc[ai][bj][m][1] = b1; } } }
    __device__ __forceinline__ void fill(GDesc& d, int rt_, int pn_, int e_) { ++nu; GEMM_STAGE_IDS(); char* ws = p->ws; d.A = ws + OFF_HID; d.B = ws + OFF_W2 + (((size_t)(l * 32 + e_)) * 1024 + (size_t)pn_ * 256) * 1024;
#pragma unroll
        for (int i = 0; i < 4; ++i) d.aoff[i] = (unsigned)(((size_t)rt_ * 256 + TILE_ROW(i)) * 1024 + cS * 2); }
    __device__ __forceinline__ bool first(GDesc& d) { it.init(RFL(tbl[32]), 4); if (!it.take(rt, pn)) return false; e = moe_find(tbl, rt); fill(d, rt, pn, e); return true; }
    __device__ __forceinline__ bool next(GDesc& d) { int a, b; if (!it.take(a, b)) return false; nrt = a; npn = b; ne = moe_find(tbl, a, e); fill(d, a, b, ne); return true; }
    __device__ __forceinline__ void advance() { rt = nrt; pn = npn; e = ne; }
    __device__ __forceinline__ void epilogue(AccRef acc) {
        if (hn) load_bias(npn, ne);
        GEMM_LANE_IDS(); char* ws = p->ws; unsigned char* y = (unsigned char*)(ws + OFF_Y);
        const size_t row0 = (size_t)rt * 256 + wr * 64 + fr; const int col0 = pn * 256 + wc * 32 + fq * 8;
#pragma unroll
        for (int bj = 0; bj < 2; ++bj) { const int col = col0 + bj * 128;
#pragma unroll
            for (int ai = 0; ai < 2; ++ai)
#pragma unroll
                for (int m2 = 0; m2 < 4; m2 += 2) { u32x2 wp[2];
#pragma unroll
                  for (int mq = 0; mq < 2; ++mq) { const int m = m2 + mq; f32x4 v0 = acc[ai][bj][m][0], v1 = acc[ai][bj][m][1];
#pragma unroll
                    for (int q = 0; q < 4; ++q) { v0[q] = __builtin_amdgcn_fmed3f(v0[q], -448.0f, 448.0f); v1[q] = __builtin_amdgcn_fmed3f(v1[q], -448.0f, 448.0f); }
                    wp[mq].x = pk4_fp8(v0[0], v0[1], v0[2], v0[3]); wp[mq].y = pk4_fp8(v1[0], v1[1], v1[2], v1[3]); }
                  *(u32x4*)(y + (row0 + ai * 128 + (m2 + (fq & 1)) * 16) * 1024 + col - (fq & 1) * 8) = pair16(wp[0], wp[1]); } }
    }
};
__device__ __forceinline__ void phase_moe2(KP p, int l, unsigned char* lds) { int* tbl = MOE_TBL(lds); moe_tables(p, l, tbl); Moe2S s; s.p = p; s.l = l; s.tbl = tbl; s.nu = 0; gemm_stream<Moe2S, true, 0x7d7d7d7d, 0x7e7e7e7e>(s, 1024, 128u, lds); __syncthreads();
    if (COSCHED && l == 0 && s.nu < (int)((RFL(tbl[32]) * 4 + gridDim.x - 1) / gridDim.x)) pull_groups(p, 1, 3, lds); }

#define AT_MISC 65536


typedef short s16x4 __attribute__((ext_vector_type(4)));
__device__ __forceinline__ int crow(int r, int h) { return (r & 3) + 8 * (r >> 2) + 4 * h; }
__device__ __forceinline__ int kaddr(int key, int c) { return (key >> 1) * 256 + (((((key & 1) << 3) | c) ^ ((key >> 1) & 15)) << 4); }
__device__ __forceinline__ int vaddr64(int key, int c) { return (key >> 1) * 256 + (((key & 1) * 2 + ((c >> 2) ^ ((key >> 1) & 1))) << 6) + ((c & 3) << 4); }
__device__ __forceinline__ int vaddr128(int key, int c) { return key * 256 + (((c >> 2) ^ (key & 3)) << 6) + ((c & 3) << 4); }
__device__ __forceinline__ s16x4 vtr(const unsigned char* p) { return __builtin_bit_cast(s16x4, __builtin_amdgcn_ds_read_tr16_b64_v4i16((LAS s16x4*)(p))); }
__device__ __forceinline__ float swap_max(float v) { auto rr = __builtin_amdgcn_permlane32_swap(__float_as_uint(v), __float_as_uint(v), false, false); return fmaxf(__uint_as_float(rr[0]), __uint_as_float(rr[1])); }
__device__ __forceinline__ float swap_sum(float v) { auto rr = __builtin_amdgcn_permlane32_swap(__float_as_uint(v), __float_as_uint(v), false, false); return __uint_as_float(rr[0]) + __uint_as_float(rr[1]); }
__device__ __forceinline__ float swap_other(float v, int h) { auto rr = __builtin_amdgcn_permlane32_swap(__float_as_uint(v), __float_as_uint(v), false, false); return __uint_as_float(h ? rr[0] : rr[1]); }
#define MFMA32(a, b, c) __builtin_amdgcn_mfma_f32_32x32x16_bf16((a), (b), (c), 0, 0, 0)

struct KVSrc { const char* k; unsigned kstride; const char* v; unsigned vstride; };
__device__ __forceinline__ void kinv(int o, int& key, int& c) { const int sup = o >> 8, x = ((o >> 4) & 15) ^ (sup & 15); key = 2 * sup + (x >> 3); c = x & 7; }
__device__ __forceinline__ void vinv64(int o, int& key, int& c) { const int sup = o >> 8, seg = (o >> 6) & 3; key = 2 * sup + (seg >> 1); c = (((seg & 1) ^ (sup & 1)) << 2) | ((o >> 4) & 3); }
__device__ __forceinline__ void vinv128(int o, int& key, int& c) { key = o >> 8; c = ((((o >> 6) & 3) ^ (key & 3)) << 2) | ((o >> 4) & 3); }
#define RING_NB 4
#define RING_AHEAD 3
template <int KW, int DV> struct KVRing {
    static constexpr int LPT = KW + DV / 64, BUFB = KW * 8192 + DV * 128;
    unsigned kof[KW], vof[DV / 64];
    unsigned kdst[KW], vdst[DV / 64];
    const char* kb; const char* vb; unsigned kstride, vstride;
    __device__ __forceinline__ void init(const KVSrc& s, int tid) {
        kb = s.k; vb = s.v; kstride = s.kstride; vstride = s.vstride;
        const int wv = tid >> 6, lane = tid & 63;
#pragma unroll
        for (int i = 0; i < KW; ++i) { const int o = (i * 8 + wv) * 1024 + lane * 16, img = o >> 13; int key, c; kinv(o & 8191, key, c); kof[i] = (unsigned)key * kstride + (unsigned)(img * 128 + c * 16); kdst[i] = (unsigned)o; }
#pragma unroll
        for (int i = 0; i < DV / 64; ++i) { const int o = (i * 8 + wv) * 1024 + lane * 16; int key, c; if (DV == 64) vinv64(o, key, c); else vinv128(o, key, c);
            vof[i] = (unsigned)key * vstride + (unsigned)(c * 16); vdst[i] = (unsigned)(KW * 8192 + o); }
    }
    __device__ __forceinline__ void issue(int key0, int buf, unsigned char* lds) const {
        const char* kt = UNIPTR(kb + (size_t)key0 * kstride); const char* vt = UNIPTR(vb + (size_t)key0 * vstride);
#pragma unroll
        for (int i = 0; i < KW; ++i) { unsigned o = kof[i]; asm volatile("" : "+v"(o)); __builtin_amdgcn_global_load_lds((const unsigned*)(kt + o), (unsigned*)(lds + buf * BUFB + kdst[i]), 16, 0, 0); }
#pragma unroll
        for (int i = 0; i < DV / 64; ++i) { unsigned o = vof[i]; asm volatile("" : "+v"(o)); __builtin_amdgcn_global_load_lds((const unsigned*)(vt + o), (unsigned*)(lds + buf * BUFB + vdst[i]), 16, 0, 0); }
    }
    __device__ __forceinline__ void wait_bar(int later) const {
        if (later >= 2 && RING_AHEAD >= 3) asm volatile("s_waitcnt vmcnt(%0)" :: "n"(2 * LPT) : "memory");
        else if (later >= 1) asm volatile("s_waitcnt vmcnt(%0)" :: "n"(LPT) : "memory");
        else asm volatile("s_waitcnt vmcnt(0)" ::: "memory");
        __builtin_amdgcn_s_barrier(); asm volatile("" ::: "memory");
    }
    __device__ __forceinline__ const unsigned char* kimg(const unsigned char* lds, int buf, int img) const { return lds + buf * BUFB + img * 8192; }
    __device__ __forceinline__ const unsigned char* vimg(const unsigned char* lds, int buf) const { return lds + buf * BUFB + KW * 8192; }
};

template <int DV> struct WaveAcc { float m, l; f32x16 o[DV / 32]; };
template <int DV> __device__ __forceinline__ void acc_init(WaveAcc<DV>& a) { a.m = -1e30f; a.l = 0.f;
#pragma unroll
    for (int d = 0; d < DV / 32; ++d)
#pragma unroll
        for (int r = 0; r < 16; ++r) a.o[d][r] = 0.f; }

__device__ __forceinline__ f32x16 qk_sub(const bf16x8 (&qf)[4], const unsigned char* kimg, int sub, int lane) {
    const int r32 = lane & 31, h = lane >> 5;
    f32x16 s;
#pragma unroll
    for (int r = 0; r < 16; ++r) s[r] = 0.f;
#pragma unroll
    for (int ks = 0; ks < 4; ++ks) { const bf16x8 kf = *(const bf16x8*)(kimg + kaddr(32 * sub + r32, 2 * ks + h)); s = MFMA32(kf, qf[ks], s); }
    return s;
}
template <int DV> struct VFrag { s16x4 r[2][DV / 32][2]; };
__device__ __forceinline__ void v_read_all(VFrag<64>& f, const unsigned char* vimg, int sub, int lane) {
    const int h = lane >> 5, i16 = lane & 15, qq = i16 >> 2, pp = i16 & 3, g1 = (lane >> 4) & 1, k0 = 32 * sub + 4 * h + qq;
    const unsigned b0 = (unsigned)(uintptr_t)(vimg + vaddr64(k0, 2 * g1 + (pp >> 1)) + (pp & 1) * 8), b1 = (unsigned)(uintptr_t)(vimg + vaddr64(k0, 4 + 2 * g1 + (pp >> 1)) + (pp & 1) * 8);
    asm volatile("ds_read_b64_tr_b16 %0, %8\n\tds_read_b64_tr_b16 %1, %8 offset:1024\n\tds_read_b64_tr_b16 %2, %9\n\tds_read_b64_tr_b16 %3, %9 offset:1024\n\t"
                 "ds_read_b64_tr_b16 %4, %8 offset:2048\n\tds_read_b64_tr_b16 %5, %8 offset:3072\n\tds_read_b64_tr_b16 %6, %9 offset:2048\n\tds_read_b64_tr_b16 %7, %9 offset:3072\n\t"
                 "s_waitcnt lgkmcnt(0)"
                 : "=&v"(f.r[0][0][0]), "=&v"(f.r[0][0][1]), "=&v"(f.r[0][1][0]), "=&v"(f.r[0][1][1]), "=&v"(f.r[1][0][0]), "=&v"(f.r[1][0][1]), "=&v"(f.r[1][1][0]), "=&v"(f.r[1][1][1])
                 : "v"(b0), "v"(b1) : "memory");
}
__device__ __forceinline__ void v_read_all(VFrag<128>& f, const unsigned char* vimg, int sub, int lane) {
    const int h = lane >> 5, i16 = lane & 15, qq = i16 >> 2, pp = i16 & 3, g1 = (lane >> 4) & 1, k0 = 32 * sub + 4 * h + qq;
    unsigned b[4];
#pragma unroll
    for (int db = 0; db < 4; ++db) b[db] = (unsigned)(uintptr_t)(vimg + vaddr128(k0, db * 4 + 2 * g1 + (pp >> 1)) + (pp & 1) * 8);
    asm volatile("ds_read_b64_tr_b16 %0, %16\n\tds_read_b64_tr_b16 %1, %16 offset:2048\n\tds_read_b64_tr_b16 %2, %17\n\tds_read_b64_tr_b16 %3, %17 offset:2048\n\t"
                 "ds_read_b64_tr_b16 %4, %18\n\tds_read_b64_tr_b16 %5, %18 offset:2048\n\tds_read_b64_tr_b16 %6, %19\n\tds_read_b64_tr_b16 %7, %19 offset:2048\n\t"
                 "ds_read_b64_tr_b16 %8, %16 offset:4096\n\tds_read_b64_tr_b16 %9, %16 offset:6144\n\tds_read_b64_tr_b16 %10, %17 offset:4096\n\tds_read_b64_tr_b16 %11, %17 offset:6144\n\t"
                 "ds_read_b64_tr_b16 %12, %18 offset:4096\n\tds_read_b64_tr_b16 %13, %18 offset:6144\n\tds_read_b64_tr_b16 %14, %19 offset:4096\n\tds_read_b64_tr_b16 %15, %19 offset:6144\n\t"
                 "s_waitcnt lgkmcnt(0)"
                 : "=&v"(f.r[0][0][0]), "=&v"(f.r[0][0][1]), "=&v"(f.r[0][1][0]), "=&v"(f.r[0][1][1]), "=&v"(f.r[0][2][0]), "=&v"(f.r[0][2][1]), "=&v"(f.r[0][3][0]), "=&v"(f.r[0][3][1]),
                   "=&v"(f.r[1][0][0]), "=&v"(f.r[1][0][1]), "=&v"(f.r[1][1][0]), "=&v"(f.r[1][1][1]), "=&v"(f.r[1][2][0]), "=&v"(f.r[1][2][1]), "=&v"(f.r[1][3][0]), "=&v"(f.r[1][3][1])
                 : "v"(b[0]), "v"(b[1]), "v"(b[2]), "v"(b[3]) : "memory");
}
template <int DV> __device__ __forceinline__ void pv_sub(const f32x16& pr, const VFrag<DV>& f, f32x16 (&o)[DV / 32]) {
#pragma unroll
    for (int s2 = 0; s2 < 2; ++s2) {
        u32x4 pw; pw.x = cvt_pk_bf16(pr[8 * s2 + 0], pr[8 * s2 + 1]); pw.y = cvt_pk_bf16(pr[8 * s2 + 2], pr[8 * s2 + 3]);
        pw.z = cvt_pk_bf16(pr[8 * s2 + 4], pr[8 * s2 + 5]); pw.w = cvt_pk_bf16(pr[8 * s2 + 6], pr[8 * s2 + 7]);
        const bf16x8 pf = __builtin_bit_cast(bf16x8, pw);
#pragma unroll
        for (int db = 0; db < DV / 32; ++db) { const s16x4 lo = f.r[s2][db][0], hi = f.r[s2][db][1];
            bf16x8 vf; vf[0] = lo[0]; vf[1] = lo[1]; vf[2] = lo[2]; vf[3] = lo[3]; vf[4] = hi[0]; vf[5] = hi[1]; vf[6] = hi[2]; vf[7] = hi[3];
            o[db] = MFMA32(vf, pf, o[db]); }
    }
}
template <int DV> __device__ __forceinline__ void attn_sub_auto(const bf16x8 (&qf)[5], const unsigned char* kimg, const unsigned char* vimg, int sub, int key0, int tqw, int tq, int h,
                                                               int whi, bool lbit, WaveAcc<DV>& a, int lane) {
    f32x16 s = qk_sub(*(const bf16x8 (*)[4])&qf, kimg, sub, lane);
    { const int r32 = lane & 31, tk = key0 + r32; const unsigned hi = __float_as_uint((float)(tk >> 8)) >> 16, lo = __float_as_uint((float)(tk & 255)) & 0xffff0000u;
      u32x4 kw; kw.x = (lane < 32) ? (hi | lo) : 0u; kw.y = 0u; kw.z = 0u; kw.w = 0u;
      s = MFMA32(__builtin_bit_cast(bf16x8, kw), qf[4], s); }
    VFrag<DV> vf; v_read_all(vf, vimg, sub, lane);
    const bool interior = (tqw - (key0 + 31) >= 0) && (tqw + 31 - key0 < whi) && __all(lbit);
    if (!interior) { const int d0 = tq - key0 - 4 * h;
#pragma unroll
        for (int r = 0; r < 16; ++r) { const int dist = d0 - ((r & 3) + 8 * (r >> 2)); s[r] = (lbit && dist >= 0 && dist < whi) ? s[r] : -INFINITY; } }
    float tmax = fmaxf(fmaxf(s[0], s[1]), fmaxf(s[2], s[3]));
#pragma unroll
    for (int r = 4; r < 16; r += 4) tmax = fmaxf(tmax, fmaxf(fmaxf(s[r], s[r + 1]), fmaxf(s[r + 2], s[r + 3])));
    tmax = swap_max(tmax);
    if (!__all(tmax - a.m <= 8.0f)) {
        const float mnew = fmaxf(a.m, tmax), alpha = fast_exp2((a.m - mnew) * LOG2E);
        a.l *= alpha; a.m = mnew;
#pragma unroll
        for (int d = 0; d < DV / 32; ++d)
#pragma unroll
            for (int r = 0; r < 16; ++r) a.o[d][r] *= alpha;
    }
    const float nm = -a.m * LOG2E;
    float rs0 = 0.f, rs1 = 0.f;
#pragma unroll
    for (int r = 0; r < 16; r += 2) { s[r] = fast_exp2(__builtin_fmaf(s[r], LOG2E, nm)); s[r + 1] = fast_exp2(__builtin_fmaf(s[r + 1], LOG2E, nm)); rs0 += s[r]; rs1 += s[r + 1]; }
    a.l += rs0 + rs1;
    pv_sub<DV>(s, vf, a.o);
}
__device__ __forceinline__ void load_q(bf16x8 (&qf)[5], const bf16_t* qp  , float slope, int lane) {
#pragma unroll
    for (int ks = 0; ks < 4; ++ks) qf[ks] = *(const bf16x8*)(qp + 16 * ks);
    u32x4 qw; qw.x = (lane < 32) ? ((__float_as_uint(256.0f * slope) >> 16) | (__float_as_uint(slope) & 0xffff0000u)) : 0u; qw.y = 0u; qw.z = 0u; qw.w = 0u;
    qf[4] = __builtin_bit_cast(bf16x8, qw);
}
__device__ __forceinline__ void store8_pair(unsigned wk, unsigned wk1, unsigned char* rowbase  , int h) {
    auto rr = __builtin_amdgcn_permlane32_swap(wk, wk1, false, false);
    u32x2 w; w.x = rr[0]; w.y = rr[1];
    *(u32x2*)(rowbase + 8 * h) = w;
}
template <int DV> __device__ __forceinline__ void store_o8(const f32x16 (&o)[DV / 32], float sc, unsigned char* orow, int h) {
#pragma unroll
    for (int db = 0; db < DV / 32; ++db)
#pragma unroll
        for (int rg = 0; rg < 4; rg += 2)
            store8_pair(pk4_fp8c(o[db][4 * rg] * sc, o[db][4 * rg + 1] * sc, o[db][4 * rg + 2] * sc, o[db][4 * rg + 3] * sc),
                        pk4_fp8c(o[db][4 * rg + 4] * sc, o[db][4 * rg + 5] * sc, o[db][4 * rg + 6] * sc, o[db][4 * rg + 7] * sc), orow + db * 32 + 8 * rg, h);
}
template <int DV> __device__ __forceinline__ void store_o8_narrow(const f32x16 (&o)[DV / 32], float sc, unsigned char* orow, int h) {
#pragma unroll
    for (int db = 0; db < DV / 32; ++db)
#pragma unroll
        for (int rg = 0; rg < 4; ++rg) *(unsigned*)(orow + db * 32 + 8 * rg + 4 * h) = pk4_fp8c(o[db][4 * rg] * sc, o[db][4 * rg + 1] * sc, o[db][4 * rg + 2] * sc, o[db][4 * rg + 3] * sc);
}
template <int DV> __device__ __forceinline__ void store_o(const f32x16 (&o)[DV / 32], float sc, bf16_t* orow, int h) {
#pragma unroll
    for (int db = 0; db < DV / 32; ++db)
#pragma unroll
        for (int rg = 0; rg < 4; rg += 2) {
            const unsigned a0 = cvt_pk_bf16(o[db][4 * rg] * sc, o[db][4 * rg + 1] * sc), a1 = cvt_pk_bf16(o[db][4 * rg + 2] * sc, o[db][4 * rg + 3] * sc);
            const unsigned b0 = cvt_pk_bf16(o[db][4 * rg + 4] * sc, o[db][4 * rg + 5] * sc), b1 = cvt_pk_bf16(o[db][4 * rg + 6] * sc, o[db][4 * rg + 7] * sc);
            auto r0 = __builtin_amdgcn_permlane32_swap(a0, b0, false, false); auto r1 = __builtin_amdgcn_permlane32_swap(a1, b1, false, false);
            u32x4 w; w.x = r0[0]; w.y = r1[0]; w.z = r0[1]; w.w = r1[1];
            *(u32x4*)(orow + db * 32 + 8 * rg + 8 * h) = w; }
}


template <bool SINK> __device__ __forceinline__ void attn_window_unit(KP p, int l, int b, int hkv, int qt, int W, int cq, int ck, int cv, bf16_t* outbuf, unsigned char* lds) {
    const int tid = hidden_tid(), lane = tid & 63, wv = __builtin_amdgcn_readfirstlane(tid >> 6), r32 = lane & 31, h = lane >> 5, g = wv & 3, qsub = wv >> 2;
    if (ATT_PRIO && wv >= 4) __builtin_amdgcn_s_setprio(1);
    const int head = hkv * 4 + g, t0 = qt * 64, tqw = t0 + 32 * qsub, tq = tqw + r32;
    const bf16_t* z = (const bf16_t*)(p->ws + OFF_Z);
    const float slope = exp2f(-(float)(head + 1));
    KVSrc src; src.k = (const char*)(z + (size_t)b * NS * ZW + ck + hkv * 64); src.v = (const char*)(z + (size_t)b * NS * ZW + cv + hkv * 64); src.kstride = ZW * 2; src.vstride = ZW * 2;
    int klo = t0 - W + 1; klo = klo < 0 ? 0 : klo; const int kt0 = klo >> 6, kt1 = qt;
    WaveAcc<64> a; acc_init(a);
    KVRing<1, 64> ring; ring.init(src, tid);
    const int nt = kt1 - kt0 + 1;
    for (int j = 0; j < RING_AHEAD && j < nt; ++j) ring.issue((kt1 - j) * 64, j, lds);
    bf16x8 qf[5]; load_q(qf, z + ((size_t)b * NS + tq) * ZW + cq + head * 64 + 8 * h, slope, lane);
    float sinkv = 0.f; if (SINK) sinkv = p->sinks[l * 8 + head];
    asm volatile("" :: "v"(qf[0]), "v"(qf[1]), "v"(qf[2]), "v"(qf[3]), "v"(sinkv));
    asm volatile(".p2align 8");
    for (int t = 0; t < nt; ++t) {
        const int kt = kt1 - t, buf = t & (RING_NB - 1);
        ring.wait_bar(nt - 1 - t);
        if (t + RING_AHEAD < nt) ring.issue((kt - RING_AHEAD) * 64, (t + RING_AHEAD) & (RING_NB - 1), lds);
        const unsigned char* kimg = ring.kimg(lds, buf, 0); const unsigned char* vimg = ring.vimg(lds, buf);
#pragma unroll
        for (int sr = 0; sr < 2; ++sr) { const int sub = 1 - sr, key0 = kt * 64 + 32 * sub;
            if (key0 <= tqw + 31 && key0 + 31 >= tqw - W + 1) attn_sub_auto<64>(qf, kimg, vimg, sub, key0, tqw, tq, h, W, true, a, lane); }
    }
    __syncthreads();
    float den = swap_sum(a.l);
    if (SINK) den += fast_exp2((sinkv + slope * (float)tq - a.m) * LOG2E);
    if (SINK && MERGE_FP8) store_o8<64>(a.o, 1.0f / den, (unsigned char*)outbuf + ((size_t)b * NS + tq) * 512 + head * 64, h);
    else store_o<64>(a.o, 1.0f / den, outbuf + ((size_t)b * NS + tq) * 512 + head * 64, h);
}

#ifndef EXPER
#define EXPER 0
#endif
__device__ __forceinline__ void attn_diff_unit(KP p, int l, int b, int hd, int qt, unsigned char* lds, const int shadow = 0) {
    const int tid = hidden_tid(), lane = tid & 63, wv = __builtin_amdgcn_readfirstlane(tid >> 6), r32 = lane & 31, h = lane >> 5, c = wv & 1, qsub = wv >> 1;
    if (ATT_PRIO && wv >= 4) __builtin_amdgcn_s_setprio(1);
    const int t0 = qt * 128, tqw = t0 + 32 * qsub, tq = tqw + r32;
    const bf16_t* z = (const bf16_t*)(p->ws + OFF_Z);
    KVSrc src; src.k = (const char*)(z + (size_t)b * NS * ZW + C_KB + hd * 128); src.v = (const char*)(z + (size_t)b * NS * ZW + C_VB + hd * 128); src.kstride = ZW * 2; src.vstride = ZW * 2;
    const int kt1 = 2 * qt + 1;
    WaveAcc<128> a; acc_init(a);
    KVRing<2, 128> ring; ring.init(src, tid);
    const int nt = kt1 + 1;
    for (int j = 0; j < RING_AHEAD && j < nt; ++j) ring.issue((kt1 - j) * 64, j, lds);
    bf16x8 qf[5]; load_q(qf, z + ((size_t)b * NS + tq) * ZW + C_QB + hd * 128 + c * 64 + 8 * h, exp2f(-2.0f * (float)(hd + 1)), lane);
    float lam = ((const float*)p->ws)[CW_LAM + l];
    asm volatile("" :: "v"(qf[0]), "v"(qf[1]), "v"(qf[2]), "v"(qf[3]), "v"(lam));
    asm volatile(".p2align 8");
    for (int t = 0; t < nt; ++t) {
        const int kt = kt1 - t, buf = t & (RING_NB - 1);
        ring.wait_bar(nt - 1 - t);
        if (t + RING_AHEAD < nt) ring.issue((kt - RING_AHEAD) * 64, (t + RING_AHEAD) & (RING_NB - 1), lds);
        const unsigned char* kimg = ring.kimg(lds, buf, c); const unsigned char* vimg = ring.vimg(lds, buf);
#pragma unroll
        for (int sr = 0; sr < 2; ++sr) { const int sub = 1 - sr, key0 = kt * 64 + 32 * sub;
            if (key0 <= tqw + 31) {
                if (shadow && EXPER == 1) { }
                else attn_sub_auto<128>(qf, kimg, vimg, sub, key0, tqw, tq, h, 1 << 30, true, a, lane); } }
    }
    __syncthreads();
    const float lam_init = 0.8f - 0.6f * expf(-0.3f * (float)l);
    const float inv = 1.0f / swap_sum(a.l);
    f32x4 gvv[4][4];
    if (c == 0) {
#pragma unroll
        for (int db = 0; db < 4; ++db)
#pragma unroll
            for (int rg = 0; rg < 4; ++rg) gvv[db][rg] = DIFF_GAIN_IN_W ? (f32x4){1.f, 1.f, 1.f, 1.f} : *(const f32x4*)(p->diff_subln_g + (size_t)l * 128 + db * 32 + 8 * rg + 4 * h); }
    float* ex = (float*)lds;
    if (c == 1) {
#pragma unroll
        for (int db = 0; db < 4; ++db)
#pragma unroll
            for (int rg = 0; rg < 4; ++rg) *(f32x4*)(ex + (qsub * 32 + r32) * 132 + db * 32 + 8 * rg + 4 * h) = (f32x4){a.o[db][4 * rg] * inv, a.o[db][4 * rg + 1] * inv, a.o[db][4 * rg + 2] * inv, a.o[db][4 * rg + 3] * inv};
    }
    __syncthreads();
    if (c == 0) {
        float ss = 0.f;
#pragma unroll
        for (int db = 0; db < 4; ++db)
#pragma unroll
            for (int rg = 0; rg < 4; ++rg) { const f32x4 e4 = *(const f32x4*)(ex + (qsub * 32 + r32) * 132 + db * 32 + 8 * rg + 4 * h);
#pragma unroll
                for (int q = 0; q < 4; ++q) { const float v = a.o[db][4 * rg + q] * inv - lam * e4[q]; a.o[db][4 * rg + q] = v; ss += v * v; } }
        ss = swap_sum(ss);
        const float rn = (1.0f - lam_init) / sqrtf(ss * (1.0f / 128.0f) + 1e-5f);
        const float* sg = p->diff_subln_g + (size_t)l * 128;
        bf16_t* orow = (shadow ? (bf16_t*)(p->ws + OFF_MSCR) : (bf16_t*)(p->ws + OFF_OABC) + (size_t)1 * NTOK * 512) + ((size_t)b * NS + tq) * 512 + hd * 128;
#pragma unroll
        for (int db = 0; db < 4; ++db)
#pragma unroll
#if MERGE_FP8
            for (int rg = 0; rg < 4; rg += 2) { const f32x4 gv = gvv[db][rg], gw = gvv[db][rg + 1]; (void)orow;
                store8_pair(pk4_fp8c(a.o[db][4 * rg] * rn * gv[0], a.o[db][4 * rg + 1] * rn * gv[1], a.o[db][4 * rg + 2] * rn * gv[2], a.o[db][4 * rg + 3] * rn * gv[3]),
                            pk4_fp8c(a.o[db][4 * rg + 4] * rn * gw[0], a.o[db][4 * rg + 5] * rn * gw[1], a.o[db][4 * rg + 6] * rn * gw[2], a.o[db][4 * rg + 7] * rn * gw[3]),
                            (unsigned char*)(p->ws + OFF_OABC) + (size_t)1 * NTOK * 512 + ((size_t)b * NS + tq) * 512 + hd * 128 + db * 32 + 8 * rg, h); }
#else
            for (int rg = 0; rg < 4; ++rg) { const int d = db * 32 + 8 * rg + 4 * h; const f32x4 gv = gvv[db][rg];
                u32x2 w; w.x = cvt_pk_bf16(a.o[db][4 * rg] * rn * gv[0], a.o[db][4 * rg + 1] * rn * gv[1]); w.y = cvt_pk_bf16(a.o[db][4 * rg + 2] * rn * gv[2], a.o[db][4 * rg + 3] * rn * gv[3]);
                *(u32x2*)(orow + d) = w; }
#endif
    }
    __syncthreads();
}

#define AT_IMP   (AT_MISC)
#define AT_SELM  (AT_MISC + 34816)
__device__ __forceinline__ void attn_nsa_unit(KP p, int l, int b, int hkv, int qt, unsigned char* lds) {
    const int tid = hidden_tid(), lane = tid & 63, wv = __builtin_amdgcn_readfirstlane(tid >> 6), r32 = lane & 31, h = lane >> 5, g = wv & 3, qsub = wv >> 2;
    if (ATT_PRIO && wv >= 4) __builtin_amdgcn_s_setprio(1);
    const int head = hkv * 4 + g, t0 = qt * 64, tqw = t0 + 32 * qsub, tq = tqw + r32;
    const bf16_t* z = (const bf16_t*)(p->ws + OFF_Z);
    bf16x8 qf[5]; load_q(qf, z + ((size_t)b * NS + tq) * ZW + C_QC + head * 64 + 8 * h, exp2f(-(float)(head + 1)), lane);
    float* imp = (float*)(lds + AT_IMP); unsigned* selm = (unsigned*)(lds + AT_SELM);
    KVRing<1, 64> ring, ring2;
    f32x16 ocmp[2];
    {
        const bf16_t* kvc = (const bf16_t*)(p->ws + OFF_KVC);
        KVSrc cs; cs.k = (const char*)(kvc + ((size_t)(0 * 16 + b) * 2 + hkv) * 128 * 64); cs.v = (const char*)(kvc + ((size_t)(1 * 16 + b) * 2 + hkv) * 128 * 64); cs.kstride = 128; cs.vstride = 128;
        ring.init(cs, tid); ring.issue(0, 0, lds); ring.issue(64, 1, lds);
        if (tid == 0) selm[64] = 0u;
        ring.wait_bar(0);
        { KVSrc src; src.k = (const char*)(z + (size_t)b * NS * ZW + C_KSL + hkv * 64); src.v = (const char*)(z + (size_t)b * NS * ZW + C_VSL + hkv * 64); src.kstride = ZW * 2; src.vstride = ZW * 2;
          ring2.init(src, tid); ring2.issue(qt * 64, 2, lds); if (qt >= 1) ring2.issue((qt - 1) * 64, 3, lds); }
        f32x16 sc[4];
#pragma unroll
        for (int st = 0; st < 4; ++st) sc[st] = qk_sub(*(const bf16x8 (*)[4])&qf, ring.kimg(lds, st >> 1, 0), st & 1, lane);
        const int nvalid = tq >= 31 ? min(127, ((tq - 31) >> 4) + 1) : 0;
        float mx = -1e30f;
#pragma unroll
        for (int st = 0; st < 4; ++st)
#pragma unroll
            for (int r = 0; r < 16; ++r) { const int cidx = 32 * st + crow(r, h); const float v = cidx < nvalid ? sc[st][r] * LOG2E : -INFINITY; sc[st][r] = v; mx = fmaxf(mx, v); }
        mx = swap_max(mx);
        float ls = 0.f;
#pragma unroll
        for (int st = 0; st < 4; ++st)
#pragma unroll
            for (int r = 0; r < 16; ++r) { sc[st][r] = fast_exp2(sc[st][r] - mx); ls += sc[st][r]; }
        ls = swap_sum(ls); const float inv = ls > 0.f ? 1.0f / ls : 0.f;
        float Bv[4][4];
#pragma unroll
        for (int st = 0; st < 4; ++st)
#pragma unroll
            for (int r = 0; r < 16; ++r) sc[st][r] *= inv;
#pragma unroll
        for (int st = 0; st < 4; ++st)
#pragma unroll
            for (int g4 = 0; g4 < 4; ++g4) Bv[st][g4] = swap_other(sc[st][4 * g4 + 3], h);
#pragma unroll
        for (int st = 0; st < 4; ++st)
#pragma unroll
            for (int g4 = 0; g4 < 4; ++g4) {
                const float A = sc[st][4 * g4] + sc[st][4 * g4 + 1] + sc[st][4 * g4 + 2] + 0.5f * sc[st][4 * g4 + 3];
                const float prevlo = g4 > 0 ? Bv[st][g4 - 1] : (st > 0 ? Bv[st - 1][3] : 0.f);
                const float prev = h ? Bv[st][g4] : prevlo;
                imp[(g * 64 + qsub * 32 + r32) * 33 + 8 * st + 2 * g4 + h] = A + 0.5f * prev;
            }
#pragma unroll
        for (int d = 0; d < 2; ++d)
#pragma unroll
            for (int r = 0; r < 16; ++r) ocmp[d][r] = 0.f;
#pragma unroll
        for (int st = 0; st < 4; ++st) { VFrag<64> vf; v_read_all(vf, ring.vimg(lds, st >> 1), st & 1, lane); pv_sub<64>(sc[st], vf, ocmp); }
    }
    __syncthreads();
    const int cur = qt;
    for (int i = tid; i < 64 * 32; i += NTHREADS) { const int q = i >> 5, n = i & 31; imp[q * 33 + n] = (imp[q * 33 + n] + imp[(64 + q) * 33 + n]) + (imp[(128 + q) * 33 + n] + imp[(192 + q) * 33 + n]); }
    __syncthreads();
#pragma unroll 1
    for (int ps = 0; ps < 4; ++ps) {
        const int i = ps * NTHREADS + tid, q = i >> 5, n = i & 31;
        const bool forced = (n == 0) | (n == cur) | (n == cur - 1);
        const float kn = forced ? INFINITY : imp[q * 33 + n];
        float km[32];
#pragma unroll
        for (int m2 = 0; m2 < 32; ++m2) km[m2] = __int_as_float(__builtin_amdgcn_ds_bpermute(((lane & 32) + m2) << 2, __float_as_int(kn)));
        int rank = 0;
#pragma unroll
        for (int m2 = 0; m2 < 32; ++m2) { const int gt = km[m2] > kn ? 1 : 0, eq = km[m2] == kn ? 1 : 0, lo = m2 < n ? 1 : 0, ne = m2 != n ? 1 : 0, in = m2 <= cur ? 1 : 0;
            rank += in & ne & (gt | (eq & lo)); }
        const bool sel = (n <= cur) && (rank < 16);
        const unsigned long long bal = __ballot(sel);
        if ((lane & 31) == 0) { const unsigned mk = (unsigned)(lane ? (bal >> 32) : bal); selm[q] = mk; atomicOr(&selm[64], mk); }
    }
    __syncthreads();
    const unsigned mymask = selm[qsub * 32 + r32]; unsigned um = __builtin_amdgcn_readfirstlane(selm[64]);
    WaveAcc<64> a; acc_init(a);
    {
        KVSrc src; src.k = (const char*)(z + (size_t)b * NS * ZW + C_KSL + hkv * 64); src.v = (const char*)(z + (size_t)b * NS * ZW + C_VSL + hkv * 64); src.kstride = ZW * 2; src.vstride = ZW * 2;
        const int npre = qt >= 1 ? 2 : 1;
        unsigned m_issue = um & ~((1u << qt) | (qt >= 1 ? 1u << (qt - 1) : 0u)); int nis = npre, ncp = 0; const int ntl = __popc(um);
        for (int j = npre; j < RING_AHEAD && m_issue; ++j) { const int kt = 31 - __clz((int)m_issue); m_issue &= ~(1u << kt); ring2.issue(kt * 64, (nis + 2) & (RING_NB - 1), lds); ++nis; }
    asm volatile(".p2align 8");
        while (um) {
            const int kt = 31 - __clz((int)um); um &= ~(1u << kt); const int buf = (ncp + 2) & (RING_NB - 1);
            ring2.wait_bar(nis - 1 - ncp);
            if (m_issue) { const int ktn = 31 - __clz((int)m_issue); m_issue &= ~(1u << ktn); ring2.issue(ktn * 64, (nis + 2) & (RING_NB - 1), lds); ++nis; }
            const bool lbit = (mymask >> kt) & 1u;
            if (__any(lbit)) {
                const unsigned char* kimg = ring2.kimg(lds, buf, 0); const unsigned char* vimg = ring2.vimg(lds, buf);
#pragma unroll
                for (int sr = 0; sr < 2; ++sr) { const int sub = 1 - sr, key0 = kt * 64 + 32 * sub;
                    if (key0 <= tqw + 31) attn_sub_auto<64>(qf, kimg, vimg, sub, key0, tqw, tq, h, 1 << 30, lbit, a, lane); }
            }
            ++ncp;
        }
        (void)ntl;
    }
    {
        const size_t tok = (size_t)b * NS + tq;
        const bf16_t* gp = z + tok * ZW + C_GN + head * 3;
        const float gc = bf2f(gp[0]), gs = bf2f(gp[1]) / swap_sum(a.l), gw = bf2f(gp[2]);
        const bf16_t* ow = (const bf16_t*)(p->ws + OFF_OWIN) + tok * 512 + head * 64;
        bf16_t* oc = (bf16_t*)(p->ws + OFF_OABC) + (size_t)2 * NTOK * 512 + tok * 512 + head * 64;
        u32x2 wvv[2][4];
#pragma unroll
        for (int db = 0; db < 2; ++db)
#pragma unroll
            for (int rg = 0; rg < 4; ++rg) wvv[db][rg] = *(const u32x2*)(ow + db * 32 + 8 * rg + 4 * h);
        asm volatile("" ::: "memory");
#pragma unroll
        for (int db = 0; db < 2; ++db)
#pragma unroll
#if MERGE_FP8
            for (int rg = 0; rg < 4; rg += 2) { unsigned wq[2]; (void)oc;
#pragma unroll
                for (int q = 0; q < 2; ++q) { const int r4 = 4 * (rg + q); const u32x2 wv2 = wvv[db][rg + q];
                    wq[q] = pk4_fp8c(gc * ocmp[db][r4] + gs * a.o[db][r4] + gw * bflo(wv2.x), gc * ocmp[db][r4 + 1] + gs * a.o[db][r4 + 1] + gw * bfhi(wv2.x),
                                     gc * ocmp[db][r4 + 2] + gs * a.o[db][r4 + 2] + gw * bflo(wv2.y), gc * ocmp[db][r4 + 3] + gs * a.o[db][r4 + 3] + gw * bfhi(wv2.y)); }
                store8_pair(wq[0], wq[1], (unsigned char*)(p->ws + OFF_OABC) + (size_t)2 * NTOK * 512 + tok * 512 + head * 64 + db * 32 + 8 * rg, h); }
#else
            for (int rg = 0; rg < 4; ++rg) { const int d = db * 32 + 8 * rg + 4 * h; const u32x2 wv2 = wvv[db][rg];
                const float o0 = gc * ocmp[db][4 * rg] + gs * a.o[db][4 * rg] + gw * bflo(wv2.x), o1 = gc * ocmp[db][4 * rg + 1] + gs * a.o[db][4 * rg + 1] + gw * bfhi(wv2.x);
                const float o2 = gc * ocmp[db][4 * rg + 2] + gs * a.o[db][4 * rg + 2] + gw * bflo(wv2.y), o3 = gc * ocmp[db][4 * rg + 3] + gs * a.o[db][4 * rg + 3] + gw * bfhi(wv2.y);
                u32x2 w; w.x = cvt_pk_bf16(o0, o1); w.y = cvt_pk_bf16(o2, o3); *(u32x2*)(oc + d) = w; }
#endif
    }
    __syncthreads();
}

__device__ __forceinline__ void compress_unit(KP p, int l, int u, unsigned char* lds) {
    char* ws = p->ws;
    const int kv = u >> 4, rt = u & 15;
    GemmOperands g; g.Abase = ws + OFF_Z; g.kstride = ZW * 2; g.K = 2048; g.Bbase = ws + OFF_WC1 + ((size_t)(l * 2 + kv) * 256) * 2048 * 2;
GEMM_STAGE_IDS();
#pragma unroll
    for (int i = 0; i < 4; ++i) { const int row = rt * 256 + TILE_ROW(i), bh = row >> 7, b = bh >> 1, hk = bh & 1; int c = row & 127; c = c > 126 ? 126 : c;
        g.aoff[i] = (unsigned)((((size_t)b * NS + 16 * c) * ZW + (kv ? C_VCM : C_KCM) + hk * 64 + cS) * 2); } g.boff = (unsigned)((rS * 2048 + cS) * 2);
    f32x4 acc[2][2][4][2];
    gemm_unit(g, (bf16_t*)lds, acc);
    GEMM_LANE_IDS();
    const float* cb = (const float*)(ws + OFF_CBIAS) + (size_t)(l * 2 + kv) * 4 * 256; const float* cb1 = p->cmp_b1 + (l * 2 + kv) * 256;
    f32x4 bvv[2][2];
#pragma unroll
    for (int bj = 0; bj < 2; ++bj)
#pragma unroll
        for (int n = 0; n < 2; ++n) { const int col = bj * 128 + wc * 32 + n * 16 + fq * 4; bvv[bj][n] = (*(const f32x4*)(cb + col) + *(const f32x4*)(cb + 256 + col)) + (*(const f32x4*)(cb + 512 + col) + *(const f32x4*)(cb + 768 + col)) + *(const f32x4*)(cb1 + col); }
    asm volatile("" ::: "memory");
#pragma unroll
    for (int bj = 0; bj < 2; ++bj)
#pragma unroll
        for (int n = 0; n < 2; ++n) { const int col = bj * 128 + wc * 32 + n * 16 + fq * 4; const f32x4 bv = bvv[bj][n];
#pragma unroll
            for (int ai = 0; ai < 2; ++ai)
#pragma unroll
                for (int m = 0; m < 4; ++m) { const int row = ai * 128 + wr * 64 + m * 16 + fr; f32x4 v = acc[ai][bj][m][n] + bv;
#pragma unroll
                    for (int j = 0; j < 4; ++j) { const float x = v[j]; v[j] = x * sigmoidf_(1.5957691216057308f * (x + 0.044715f * x * x * x)); }
                    u32x2 w; w.x = cvt_pk_bf16(v[0], v[1]); w.y = cvt_pk_bf16(v[2], v[3]); *(u32x2*)(lds + row * 528 + col * 2) = w; } }
    __syncthreads();
    {
        const bf16_t* w2 = (const bf16_t*)(ws + OFF_WC2) + (size_t)(l * 2 + kv) * 64 * 256;
        f32x4 c2[2][4];
#pragma unroll
        for (int mt = 0; mt < 2; ++mt)
#pragma unroll
            for (int nt = 0; nt < 4; ++nt) c2[mt][nt] = (f32x4){0.f, 0.f, 0.f, 0.f};
#pragma unroll
        for (int ks = 0; ks < 8; ++ks) {
            bf16x8 af[2], bfr[4];
#pragma unroll
            for (int mt = 0; mt < 2; ++mt) af[mt] = *(const bf16x8*)(lds + (wid * 32 + mt * 16 + fr) * 528 + (ks * 32 + fq * 8) * 2);
#pragma unroll
            for (int nt = 0; nt < 4; ++nt) bfr[nt] = *(const bf16x8*)(w2 + (size_t)(nt * 16 + fr) * 256 + ks * 32 + fq * 8);
#pragma unroll
            for (int mt = 0; mt < 2; ++mt)
#pragma unroll
                for (int nt = 0; nt < 4; ++nt) c2[mt][nt] = __builtin_amdgcn_mfma_f32_16x16x32_bf16(af[mt], bfr[nt], c2[mt][nt], 0, 0, 0);
        }
        bf16_t* kvc = (bf16_t*)(ws + OFF_KVC) + (size_t)kv * 16 * 2 * 128 * 64;
        const float* b2 = p->cmp_b2 + (l * 2 + kv) * 64;
        float b2v[4];
#pragma unroll
        for (int nt = 0; nt < 4; ++nt) b2v[nt] = b2[nt * 16 + fr];
        asm volatile("" ::: "memory");
#pragma unroll
        for (int mt = 0; mt < 2; ++mt)
#pragma unroll
            for (int nt = 0; nt < 4; ++nt)
#pragma unroll
                for (int r = 0; r < 4; ++r) { const int row = rt * 256 + wid * 32 + mt * 16 + 4 * fq + r, col = nt * 16 + fr;
                    kvc[(size_t)row * 64 + col] = f2bf(c2[mt][nt][r] + b2v[nt]); }
    }
    __syncthreads();
}

#define RT_HS    0
#define RT_LG    132096
#define RT_HIST  (RT_LG + 8448)
#ifndef REPN2
#define REPN2 1
#endif
__device__ __forceinline__ void phase_norm2_router(KP p, int l, unsigned char* lds) {
  for (int shadow = 0; shadow < REPN2; ++shadow) {
    char* ws = p->ws; const int tid = hidden_tid(), lane = tid & 63, wv = __builtin_amdgcn_readfirstlane(tid >> 6);
    const float* modl = (const float*)(ws + OFF_MOD) + (size_t)l * 16 * 6144; const float* g = p->norm2_g + (size_t)l * 1024;
    const bf16_t* xrb = (const bf16_t*)(ws + OFF_XR);
    float* LG = (float*)(lds + RT_LG); int* hist = (int*)(lds + RT_HIST); int* basep = hist + 32;
    unsigned* ctrl = (unsigned*)ws;
    const bf16_t* wrt = (const bf16_t*)(ws + OFF_WRT) + (size_t)l * 2 * 32 * 1024;
    for (int chunk = hidden_bid(); chunk < NTOK / 64; chunk += gridDim.x) {
        if (tid < 32) hist[tid] = 0;
        {
            const int rowa = chunk * 64 + wv * 8, b = rowa >> 11;
            f32x4 gg[4], sc[4], sh[4]; u32x2 xa[8][4];
#pragma unroll
            for (int i = 0; i < 8; ++i)
#pragma unroll
                for (int j = 0; j < 4; ++j) xa[i][j] = *(const u32x2*)(xrb + (size_t)(rowa + i) * 1024 + 256 * j + 4 * lane);
#pragma unroll
            for (int j = 0; j < 4; ++j) { const int col = 256 * j + 4 * lane; gg[j] = *(const f32x4*)(g + col); sc[j] = *(const f32x4*)(modl + (size_t)b * 6144 + 4096 + col); sh[j] = *(const f32x4*)(modl + (size_t)b * 6144 + 3072 + col); }
#pragma unroll
            for (int i = 0; i < 8; ++i) {
                const int rl = wv * 8 + i, row = rowa + i;
                f32x4 v[4]; float ss = 0.f;
#pragma unroll
                for (int j = 0; j < 4; ++j) { const u32x2 xn = xa[i][j]; v[j] = (f32x4){bflo(xn.x), bfhi(xn.x), bflo(xn.y), bfhi(xn.y)};
                    ss += v[j][0] * v[j][0] + v[j][1] * v[j][1] + v[j][2] * v[j][2] + v[j][3] * v[j][3]; }
                ss = wave_sum(ss, lane); const float r = 1.0f / sqrtf(ss * (1.0f / 1024.0f) + 1e-5f);
#pragma unroll
                for (int j = 0; j < 4; ++j) { const int col = 256 * j + 4 * lane;
                    float o[4];
#pragma unroll
                    for (int q = 0; q < 4; ++q) o[q] = v[j][q] * r * gg[j][q] * (1.0f + sc[j][q]) + sh[j][q];
                    u32x2 w; w.x = cvt_pk_bf16(o[0], o[1]); w.y = cvt_pk_bf16(o[2], o[3]);
                    if (!shadow) *(unsigned*)((unsigned char*)(ws + OFF_H8) + (size_t)row * 1024 + col) = pk4_fp8(o[0], o[1], o[2], o[3]);
                    *(u32x2*)(lds + RT_HS + rl * 2064 + col * 2) = w; }
            }
        }
        __syncthreads();
        {
            const int mt = wv & 3, nt = wv >> 2, fr = lane & 15, fq = lane >> 4;
            f32x4 acc = (f32x4){0.f, 0.f, 0.f, 0.f};
            const bf16_t* wh = wrt + ((size_t)nt * 32 * 64 + lane) * 8; const bf16_t* wl = wh + 32768;
            const unsigned char* ap = lds + RT_HS + (mt * 16 + fr) * 2064 + fq * 16;
#pragma unroll 1
            for (int ks0 = 0; ks0 < 32; ks0 += 8) {
                bf16x8 bh[8], bl[8], af[8];
#pragma unroll
                for (int i = 0; i < 8; ++i) { bh[i] = *(const bf16x8*)(wh + (ks0 + i) * 512); bl[i] = *(const bf16x8*)(wl + (ks0 + i) * 512); }
#pragma unroll
                for (int i = 0; i < 8; ++i) af[i] = *(const bf16x8*)(ap + (ks0 + i) * 64);
                __builtin_amdgcn_sched_barrier(0);
#pragma unroll
                for (int i = 0; i < 8; ++i) { acc = __builtin_amdgcn_mfma_f32_16x16x32_bf16(af[i], bh[i], acc, 0, 0, 0); acc = __builtin_amdgcn_mfma_f32_16x16x32_bf16(af[i], bl[i], acc, 0, 0, 0); }
            }
            const float rb = p->router_b[l * 32 + nt * 16 + fr];
#pragma unroll
            for (int r = 0; r < 4; ++r) LG[(mt * 16 + 4 * fq + r) * 33 + nt * 16 + fr] = acc[r] + rb;
        }
        __syncthreads();
        int se[4], sp[4]; float sg[4];
        if (tid < 64) {
            unsigned taken = 0u; float tv[4]; float lg[32];
#pragma unroll
            for (int e = 0; e < 32; ++e) lg[e] = LG[tid * 33 + e];
#pragma unroll
            for (int k = 0; k < 4; ++k) { float best = -INFINITY; int bi = 0;
#pragma unroll
                for (int e = 0; e < 32; ++e) { const bool c = !((taken >> e) & 1u) & (lg[e] > best); best = c ? lg[e] : best; bi = c ? e : bi; }
                taken |= 1u << bi; se[k] = bi; tv[k] = best; }
            float den = 0.f;
#pragma unroll
            for (int k = 0; k < 4; ++k) { sg[k] = __expf(tv[k] - tv[0]); den += sg[k]; }
#pragma unroll
            for (int k = 0; k < 4; ++k) { sg[k] /= den; sp[k] = atomicAdd(&hist[se[k]], 1); }
        }
        __syncthreads();
        if (tid < 32) { const int c = hist[tid]; basep[tid] = (c && !shadow) ? (int)atomicAdd(&ctrl[CW_ECNT(l, tid)], (unsigned)c) : 0; }
        __syncthreads();
        if (tid < 64 && !shadow) { const int tok = chunk * 64 + tid;
#pragma unroll
            for (int k = 0; k < 4; ++k) { const int pos = basep[se[k]] + sp[k];
                ((int*)(ws + OFF_TOKE))[tok * 4 + k] = se[k]; ((int*)(ws + OFF_TOKP))[tok * 4 + k] = pos; ((float*)(ws + OFF_TOKG))[tok * 4 + k] = sg[k];
                ((int*)(ws + OFF_BUCK))[(size_t)se[k] * NTOK + pos] = tok; } }
        __syncthreads();
    }
}
  __syncthreads(); }


__device__ __forceinline__ void phase_combine(KP p, int l, unsigned char* lds) {
    char* ws = p->ws; const int tid = hidden_tid(), lane = tid & 63, wv = tid >> 6;
    int* tbl = (int*)lds; moe_tables(p, l, tbl);
    bf16_t* xr = (bf16_t*)(ws + OFF_XR); const unsigned char* y = (const unsigned char*)(ws + OFF_Y); bf16_t* hb = (bf16_t*)(ws + OFF_HB);
    const bool last = (l + 1 == NLAYER);
    for (int gw = hidden_bid() * 8 + wv; gw < NTOK / 16; gw += gridDim.x * 8) {
        const int row0 = gw * 16, b = row0 >> 11;
        const float* modl = (const float*)(ws + OFF_MOD) + ((size_t)l * 16 + b) * 6144;
        const float* gn = last ? p->final_g : p->norm1_g + (size_t)(l + 1) * 1024;
        const float* modn = (const float*)(ws + OFF_MOD) + ((size_t)(last ? l : l + 1) * 16 + b) * 6144;
        f32x4 g2[4], gg[4], sc[4], sh[4];
#pragma unroll
        for (int j = 0; j < 4; ++j) { const int col = 256 * j + 4 * lane; g2[j] = *(const f32x4*)(modl + 5120 + col); gg[j] = *(const f32x4*)(gn + col);
            sc[j] = last ? (f32x4){0.f, 0.f, 0.f, 0.f} : *(const f32x4*)(modn + 1024 + col); sh[j] = last ? (f32x4){0.f, 0.f, 0.f, 0.f} : *(const f32x4*)(modn + col); }
        typedef int i32x4_ __attribute__((ext_vector_type(4)));
        i32x4_ te = *(const i32x4_*)((const int*)(ws + OFF_TOKE) + (size_t)row0 * 4), tp = *(const i32x4_*)((const int*)(ws + OFF_TOKP) + (size_t)row0 * 4);
        f32x4 tg = *(const f32x4*)((const float*)(ws + OFF_TOKG) + (size_t)row0 * 4);
        u32x2 xin[4]; unsigned yin[4][4]; float gk[4];
        auto load_row = [&](int row, const i32x4_& e4, const i32x4_& p4, const f32x4& g4) {
#pragma unroll
            for (int k = 0; k < 4; ++k) { const unsigned char* yr = y + ((size_t)tbl[e4[k]] * 256 + p4[k]) * 1024; gk[k] = g4[k] * (1.0f / Y8S);
#pragma unroll
                for (int j = 0; j < 4; ++j) yin[k][j] = *(const unsigned*)(yr + 256 * j + 4 * lane); }
#pragma unroll
            for (int j = 0; j < 4; ++j) xin[j] = *(const u32x2*)(xr + (size_t)row * 1024 + 256 * j + 4 * lane);
        };
        load_row(row0, te, tp, tg);
        if (16 > 1) { te = *(const i32x4_*)((const int*)(ws + OFF_TOKE) + (size_t)(row0 + 1) * 4); tp = *(const i32x4_*)((const int*)(ws + OFF_TOKP) + (size_t)(row0 + 1) * 4); tg = *(const f32x4*)((const float*)(ws + OFF_TOKG) + (size_t)(row0 + 1) * 4); }
        for (int i = 0; i < 16; ++i) {
            const int row = row0 + i;
            f32x4 v[4]; float ss = 0.f;
#pragma unroll
            for (int j = 0; j < 4; ++j) { f32x4 m = (f32x4){0.f, 0.f, 0.f, 0.f};
#pragma unroll
                for (int k = 0; k < 4; ++k) { const int w = (int)yin[k][j]; m[0] += gk[k] * __builtin_amdgcn_cvt_f32_fp8(w, 0); m[1] += gk[k] * __builtin_amdgcn_cvt_f32_fp8(w, 1); m[2] += gk[k] * __builtin_amdgcn_cvt_f32_fp8(w, 2); m[3] += gk[k] * __builtin_amdgcn_cvt_f32_fp8(w, 3); }
                v[j] = (f32x4){bflo(xin[j].x), bfhi(xin[j].x), bflo(xin[j].y), bfhi(xin[j].y)} + g2[j] * m;
                ss += v[j][0] * v[j][0] + v[j][1] * v[j][1] + v[j][2] * v[j][2] + v[j][3] * v[j][3]; }
            if (i + 1 < 16) { load_row(row + 1, te, tp, tg);
                if (i + 2 < 16) { te = *(const i32x4_*)((const int*)(ws + OFF_TOKE) + (size_t)(row + 2) * 4); tp = *(const i32x4_*)((const int*)(ws + OFF_TOKP) + (size_t)(row + 2) * 4); tg = *(const f32x4*)((const float*)(ws + OFF_TOKG) + (size_t)(row + 2) * 4); } }
            ss = wave_sum(ss, lane); const float r = 1.0f / sqrtf(ss * (1.0f / 1024.0f) + 1e-5f);
#pragma unroll
            for (int j = 0; j < 4; ++j) { const int col = 256 * j + 4 * lane;
                if (last) { *(f32x4*)(p->out + (size_t)row * 1024 + col) = v[j] * r * gg[j]; }
                else { u32x2 xw; xw.x = cvt_pk_bf16(v[j][0], v[j][1]); xw.y = cvt_pk_bf16(v[j][2], v[j][3]); *(u32x2*)(xr + (size_t)row * 1024 + col) = xw; float o[4];
#pragma unroll
                    for (int q = 0; q < 4; ++q) o[q] = v[j][q] * r * gg[j][q] * (1.0f + sc[j][q]) + sh[j][q];
#if INPROJ_FP8
                    *(unsigned*)((unsigned char*)hb + (size_t)row * 1024 + col) = pk4_fp8(o[0], o[1], o[2], o[3]); }
#else
                    u32x2 w; w.x = cvt_pk_bf16(o[0], o[1]); w.y = cvt_pk_bf16(o[2], o[3]); *(u32x2*)(hb + (size_t)row * 1024 + col) = w; }
#endif
            }
        }
    }
}

#ifndef SWA_IN_AT2
#define SWA_IN_AT2 1
#endif
#define LDS_QSLOT (LDS_BYTES - 64)
#define LDS_BARW  (LDS_BYTES - 16)
__device__ __forceinline__ int q_next(unsigned* ctr, unsigned char* lds) {
    if (ATT_PRIO) __builtin_amdgcn_s_setprio(0);
    __syncthreads();
    if (hidden_tid() == 0) *(int*)(lds + LDS_QSLOT) = (int)__hip_atomic_fetch_add(ctr, 1u, __ATOMIC_RELAXED, __HIP_MEMORY_SCOPE_AGENT);
    __syncthreads();
    return __builtin_amdgcn_readfirstlane(*(int*)(lds + LDS_QSLOT));
}
__device__ __forceinline__ int q_next2(unsigned* ctr, unsigned* xg, unsigned char* lds, int& g) {
    if (ATT_PRIO) __builtin_amdgcn_s_setprio(0);
    __syncthreads();
    if (hidden_tid() == 0) { const unsigned a = __hip_atomic_fetch_add(ctr, 1u, __ATOMIC_RELAXED, __HIP_MEMORY_SCOPE_AGENT), b = __hip_atomic_fetch_add(xg, 1u, __ATOMIC_RELAXED, __HIP_MEMORY_SCOPE_AGENT);
        *(int*)(lds + LDS_QSLOT) = (int)a; *(int*)(lds + LDS_QSLOT + 4) = (int)(b < 3072u ? b : 3072u); }
    __syncthreads();
    g = __builtin_amdgcn_readfirstlane(*(int*)(lds + LDS_QSLOT + 4));
    return __builtin_amdgcn_readfirstlane(*(int*)(lds + LDS_QSLOT));
}
struct Tk { unsigned a, b; };
__device__ __forceinline__ Tk q_issue(unsigned* ctr, unsigned* xg) {
    Tk t; t.a = 0u; t.b = 3072u;
    if (hidden_tid() == 0) { t.a = __hip_atomic_fetch_add(ctr, 1u, __ATOMIC_RELAXED, __HIP_MEMORY_SCOPE_AGENT); if (xg) t.b = __hip_atomic_fetch_add(xg, 1u, __ATOMIC_RELAXED, __HIP_MEMORY_SCOPE_AGENT); }
    return t;
}
__device__ __forceinline__ int q_take(const Tk& t, unsigned char* lds, int& g) {
    if (ATT_PRIO) __builtin_amdgcn_s_setprio(0);
    __syncthreads();
    if (hidden_tid() == 0) { *(int*)(lds + LDS_QSLOT) = (int)t.a; *(int*)(lds + LDS_QSLOT + 4) = (int)(t.b < 3072u ? t.b : 3072u); }
    __syncthreads();
    g = __builtin_amdgcn_readfirstlane(*(int*)(lds + LDS_QSLOT + 4));
    return __builtin_amdgcn_readfirstlane(*(int*)(lds + LDS_QSLOT));
}
#define QLOOP(QI, NU, UNIT) { unsigned* ctr_ = ctrl + CW_QCTR(lq, QI); unsigned* xg_ = COSCHED ? ctrl + CW_XG(l) : nullptr; Tk tk = q_issue(ctr_, xg_); int g; int u = q_take(tk, lds, g); \
        while (u < (NU)) { tk = q_issue(ctr_, xg_); UNIT; if (g < 3072) xpose8_group(p, l, g, lds); u = q_take(tk, lds, g); } \
        if (g < 3072) xpose8_group(p, l, g, lds); }
__device__ __forceinline__ void phase_at1(KP p, int lq, unsigned char* lds) {
    unsigned* ctrl = (unsigned*)p->ws; const int l = lq & 1;
#ifndef SUB
#define SUB -1
#endif
#ifndef DBLSUB
#define DBLSUB -1
#endif
#ifndef REP0
#define REP0 1
#endif
#ifndef REP1
#define REP1 1
#endif
#ifndef REP2
#define REP2 1
#endif
#ifndef REP3
#define REP3 1
#endif
#ifndef REP4
#define REP4 1
#endif
#define SUBON(k) ((SUB < 0 || SUB == (k)) && (lq < 2 || DBLSUB < 0 || DBLSUB == (k)))
    if (SUBON(0)) for (int rep = 0; rep < REP0; ++rep) for (;;) { const int u = q_next(ctrl + CW_QCTR(lq + 2 * rep, 0), lds); if (u >= 32) break; compress_unit(p, l, u, lds); }
    if (SUBON(1)) for (int rep = 0; rep < REP1; ++rep) for (;;) { int g; const int u = q_next2(ctrl + CW_QCTR(lq + 2 * rep, 1), ctrl + CW_XG(l), lds, g); if (u >= 1024) { if (COSCHED && rep == 0 && g < 3072) xpose8_group(p, l, g, lds); break; }     attn_diff_unit(p, l, (u & 63) >> 2, u & 3, 15 - (u >> 6), lds, rep); if (COSCHED && rep == 0 && g < 3072) xpose8_group(p, l, g, lds); }
    if (SUBON(2)) QLOOP(2, 1024, attn_window_unit<false>(p, l, (u & 31) >> 1, u & 1, 31 - (u >> 5), 512, C_QC, C_KWN, C_VWN, (bf16_t*)(p->ws + OFF_OWIN), lds));
#if !SWA_IN_AT2
    if (SUBON(3)) for (int rep = 0; rep < REP3; ++rep) for (;;) { int g; const int u = q_next2(ctrl + CW_QCTR(lq + 2 * rep, 3), ctrl + CW_XG(l), lds, g); if (u >= 1024) { if (COSCHED && rep == 0 && g < 3072) xpose8_group(p, l, g, lds); break; }
        attn_window_unit<true>(p, l, (u & 31) >> 1, u & 1, 31 - (u >> 5), 128, C_QA, C_KA, C_VA, (bf16_t*)(p->ws + OFF_OABC), lds); if (COSCHED && rep == 0 && g < 3072) xpose8_group(p, l, g, lds); }
#endif
}
__device__ __forceinline__ void phase_at2(KP p, int lq, unsigned char* lds) {
    unsigned* ctrl = (unsigned*)p->ws; const int l = lq & 1;
    for (int rep = 0; rep < REP4; ++rep) for (;;) { const int u = q_next(ctrl + CW_QCTR(lq + 2 * rep, 4), lds); if (u >= 1024) break; attn_nsa_unit(p, l, (u & 31) >> 1, u & 1, 31 - (u >> 5), lds); if (COSCHED && INPROJ_FP8 && rep == 0 && lq == 0 && u < MISC_GROUPS) misc_group(p, u, lds); }
#if SWA_IN_AT2
    QLOOP(3, 1024, attn_window_unit<true>(p, l, (u & 31) >> 1, u & 1, 31 - (u >> 5), 128, C_QA, C_KA, C_VA, (bf16_t*)(p->ws + OFF_OABC), lds));
#endif
}

#ifndef BAR_RIDERS
#define BAR_RIDERS 1
#endif
__device__ __forceinline__ void xcd_barrier_work(const XcdBarrier& b, int ph, KP p, unsigned char* lds) {
    asm volatile("s_waitcnt vmcnt(0)" ::: "memory");
    __syncthreads();
    volatile LAS unsigned* st = b.st;
    const int wl = (!COSCHED || !BAR_RIDERS) ? -1 : (ph <= 6 ? 0 : (ph <= 15 ? 1 : -1));
    bool lastx = true; unsigned gen = 0u;
    if (hidden_tid() == 0) {
        unsigned* bar = b.bar;
        __builtin_amdgcn_s_waitcnt(0);
        unsigned nloc = st[0], nx = st[1];
        if (nloc == 0u) { xcd_barrier_complete(bar, b.x, nloc, nx); st[0] = nloc; st[1] = nx; }
        const unsigned old = xb_add(&bar[XB_XSUB(b.x)], 1u);
        gen = old / nloc;
        lastx = old + 1u == (gen + 1u) * nloc;
        int gl = -1; unsigned g = 0u;
        if (!lastx && wl >= 0 && (old - gen * nloc) < (nloc >> 1)) {
            gl = wl; g = xb_add(&bar[CW_XG(gl)], 1u);
            if (g >= 3072u && gl == 0) { gl = 1; g = xb_add(&bar[CW_XG(1)], 1u); }
            if (g >= 3072u) gl = -1; }
        st[2] = (unsigned)(gl + 1); st[3] = g;
        if (lastx) {
            __builtin_amdgcn_fence(__ATOMIC_RELEASE, "agent");
            asm volatile("s_waitcnt vmcnt(0)" ::: "memory");
            const unsigned og = xb_add(&bar[XB_TOP], 1u);
            const unsigned tg = og / nx;
            if (og + 1u == (tg + 1u) * nx) xb_add(&bar[XB_TOPGEN], 1u);
            else XB_SPIN(xb_ld(&bar[XB_TOPGEN]) == tg, bar);
            __builtin_amdgcn_fence(__ATOMIC_ACQUIRE, "agent");
            xb_add(&bar[XB_XGEN(b.x)], 1u);
            asm volatile("s_waitcnt vmcnt(0)" ::: "memory");
        }
    }
    __syncthreads();
    const int gl = __builtin_amdgcn_readfirstlane((int)st[2]) - 1;
    if (gl >= 0) { const int g = __builtin_amdgcn_readfirstlane((int)st[3]); xpose8_group(p, gl, g, lds); asm volatile("s_waitcnt vmcnt(0)" ::: "memory"); }
    if (hidden_tid() == 0 && !lastx) {
        unsigned* bar = b.bar;
        XB_SPIN(xb_ld(&bar[XB_XGEN(b.x)]) == gen, bar);
        __builtin_amdgcn_fence(__ATOMIC_ACQUIRE, "agent");
        asm volatile("s_waitcnt vmcnt(0)" ::: "memory");
    }
    __syncthreads();
}

#define NPHASE 20
__global__ void __launch_bounds__(NTHREADS, 2) mega(Params pv_unused) {
    KP p0 = (KP)__builtin_amdgcn_kernarg_segment_ptr();
    extern __shared__ __attribute__((aligned(16))) unsigned char lds0[];
    volatile LAS unsigned* st = (volatile LAS unsigned*)(lds0 + LDS_BARW);
    if (hidden_tid() == 0) { st[0] = 0u; st[1] = 0u; st[2] = 0u; st[3] = 0u; }
    __syncthreads();
    XcdBarrier bar = xcd_barrier_post((unsigned*)p0->ws, st);
    int ph = 0;
#ifndef DBL
#define DBL -1
#endif
    int qrep = 0; (void)qrep;
#define PHASE(body) { KP p = p0; asm volatile("" : "+s"(p)); unsigned char* lds = lds0; (void)lds; if (ph >= p->ph_lo && ph <= p->ph_hi) { body; if (ph < p->ph_hi) xcd_barrier_work(bar, ph, p, lds); } ++ph; }
#ifndef ONLY
#define ONLY -1
#endif
#ifndef DBLL
#define DBLL -1
#endif
    int lcur = -1; (void)lcur;
#define SEL(n, body) { if (ONLY < 0 || ONLY == (n)) { body; if (DBL == (n) && (DBLL < 0 || DBLL == lcur)) { xcd_barrier(bar); qrep = 2; body; qrep = 0; } } }
    PHASE(SEL(0, phase_prologue(p, lds)));
    PHASE(SEL(1, phase_norm_mod(p->x, p->norm1_g, (const float*)(p->ws + OFF_MOD), 0, 1024, (bf16_t*)(p->ws + OFF_HB))));
#pragma unroll
    for (int l = 0; l < NLAYER; ++l) { lcur = l;
        PHASE(SEL(2, phase_inproj(p, l, lds)));
        PHASE(SEL(3, phase_at1(p, l + qrep, lds)));
        PHASE(SEL(4, phase_at2(p, l + qrep, lds)));
        PHASE(SEL(5, phase_merge(p, l, lds)));
        PHASE(SEL(6, phase_outproj(p, l, lds)));
        PHASE(SEL(7, phase_norm2_router(p, l, lds)));
        PHASE(SEL(8, phase_moe1(p, l, lds)));
        PHASE(SEL(9, phase_moe2(p, l, lds)));
        PHASE(SEL(10, phase_combine(p, l, lds)));
    }
}

#ifndef MK_LAUNCHES
#define MK_LAUNCHES 1
#endif
extern "C" void kernel_launch(void* const* d_in, const int* in_sizes, int n_in, void* d_out, int out_size, void* d_ws, size_t ws_size, hipStream_t stream) {
    if (ws_size < WS_NEED) { fprintf(stderr, "workspace too small: %zu < %zu\n", ws_size, (size_t)WS_NEED); return; }
    static bool attr_done = false;
    if (!attr_done) { hipFuncSetAttribute((const void*)mega, hipFuncAttributeMaxDynamicSharedMemorySize, LDS_BYTES); attr_done = true; }
    Params p{};
    const float** f = (const float**)&p;
    for (int i = 0; i < 25; ++i) f[i] = (const float*)d_in[i];
    p.out = (float*)d_out; p.ws = (char*)d_ws;
    hipMemsetAsync(d_ws, 0, SZ_CTRL, stream);
    int dev = 0, cus = 0; hipGetDevice(&dev); hipDeviceGetAttribute(&cus, hipDeviceAttributeMultiprocessorCount, dev);
    const int grid = cus > 0 ? cus : 256;
#if MK_LAUNCHES == 1
    p.ph_lo = 0; p.ph_hi = NPHASE - 1;
    hipLaunchKernelGGL(mega, dim3(grid), dim3(NTHREADS), LDS_BYTES, stream, p);
#else
    for (int k = 0; k < NPHASE; ++k) { p.ph_lo = k; p.ph_hi = k; hipLaunchKernelGGL(mega, dim3(grid), dim3(NTHREADS), LDS_BYTES, stream, p); }
#endif
}
```
